# Optimizing an MI355X kernel written in HIP

```python
import math
import jax
import jax.numpy as jnp
from jax import lax
import numpy as np


D_MODEL = 2048
BATCH = 2
SEQ = 8192
DEPTH = 4

GRID_W = 64
CTX_LEN = 256
RMS_EPS = 1e-6
N_MOD = 6
HEAD_DIM = 128
A_WIDTH = D_MODEL // 2
A_Q_HEADS = A_WIDTH // HEAD_DIM
A_KV_HEADS = max(1, A_Q_HEADS // 4)
A_GROUP = A_Q_HEADS // A_KV_HEADS
WINDOW = 128
BLOCK = 128
ROPE_BASE = 10000.0
NEG_INF = -1e30
B_WIDTH = D_MODEL - A_WIDTH
HY_EMB = 33
HY_BANDS = (HY_EMB - 1) // 2
HY_HIDDEN = 64
HY_FAST_DECAY = 0.3
HY_SLOW_DECAY = 1.5
HY_TARGET = 1e-2
S5_GROUP = 16
S5_GROUPS = D_MODEL // S5_GROUP
S5_STATE = 64
S5_DT_MIN = 1e-3
S5_DT_MAX = 1e-1
D_FF = ((8 * D_MODEL // 3 + 127) // 128) * 128
N_EVEN = (DEPTH + 1) // 2
N_ODD = DEPTH // 2
Q_COLS = A_Q_HEADS * HEAD_DIM
KV_COLS = A_KV_HEADS * HEAD_DIM
HY_COLS = 3 * B_WIDTH
IN_COLS = Q_COLS + 2 * KV_COLS + HY_COLS

kernel_name = 'hybrid_swa_hyena_s5_prefix_dit'


def rmsnorm(x, g):
    xf = x.astype(jnp.float32)
    y = xf * lax.rsqrt(jnp.mean(xf * xf, axis=-1, keepdims=True) + RMS_EPS)
    return (y * g.astype(jnp.float32)).astype(x.dtype)


def modulate(x, g, shift, scale):
    return rmsnorm(x, g) * (1.0 + scale) + shift


def dwconv3(u, w, b):
    up = jnp.pad(u, ((0, 0), (1, 1), (0, 0)))
    return up[:, :-2] * w[0] + up[:, 1:-1] * w[1] + up[:, 2:] * w[2] + b


def axial_rope_tables(n):
    rows = n // GRID_W
    row = jnp.broadcast_to(jnp.arange(rows, dtype=jnp.float32)[:, None], (rows, GRID_W)).reshape(-1)
    col = jnp.broadcast_to(jnp.arange(GRID_W, dtype=jnp.float32)[None, :], (rows, GRID_W)).reshape(-1)
    half = HEAD_DIM // 2
    inv_freq = ROPE_BASE ** (-jnp.arange(0, half, 2, dtype=jnp.float32) / half)
    ang = jnp.concatenate([row[:, None] * inv_freq, col[:, None] * inv_freq], axis=-1)
    return jnp.cos(ang), jnp.sin(ang)


def apply_axial_rope(x, cos, sin):
    qd = HEAD_DIM // 4
    c = cos[None, :, None, :]
    s = sin[None, :, None, :]
    cr, cc = c[..., :qd], c[..., qd:]
    sr, sc = s[..., :qd], s[..., qd:]
    x1, x2, x3, x4 = jnp.split(x.astype(jnp.float32), 4, axis=-1)
    out = jnp.concatenate([x1 * cr - x2 * sr, x2 * cr + x1 * sr, x3 * cc - x4 * sc, x4 * cc + x3 * sc], axis=-1)
    return out.astype(x.dtype)


def window_attention(q, k, v, kc, vc, sink):
    bsz, n = q.shape[0], q.shape[1]
    nc = kc.shape[1]
    nb = n // BLOCK
    scale = HEAD_DIM ** -0.5
    qb = q.reshape(bsz, nb, BLOCK, A_KV_HEADS, A_GROUP, HEAD_DIM)
    pad = ((0, 0), (BLOCK, BLOCK), (0, 0), (0, 0))
    kp, vp = jnp.pad(k, pad), jnp.pad(v, pad)

    def band(t):
        return jnp.concatenate([t[:, i * BLOCK:i * BLOCK + n].reshape(bsz, nb, BLOCK, A_KV_HEADS, HEAD_DIM) for i in range(3)], axis=2)

    kb, vb = band(kp), band(vp)
    qi = jnp.arange(BLOCK)[:, None]
    kj = jnp.arange(3 * BLOCK)[None, :]
    kpos = (jnp.arange(nb) * BLOCK - BLOCK)[:, None, None] + kj[None]
    valid = (jnp.abs(kj - BLOCK - qi) <= WINDOW)[None] & (kpos >= 0) & (kpos < n)
    s_band = jnp.einsum('bnqhgd,bnkhd->bnhgqk', qb, kb).astype(jnp.float32) * scale
    s_band = jnp.where(valid[None, :, None, None], s_band, NEG_INF)
    s_ctx = jnp.einsum('bnqhgd,bchd->bnhgqc', qb, kc).astype(jnp.float32) * scale
    s_sink = jnp.broadcast_to(sink.astype(jnp.float32).reshape(A_KV_HEADS, A_GROUP)[None, None, :, :, None, None], s_band.shape[:-1] + (1,))
    p = jax.nn.softmax(jnp.concatenate([s_band, s_ctx, s_sink], axis=-1), axis=-1).astype(v.dtype)
    nk = 3 * BLOCK
    o = jnp.einsum('bnhgqk,bnkhd->bnqhgd', p[..., :nk], vb) + jnp.einsum('bnhgqc,bchd->bnqhgd', p[..., nk:nk + nc], vc)
    return o.reshape(bsz, n, Q_COLS)


def context_attention(qc, kc, vc, sink):
    bsz, nc = qc.shape[0], qc.shape[1]
    scale = HEAD_DIM ** -0.5
    qg = qc.reshape(bsz, nc, A_KV_HEADS, A_GROUP, HEAD_DIM)
    s = jnp.einsum('bqhgd,bkhd->bhgqk', qg, kc).astype(jnp.float32) * scale
    s_sink = jnp.broadcast_to(sink.astype(jnp.float32).reshape(A_KV_HEADS, A_GROUP)[None, :, :, None, None], s.shape[:-1] + (1,))
    p = jax.nn.softmax(jnp.concatenate([s, s_sink], axis=-1), axis=-1).astype(vc.dtype)
    o = jnp.einsum('bhgqk,bkhd->bqhgd', p[..., :nc], vc)
    return o.reshape(bsz, nc, Q_COLS)


def hyena_filter(n, w1, b1, w2, b2, w3, freq):
    f32 = jnp.float32
    t = jnp.linspace(0.0, 1.0, n, dtype=f32)[:, None]
    w = (2.0 * math.pi / n) * jnp.arange(n, dtype=f32)
    bands = jnp.linspace(1e-4, HY_BANDS - 1, HY_BANDS, dtype=f32)
    ang = w[:, None] * bands[None, :]
    z = jnp.concatenate([t, jnp.cos(ang), -jnp.sin(ang)], axis=-1)
    fr = freq.astype(f32)
    hid = jnp.sin(fr * (z @ w1.astype(f32) + b1.astype(f32)))
    hid = jnp.sin(fr * (hid @ w2.astype(f32) + b2.astype(f32)))
    filt = (hid @ w3.astype(f32)).reshape(n, 2, B_WIDTH)
    max_decay = math.log(HY_TARGET) / HY_FAST_DECAY
    min_decay = math.log(HY_TARGET) / HY_SLOW_DECAY
    deltas = jnp.linspace(min_decay, max_decay, B_WIDTH, dtype=f32)
    decay = jnp.exp(-t * jnp.abs(deltas)[None, :])
    filt = filt * decay[:, None, :]
    circ = jnp.concatenate([filt[:, 0], jnp.zeros((1, B_WIDTH), f32), filt[:0:-1, 1]], axis=0)
    return circ / jnp.sum(jnp.abs(circ), axis=0, keepdims=True)


def long_conv(u, circ):
    n = u.shape[1]
    cf = jnp.fft.rfft(circ, n=2 * n, axis=0)
    uf = jnp.fft.rfft(u.astype(jnp.float32), n=2 * n, axis=1)
    return jnp.fft.irfft(uf * cf[None], n=2 * n, axis=1)[:, :n].astype(u.dtype)


def hyena(z, conv_w, conv_b, circ, bias):
    p = dwconv3(z, conv_w, conv_b)
    x0, x1, v = jnp.split(p, 3, axis=-1)
    v = v * x1
    v = long_conv(v, circ) + v * bias
    return v * x0


def conv_ffn(h, w_up, conv_w, conv_b, w_down):
    u = dwconv3(h @ w_up, conv_w, conv_b)
    gate, val = jnp.split(u, 2, axis=-1)
    return (jax.nn.silu(gate) * val) @ w_down


def attn_hyena_mixer(h, hc, w_in, w_out, sink, hy_conv_w, hy_conv_b, f_w1, f_b1, f_w2, f_b2, f_w3, f_freq, hy_bias, ctx_out):
    bsz, n = h.shape[0], h.shape[1]
    nc = hc.shape[1]
    cuts = [Q_COLS, Q_COLS + KV_COLS, Q_COLS + 2 * KV_COLS]
    q, k, v, zb = jnp.split(h @ w_in, cuts, axis=-1)
    cos, sin = axial_rope_tables(n)
    q = apply_axial_rope(q.reshape(bsz, n, A_Q_HEADS, HEAD_DIM), cos, sin)
    k = apply_axial_rope(k.reshape(bsz, n, A_KV_HEADS, HEAD_DIM), cos, sin)
    v = v.reshape(bsz, n, A_KV_HEADS, HEAD_DIM)
    if ctx_out:
        qc, kc, vc, zbc = jnp.split(hc @ w_in, cuts, axis=-1)
    else:
        kc, vc = jnp.split(hc @ w_in[:, Q_COLS:Q_COLS + 2 * KV_COLS], 2, axis=-1)
    kc = kc.reshape(bsz, nc, A_KV_HEADS, HEAD_DIM)
    vc = vc.reshape(bsz, nc, A_KV_HEADS, HEAD_DIM)
    y_a = window_attention(q, k, v, kc, vc, sink)
    y_b = hyena(zb, hy_conv_w, hy_conv_b, hyena_filter(n, f_w1, f_b1, f_w2, f_b2, f_w3, f_freq), hy_bias)
    y = jnp.concatenate([y_a, y_b], axis=-1) @ w_out
    if not ctx_out:
        return y, None
    yc_a = context_attention(qc.reshape(bsz, nc, A_Q_HEADS, HEAD_DIM), kc, vc, sink)
    yc_b = hyena(zbc, hy_conv_w, hy_conv_b, hyena_filter(nc, f_w1, f_b1, f_w2, f_b2, f_w3, f_freq), hy_bias)
    yc = jnp.concatenate([yc_a, yc_b], axis=-1) @ w_out
    return y, yc


def _lin_combine(e1, e2):
    a1, b1 = e1
    a2, b2 = e2
    return a1 * a2, a2 * b1 + b2


def s5_scan(u, lam_bar, b_bar, s0, reverse):
    bu = jnp.einsum('bngj,gpj->bngp', u.astype(jnp.complex64), b_bar)
    if s0 is not None:
        idx = -1 if reverse else 0
        bu = bu.at[:, idx].add(lam_bar * s0)
    a = jnp.broadcast_to(lam_bar, bu.shape)
    _, s = lax.associative_scan(_lin_combine, (a, bu), reverse=reverse, axis=1)
    return s


def s5_mixer(h, hc, lam_re, lam_im, log_step, b_re, b_im, c_re, c_im, d, w_glu, b_glu, ctx_out):
    f32 = jnp.float32
    lam = lax.complex(lam_re.astype(f32), lam_im.astype(f32))
    lam_bar = jnp.exp(lam * jnp.exp(log_step.astype(f32))[..., None])
    b_bar = ((lam_bar - 1.0) / lam)[..., None] * lax.complex(b_re.astype(f32), b_im.astype(f32))
    c_mat = lax.complex(c_re.astype(f32), c_im.astype(f32))
    d_g = d.astype(f32).reshape(S5_GROUPS, S5_GROUP)

    def groups(t):
        return t.astype(f32).reshape(t.shape[0], t.shape[1], S5_GROUPS, S5_GROUP)

    def readout(s, dirn):
        return jnp.real(jnp.einsum('bngp,gjp->bngj', s, c_mat[dirn]))

    def glu(t, ref):
        g = jax.nn.gelu(t.reshape(ref.shape).astype(ref.dtype))
        a, gt = jnp.split(g @ w_glu + b_glu, 2, axis=-1)
        return a * jax.nn.sigmoid(gt)

    u, uc = groups(h), groups(hc)
    y = d_g * u
    yc = d_g * uc if ctx_out else None
    for dirn, rev in ((0, False), (1, True)):
        s_ctx = s5_scan(uc, lam_bar[dirn], b_bar[dirn], None, rev)
        s_end = s_ctx[:, 0] if rev else s_ctx[:, -1]
        y = y + readout(s5_scan(u, lam_bar[dirn], b_bar[dirn], s_end, rev), dirn)
        if ctx_out:
            yc = yc + readout(s_ctx, dirn)
    return glu(y, h), (glu(yc, hc) if ctx_out else None)


def setup_inputs(seed: int = 0) -> dict:
    key = jax.random.key(seed)
    ks = iter(jax.random.split(key, 40))
    f32 = jnp.float32

    def nrm(shape, std):
        return std * jax.random.normal(next(ks), shape, f32)

    D = D_MODEL
    lam_im_base = math.pi * jnp.arange(S5_STATE, dtype=f32)
    return {
        'x': nrm((BATCH, SEQ, D), 1.0),
        'c': nrm((BATCH, D), 1.0),
        'ctx': nrm((BATCH, CTX_LEN, D), 1.0),
        'c_ctx': nrm((D,), 1.0),
        'w_mod': nrm((DEPTH, D, N_MOD * D), 0.5 * D ** -0.5),
        'b_mod': nrm((DEPTH, N_MOD * D), 0.02),
        'norm_g': 1.0 + nrm((DEPTH, 4, D), 0.05),
        'ffn_w_up': nrm((DEPTH, D, 2 * D_FF), D ** -0.5),
        'ffn_conv_w': nrm((DEPTH, 3, 2 * D_FF), 3 ** -0.5),
        'ffn_conv_b': nrm((DEPTH, 2 * D_FF), 0.02),
        'ffn_w_down': nrm((DEPTH, D_FF, D), D_FF ** -0.5),
        'ab_w_in': nrm((N_EVEN, D, IN_COLS), D ** -0.5),
        'ab_w_out': nrm((N_EVEN, Q_COLS + B_WIDTH, D), (Q_COLS + B_WIDTH) ** -0.5),
        'attn_sink': nrm((N_EVEN, A_Q_HEADS), 0.5),
        'hy_conv_w': nrm((N_EVEN, 3, HY_COLS), 3 ** -0.5),
        'hy_conv_b': nrm((N_EVEN, HY_COLS), 0.02),
        'hy_f_w1': nrm((N_EVEN, HY_EMB, HY_HIDDEN), 1.0),
        'hy_f_b1': nrm((N_EVEN, HY_HIDDEN), 0.5),
        'hy_f_w2': nrm((N_EVEN, HY_HIDDEN, HY_HIDDEN), HY_HIDDEN ** -0.5),
        'hy_f_b2': nrm((N_EVEN, HY_HIDDEN), 0.5),
        'hy_f_w3': nrm((N_EVEN, HY_HIDDEN, 2 * B_WIDTH), HY_HIDDEN ** -0.5),
        'hy_f_freq': 1.0 + nrm((N_EVEN, HY_HIDDEN), 0.1),
        'hy_bias': nrm((N_EVEN, B_WIDTH), 1.0),
        's5_lam_re': -0.5 + nrm((N_ODD, 2, S5_GROUPS, S5_STATE), 0.01),
        's5_lam_im': lam_im_base + nrm((N_ODD, 2, S5_GROUPS, S5_STATE), 0.01),
        's5_log_step': jax.random.uniform(next(ks), (N_ODD, 2, S5_GROUPS), f32, math.log(S5_DT_MIN), math.log(S5_DT_MAX)),
        's5_b_re': nrm((N_ODD, 2, S5_GROUPS, S5_STATE, S5_GROUP), (2 * S5_GROUP) ** -0.5),
        's5_b_im': nrm((N_ODD, 2, S5_GROUPS, S5_STATE, S5_GROUP), (2 * S5_GROUP) ** -0.5),
        's5_c_re': nrm((N_ODD, 2, S5_GROUPS, S5_GROUP, S5_STATE), 0.5 ** 0.5),
        's5_c_im': nrm((N_ODD, 2, S5_GROUPS, S5_GROUP, S5_STATE), 0.5 ** 0.5),
        's5_d': nrm((N_ODD, D), 1.0),
        's5_w_glu': nrm((N_ODD, D, 2 * D), D ** -0.5),
        's5_b_glu': nrm((N_ODD, 2 * D), 0.02),
    }


def reference(x, c, ctx, c_ctx, w_mod, b_mod, norm_g, ffn_w_up, ffn_conv_w, ffn_conv_b, ffn_w_down, ab_w_in, ab_w_out, attn_sink, hy_conv_w, hy_conv_b, hy_f_w1, hy_f_b1, hy_f_w2, hy_f_b2, hy_f_w3, hy_f_freq, hy_bias, s5_lam_re, s5_lam_im, s5_log_step, s5_b_re, s5_b_im, s5_c_re, s5_c_im, s5_d, s5_w_glu, s5_b_glu):
    xc = ctx
    s_lat = jax.nn.silu(c)
    s_ctx = jax.nn.silu(c_ctx)
    for layer in range(DEPTH):
        last = layer == DEPTH - 1
        m = jnp.split((s_lat @ w_mod[layer] + b_mod[layer])[:, None, :], N_MOD, axis=-1)
        mc = jnp.split(s_ctx @ w_mod[layer] + b_mod[layer], N_MOD, axis=-1)
        hm = modulate(x, norm_g[layer, 0], m[0], m[1])
        hmc = modulate(xc, norm_g[layer, 0], mc[0], mc[1])
        j = layer // 2
        if layer % 2 == 0:
            y, yc = attn_hyena_mixer(hm, hmc, ab_w_in[j], ab_w_out[j], attn_sink[j], hy_conv_w[j], hy_conv_b[j], hy_f_w1[j], hy_f_b1[j], hy_f_w2[j], hy_f_b2[j], hy_f_w3[j], hy_f_freq[j], hy_bias[j], not last)
        else:
            y, yc = s5_mixer(hm, hmc, s5_lam_re[j], s5_lam_im[j], s5_log_step[j], s5_b_re[j], s5_b_im[j], s5_c_re[j], s5_c_im[j], s5_d[j], s5_w_glu[j], s5_b_glu[j], not last)
        x = x + m[2] * rmsnorm(y, norm_g[layer, 1])
        f = conv_ffn(modulate(x, norm_g[layer, 2], m[3], m[4]), ffn_w_up[layer], ffn_conv_w[layer], ffn_conv_b[layer], ffn_w_down[layer])
        x = x + m[5] * rmsnorm(f, norm_g[layer, 3])
        if not last:
            xc = xc + mc[2] * rmsnorm(yc, norm_g[layer, 1])
            fc = conv_ffn(modulate(xc, norm_g[layer, 2], mc[3], mc[4]), ffn_w_up[layer], ffn_conv_w[layer], ffn_conv_b[layer], ffn_w_down[layer])
            xc = xc + mc[5] * rmsnorm(fc, norm_g[layer, 3])
    return x
```

```cpp
#include <hip/hip_runtime.h>
#include <cstdio>
#include <cstdint>
namespace pg8 {
#define PG8_LAS __attribute__((address_space(3)))
typedef unsigned short bf16_t;
typedef short bf16x8 __attribute__((ext_vector_type(8)));
typedef float f32x4 __attribute__((ext_vector_type(4)));
typedef unsigned u32x4 __attribute__((ext_vector_type(4)));
typedef unsigned u32x2 __attribute__((ext_vector_type(2)));
constexpr int BM = 256, BK = 64, HALF = 128, HTB = HALF * BK * 2  , STAGE_BYTES = 8 * HTB, NXCD = 8, WGM = 4;

__host__ __device__ __forceinline__ int lds_byte(int r, int c) { const int st = (r >> 4) * 2 + (c >> 5), rr = r & 15, cc = c & 31, ob = rr * 64 + cc * 2; return st * 1024 + (ob ^ (((ob >> 9) & 1) << 5)); }
__host__ __device__ __forceinline__ void stage_rc(int b, int& R, int& C) { const int st = b / 1024, sb = b % 1024, swz = sb ^ (((sb >> 9) & 1) << 5); R = (st >> 1) * 16 + swz / 64; C = (st & 1) * 32 + (swz % 64) / 2; }
__host__ __device__ __forceinline__ int perm32(int rho) { const int n = rho >> 4, i = rho & 15; return 8 * (i >> 2) + 4 * n + (i & 3); }

struct Unit { int pm, pn, kind, nt; const char* a; const char* b; };
struct Gemm { int lda, ldb; };

__host__ __device__ __forceinline__ void tile_map(int wgid, int nM, int nN, int& pm, int& pn, const int wgm = WGM) {
    const int nwg = nM * nN;
    { const int q = nwg / NXCD, r = nwg % NXCD, xcd = wgid % NXCD, off = wgid / NXCD; wgid = (xcd < r ? xcd * (q + 1) : r * (q + 1) + (xcd - r) * q) + off; }
    const int nig = wgm * nN, gid = wgid / nig, fm = gid * wgm, gsz = (nM - fm) < wgm ? (nM - fm) : wgm;
    pm = fm + ((wgid % nig) % gsz); pn = (wgid % nig) / gsz;
}
struct StaticOrder {
    int nM, nN, nwg, G, c, nt; const char* A; const char* Bt; size_t ta, tb;
    __device__ void init(const void* A_, const void* Bt_, int M, int N, int K, int lda, int ldb, int G_, int c_) { nt = K / BK; nM = M / BM; nN = N / BM; nwg = nM * nN; G = G_; c = c_; A = (const char*)A_; Bt = (const char*)Bt_; ta = (size_t)BM * lda * 2; tb = (size_t)BM * ldb * 2; }
    __device__ bool next(int i, Unit& u) const {
        const long L = (long)i * G + c; if (L >= nwg) return false;
        tile_map((int)L, nM, nN, u.pm, u.pn); u.kind = 0; u.nt = nt; u.a = A + (size_t)u.pm * ta; u.b = Bt + (size_t)u.pn * tb; return true;
    }
};

__device__ __forceinline__ unsigned cvt_pk_bf16(float lo, float hi) { unsigned r; asm volatile("v_cvt_pk_bf16_f32 %0, %1, %2" : "=v"(r) : "v"(lo), "v"(hi)); return r; }

template <class Epi, class Sched, bool ALIGN_EPI, int AMODE = 0>
__device__ __forceinline__ void gemm_phase(PG8_LAS unsigned char* lds, const int tid, const Gemm g, const Sched& S, const Epi& E) {
    const int wid = __builtin_amdgcn_readfirstlane(tid >> 6), lane = tid & 63, wr = wid >> 2, wc = wid & 3, fr = lane & 15, fq = lane >> 4;
    unsigned voffA[2], voffB[2];
#pragma unroll
    for (int i = 0; i < 2; ++i) { int R, C; stage_rc(tid * 16 + i * 8192, R, C); const int Rb = Epi::PERM ? ((R & ~31) + perm32(R & 31)) : R;
        voffA[i] = AMODE == 1 ? (unsigned)((C >> 4) * (1280 * 256) + (R >> 4) * 256 + (R & 15) * 16 + (C & 15)) * 2u : (unsigned)(R * g.lda + C) * 2u; voffB[i] = (unsigned)(Rb * g.ldb + C) * 2u; }
    const size_t kstepB = (size_t)(BK * 2), kstepA = AMODE == 1 ? (size_t)4 * 1280 * 256 * 2 : (size_t)(BK * 2);
    const size_t hstepA = AMODE == 1 ? (size_t)8 * 256 * 2 : (size_t)HALF * g.lda * 2, hstepB = (size_t)HALF * g.ldb * 2;
    const unsigned ldsw = (unsigned)wid * 1024u;
    const int aoff = lds_byte(wr * 64 + fr, fq * 8), boff = lds_byte(wc * 32 + fr, fq * 8);
#define PG8_SA(b, h) (((b) * 2 + (h)) * HTB)
#define PG8_SB(b, h) ((4 + (b) * 2 + (h)) * HTB)
#define PG8_STAGE(bufoff, gbase, voff) do { _Pragma("unroll") for (int _i = 0; _i < 2; ++_i) \
        __builtin_amdgcn_global_load_lds((const unsigned*)((const char*)(gbase) + (voff)[_i]), (PG8_LAS unsigned*)(lds + (bufoff) + ldsw + _i * 8192), 16, 0, 0); } while (0)
#define PG8_LDA(dst, b, h) do { _Pragma("unroll") for (int m = 0; m < 4; ++m) _Pragma("unroll") for (int k = 0; k < 2; ++k) dst[m][k] = *(const PG8_LAS bf16x8*)(lds + PG8_SA(b, h) + aoff + m * 2048 + k * 1024); } while (0)
#define PG8_LDB(dst, b, h) do { _Pragma("unroll") for (int n = 0; n < 2; ++n) _Pragma("unroll") for (int k = 0; k < 2; ++k) dst[n][k] = *(const PG8_LAS bf16x8*)(lds + PG8_SB(b, h) + boff + n * 2048 + k * 1024); } while (0)
#define PG8_MMA(ai, bj, At, Bt) do { __builtin_amdgcn_s_setprio(1); _Pragma("unroll") for (int m = 0; m < 4; ++m) _Pragma("unroll") for (int n = 0; n < 2; ++n) _Pragma("unroll") for (int k = 0; k < 2; ++k) \
        acc[ai][bj][m][n] = __builtin_amdgcn_mfma_f32_16x16x32_bf16(Bt[n][k], At[m][k], acc[ai][bj][m][n], 0, 0, 0); __builtin_amdgcn_s_setprio(0); } while (0)
#define PG8_WAIT_V(n) asm volatile("s_waitcnt vmcnt(" #n ")" ::: "memory")
#define PG8_WAIT_L(n) asm volatile("s_waitcnt lgkmcnt(" #n ")" ::: "memory")
#define PG8_BAR __builtin_amdgcn_s_barrier()
#define PG8_SCHED __builtin_amdgcn_sched_barrier(0)
    Unit cur, nxt; int ui = 0;
    if (!S.next(0, cur)) return;
    f32x4 acc[2][2][4][2];
#pragma unroll
    for (int a = 0; a < 2; ++a)
#pragma unroll
        for (int b = 0; b < 2; ++b)
#pragma unroll
            for (int m = 0; m < 4; ++m)
#pragma unroll
                for (int n = 0; n < 2; ++n) acc[a][b][m][n] = (f32x4){0.f, 0.f, 0.f, 0.f};
    bf16x8 At[4][2], B0[2][2], B1[2][2];
    const char* cA = cur.a; const char* cB = cur.b;
    PG8_STAGE(PG8_SB(0, 0), cB, voffB); PG8_STAGE(PG8_SB(0, 1), cB + hstepB, voffB); PG8_STAGE(PG8_SA(0, 0), cA, voffA); PG8_STAGE(PG8_SA(0, 1), cA + hstepA, voffA);
    if (wr == 1) PG8_BAR;
    PG8_WAIT_V(2); PG8_BAR;
    PG8_STAGE(PG8_SB(1, 0), cB + kstepB, voffB); PG8_STAGE(PG8_SA(1, 0), cA + kstepA, voffA); PG8_STAGE(PG8_SB(1, 1), cB + hstepB + kstepB, voffB);
    PG8_WAIT_V(6); PG8_BAR;
    for (;;) {
        const bool has_next = S.next(ui + 1, nxt);
        const char* nA = has_next ? nxt.a : cA; const char* nB = has_next ? nxt.b : cB;
        const int nt = cur.nt;
        for (int t = 0; t < nt; t += 2) {
            const bool last = (t == nt - 2);
            const char* a1 = cA + (size_t)(t + 1) * kstepA;
            const char* a2 = last ? nA : cA + (size_t)(t + 2) * kstepA; const char* b2 = last ? nB : cB + (size_t)(t + 2) * kstepB;
            const char* a3 = a2 + kstepA; const char* b3 = b2 + kstepB;
            PG8_LDB(B0, 0, 0); PG8_LDB(B1, 0, 1); PG8_SCHED; PG8_LDA(At, 0, 0); PG8_STAGE(PG8_SA(1, 1), a1 + hstepA, voffA);
            PG8_WAIT_V(8); PG8_WAIT_L(0); PG8_BAR; PG8_MMA(0, 0, At, B0); PG8_MMA(0, 1, At, B1); PG8_BAR; PG8_SCHED;
            PG8_LDA(At, 0, 1); PG8_STAGE(PG8_SB(0, 0), b2, voffB); PG8_STAGE(PG8_SB(0, 1), b2 + hstepB, voffB); PG8_STAGE(PG8_SA(0, 0), a2, voffA);
            PG8_WAIT_V(8); PG8_WAIT_L(0); PG8_BAR; PG8_MMA(1, 0, At, B0); PG8_MMA(1, 1, At, B1); PG8_BAR; PG8_SCHED;
            PG8_LDB(B0, 1, 0); PG8_LDB(B1, 1, 1); PG8_SCHED; PG8_LDA(At, 1, 0); PG8_STAGE(PG8_SA(0, 1), a2 + hstepA, voffA);
            PG8_WAIT_V(8); PG8_WAIT_L(0); PG8_BAR; PG8_MMA(0, 0, At, B0); PG8_MMA(0, 1, At, B1); PG8_BAR; PG8_SCHED;
            PG8_LDA(At, 1, 1); PG8_STAGE(PG8_SB(1, 0), b3, voffB); PG8_STAGE(PG8_SB(1, 1), b3 + hstepB, voffB); PG8_STAGE(PG8_SA(1, 0), a3, voffA);
            PG8_WAIT_V(8); PG8_WAIT_L(0); PG8_BAR; PG8_MMA(1, 0, At, B0); PG8_MMA(1, 1, At, B1); PG8_BAR; PG8_SCHED;
        }
        if constexpr (ALIGN_EPI) { if (wr == 0) PG8_BAR; }
        { int fr_ = fr, fq_ = fq; asm volatile("" : "+v"(fr_), "+v"(fq_)); if constexpr (Epi::REP == 1) E(acc, cur, wr, wc, fr_, fq_); else { int nrep_ = Epi::REP; asm volatile("" : "+s"(nrep_)); _Pragma("unroll 1") for (int rep_e = 0; rep_e < nrep_; ++rep_e) E(acc, cur, wr, wc, fr_, fq_); } }
        if (!has_next) break;
#pragma unroll
        for (int a = 0; a < 2; ++a)
#pragma unroll
            for (int b = 0; b < 2; ++b)
#pragma unroll
                for (int m = 0; m < 4; ++m)
#pragma unroll
                    for (int n = 0; n < 2; ++n) acc[a][b][m][n] = (f32x4){0.f, 0.f, 0.f, 0.f};
        cur = nxt; cA = nA; cB = nB; ++ui;
        if constexpr (ALIGN_EPI) { if (wr == 1) PG8_BAR; }
    }
    PG8_WAIT_V(0);
    if constexpr (!ALIGN_EPI) { if (wr == 0) PG8_BAR; }
    PG8_BAR;
#undef PG8_SA
#undef PG8_SB
#undef PG8_STAGE
#undef PG8_LDA
#undef PG8_LDB
#undef PG8_MMA
#undef PG8_WAIT_V
#undef PG8_WAIT_L
#undef PG8_BAR
#undef PG8_SCHED
}
}
#ifndef WGM_E1
#define WGM_E1 4
#endif
constexpr int DM = 2048, NBATCH = 2, SEQ = 8192, DEPTH = 4, CTXL = 256;
constexpr int NLAT = NBATCH * SEQ, NCTX = NBATCH * CTXL, MROWS = NLAT + NCTX;
constexpr int DFF = 5504, DFF2 = 11008, NMOD = 6;
constexpr int QCOLS = 1024, KVC = 256, HYC = 3072, INCOLS = 4608, QKVC = 1536, HD = 128;
constexpr int S5G = 128, S5P = 64, S5J = 16, S5L = 16, S5ROWS = 1280, S5K = 512;
constexpr float RMS_EPS = 1e-6f;
constexpr float LOG2E = 1.4426950408889634f;
constexpr float QSCALE = 0.08838834764831845f * LOG2E;

typedef unsigned short bf16;
typedef float f32x4 __attribute__((ext_vector_type(4)));
typedef float f32x2 __attribute__((ext_vector_type(2)));
typedef float f32x16 __attribute__((ext_vector_type(16)));
typedef unsigned u32x4 __attribute__((ext_vector_type(4)));
typedef unsigned u32x2 __attribute__((ext_vector_type(2)));
typedef short bf16x8 __attribute__((ext_vector_type(8)));
typedef short s16x4 __attribute__((ext_vector_type(4)));
#define GAS __attribute__((address_space(1)))
#define LAS __attribute__((address_space(3)))
#define DI __device__ __forceinline__

DI unsigned f2bf(float f) { unsigned u = __builtin_bit_cast(unsigned, f); return (u + 0x7fffu + ((u >> 16) & 1u)) >> 16; }
DI unsigned pk2(float lo, float hi) { return pg8::cvt_pk_bf16(lo, hi); }
DI float bf2f(unsigned short b) { return __builtin_bit_cast(float, ((unsigned)b) << 16); }
DI float bflo(unsigned w) { return __builtin_bit_cast(float, w << 16); }
DI float bfhi(unsigned w) { return __builtin_bit_cast(float, w & 0xffff0000u); }
DI float fast_exp(float x) { return __builtin_amdgcn_exp2f(x * LOG2E); }
DI float sigmoidf_(float x) { return __builtin_amdgcn_rcpf(1.0f + fast_exp(-x)); }
DI float siluf_(float x) { return x * sigmoidf_(x); }
DI float gelu_tanh(float x) { const float z = 0.7978845608028654f * (x + 0.044715f * x * x * x); const float e = fast_exp(2.0f * z); const float th = 1.0f - 2.0f * __builtin_amdgcn_rcpf(e + 1.0f); return 0.5f * x * (1.0f + th); }

namespace pg8 {
struct EpiF32g {
    static constexpr bool PERM = false; static constexpr int REP = 1;
    float* C; int ldc; const float* bias;
    __device__ __forceinline__ void operator()(const f32x4 (&acc)[2][2][4][2], const Unit& u, int wr, int wc, int fr, int fq) const {
        const int row0 = u.pm * BM + wr * 64 + fr, col0 = u.pn * BM + wc * 32 + 4 * fq;
        f32x4 bv[2][2];
#pragma unroll
        for (int bj = 0; bj < 2; ++bj)
#pragma unroll
            for (int n = 0; n < 2; ++n) bv[bj][n] = bias ? *(const f32x4*)(bias + col0 + bj * HALF + n * 16) : (f32x4){0.f, 0.f, 0.f, 0.f};
#pragma unroll
        for (int ai = 0; ai < 2; ++ai)
#pragma unroll
            for (int m = 0; m < 4; ++m) { float* rowp = C + (size_t)(row0 + ai * HALF + m * 16) * ldc + col0;
#pragma unroll
                for (int bj = 0; bj < 2; ++bj)
#pragma unroll
                    for (int n = 0; n < 2; ++n) *(f32x4*)(rowp + bj * HALF + n * 16) = acc[ai][bj][m][n] + bv[bj][n]; }
    }
};
struct EpiBf16g {
    static constexpr bool PERM = true; static constexpr int REP = 1;
    bf16_t* O; int ldc;
    __device__ __forceinline__ void operator()(const f32x4 (&acc)[2][2][4][2], const Unit& u, int wr, int wc, int fr, int fq) const {
        const int row0 = u.pm * BM + wr * 64 + fr, col0 = u.pn * BM + wc * 32 + 8 * fq;
#pragma unroll
        for (int ai = 0; ai < 2; ++ai)
#pragma unroll
            for (int m = 0; m < 4; ++m) { bf16_t* rowp = O + (size_t)(row0 + ai * HALF + m * 16) * ldc + col0;
#pragma unroll
                for (int bj = 0; bj < 2; ++bj) { const f32x4 v0 = acc[ai][bj][m][0], v1 = acc[ai][bj][m][1];
                    u32x4 w; w.x = cvt_pk_bf16(v0[0], v0[1]); w.y = cvt_pk_bf16(v0[2], v0[3]); w.z = cvt_pk_bf16(v1[0], v1[1]); w.w = cvt_pk_bf16(v1[2], v1[3]);
                    *(u32x4*)(rowp + bj * HALF) = w; } }
    }
};
struct EpiYb {
    static constexpr bool PERM = true; static constexpr int REP = 1;
    bf16_t* O; int ldc; const float* bias; float* part;
    __device__ __forceinline__ void operator()(const f32x4 (&acc)[2][2][4][2], const Unit& u, int wr, int wc, int fr, int fq) const {
        const int col0 = u.pn * BM + wc * 32 + 8 * fq;
        const bool addb = bias != nullptr && (u.kind == 0 || u.kind == 16);
        f32x4 bv[2][2];
#pragma unroll
        for (int bj = 0; bj < 2; ++bj)
#pragma unroll
            for (int n = 0; n < 2; ++n) bv[bj][n] = addb ? *(const f32x4*)(bias + col0 + bj * HALF + 4 * n) : (f32x4){0.f, 0.f, 0.f, 0.f};
        if (u.kind >= 16) {
            float* base = part + ((size_t)(u.kind - 16) * NCTX + (size_t)(u.pm - NLAT / BM) * BM + wr * 64 + fr) * ldc + col0;
#pragma unroll
            for (int ai = 0; ai < 2; ++ai)
#pragma unroll
                for (int m = 0; m < 4; ++m) { float* rowp = base + (size_t)(ai * HALF + m * 16) * ldc;
#pragma unroll
                    for (int bj = 0; bj < 2; ++bj) { *(f32x4*)(rowp + bj * HALF) = acc[ai][bj][m][0] + bv[bj][0]; *(f32x4*)(rowp + bj * HALF + 4) = acc[ai][bj][m][1] + bv[bj][1]; } }
        } else {
            const int row0 = u.pm * BM + wr * 64 + fr;
#pragma unroll
            for (int ai = 0; ai < 2; ++ai)
#pragma unroll
                for (int m = 0; m < 4; ++m) { bf16_t* rowp = O + (size_t)(row0 + ai * HALF + m * 16) * ldc + col0;
#pragma unroll
                    for (int bj = 0; bj < 2; ++bj) { const f32x4 v0 = acc[ai][bj][m][0] + bv[bj][0], v1 = acc[ai][bj][m][1] + bv[bj][1];
                        u32x4 w; w.x = cvt_pk_bf16(v0[0], v0[1]); w.y = cvt_pk_bf16(v0[2], v0[3]); w.z = cvt_pk_bf16(v1[0], v1[1]); w.w = cvt_pk_bf16(v1[2], v1[3]);
                        *(u32x4*)(rowp + bj * HALF) = w; } }
        }
    }
};
struct OrderSplit {
    int nN, G, c, nt_full, nmain, nchunk, split, ktype, amode, wgm; const char* A; const char* Bt; size_t ta, tb;
    __device__ size_t aoff(int pm, int k0) const { if (!amode) return (size_t)pm * ta + (size_t)k0 * BK * 2; const int cr0 = pm < 64 ? ((pm >> 5) * 512 + (pm & 31) * 16) : (1024 + (pm - 64) * 16); return (size_t)cr0 * 512 + (size_t)k0 * (4 * 1280 * 256 * 2); }
    __device__ void init(const void* A_, const void* Bt_, int N, int K, int lda, int ldb, int split_, int G_, int c_, int amode_ = 0, int wgm_ = WGM) { amode = amode_; wgm = wgm_; nN = N / BM; G = G_; c = c_; nt_full = K / BK; nmain = (NLAT / BM) * nN; ktype = (K == 2048) ? 0 : 1; nchunk = ktype ? 15 : 8; split = split_;
        A = (const char*)A_; Bt = (const char*)Bt_; ta = (size_t)BM * lda * 2; tb = (size_t)BM * ldb * 2; }
    __device__ bool next(int i, Unit& u) const {
        const long L = (long)i * G + c;
        if (L < nmain) { tile_map((int)L, NLAT / BM, nN, u.pm, u.pn, wgm); u.kind = 0; u.nt = nt_full; u.a = A + aoff(u.pm, 0); u.b = Bt + (size_t)u.pn * tb; return true; }
        if (!split) return false;
        const int s = (int)(L - nmain); if (s >= 2 * nN * nchunk) return false;
        const int tile = s / nchunk, chunk = s - tile * nchunk; const int pmc = tile / nN; u.pn = tile - pmc * nN; u.pm = NLAT / BM + pmc; u.kind = 16 + chunk;
        int k0, ntc; if (ktype == 0) { k0 = chunk * 4; ntc = 4; } else if (chunk < 13) { k0 = chunk * 6; ntc = 6; } else { k0 = 78 + (chunk - 13) * 4; ntc = 4; }
        u.nt = ntc; u.a = A + aoff(u.pm, k0); u.b = Bt + (size_t)u.pn * tb + (size_t)k0 * BK * 2; return true;
    }
};
typedef __bf16 bf16x2v_ __attribute__((ext_vector_type(2)));
__device__ __forceinline__ unsigned cvt_pk_c(float lo, float hi) { const f32x2 v = {lo, hi}; const bf16x2v_ b = __builtin_convertvector(v, bf16x2v_); return __builtin_bit_cast(unsigned, b); }
#define DPP0(src, ctrl) __builtin_bit_cast(float, __builtin_amdgcn_update_dpp(0, __builtin_bit_cast(int, (float)(src)), (ctrl), 0xf, 0xf, true))
__device__ __forceinline__ void up_panel(int pm, int& seq0, int& seqlen, int& g0) {
    int p; if (pm < 66) { const int b = pm / 33; p = pm - 33 * b; seq0 = b * SEQ; seqlen = SEQ; } else { const int c = pm - 66; p = c & 1; seq0 = NLAT + (c >> 1) * CTXL; seqlen = CTXL; }
    g0 = seq0 + 254 * p - 1;
}
template <int REP_ = 1> struct EpiUpGlu {
    static constexpr bool PERM = true; static constexpr int REP = REP_;
    bf16_t* A5; const float* cw; const float* cb; PG8_LAS float* halo;
    __device__ __forceinline__ void operator()(f32x4 (&acc)[2][2][4][2], const Unit& u, int wr, int wc, int fr, int fq) const {
        int seq0, seqlen, g0; up_panel(u.pm, seq0, seqlen, g0);
        const int send = seq0 + seqlen;
        const int cl = wc * 32 + 8 * fq;
        if (g0 < seq0 || g0 + BM > send) {
#pragma unroll
            for (int ai = 0; ai < 2; ++ai)
#pragma unroll
                for (int m = 0; m < 4; ++m) { const int g = g0 + ai * HALF + wr * 64 + m * 16 + fr; const bool in = g >= seq0 && g < send;
#pragma unroll
                    for (int bj = 0; bj < 2; ++bj)
#pragma unroll
                        for (int n = 0; n < 2; ++n)
#pragma unroll
                            for (int e = 0; e < 4; ++e) acc[ai][bj][m][n][e] = in ? acc[ai][bj][m][n][e] : 0.f; } }
#pragma unroll
        for (int ai = 0; ai < 2; ++ai)
#pragma unroll
            for (int bj = 0; bj < 2; ++bj)
#pragma unroll
                for (int n = 0; n < 2; ++n) {
                    if (fr == 0) *(PG8_LAS f32x4*)(halo + (2 * ai + wr) * 512 + bj * 128 + cl + 4 * n) = acc[ai][bj][0][n];
                    if (fr == 15) *(PG8_LAS f32x4*)(halo + (2 * ai + wr) * 512 + 256 + bj * 128 + cl + 4 * n) = acc[ai][bj][3][n]; }
        asm volatile("s_waitcnt lgkmcnt(0)" ::: "memory"); __builtin_amdgcn_s_barrier(); asm volatile("" ::: "memory");
#pragma unroll
        for (int bj = 0; bj < 2; ++bj) {
            const int ch0 = 128 * u.pn + 64 * bj + 16 * wc + 4 * fq;
            f32x4 wg[3], wv[3];
#pragma unroll
            for (int k = 0; k < 3; ++k) { wg[k] = *(const f32x4*)(cw + (size_t)k * DFF2 + ch0); wv[k] = *(const f32x4*)(cw + (size_t)k * DFF2 + DFF + ch0); }
            const f32x4 bg = *(const f32x4*)(cb + ch0), bv = *(const f32x4*)(cb + DFF + ch0);
#pragma unroll
            for (int ai = 0; ai < 2; ++ai) { const int blk = 2 * ai + wr;
                f32x4 hag = (f32x4){0.f, 0.f, 0.f, 0.f}, hav = hag, hbg = hag, hbv = hag;
                if (blk > 0) { hag = *(const PG8_LAS f32x4*)(halo + (blk - 1) * 512 + 256 + bj * 128 + cl); hav = *(const PG8_LAS f32x4*)(halo + (blk - 1) * 512 + 256 + bj * 128 + cl + 4); }
                if (blk < 3) { hbg = *(const PG8_LAS f32x4*)(halo + (blk + 1) * 512 + bj * 128 + cl); hbv = *(const PG8_LAS f32x4*)(halo + (blk + 1) * 512 + bj * 128 + cl + 4); }
                u32x2 pk[4];
#pragma unroll
                for (int m = 0; m < 4; ++m) {
                    const f32x4 cg = acc[ai][bj][m][0], cv = acc[ai][bj][m][1];
                    const f32x4 pbg = m > 0 ? acc[ai][bj][m > 0 ? m - 1 : 0][0] : hag, pbv = m > 0 ? acc[ai][bj][m > 0 ? m - 1 : 0][1] : hav;
                    const f32x4 nbg = m < 3 ? acc[ai][bj][m < 3 ? m + 1 : 3][0] : hbg, nbv = m < 3 ? acc[ai][bj][m < 3 ? m + 1 : 3][1] : hbv;
                    float o[4];
#pragma unroll
                    for (int ep = 0; ep < 2; ++ep) { const int e0 = 2 * ep, e1 = 2 * ep + 1;
                        const f32x2 w0g = {wg[0][e0], wg[0][e1]}, w1g = {wg[1][e0], wg[1][e1]}, w2g = {wg[2][e0], wg[2][e1]};
                        const f32x2 w0v = {wv[0][e0], wv[0][e1]}, w1v = {wv[1][e0], wv[1][e1]}, w2v = {wv[2][e0], wv[2][e1]};
                        f32x2 gate = (f32x2){bg[e0], bg[e1]} + (f32x2){cg[e0], cg[e1]} * w1g;
                        gate += (f32x2){DPP0(cg[e0], 0x111), DPP0(cg[e1], 0x111)} * w0g; gate += (f32x2){DPP0(pbg[e0], 0x10f), DPP0(pbg[e1], 0x10f)} * w0g;
                        gate += (f32x2){DPP0(cg[e0], 0x101), DPP0(cg[e1], 0x101)} * w2g; gate += (f32x2){DPP0(nbg[e0], 0x11f), DPP0(nbg[e1], 0x11f)} * w2g;
                        f32x2 val = (f32x2){bv[e0], bv[e1]} + (f32x2){cv[e0], cv[e1]} * w1v;
                        val += (f32x2){DPP0(cv[e0], 0x111), DPP0(cv[e1], 0x111)} * w0v; val += (f32x2){DPP0(pbv[e0], 0x10f), DPP0(pbv[e1], 0x10f)} * w0v;
                        val += (f32x2){DPP0(cv[e0], 0x101), DPP0(cv[e1], 0x101)} * w2v; val += (f32x2){DPP0(nbv[e0], 0x11f), DPP0(nbv[e1], 0x11f)} * w2v;
                        const f32x2 ex = gate * (-LOG2E);
                        const f32x2 den = (f32x2){__builtin_amdgcn_exp2f(ex[0]), __builtin_amdgcn_exp2f(ex[1])} + 1.0f;
                        const f32x2 sg = {__builtin_amdgcn_rcpf(den[0]), __builtin_amdgcn_rcpf(den[1])};
                        const f32x2 ov = gate * sg * val; o[e0] = ov[0]; o[e1] = ov[1]; }
                    pk[m].x = cvt_pk_c(o[0], o[1]); pk[m].y = cvt_pk_c(o[2], o[3]);
                }
#pragma unroll
                for (int m2 = 0; m2 < 4; m2 += 2) {
                    const auto rx = __builtin_amdgcn_permlane16_swap(pk[m2].x, pk[m2 + 1].x, false, false);
                    const auto ry = __builtin_amdgcn_permlane16_swap(pk[m2].y, pk[m2 + 1].y, false, false);
                    const int r = ai * HALF + wr * 64 + (m2 + (fq & 1)) * 16 + fr, g = g0 + r;
                    if (r >= 1 && r <= 254 && g >= seq0 && g < send) *(u32x4*)(A5 + (size_t)g * DFF + ch0 - 4 * (fq & 1)) = (u32x4){rx[0], ry[0], rx[1], ry[1]};
                }
            }
        }
    }
};
struct OrderUp {
    int G, c, nP; const char* HM; const char* W; int wgm;
    __device__ bool next(int i, Unit& u) const {
        const long L = (long)i * G + c; if (L >= (long)nP * 43) return false;
        tile_map((int)L, nP, 43, u.pm, u.pn, wgm); u.kind = 0; u.nt = DM / BK;
        int seq0, seqlen, g0; up_panel(u.pm, seq0, seqlen, g0);
        u.a = HM + (long)g0 * (DM * 2); u.b = W + (size_t)u.pn * BM * DM * 2; return true;
    }
};
template <int REP_ = 1> struct EpiQKVZ {
    static constexpr bool PERM = true; static constexpr int REP = REP_;
    bf16_t* QKV; bf16_t* ZBT; const float* tab;
    __device__ __forceinline__ void operator()(const f32x4 (&acc)[2][2][4][2], const Unit& u, int wr, int wc, int fr, int fq) const {
        const int row0 = u.pm * BM + wr * 64 + fr, col0 = u.pn * BM + wc * 32 + 8 * fq;
        if (u.kind == 1) {
#pragma unroll
            for (int ai = 0; ai < 2; ++ai)
#pragma unroll
                for (int m = 0; m < 4; ++m) { bf16_t* rowp = ZBT + (size_t)(row0 + ai * HALF + m * 16) * MROWS + col0;
#pragma unroll
                    for (int bj = 0; bj < 2; ++bj) { const f32x4 v0 = acc[ai][bj][m][0], v1 = acc[ai][bj][m][1];
                        u32x4 w; w.x = cvt_pk_bf16(v0[0], v0[1]); w.y = cvt_pk_bf16(v0[2], v0[3]); w.z = cvt_pk_bf16(v1[0], v1[1]); w.w = cvt_pk_bf16(v1[2], v1[3]);
                        *(u32x4*)(rowp + bj * HALF) = w; } }
        } else {
            const bool rope = (u.pn < 5) && (u.pm < 64);
            const float sc = (u.pn < 4) ? QSCALE : 1.0f;
            const int gi = 4 * wc + fq, f0 = 4 * (gi & 7); const bool rowang = gi < 8;
#pragma unroll
            for (int ai = 0; ai < 2; ++ai)
#pragma unroll
                for (int m = 0; m < 4; ++m) { const int r = row0 + ai * HALF + m * 16;
                    f32x4 cs0 = (f32x4){1.f, 0.f, 1.f, 0.f}, cs1 = cs0;
                    if (rope) { const int tok = r & (SEQ - 1); const int pos = rowang ? (tok >> 6) : (tok & 63); const f32x4* tp = (const f32x4*)(tab + (size_t)(pos * 32 + f0) * 2); cs0 = tp[0]; cs1 = tp[1]; }
                    const f32x4 cv = (f32x4){cs0[0], cs0[2], cs1[0], cs1[2]}, sv = (f32x4){cs0[1], cs0[3], cs1[1], cs1[3]};
                    bf16_t* rowp = QKV + (size_t)r * QKVC + col0;
#pragma unroll
                    for (int bj = 0; bj < 2; ++bj) { const f32x4 a0 = acc[ai][bj][m][0], a1 = acc[ai][bj][m][1];
                        const f32x4 v0 = (a0 * cv - a1 * sv) * sc, v1 = (a1 * cv + a0 * sv) * sc;
                        u32x4 w; w.x = cvt_pk_bf16(v0[0], v0[1]); w.y = cvt_pk_bf16(v0[2], v0[3]); w.z = cvt_pk_bf16(v1[0], v1[1]); w.w = cvt_pk_bf16(v1[2], v1[3]);
                        *(u32x4*)(rowp + bj * HALF) = w; } }
        }
    }
};
struct EpiS5G {
    static constexpr bool PERM = true; static constexpr int REP = 1;
    bf16_t* O;
    __device__ __forceinline__ void operator()(const f32x4 (&acc)[2][2][4][2], const Unit& u, int wr, int wc, int fr, int fq) const {
        const int row0 = u.pm * BM + wr * 64 + fr, col0 = wc * 32 + 8 * fq;
#pragma unroll
        for (int ai = 0; ai < 2; ++ai)
#pragma unroll
            for (int m = 0; m < 4; ++m) { bf16_t* rowp = O + (size_t)(row0 + ai * HALF + m * 16) * 256 + col0;
#pragma unroll
                for (int bj = 0; bj < 2; ++bj) { const f32x4 a0 = acc[ai][bj][m][0], a1 = acc[ai][bj][m][1];
                    u32x4 w; w.x = cvt_pk_bf16(gelu_tanh(a0[0]), gelu_tanh(a0[1])); w.y = cvt_pk_bf16(gelu_tanh(a0[2]), gelu_tanh(a0[3]));
                    w.z = cvt_pk_bf16(gelu_tanh(a1[0]), gelu_tanh(a1[1])); w.w = cvt_pk_bf16(gelu_tanh(a1[2]), gelu_tanh(a1[3]));
                    *(u32x4*)(rowp + bj * HALF) = w; } }
    }
};
struct OrderE1 {
    int G, c; const char* HM; const char* Win;
    __device__ bool next(int i, Unit& u) const {
        const long L = (long)i * G + c; if (L >= 1188) return false;
        if (L < 792) { tile_map((int)L, 12, 66, u.pm, u.pn, WGM_E1); u.kind = 1; u.nt = DM / BK; u.a = Win + (size_t)(QKVC + u.pm * BM) * DM * 2; u.b = HM + (size_t)u.pn * BM * DM * 2; }
        else { tile_map((int)L - 792, 66, 6, u.pm, u.pn, WGM_E1); u.kind = 0; u.nt = DM / BK; u.a = HM + (size_t)u.pm * BM * DM * 2; u.b = Win + (size_t)u.pn * BM * DM * 2; }
        return true;
    }
};
struct OrderS5 {
    int G, c, nt; const char* UA; const char* Bm; size_t bstride; int swapped;
    __device__ bool next(int i, Unit& u) const {
        const long L0 = (long)i * G + c; if (L0 >= S5G * 4) return false;
        const int L = (int)(L0 % NXCD) * (S5G * 4 / NXCD) + (int)(L0 / NXCD);
        const int g = L >> 2, pml = L & 3;
        u.kind = 0; u.nt = nt; const char* ua = UA + ((size_t)g * S5ROWS + (size_t)pml * BM) * S5K * 2; const char* bm = Bm + (size_t)g * bstride;
        if (swapped) { u.pm = g; u.pn = pml; u.a = bm; u.b = ua; } else { u.pm = 5 * g + pml; u.pn = 0; u.a = ua; u.b = bm; }
        return true;
    }
};
}
#define XB_TMO      128
#define XB_XCNT(j)  (256  + 64 * (j))
#define XB_XSUB(j)  (1280 + 64 * (j))
#define XB_XGEN(j)  (2304 + 64 * (j))
#define XB_TOP      3328
#define XB_TOPGEN   3392
#define XCD_BAR_WORDS 3456
#define XB_SPIN_CAP (1u << 22)

__device__ __forceinline__ unsigned xb_ld(unsigned* p)              { return __hip_atomic_load(p, __ATOMIC_RELAXED, __HIP_MEMORY_SCOPE_AGENT); }
__device__ __forceinline__ unsigned xb_add(unsigned* p, unsigned v) { return __hip_atomic_fetch_add(p, v, __ATOMIC_RELAXED, __HIP_MEMORY_SCOPE_AGENT); }
__device__ __forceinline__ unsigned xb_xcc_id() { return (unsigned)__builtin_amdgcn_s_getreg((3 << 11) | 20) & 0xFu; }
#define XB_SPIN(cond, bar) do { unsigned _sp = 0; while (cond) { __builtin_amdgcn_s_sleep(1); \
    if ((++_sp & 255u) == 0u) { if (xb_ld(&(bar)[XB_TMO])) break; if (_sp > XB_SPIN_CAP) { atomicAdd(&(bar)[XB_TMO], 1u); break; } } } } while (0)

struct XcdBarrier {
    unsigned* bar; unsigned x;
    volatile LAS unsigned* st;
};

__device__ __forceinline__ XcdBarrier xcd_barrier_post(unsigned* bar, volatile LAS unsigned* st) {
    XcdBarrier b; b.bar = bar; b.x = xb_xcc_id(); b.st = st;
    if (threadIdx.x == 0) (void)xb_add(&bar[XB_XCNT(b.x)], 1u);
    return b;
}
__device__ __forceinline__ void xcd_barrier_complete(unsigned* bar, unsigned x, unsigned& nloc, unsigned& nx) {
    const unsigned G = gridDim.x * gridDim.y * gridDim.z;
    unsigned sum, cnt, mine, sp = 0u;
    for (;;) {
        sum = 0u; cnt = 0u; mine = 0u;
#pragma unroll
        for (unsigned j = 0; j < 16; ++j) { const unsigned c = xb_ld(&bar[XB_XCNT(j)]); sum += c; cnt += (c > 0u) ? 1u : 0u; mine = (j == x) ? c : mine; }
        if (sum == G) break;
        __builtin_amdgcn_s_sleep(1);
        if ((++sp & 255u) == 0u) { if (xb_ld(&bar[XB_TMO])) break; if (sp > XB_SPIN_CAP) { atomicAdd(&bar[XB_TMO], 1u); break; } }
    }
    nloc = mine > 0u ? mine : 1u; nx = cnt > 0u ? cnt : 1u;
}

__device__ __forceinline__ void xcd_barrier(const XcdBarrier& b) {
    asm volatile("s_waitcnt vmcnt(0)" ::: "memory");
    __syncthreads();
    if (threadIdx.x == 0) {
        unsigned* bar = b.bar;
        __builtin_amdgcn_s_waitcnt(0);
        unsigned nloc = b.st[0], nx = b.st[1];
        if (nloc == 0u) { xcd_barrier_complete(bar, b.x, nloc, nx); b.st[0] = nloc; b.st[1] = nx; }
        const unsigned old = xb_add(&bar[XB_XSUB(b.x)], 1u);
        const unsigned gen = old / nloc;
        if (old + 1u == (gen + 1u) * nloc) {
            __builtin_amdgcn_fence(__ATOMIC_RELEASE, "agent");
            asm volatile("s_waitcnt vmcnt(0)" ::: "memory");
            const unsigned og = xb_add(&bar[XB_TOP], 1u);
            const unsigned tg = og / nx;
            if (og + 1u == (tg + 1u) * nx) xb_add(&bar[XB_TOPGEN], 1u);
            else XB_SPIN(xb_ld(&bar[XB_TOPGEN]) == tg, bar);
            __builtin_amdgcn_fence(__ATOMIC_ACQUIRE, "agent");
            xb_add(&bar[XB_XGEN(b.x)], 1u);
            asm volatile("s_waitcnt vmcnt(0)" ::: "memory");
        } else {
            XB_SPIN(xb_ld(&bar[XB_XGEN(b.x)]) == gen, bar);
            __builtin_amdgcn_fence(__ATOMIC_ACQUIRE, "agent");
            asm volatile("s_waitcnt vmcnt(0)" ::: "memory");
        }
    }
    __syncthreads();
}

constexpr size_t MiB = 1u << 20;
constexpr size_t WS_CTL = 0, CTL_BYTES = 1 * MiB;
constexpr size_t WS_MOD = 1 * MiB;
constexpr size_t WS_MODP = 2 * MiB;
constexpr size_t WS_TAB = 7 * MiB;
constexpr size_t WS_HID = 8 * MiB;
constexpr size_t WS_LAML = 13 * MiB;
constexpr size_t WS_XC = 14 * MiB;
constexpr size_t WS_FILTC = 18 * MiB;
constexpr size_t WS_FILT = 22 * MiB;
constexpr size_t WS_TT = 150 * MiB;
constexpr size_t WS_WW = 214 * MiB;
constexpr size_t WS_WUP = 246 * MiB;
constexpr size_t WS_WDOWN = 418 * MiB;
constexpr size_t WS_WIN = 504 * MiB;
constexpr size_t WS_WOUT = 540 * MiB;
constexpr size_t WS_WGLU = 556 * MiB;
constexpr size_t WS_HM = 588 * MiB;
constexpr size_t WS_YAB = 654 * MiB;
constexpr size_t WS_Y = 720 * MiB;
constexpr size_t WS_A5 = 852 * MiB;
constexpr size_t WS_U = 1030 * MiB;
constexpr size_t WS_PART = 1385 * MiB;
constexpr size_t WS_END = 1453 * MiB;
constexpr size_t SZ_WUP = (size_t)DFF2 * DM * 2, SZ_WDOWN = (size_t)DM * DFF * 2, SZ_WIN = (size_t)INCOLS * DM * 2, SZ_WOUT = (size_t)DM * DM * 2, SZ_WGLU = (size_t)2 * DM * DM * 2;
constexpr int CW_BAR = 4096;

constexpr int RING_BYTES = 131072, AUX_OFF = 131072, AUX_BYTES = 16384, LDSCTL_OFF = AUX_OFF + AUX_BYTES, LDS_BYTES = LDSCTL_OFF + 512;
constexpr int NWAVES = 8, NTHR = 512;

struct Params { const float* in[33]; float* out; unsigned char* ws; int lo, hi, pad0, pad1; };
struct Frame { LAS unsigned char* lds; int tid, lane, wave, G, bid; };

DI void sincos_rr(float x, float& sn, float& cs) {
    double r = (double)x * 0.15915494309189535; r = r - floor(r); const float rf = (float)r; sn = __builtin_amdgcn_sinf(rf); cs = __builtin_amdgcn_cosf(rf); }
DI float wave_sum(float v) {
#pragma unroll
    for (int o = 1; o < 64; o <<= 1) v += __shfl_xor(v, o);
    return v;
}
DI float block_sum(const Frame& F, float v, LAS float* red) {
    v = wave_sum(v);
    __syncthreads();
    if (F.lane == 0) red[F.wave] = v;
    __syncthreads();
    float t = 0.f;
#pragma unroll
    for (int i = 0; i < NWAVES; ++i) t += red[i];
    return t;
}

DI void transpose_item(const Frame& F, const float* W, int K, int N, bf16* WT, int item, int mode) {
    const int nb = N >> 7; const int kb = item / nb, nbk = item - kb * nb; const int k0 = kb * 64, n0 = nbk * 128;
    LAS unsigned short* tile = (LAS unsigned short*)F.lds;
    const int tn = (F.tid & 31) * 4, tk = (F.tid >> 5) * 4;
    const int nd = n0 + tn; int ns = nd;
    if (mode == 2) { const int tile = nd >> 8, pp = nd & 255; ns = ((pp >> 2) & 1) * DFF + 128 * tile + 4 * (pp >> 3); }
    if (mode == 1 && nd < 1280) { const int d = nd & 127, gi = d >> 3, n = (d >> 2) & 1; ns = (nd & ~127) + ((gi < 8) ? 0 : 64) + 32 * n + 4 * (gi & 7); }
    f32x4 v[4];
#pragma unroll
    for (int i = 0; i < 4; ++i) v[i] = *(const f32x4*)(W + (size_t)(k0 + tk + i) * N + ns);
#pragma unroll
    for (int e = 0; e < 4; ++e) { u32x2 w; w.x = pk2(v[0][e], v[1][e]); w.y = pk2(v[2][e], v[3][e]); *(LAS u32x2*)(tile + (tn + e) * 72 + tk) = w; }
    __syncthreads();
#pragma unroll
    for (int i = 0; i < 2; ++i) { const int p = F.tid + 512 * i, n = p >> 3, kc = p & 7;
        const u32x4 w = *(const LAS u32x4*)(tile + n * 72 + kc * 8);
        *(u32x4*)(WT + (size_t)(n0 + n) * K + k0 + kc * 8) = w; }
    __syncthreads();
}
DI void modp_unit(const Frame& F, const Params& P, int u) {
    const int cb = u % 24, lk = u / 24, kc = lk & 7, l = lk >> 3;
    LAS float* sv = (LAS float*)F.lds;
    for (int i = F.tid; i < 768; i += NTHR) { const int r = i >> 8, k = i & 255, kk = kc * 256 + k; const float v = (r < 2) ? P.in[1][r * DM + kk] : P.in[3][kk]; sv[i] = v / (1.0f + expf(-v)); }
    __syncthreads();
    const int j = cb * 512 + F.tid; const float* w = P.in[4] + ((size_t)l * DM + kc * 256) * (NMOD * DM) + j;
    float a0 = 0.f, a1 = 0.f, a2 = 0.f;
#pragma unroll 1
    for (int k0 = 0; k0 < 256; k0 += 32) { float wv[32];
#pragma unroll
        for (int k = 0; k < 32; ++k) wv[k] = __builtin_nontemporal_load(w + (size_t)(k0 + k) * (NMOD * DM));
#pragma unroll
        for (int k = 0; k < 32; ++k) { a0 += sv[k0 + k] * wv[k]; a1 += sv[256 + k0 + k] * wv[k]; a2 += sv[512 + k0 + k] * wv[k]; } }
    float* mp = (float*)(P.ws + WS_MODP) + (size_t)(l * 8 + kc) * 3 * (NMOD * DM) + j;
    mp[0] = a0; mp[NMOD * DM] = a1; mp[2 * NMOD * DM] = a2;
    __syncthreads();
}
DI void hid_unit(const Frame& F, const Params& P, int u) {
    int l, n, tb; float* dst;
    if (u < 256) { l = u >> 7; n = SEQ; tb = u & 127; dst = (float*)(P.ws + WS_HID) + (size_t)l * SEQ * 64; }
    else { const int v = u - 256; l = v >> 2; n = CTXL; tb = v & 3; dst = (float*)(P.ws + WS_HID + 4 * MiB) + (size_t)l * CTXL * 64; }
    LAS float* zs = (LAS float*)F.lds; LAS float* h1 = zs + 64 * 33;
    const int pos0 = tb * 64;
    const float wstep = 6.283185307179586f / (float)n;
    for (int i = F.tid; i < 64 * 33; i += NTHR) { const int pos = i / 33, k = i - pos * 33; const int ti = pos0 + pos; float val;
        if (k == 0) val = (float)ti / (float)(n - 1);
        else { const int kb = (k - 1) & 15; const float band = 1e-4f + (float)kb * ((15.0f - 1e-4f) / 15.0f); const float ang = (wstep * (float)ti) * band; float sn, cs; sincos_rr(ang, sn, cs); val = (k <= 16) ? cs : -sn; }
        zs[i] = val; }
    __syncthreads();
    const int pos = F.tid >> 3, h0 = (F.tid & 7) * 8;
    const float* w1 = P.in[16] + (size_t)l * 33 * 64; const float* b1 = P.in[17] + l * 64; const float* w2 = P.in[18] + (size_t)l * 64 * 64; const float* b2 = P.in[19] + l * 64; const float* fr = P.in[21] + l * 64;
    float acc[8];
#pragma unroll
    for (int e = 0; e < 8; ++e) acc[e] = b1[h0 + e];
#pragma unroll 1
    for (int k = 0; k < 33; ++k) { const float zv = zs[pos * 33 + k];
#pragma unroll
        for (int e = 0; e < 8; ++e) acc[e] += zv * w1[k * 64 + h0 + e]; }
#pragma unroll
    for (int e = 0; e < 8; ++e) { float sn, cs; sincos_rr(fr[h0 + e] * acc[e], sn, cs); h1[pos * 65 + h0 + e] = sn; }
    __syncthreads();
#pragma unroll
    for (int e = 0; e < 8; ++e) acc[e] = b2[h0 + e];
#pragma unroll 1
    for (int k = 0; k < 64; ++k) { const float hv = h1[pos * 65 + k];
#pragma unroll
        for (int e = 0; e < 8; ++e) acc[e] += hv * w2[k * 64 + h0 + e]; }
#pragma unroll
    for (int e = 0; e < 8; ++e) { float sn, cs; sincos_rr(fr[h0 + e] * acc[e], sn, cs); dst[(size_t)(pos0 + pos) * 64 + h0 + e] = sn; }
    __syncthreads();
}
DI void tab_unit(const Frame& F, const Params& P) {
    float* tab = (float*)(P.ws + WS_TAB);
    for (int i = F.tid; i < 4096; i += NTHR) { const int pos = i >> 5, f = i & 31; const float inv = exp2f(-(float)(2 * f) * (13.287712379549449f / 64.0f)); const float ang = (float)pos * inv; float sn, cs; sincos_rr(ang, sn, cs); tab[2 * i] = cs; tab[2 * i + 1] = sn; }
}
DI void s5_unit(const Frame& F, const Params& P, int u) {
    const int jo = u >> 7, g = u & 127;
    LAS float* pw = (LAS float*)F.lds;
    LAS float* bb = pw + 2 * 64 * 17 * 2;
    LAS float* cc = bb + 2 * 64 * 16 * 2;
    LAS float* Kt = cc + 2 * 16 * 64 * 2;
    if (F.tid < 128) { const int dir = F.tid >> 6, p = F.tid & 63; const int gi = ((jo * 2 + dir) * S5G + g);
        const float lr = P.in[23][(size_t)gi * 64 + p], li = P.in[24][(size_t)gi * 64 + p]; const float st = expf(P.in[25][gi]);
        float pr1 = 1.f, pi1 = 0.f;
        for (int d = 0; d <= 16; ++d) { const float a = lr * st * (float)d, b = li * st * (float)d; const float mag = expf(a); float sn, cs; sincos_rr(b, sn, cs);
            pw[((dir * 64 + p) * 17 + d) * 2] = mag * cs; pw[((dir * 64 + p) * 17 + d) * 2 + 1] = mag * sn; if (d == 1) { pr1 = mag * cs; pi1 = mag * sn; } }
        float* lamL = (float*)(P.ws + WS_LAML) + ((size_t)gi * 64 + p) * 2; lamL[0] = pw[((dir * 64 + p) * 17 + 16) * 2]; lamL[1] = pw[((dir * 64 + p) * 17 + 16) * 2 + 1];
        const float den = 1.0f / (lr * lr + li * li); const float nr = pr1 - 1.0f, ni = pi1; const float qr = (nr * lr + ni * li) * den, qi = (ni * lr - nr * li) * den;
        for (int j = 0; j < 16; ++j) { const float br = P.in[26][((size_t)gi * 64 + p) * 16 + j], bi = P.in[27][((size_t)gi * 64 + p) * 16 + j];
            bb[((dir * 64 + p) * 16 + j) * 2] = qr * br - qi * bi; bb[((dir * 64 + p) * 16 + j) * 2 + 1] = qr * bi + qi * br; } }
    for (int i = F.tid; i < 2048; i += NTHR) { const int dir = i >> 10, j = (i >> 6) & 15, p = i & 63; const size_t si = (((size_t)(jo * 2 + dir) * S5G + g) * 16 + j) * 64 + p;
        cc[i * 2] = P.in[28][si]; cc[i * 2 + 1] = P.in[29][si]; }
    __syncthreads();
    { const int dir = F.tid >> 8, d = (F.tid >> 4) & 15, j = F.tid & 15; float s16[16];
#pragma unroll
        for (int jp = 0; jp < 16; ++jp) s16[jp] = 0.f;
#pragma unroll 2
        for (int p = 0; p < 64; ++p) { const float cr = cc[((dir * 16 + j) * 64 + p) * 2], ci = cc[((dir * 16 + j) * 64 + p) * 2 + 1];
            const float wr_ = pw[((dir * 64 + p) * 17 + d) * 2], wi_ = pw[((dir * 64 + p) * 17 + d) * 2 + 1];
            const float xr = cr * wr_ - ci * wi_, xi = cr * wi_ + ci * wr_;
#pragma unroll
            for (int jp = 0; jp < 16; ++jp) s16[jp] += xr * bb[((dir * 64 + p) * 16 + jp) * 2] - xi * bb[((dir * 64 + p) * 16 + jp) * 2 + 1]; }
#pragma unroll
        for (int jp = 0; jp < 16; ++jp) Kt[((dir * 16 + d) * 16 + j) * 16 + jp] = s16[jp]; }
    __syncthreads();
    bf16* TT = (bf16*)(P.ws + WS_TT) + ((size_t)(jo * S5G + g) * 256) * 512;
    const float* dv = P.in[30] + (size_t)jo * DM + g * 16;
    for (int q = F.tid; q < 256 * 64; q += NTHR) { const int row = q >> 6, k0 = (q & 63) * 8; const int t = row >> 4, j = row & 15; float v[8];
        if (k0 < 256) { const int s = k0 >> 4, jp0 = k0 & 15;
#pragma unroll
            for (int e = 0; e < 8; ++e) { float x = 0.f; if (s <= t) x += Kt[((0 * 16 + (t - s)) * 16 + j) * 16 + jp0 + e]; if (s >= t) x += Kt[((1 * 16 + (s - t)) * 16 + j) * 16 + jp0 + e];
                if (s == t && j == jp0 + e) x += dv[j]; v[e] = x; } }
        else { const int region = (k0 - 256) >> 6, p0 = (k0 - 256) & 63, dir = region >> 1, pwr = dir == 0 ? t + 1 : 16 - t;
#pragma unroll
            for (int e = 0; e < 8; ++e) { const int p = p0 + e; const float cr = cc[((dir * 16 + j) * 64 + p) * 2], ci = cc[((dir * 16 + j) * 64 + p) * 2 + 1];
                const float wr_ = pw[((dir * 64 + p) * 17 + pwr) * 2], wi_ = pw[((dir * 64 + p) * 17 + pwr) * 2 + 1];
                v[e] = (region & 1) ? -(cr * wi_ + ci * wr_) : (cr * wr_ - ci * wi_); } }
        u32x4 w; w.x = pk2(v[0], v[1]); w.y = pk2(v[2], v[3]); w.z = pk2(v[4], v[5]); w.w = pk2(v[6], v[7]);
        *(u32x4*)(TT + (size_t)row * 512 + k0) = w; }
    bf16* WW = (bf16*)(P.ws + WS_WW) + ((size_t)(jo * S5G + g) * 256) * 256;
    for (int q = F.tid; q < 256 * 32; q += NTHR) { const int row = q >> 5, k0 = (q & 31) * 8; const int s = k0 >> 4, jp0 = k0 & 15; const int region = row >> 6, p = row & 63, dir = region >> 1, pwr = dir == 0 ? 15 - s : s; float v[8];
        const float wr_ = pw[((dir * 64 + p) * 17 + pwr) * 2], wi_ = pw[((dir * 64 + p) * 17 + pwr) * 2 + 1];
#pragma unroll
        for (int e = 0; e < 8; ++e) { const float br = bb[((dir * 64 + p) * 16 + jp0 + e) * 2], bi = bb[((dir * 64 + p) * 16 + jp0 + e) * 2 + 1];
            v[e] = (region & 1) ? (wr_ * bi + wi_ * br) : (wr_ * br - wi_ * bi); }
        u32x4 w; w.x = pk2(v[0], v[1]); w.y = pk2(v[2], v[3]); w.z = pk2(v[4], v[5]); w.w = pk2(v[6], v[7]);
        *(u32x4*)(WW + (size_t)row * 256 + k0) = w; }
    __syncthreads();
}
DI void p0_prologue(const Frame& F, const Params& P) {
    constexpr int IT_UP = (DM / 64) * (DFF2 / 128), IT_DOWN = (DFF / 64) * (DM / 128), IT_IN = (DM / 64) * (INCOLS / 128), IT_OUT = (DM / 64) * (DM / 128), IT_GLU = (DM / 64) * (2 * DM / 128);
    constexpr int NT = 4 * (IT_UP + IT_DOWN) + 2 * (IT_IN + IT_OUT + IT_GLU);
    constexpr int N_S5 = 256, N_MODP = 768, N_HID = 264;
    constexpr int TOTAL = N_S5 + N_MODP + N_HID + 1 + NT;
    for (int it = F.bid; it < TOTAL; it += F.G) {
        int r = it;
        if (r < N_S5) { s5_unit(F, P, r); continue; } r -= N_S5;
        if (r < N_MODP) { modp_unit(F, P, r); continue; } r -= N_MODP;
        if (r < N_HID) { hid_unit(F, P, r); continue; } r -= N_HID;
        if (r < 1) { tab_unit(F, P); continue; } r -= 1;
        if (r < 4 * (IT_UP + IT_DOWN)) { const int l = r / (IT_UP + IT_DOWN); r -= l * (IT_UP + IT_DOWN);
            if (r < IT_UP) transpose_item(F, P.in[7] + (size_t)l * DM * DFF2, DM, DFF2, (bf16*)(P.ws + WS_WUP + l * SZ_WUP), r, 2);
            else transpose_item(F, P.in[10] + (size_t)l * DFF * DM, DFF, DM, (bf16*)(P.ws + WS_WDOWN + l * SZ_WDOWN), r - IT_UP, 0);
            continue; }
        r -= 4 * (IT_UP + IT_DOWN);
        { const int j = r / (IT_IN + IT_OUT + IT_GLU); r -= j * (IT_IN + IT_OUT + IT_GLU);
            if (r < IT_IN) transpose_item(F, P.in[11] + (size_t)j * DM * INCOLS, DM, INCOLS, (bf16*)(P.ws + WS_WIN + j * SZ_WIN), r, 1);
            else if (r < IT_IN + IT_OUT) transpose_item(F, P.in[12] + (size_t)j * DM * DM, DM, DM, (bf16*)(P.ws + WS_WOUT + j * SZ_WOUT), r - IT_IN, 0);
            else transpose_item(F, P.in[31] + (size_t)j * DM * 2 * DM, DM, 2 * DM, (bf16*)(P.ws + WS_WGLU + j * SZ_WGLU), r - IT_IN - IT_OUT, 0); }
    }
}
DI void filt_unit(const Frame& F, const Params& P, int u) {
    int l, n, tb, ct; const float* hid; bf16* dst;
    if (u < 2048) { l = u >> 10; tb = (u >> 3) & 127; ct = u & 7; n = SEQ; hid = (const float*)(P.ws + WS_HID) + (size_t)l * SEQ * 64; dst = (bf16*)(P.ws + WS_FILT) + (size_t)l * 2 * 1024 * SEQ; }
    else { const int v = u - 2048; l = v >> 5; tb = (v >> 3) & 3; ct = v & 7; n = CTXL; hid = (const float*)(P.ws + WS_HID + 4 * MiB) + (size_t)l * CTXL * 64; dst = (bf16*)(P.ws + WS_FILTC) + (size_t)l * 2 * 1024 * CTXL; }
    LAS unsigned short* hsb = (LAS unsigned short*)F.lds;
    LAS unsigned short* w3t = hsb + 64 * 72;
    const int t0 = tb * 64;
    { const int pos = F.tid >> 3, k8 = (F.tid & 7) * 8; const f32x4 a = *(const f32x4*)(hid + (size_t)(t0 + pos) * 64 + k8), bq = *(const f32x4*)(hid + (size_t)(t0 + pos) * 64 + k8 + 4);
        u32x4 w; w.x = pk2(a[0], a[1]); w.y = pk2(a[2], a[3]); w.z = pk2(bq[0], bq[1]); w.w = pk2(bq[2], bq[3]); *(LAS u32x4*)(hsb + pos * 72 + k8) = w; }
    const float* w3 = P.in[20] + (size_t)l * 64 * 2048;
    { const int c4 = (F.tid & 63) * 4, k4 = (F.tid >> 6) * 4;
#pragma unroll
        for (int half = 0; half < 2; ++half) { f32x4 v[4];
#pragma unroll
            for (int i = 0; i < 4; ++i) v[i] = *(const f32x4*)(w3 + (size_t)(32 * half + k4 + i) * 2048 + ct * 256 + c4);
#pragma unroll
            for (int e = 0; e < 4; ++e) { u32x2 w; w.x = pk2(v[0][e], v[1][e]); w.y = pk2(v[2][e], v[3][e]); *(LAS u32x2*)(w3t + (c4 + e) * 72 + 32 * half + k4) = w; } } }
    __syncthreads();
    const int r = F.lane & 31, h = F.lane >> 5;
    f32x16 acc[2];
#pragma unroll
    for (int nt = 0; nt < 2; ++nt)
#pragma unroll
        for (int i = 0; i < 16; ++i) acc[nt][i] = 0.f;
#pragma unroll
    for (int s = 0; s < 4; ++s) { const bf16x8 a = *(const LAS bf16x8*)(w3t + (32 * F.wave + r) * 72 + 16 * s + 8 * h);
#pragma unroll
        for (int nt = 0; nt < 2; ++nt) { const bf16x8 bq = *(const LAS bf16x8*)(hsb + (nt * 32 + r) * 72 + 16 * s + 8 * h); acc[nt] = __builtin_amdgcn_mfma_f32_32x32x16_bf16(a, bq, acc[nt], 0, 0, 0); } }
#pragma unroll
    for (int nt = 0; nt < 2; ++nt) { const int t = t0 + nt * 32 + r; const float tt = (float)t / (float)(n - 1);
#pragma unroll
        for (int i = 0; i < 16; ++i) { const int col = ct * 256 + 32 * F.wave + (i & 3) + 8 * (i >> 2) + 4 * h, dir = col >> 10, c = col & 1023;
            const float delta = 3.0701134573253945f + (float)c * (12.280453829301578f / 1023.0f);
            dst[((size_t)(dir * 1024 + c)) * n + t] = (bf16)f2bf(acc[nt][i] * fast_exp(-tt * delta)); } }
    __syncthreads();
}
DI void p1_phase(const Frame& F, const Params& P) {
    for (int u = F.bid; u < 2048 + 64; u += F.G) filt_unit(F, P, u);
    const float* mp = (const float*)(P.ws + WS_MODP); float* mo = (float*)(P.ws + WS_MOD);
    for (int i = F.bid * NTHR + F.tid; i < DEPTH * 3 * NMOD * DM; i += F.G * NTHR) { const int j = i % (NMOD * DM), lr = i / (NMOD * DM), l = lr / 3, r = lr - 3 * l;
        float s = P.in[5][(size_t)l * NMOD * DM + j];
#pragma unroll
        for (int kc = 0; kc < 8; ++kc) s += mp[((size_t)(l * 8 + kc) * 3 + r) * (NMOD * DM) + j];
        mo[i] = s; }
}
typedef short v4i16_t __attribute__((ext_vector_type(4)));
DI s16x4 vtr(const LAS unsigned char* p) { return __builtin_bit_cast(s16x4, __builtin_amdgcn_ds_read_tr16_b64_v4i16((LAS v4i16_t*)p)); }
DI void ld8f(const float* p, float (&v)[8]) { const f32x4 a = *(const f32x4*)p, b = *(const f32x4*)(p + 4); v[0] = a[0]; v[1] = a[1]; v[2] = a[2]; v[3] = a[3]; v[4] = b[0]; v[5] = b[1]; v[6] = b[2]; v[7] = b[3]; }
DI void st8f(float* p, const float (&v)[8]) { *(f32x4*)p = (f32x4){v[0], v[1], v[2], v[3]}; *(f32x4*)(p + 4) = (f32x4){v[4], v[5], v[6], v[7]}; }
DI void ld8b(const bf16* p, float (&v)[8]) { const u32x4 w = *(const u32x4*)p; v[0] = bflo(w.x); v[1] = bfhi(w.x); v[2] = bflo(w.y); v[3] = bfhi(w.y); v[4] = bflo(w.z); v[5] = bfhi(w.z); v[6] = bflo(w.w); v[7] = bfhi(w.w); }
template <int SRC>
DI void row_phase(const Frame& F, const bf16* ysrc, const float* part, int nparts, int nrows, const float* xin_lat, const float* xin_ctx, float* xout_lat, float* xout_ctx,
                  const float* gA, const float* modA, int mA, bool do_mod, const float* gB, const float* modB, int shiftc, int scalec, bf16* HM, bf16* UA) {
    const int gw = F.bid * NWAVES + F.wave, NGW = F.G * NWAVES;
    constexpr int LDY = (SRC == 2) ? 2 * DM : DM;
    for (int r = gw; r < nrows; r += NGW) {
        const int set = r < SEQ ? 0 : (r < NLAT ? 1 : 2);
        const float* xr = r < NLAT ? xin_lat + (size_t)r * DM : xin_ctx + (size_t)(r - NLAT) * DM;
        float x[4][8];
#pragma unroll
        for (int j = 0; j < 4; ++j) ld8f(xr + 8 * F.lane + 512 * j, x[j]);
        if (SRC != 0) {
            float y[4][8];
            if (r >= NLAT && nparts > 0) {
#pragma unroll
                for (int j = 0; j < 4; ++j)
#pragma unroll
                    for (int e = 0; e < 8; ++e) y[j][e] = 0.f;
                float g[4][8];
                if (SRC == 2) {
#pragma unroll
                    for (int j = 0; j < 4; ++j)
#pragma unroll
                        for (int e = 0; e < 8; ++e) g[j][e] = 0.f; }
#pragma unroll 1
                for (int k = 0; k < nparts; ++k) { const float* pr = part + ((size_t)k * NCTX + (r - NLAT)) * LDY + 8 * F.lane;
#pragma unroll
                    for (int j = 0; j < 4; ++j) { float t[8]; ld8f(pr + 512 * j, t);
#pragma unroll
                        for (int e = 0; e < 8; ++e) y[j][e] += t[e];
                        if (SRC == 2) { ld8f(pr + DM + 512 * j, t);
#pragma unroll
                            for (int e = 0; e < 8; ++e) g[j][e] += t[e]; } } }
                if (SRC == 2) {
#pragma unroll
                    for (int j = 0; j < 4; ++j)
#pragma unroll
                        for (int e = 0; e < 8; ++e) y[j][e] *= sigmoidf_(g[j][e]); }
            } else {
                const bf16* yr = ysrc + (size_t)r * LDY + 8 * F.lane;
#pragma unroll
                for (int j = 0; j < 4; ++j) ld8b(yr + 512 * j, y[j]);
                if (SRC == 2) {
#pragma unroll
                    for (int j = 0; j < 4; ++j) { float t[8]; ld8b(yr + DM + 512 * j, t);
#pragma unroll
                        for (int e = 0; e < 8; ++e) y[j][e] *= sigmoidf_(t[e]); } }
            }
            float ss = 0.f;
#pragma unroll
            for (int j = 0; j < 4; ++j)
#pragma unroll
                for (int e = 0; e < 8; ++e) ss += y[j][e] * y[j][e];
            ss = wave_sum(ss);
            const float rs = __builtin_amdgcn_rsqf(ss * (1.0f / DM) + RMS_EPS);
            const float* mm = modA + (size_t)set * (NMOD * DM) + mA * DM;
            float* xo = r < NLAT ? xout_lat + (size_t)r * DM : xout_ctx + (size_t)(r - NLAT) * DM;
#pragma unroll
            for (int j = 0; j < 4; ++j) { const int c = 8 * F.lane + 512 * j; float ga[8], mv[8]; ld8f(gA + c, ga); ld8f(mm + c, mv);
#pragma unroll
                for (int e = 0; e < 8; ++e) x[j][e] += mv[e] * (y[j][e] * rs * ga[e]);
                st8f(xo + c, x[j]); }
        }
        if (do_mod) {
            float ss = 0.f;
#pragma unroll
            for (int j = 0; j < 4; ++j)
#pragma unroll
                for (int e = 0; e < 8; ++e) ss += x[j][e] * x[j][e];
            ss = wave_sum(ss);
            const float rs = __builtin_amdgcn_rsqf(ss * (1.0f / DM) + RMS_EPS);
            const float* mb = modB + (size_t)set * (NMOD * DM);
            bf16* hr = HM + (size_t)r * DM;
            int cr = 0; if (UA) cr = r < NLAT ? ((r >> 13) * 512 + ((r & (SEQ - 1)) >> 4)) : (1024 + ((r - NLAT) >> 4));
#pragma unroll
            for (int j = 0; j < 4; ++j) { const int c = 8 * F.lane + 512 * j; float gb[8], sc[8], sh[8]; ld8f(gB + c, gb); ld8f(mb + scalec * DM + c, sc); ld8f(mb + shiftc * DM + c, sh);
                float h[8];
#pragma unroll
                for (int e = 0; e < 8; ++e) h[e] = (x[j][e] * rs * gb[e]) * (sc[e] + 1.0f) + sh[e];
                u32x4 w; w.x = pk2(h[0], h[1]); w.y = pk2(h[2], h[3]); w.z = pk2(h[4], h[5]); w.w = pk2(h[6], h[7]);
                if (HM) *(u32x4*)(hr + c) = w;
                if (UA) *(u32x4*)(UA + ((size_t)(c >> 4) * S5ROWS + cr) * S5K + (r & 15) * 16 + (c & 15)) = w; }
        }
    }
}
DI void load8(const bf16* p, float (&v)[8]) { const u32x4 w = *(const u32x4*)p; v[0] = bflo(w.x); v[1] = bfhi(w.x); v[2] = bflo(w.y); v[3] = bfhi(w.y); v[4] = bflo(w.z); v[5] = bfhi(w.z); v[6] = bflo(w.w); v[7] = bfhi(w.w); }
DI void convglu_phase(const Frame& F, const bf16* U, bf16* A5, const float* cw, const float* cb, int nrows) {
    const int gw = F.bid * NWAVES + F.wave, NGW = F.G * NWAVES;
    constexpr int NCC = 11; const int NRC = nrows / 32;
    for (int wu = gw; wu < NRC * NCC; wu += NGW) {
        const int cc = wu % NCC, rc = wu / NCC; const int c0 = cc * 512 + F.lane * 8; const int r0 = rc * 32;
        if (c0 < DFF) {
            float wg[3][8], wv[3][8], bg[8], bv[8];
#pragma unroll
            for (int k = 0; k < 3; ++k)
#pragma unroll
                for (int e = 0; e < 8; ++e) { wg[k][e] = cw[(size_t)k * DFF2 + c0 + e]; wv[k][e] = cw[(size_t)k * DFF2 + DFF + c0 + e]; }
#pragma unroll
            for (int e = 0; e < 8; ++e) { bg[e] = cb[c0 + e]; bv[e] = cb[DFF + c0 + e]; }
            const int seqlen = r0 < NLAT ? SEQ : CTXL; const int rs0 = r0 < NLAT ? (r0 & (SEQ - 1)) : ((r0 - NLAT) & (CTXL - 1));
            float pg[8], pv[8], cg[8], cv[8], ng[8], nv[8];
            if (rs0 > 0) { load8(U + (size_t)(r0 - 1) * DFF2 + c0, pg); load8(U + (size_t)(r0 - 1) * DFF2 + DFF + c0, pv); }
            else {
#pragma unroll
                for (int e = 0; e < 8; ++e) { pg[e] = 0.f; pv[e] = 0.f; } }
            load8(U + (size_t)r0 * DFF2 + c0, cg); load8(U + (size_t)r0 * DFF2 + DFF + c0, cv);
            for (int i = 0; i < 32; ++i) { const int r = r0 + i;
                if (rs0 + i + 1 < seqlen) { load8(U + (size_t)(r + 1) * DFF2 + c0, ng); load8(U + (size_t)(r + 1) * DFF2 + DFF + c0, nv); }
                else {
#pragma unroll
                    for (int e = 0; e < 8; ++e) { ng[e] = 0.f; nv[e] = 0.f; } }
                float o[8];
#pragma unroll
                for (int e = 0; e < 8; ++e) { const float g = pg[e] * wg[0][e] + cg[e] * wg[1][e] + ng[e] * wg[2][e] + bg[e]; const float v = pv[e] * wv[0][e] + cv[e] * wv[1][e] + nv[e] * wv[2][e] + bv[e]; o[e] = siluf_(g) * v; }
                u32x4 w; w.x = pk2(o[0], o[1]); w.y = pk2(o[2], o[3]); w.z = pk2(o[4], o[5]); w.w = pk2(o[6], o[7]);
                *(u32x4*)(A5 + (size_t)r * DFF + c0) = w;
#pragma unroll
                for (int e = 0; e < 8; ++e) { pg[e] = cg[e]; pv[e] = cv[e]; cg[e] = ng[e]; cv[e] = nv[e]; } }
        }
    }
}
#define ZP(i) ((i) + ((i) >> 4))
DI f32x2 cmul(f32x2 a, f32x2 b) { return (f32x2){a[0] * b[0] - a[1] * b[1], a[0] * b[1] + a[1] * b[0]}; }
DI f32x2 cmulc(f32x2 a, f32x2 b) { return (f32x2){a[0] * b[0] + a[1] * b[1], a[1] * b[0] - a[0] * b[1]}; }
DI f32x2 mulmi(f32x2 a) { return (f32x2){a[1], -a[0]}; }
DI f32x2 mulpi(f32x2 a) { return (f32x2){-a[1], a[0]}; }
#define BFLY_F(x0, x1, x2, x3, y0, y1, y2, y3) do { const f32x2 t0_ = (x0) + (x2), t1_ = (x0) - (x2), t2_ = (x1) + (x3), t3_ = mulmi((x1) - (x3)); y0 = t0_ + t2_; y1 = t1_ + t3_; y2 = t0_ - t2_; y3 = t1_ - t3_; } while (0)
#define BFLY_I(x0, x1, x2, x3, y0, y1, y2, y3) do { const f32x2 t0_ = (x0) + (x2), t1_ = (x0) - (x2), t2_ = (x1) + (x3), t3_ = mulpi((x1) - (x3)); y0 = t0_ + t2_; y1 = t1_ + t3_; y2 = t0_ - t2_; y3 = t1_ - t3_; } while (0)
#define W16_1 ((f32x2){0.92387953251128674f, -0.38268343236508977f})
#define W16_2 ((f32x2){0.70710678118654752f, -0.70710678118654752f})
#define W16_3 ((f32x2){0.38268343236508977f, -0.92387953251128674f})
#define W16_6 ((f32x2){-0.70710678118654752f, -0.70710678118654752f})
#define W16_9 ((f32x2){-0.92387953251128674f, 0.38268343236508977f})
template <int Q2> DI void fft_pass16_fwd(const Frame& F, LAS f32x2* Z) {
    constexpr int L = 16 * Q2, ST = Q2 >= 16 ? Q2 + Q2 / 16 : Q2; constexpr float invL = 1.0f / (float)L;
#pragma unroll 1
    for (int g = F.tid; g < 1024; g += NTHR) { const int j = g & (Q2 - 1), base = ((g - j) << 4) + j;
        LAS f32x2* zp = Z + ZP(base);
        f32x2 x[16];
#pragma unroll
        for (int m = 0; m < 16; ++m) x[m] = zp[m * ST];
        const float rev = (float)j * invL; const f32x2 t1 = {__builtin_amdgcn_cosf(rev), -__builtin_amdgcn_sinf(rev)};
        const f32x2 t2 = cmul(t1, t1), t3 = cmul(t2, t1), t4 = cmul(t2, t2), t8 = cmul(t4, t4), t12 = cmul(t8, t4);
        BFLY_F(x[0], x[4], x[8], x[12], x[0], x[4], x[8], x[12]);          x[4] = cmul(x[4], t1); x[8] = cmul(x[8], t2); x[12] = cmul(x[12], t3);
        BFLY_F(x[1], x[5], x[9], x[13], x[1], x[5], x[9], x[13]);          x[5] = cmul(cmul(x[5], W16_1), t1); x[9] = cmul(cmul(x[9], W16_2), t2); x[13] = cmul(cmul(x[13], W16_3), t3);
        BFLY_F(x[2], x[6], x[10], x[14], x[2], x[6], x[10], x[14]);        x[6] = cmul(cmul(x[6], W16_2), t1); x[10] = cmul(mulmi(x[10]), t2); x[14] = cmul(cmul(x[14], W16_6), t3);
        BFLY_F(x[3], x[7], x[11], x[15], x[3], x[7], x[11], x[15]);        x[7] = cmul(cmul(x[7], W16_3), t1); x[11] = cmul(cmul(x[11], W16_6), t2); x[15] = cmul(cmul(x[15], W16_9), t3);
#pragma unroll
        for (int ap = 0; ap < 4; ++ap) { f32x2 z0, z1, z2, z3; BFLY_F(x[4 * ap], x[4 * ap + 1], x[4 * ap + 2], x[4 * ap + 3], z0, z1, z2, z3);
            zp[(4 * ap) * ST] = z0; zp[(4 * ap + 1) * ST] = cmul(z1, t4); zp[(4 * ap + 2) * ST] = cmul(z2, t8); zp[(4 * ap + 3) * ST] = cmul(z3, t12); } }
    __syncthreads();
}
template <int Q2> DI void fft_pass16_inv(const Frame& F, LAS f32x2* Z) {
    constexpr int L = 16 * Q2, ST = Q2 >= 16 ? Q2 + Q2 / 16 : Q2; constexpr float invL = 1.0f / (float)L;
#pragma unroll 1
    for (int g = F.tid; g < 1024; g += NTHR) { const int j = g & (Q2 - 1), base = ((g - j) << 4) + j;
        LAS f32x2* zp = Z + ZP(base);
        f32x2 v[16];
#pragma unroll
        for (int m = 0; m < 16; ++m) v[m] = zp[m * ST];
        const float rev = (float)j * invL; const f32x2 t1 = {__builtin_amdgcn_cosf(rev), -__builtin_amdgcn_sinf(rev)};
        const f32x2 t2 = cmul(t1, t1), t3 = cmul(t2, t1), t4 = cmul(t2, t2), t8 = cmul(t4, t4), t12 = cmul(t8, t4);
#pragma unroll
        for (int ap = 0; ap < 4; ++ap) BFLY_I(v[4 * ap], cmulc(v[4 * ap + 1], t4), cmulc(v[4 * ap + 2], t8), cmulc(v[4 * ap + 3], t12), v[4 * ap], v[4 * ap + 1], v[4 * ap + 2], v[4 * ap + 3]);
        f32x2 o0, o1, o2, o3;
        BFLY_I(v[0], cmulc(v[4], t1), cmulc(v[8], t2), cmulc(v[12], t3), o0, o1, o2, o3);
        zp[0] = o0; zp[4 * ST] = o1; zp[8 * ST] = o2; zp[12 * ST] = o3;
        BFLY_I(v[1], cmulc(cmulc(v[5], t1), W16_1), cmulc(cmulc(v[9], t2), W16_2), cmulc(cmulc(v[13], t3), W16_3), o0, o1, o2, o3);
        zp[ST] = o0; zp[5 * ST] = o1; zp[9 * ST] = o2; zp[13 * ST] = o3;
        BFLY_I(v[2], cmulc(cmulc(v[6], t1), W16_2), mulpi(cmulc(v[10], t2)), cmulc(cmulc(v[14], t3), W16_6), o0, o1, o2, o3);
        zp[2 * ST] = o0; zp[6 * ST] = o1; zp[10 * ST] = o2; zp[14 * ST] = o3;
        BFLY_I(v[3], cmulc(cmulc(v[7], t1), W16_3), cmulc(cmulc(v[11], t2), W16_6), cmulc(cmulc(v[15], t3), W16_9), o0, o1, o2, o3);
        zp[3 * ST] = o0; zp[7 * ST] = o1; zp[11 * ST] = o2; zp[15 * ST] = o3; }
    __syncthreads();
}
DI void fft_fwd(const Frame& F0, LAS f32x2* Z) {
    Frame F = F0; { int t_ = F0.tid; asm volatile("" : "+v"(t_)); F.tid = t_; }
#pragma unroll 2
    for (int u = F.tid; u < 4096; u += NTHR) { const int j = u; LAS f32x2* zp = Z + ZP(j);
        const f32x2 a0 = zp[0], a1 = zp[4352], a2 = zp[8704], a3 = zp[13056];
        f32x2 y0, y1, y2, y3; BFLY_F(a0, a1, a2, a3, y0, y1, y2, y3);
        const float rev = (float)j * (1.0f / 16384.0f); const f32x2 w1 = {__builtin_amdgcn_cosf(rev), -__builtin_amdgcn_sinf(rev)}; const f32x2 w2 = cmul(w1, w1), w3 = cmul(w2, w1);
        zp[0] = y0; zp[4352] = cmul(y1, w1); zp[8704] = cmul(y2, w2); zp[13056] = cmul(y3, w3); }
    __syncthreads();
    fft_pass16_fwd<256>(F, Z); fft_pass16_fwd<16>(F, Z); fft_pass16_fwd<1>(F, Z);
}
DI void fft_inv(const Frame& F0, LAS f32x2* Z) {
    Frame F = F0; { int t_ = F0.tid; asm volatile("" : "+v"(t_)); F.tid = t_; }
    fft_pass16_inv<1>(F, Z); fft_pass16_inv<16>(F, Z); fft_pass16_inv<256>(F, Z);
#pragma unroll 2
    for (int u = F.tid; u < 4096; u += NTHR) { const int j = u; LAS f32x2* zp = Z + ZP(j);
        const float rev = (float)j * (1.0f / 16384.0f); const f32x2 w1 = {__builtin_amdgcn_cosf(rev), -__builtin_amdgcn_sinf(rev)}; const f32x2 w2 = cmul(w1, w1), w3 = cmul(w2, w1);
        const f32x2 a0 = zp[0], a1 = cmulc(zp[4352], w1), a2 = cmulc(zp[8704], w2), a3 = cmulc(zp[13056], w3);
        f32x2 x0, x1, x2, x3; BFLY_I(a0, a1, a2, a3, x0, x1, x2, x3);
        zp[0] = x0; zp[4352] = x1; zp[8704] = x2; zp[13056] = x3; }
    __syncthreads();
}
DI float dw3(const LAS unsigned short* row, int t, int n, float w0, float w1, float w2, float b) {
    const float m = bf2f(row[t]); const float l = t > 0 ? bf2f(row[t - 1]) : 0.f; const float r = t + 1 < n ? bf2f(row[t + 1]) : 0.f;
    return l * w0 + m * w1 + r * w2 + b;
}
DI void dw3x4(const LAS unsigned short* row, int t, int n, float w0, float w1, float w2, float b, float (&o)[4]) {
    const u32x2 m = *(const LAS u32x2*)(row + t);
    const float c0 = bflo(m.x), c1 = bfhi(m.x), c2 = bflo(m.y), c3 = bfhi(m.y);
    const float l = t > 0 ? bf2f(row[t - 1]) : 0.f; const float r = t + 4 < n ? bf2f(row[t + 4]) : 0.f;
    o[0] = l * w0 + c0 * w1 + c1 * w2 + b; o[1] = c0 * w0 + c1 * w1 + c2 * w2 + b; o[2] = c1 * w0 + c2 * w1 + c3 * w2 + b; o[3] = c2 * w0 + c3 * w1 + r * w2 + b;
}
DI void hyena_unit(const Frame& F0, const Params& P, int je, int c) {
    Frame F = F0; { int t_ = F0.tid; asm volatile("" : "+v"(t_)); F.tid = t_; F.lane = t_ & 63; }
    LAS f32x2* Z = (LAS f32x2*)F.lds;
    LAS float* aux = (LAS float*)(F.lds + AUX_OFF + 8192);
    LAS float* red = aux + 1536;
    const bf16* ZBT = (const bf16*)(P.ws + WS_U + 50 * MiB);
    bf16* YBT = (bf16*)(P.ws + WS_U + 150 * MiB);
    const bf16* filt = (const bf16*)(P.ws + WS_FILT) + (size_t)je * 2 * 1024 * SEQ;
    const bf16* ff = filt + (size_t)c * SEQ; const bf16* fb = filt + (size_t)(1024 + c) * SEQ;
    const float* hw = P.in[14] + (size_t)je * 3 * HYC; const float* hb = P.in[15] + (size_t)je * HYC;
    float l1 = 0.f;
    for (int i = F.tid; i < 16384; i += NTHR) { float v;
        if (i < SEQ) v = bf2f(ff[i]); else if (i == SEQ) v = 0.f; else v = bf2f(fb[16384 - i]);
        l1 += fabsf(v); Z[ZP(i)] = (f32x2){v, 0.f}; }
    l1 = block_sum(F, l1, red);
    fft_fwd(F, Z);
    const float bias = P.in[22][(size_t)je * 1024 + c];
    const float hscale = 1.0f / (l1 * 16384.0f), hadd = bias * (1.0f / 16384.0f);
    f32x2 hs[32];
#pragma unroll
    for (int k = 0; k < 32; ++k) { const f32x2 z = Z[ZP(F.tid + 512 * k)]; hs[k] = (f32x2){z[0] * hscale + hadd, z[1] * hscale}; }
    __syncthreads();
    LAS unsigned short* raw = (LAS unsigned short*)(F.lds + 69632);
    for (int i = F.tid; i < 4096; i += NTHR) { const int rr = i >> 10, piece = i & 1023; const int b = rr & 1, which = rr >> 1;
        *(LAS u32x4*)(raw + rr * SEQ + piece * 8) = *(const u32x4*)(ZBT + (size_t)((which ? 2048 : 1024) + c) * MROWS + b * SEQ + piece * 8); }
    __syncthreads();
    const float wx10 = hw[1024 + c], wx11 = hw[HYC + 1024 + c], wx12 = hw[2 * HYC + 1024 + c], bx1 = hb[1024 + c];
    const float wv0 = hw[2048 + c], wv1 = hw[HYC + 2048 + c], wv2 = hw[2 * HYC + 2048 + c], bv = hb[2048 + c];
    const float wx00 = hw[c], wx01 = hw[HYC + c], wx02 = hw[2 * HYC + c], bx0 = hb[c];
#pragma unroll 1
    for (int k = 0; k < 4; ++k) { const int t = 4 * (k * 512 + F.tid);
        float pv0[4], px0[4], pv1[4], px1[4];
        dw3x4(raw + 2 * SEQ, t, SEQ, wv0, wv1, wv2, bv, pv0); dw3x4(raw, t, SEQ, wx10, wx11, wx12, bx1, px0);
        dw3x4(raw + 3 * SEQ, t, SEQ, wv0, wv1, wv2, bv, pv1); dw3x4(raw + SEQ, t, SEQ, wx10, wx11, wx12, bx1, px1);
        LAS f32x2* zp = Z + ZP(t);
#pragma unroll
        for (int e = 0; e < 4; ++e) zp[e] = (f32x2){pv0[e] * px0[e], pv1[e] * px1[e]}; }
    __syncthreads();
#pragma unroll 4
    for (int k = 0; k < 16; ++k) Z[ZP(SEQ + k * 512 + F.tid)] = (f32x2){0.f, 0.f};
    __syncthreads();
    fft_fwd(F, Z);
#pragma unroll
    for (int k = 0; k < 32; ++k) { const f32x2 z = Z[ZP(F.tid + 512 * k)]; Z[ZP(F.tid + 512 * k)] = (f32x2){z[0] * hs[k][0] - z[1] * hs[k][1], z[0] * hs[k][1] + z[1] * hs[k][0]}; }
    __syncthreads();
    fft_inv(F, Z);
    for (int i = F.tid; i < 2048; i += NTHR) { const int b = i >> 10, piece = i & 1023;
        *(LAS u32x4*)(raw + b * SEQ + piece * 8) = *(const u32x4*)(ZBT + (size_t)c * MROWS + b * SEQ + piece * 8); }
    __syncthreads();
#pragma unroll 1
    for (int k = 0; k < 4; ++k) { const int t = 4 * (k * 512 + F.tid);
        float g0[4], g1[4]; dw3x4(raw, t, SEQ, wx00, wx01, wx02, bx0, g0); dw3x4(raw + SEQ, t, SEQ, wx00, wx01, wx02, bx0, g1);
        const LAS f32x2* zp = Z + ZP(t); const f32x2 z0 = zp[0], z1 = zp[1], z2 = zp[2], z3 = zp[3];
        u32x2 w0_, w1_; w0_.x = pk2(z0[0] * g0[0], z1[0] * g0[1]); w0_.y = pk2(z2[0] * g0[2], z3[0] * g0[3]); w1_.x = pk2(z0[1] * g1[0], z1[1] * g1[1]); w1_.y = pk2(z2[1] * g1[2], z3[1] * g1[3]);
        *(u32x2*)(YBT + (size_t)c * MROWS + t) = w0_; *(u32x2*)(YBT + (size_t)c * MROWS + SEQ + t) = w1_; }
    const bf16* fc = (const bf16*)(P.ws + WS_FILTC) + (size_t)je * 2 * 1024 * CTXL;
    LAS float* hc = aux; LAS float* vvc = aux + 512; LAS float* x0c = aux + 1024;
    __syncthreads();
    { const int i = F.tid; float v;
        if (i >= 255 && i < 511) v = bf2f(fc[(size_t)c * CTXL + (i - 255)]); else if (i < 255) v = bf2f(fc[(size_t)(1024 + c) * CTXL + (255 - i)]); else v = 0.f;
        hc[i] = v; float l1c = block_sum(F, fabsf(v), red);
        const int b = i >> 8, t = i & 255; const bf16* zc = ZBT + NLAT + b * CTXL;
        auto rd = [&](int rowi, int tt) -> float { return (tt >= 0 && tt < CTXL) ? bf2f(zc[(size_t)rowi * MROWS + tt]) : 0.f; };
        const float pv_ = rd(2048 + c, t - 1) * wv0 + rd(2048 + c, t) * wv1 + rd(2048 + c, t + 1) * wv2 + bv;
        const float px1 = rd(1024 + c, t - 1) * wx10 + rd(1024 + c, t) * wx11 + rd(1024 + c, t + 1) * wx12 + bx1;
        const float px0 = rd(c, t - 1) * wx00 + rd(c, t) * wx01 + rd(c, t + 1) * wx02 + bx0;
        vvc[i] = pv_ * px1; x0c[i] = px0;
        __syncthreads();
        { LAS float* part = (LAS float*)F.lds;
            const int t4 = (F.tid & 63) * 4, bb = (F.tid >> 6) & 1, sq = F.tid >> 7;
            float a0 = 0.f, a1 = 0.f, a2 = 0.f, a3 = 0.f;
            int d = t4 - sq * 64 + 255;
            float h1 = hc[d + 1], h2 = hc[d + 2], h3 = hc[d + 3];
#pragma unroll 8
            for (int s = 0; s < 64; ++s) { const float h0 = hc[d - s]; const float v = vvc[bb * 256 + sq * 64 + s];
                a0 += h0 * v; a1 += h1 * v; a2 += h2 * v; a3 += h3 * v; h3 = h2; h2 = h1; h1 = h0; }
            *(LAS f32x4*)(part + (sq * 2 + bb) * 256 + t4) = (f32x4){a0, a1, a2, a3}; }
        __syncthreads();
        { const LAS float* part = (const LAS float*)F.lds;
            float s = (part[(0 * 2 + b) * 256 + t] + part[(1 * 2 + b) * 256 + t]) + (part[(2 * 2 + b) * 256 + t] + part[(3 * 2 + b) * 256 + t]);
            s = s / l1c;
            YBT[(size_t)c * MROWS + NLAT + i] = (bf16)f2bf((s + vvc[i] * bias) * x0c[i]); }
    }
    __syncthreads();
}
DI void ybt_transpose_phase(const Frame& F, const Params& P) {
    const bf16* YBT = (const bf16*)(P.ws + WS_U + 150 * MiB); bf16* YAB = (bf16*)(P.ws + WS_YAB);
    LAS unsigned char* tile = F.lds + F.wave * 16384;
    const int gw = F.bid * NWAVES + F.wave, NGW = F.G * NWAVES;
    const int rr = F.lane >> 3, piece = F.lane & 7;
    const int i16 = F.lane & 15, tq = i16 >> 2, tp = i16 & 3, g16 = F.lane >> 4;
    for (int tu = gw; tu < 16 * (MROWS / 64); tu += NGW) { const int cb = tu & 15, tb = tu >> 4; const int c0 = cb * 64, t0 = tb * 64;
        u32x4 v[8];
#pragma unroll
        for (int i = 0; i < 8; ++i) v[i] = *(const u32x4*)(YBT + (size_t)(c0 + 8 * i + rr) * MROWS + t0 + piece * 8);
#pragma unroll
        for (int i = 0; i < 8; ++i) *(LAS u32x4*)(tile + (8 * i + rr) * 192 + piece * 16) = v[i];
        asm volatile("s_waitcnt lgkmcnt(0)" ::: "memory");
        bf16* dst = YAB + (size_t)(t0 + F.lane) * DM + 1024 + c0;
#pragma unroll
        for (int k = 0; k < 8; ++k) {
            const LAS unsigned char* ap = tile + (8 * k + tq) * 192 + 32 * g16 + 8 * tp;
            const s16x4 lo = vtr(ap), hi = vtr(ap + 4 * 192);
            const bf16x8 o = __builtin_shufflevector(lo, hi, 0, 1, 2, 3, 4, 5, 6, 7);
            *(bf16x8*)(dst + 8 * k) = o; }
        asm volatile("s_waitcnt lgkmcnt(0)" ::: "memory");
    }
}
typedef __bf16 bf16x2_t __attribute__((ext_vector_type(2)));
DI unsigned cvtpk_s(float lo, float hi) { const f32x2 v = {lo, hi}; const bf16x2_t b = __builtin_convertvector(v, bf16x2_t); return __builtin_bit_cast(unsigned, b); }
DI int crow(int i, int h) { return (i & 3) + 8 * (i >> 2) + 4 * h; }
#define MFMA32(a, b, c) __builtin_amdgcn_mfma_f32_32x32x16_bf16((a), (b), (c), 0, 0, 0)
constexpr int KPITCH = 272, VPITCH = 320, VS_OFF = 128 * KPITCH;

DI void attn_unit(const Frame& F, const Params& P, int je, int au) {
    int b, qb, hk, hp; bool isctx;
    if (au < 512) { isctx = false; const int idx = (au & 7) * 64 + (au >> 3);
        hp = idx & 1; qb = (idx >> 1) & 63; hk = (idx >> 7) & 1; b = idx >> 8; }
    else { const int v = au - 512; isctx = true; hp = v & 1; hk = (v >> 1) & 1; qb = (v >> 2) & 1; b = v >> 3; }
    const bf16* QKV = (const bf16*)(P.ws + WS_U); bf16* YAB = (bf16*)(P.ws + WS_YAB);
    const int r = F.lane & 31, h = F.lane >> 5;
    const int qsub = F.wave & 3, head = hk * 4 + hp * 2 + (F.wave >> 2);
    const int seqbase = isctx ? (NLAT + b * CTXL) : b * SEQ;
    const int qrow = seqbase + qb * 128 + qsub * 32 + r;
    const bf16* qbase = QKV + (size_t)qrow * QKVC + head * HD + 8 * h;
    bf16x8 qf[8];
#pragma unroll
    for (int s = 0; s < 8; ++s) qf[s] = *(const bf16x8*)(qbase + 16 * s);
    float m = P.in[13][je * 8 + head] * LOG2E, l = (h == 0) ? 1.0f : 0.0f;
    f32x16 O[4];
#pragma unroll
    for (int dt = 0; dt < 4; ++dt)
#pragma unroll
        for (int i = 0; i < 16; ++i) O[dt][i] = 0.f;
    const LAS unsigned char* Ks = F.lds; const LAS unsigned char* Vs = F.lds + VS_OFF;
    const int ql = qsub * 32 + r;
    const int i16 = F.lane & 15, tq = i16 >> 2, tp = i16 & 3, blk = (F.lane >> 4) & 1;
    int nb = 0, brow[5], btype[5];
#pragma unroll
    for (int bi = 0; bi < 5; ++bi) { int krow0, type; bool ok;
        if (bi < 3) { const int kb = qb - 1 + bi; ok = !isctx && kb >= 0 && kb < SEQ / 128; krow0 = b * SEQ + kb * 128; type = bi; }
        else { ok = true; krow0 = NLAT + b * CTXL + (bi - 3) * 128; type = 1; }
        if (ok) {
#pragma unroll
            for (int q = 0; q < 5; ++q) if (q == nb) { brow[q] = krow0; btype[q] = type; }
            ++nb; } }
    u32x4 kreg[4], vreg[4];
    const int pkey = F.tid >> 4, ppc = F.tid & 15;
#define ATT_PREFETCH(krow0_) do { const bf16* src_ = QKV + (size_t)((krow0_) + pkey) * QKVC + hk * HD + ppc * 8 + QCOLS; \
        _Pragma("unroll") for (int i_ = 0; i_ < 4; ++i_) { kreg[i_] = *(const u32x4*)(src_ + (size_t)i_ * 32 * QKVC); vreg[i_] = *(const u32x4*)(src_ + (size_t)i_ * 32 * QKVC + KVC); } } while (0)
    ATT_PREFETCH(brow[0]);
    for (int bi = 0; bi < nb; ++bi) {
        int krow_next = 0, type = 1;
#pragma unroll
        for (int q = 0; q < 5; ++q) { if (q == bi) type = btype[q]; if (q == bi + 1) krow_next = brow[q]; }
        __syncthreads();
#pragma unroll
        for (int i = 0; i < 4; ++i) { *(LAS u32x4*)(F.lds + (pkey + 32 * i) * KPITCH + ppc * 16) = kreg[i]; *(LAS u32x4*)(F.lds + VS_OFF + (pkey + 32 * i) * VPITCH + ppc * 16) = vreg[i]; }
        __syncthreads();
        if (bi + 1 < nb) ATT_PREFETCH(krow_next);
#pragma unroll 1
        for (int hb = 0; hb < 2; ++hb) {
            f32x16 st[2];
#pragma unroll
            for (int k2 = 0; k2 < 2; ++k2) { const int kt = 2 * hb + k2;
#pragma unroll
                for (int i = 0; i < 16; ++i) st[k2][i] = 0.f;
#pragma unroll
                for (int s = 0; s < 8; ++s) { const bf16x8 kf = *(const LAS bf16x8*)(Ks + (kt * 32 + r) * KPITCH + (16 * s + 8 * h) * 2); st[k2] = MFMA32(kf, qf[s], st[k2]); }
                __builtin_amdgcn_sched_barrier(0); }
            if (type != 1) { int qlv = ql; asm volatile("" : "+v"(qlv));
#pragma unroll
                for (int k2 = 0; k2 < 2; ++k2)
#pragma unroll
                    for (int i = 0; i < 16; ++i) { const int kl = (2 * hb + k2) * 32 + crow(i, h); const bool ok = (type == 0) ? (kl >= qlv) : (kl <= qlv); st[k2][i] = ok ? st[k2][i] : -1e30f; } }
            float mx = st[0][0];
#pragma unroll
            for (int k2 = 0; k2 < 2; ++k2)
#pragma unroll
                for (int i = 0; i < 16; ++i) mx = fmaxf(mx, st[k2][i]);
            mx = fmaxf(mx, __shfl_xor(mx, 32));
            const float mnew = fmaxf(m, mx), alpha = __builtin_amdgcn_exp2f(m - mnew); m = mnew;
            float ls = 0.f;
#pragma unroll
            for (int k2 = 0; k2 < 2; ++k2)
#pragma unroll
                for (int i = 0; i < 16; ++i) { const float pe = __builtin_amdgcn_exp2f(st[k2][i] - mnew); st[k2][i] = pe; ls += pe; }
            l = l * alpha + ls;
#pragma unroll
            for (int dt = 0; dt < 4; ++dt)
#pragma unroll
                for (int i = 0; i < 16; ++i) O[dt][i] *= alpha;
#pragma unroll
            for (int k2 = 0; k2 < 2; ++k2)
#pragma unroll
                for (int s = 0; s < 2; ++s) { const int kt = 2 * hb + k2;
                    u32x4 pw; pw.x = cvtpk_s(st[k2][8 * s + 0], st[k2][8 * s + 1]); pw.y = cvtpk_s(st[k2][8 * s + 2], st[k2][8 * s + 3]); pw.z = cvtpk_s(st[k2][8 * s + 4], st[k2][8 * s + 5]); pw.w = cvtpk_s(st[k2][8 * s + 6], st[k2][8 * s + 7]);
                    const bf16x8 pf = __builtin_bit_cast(bf16x8, pw);
#pragma unroll
                    for (int dt = 0; dt < 4; ++dt) {
                        const LAS unsigned char* vp = Vs + (kt * 32 + 16 * s + 4 * h + tq) * VPITCH + 64 * dt + 32 * blk + 8 * tp;
                        const s16x4 lo = vtr(vp), hi = vtr(vp + 8 * VPITCH);
                        const bf16x8 vf = __builtin_shufflevector(lo, hi, 0, 1, 2, 3, 4, 5, 6, 7);
                        O[dt] = MFMA32(vf, pf, O[dt]); }
                    __builtin_amdgcn_sched_barrier(0); }
        }
    }
#undef ATT_PREFETCH
    const float lt = l + __shfl_xor(l, 32); const float inv = 1.0f / lt;
    bf16* orow = YAB + (size_t)qrow * DM + head * HD;
#pragma unroll
    for (int dt = 0; dt < 4; ++dt)
#pragma unroll
        for (int ig = 0; ig < 4; ++ig) { u32x2 w; w.x = cvtpk_s(O[dt][4 * ig] * inv, O[dt][4 * ig + 1] * inv); w.y = cvtpk_s(O[dt][4 * ig + 2] * inv, O[dt][4 * ig + 3] * inv);
            *(u32x2*)(orow + dt * 32 + 8 * ig + 4 * h) = w; }
    __syncthreads();
}
DI void s5_carry_phase(const Frame& F, const Params& P, int jo) {
    const int fr = F.lane & 15, fq = F.lane >> 4;
    for (int blk = F.bid; blk < 2 * S5G; blk += F.G) {
        const int g = blk & 127, b = blk >> 7;
        float* ET = (float*)(P.ws + WS_U) + (size_t)g * 256 * S5ROWS;
        bf16* UAg = (bf16*)(P.ws + WS_A5) + (size_t)g * S5ROWS * S5K;
        const bf16* UAc = UAg + (size_t)(1024 + b * 16) * S5K;
        const bf16* WWg = (const bf16*)(P.ws + WS_WW) + (size_t)(jo * S5G + g) * 256 * 256;
        const bf16* TTg = (const bf16*)(P.ws + WS_TT) + (size_t)(jo * S5G + g) * 256 * 512;
        const int rc0 = 1024 + b * 16, rl0 = b * 512;
#pragma unroll 1
        for (int mt = F.wave; mt < 16; mt += NWAVES) { pg8::f32x4 acc = {0.f, 0.f, 0.f, 0.f};
#pragma unroll
            for (int ks = 0; ks < 8; ++ks) { const bf16x8 a = *(const bf16x8*)(WWg + (size_t)(mt * 16 + fr) * 256 + 32 * ks + 8 * fq), bq = *(const bf16x8*)(UAc + (size_t)fr * S5K + 32 * ks + 8 * fq);
                acc = __builtin_amdgcn_mfma_f32_16x16x32_bf16(a, bq, acc, 0, 0, 0); }
#pragma unroll
            for (int j = 0; j < 4; ++j) ET[(size_t)(mt * 16 + 4 * fq + j) * S5ROWS + rc0 + fr] = acc[j]; }
        asm volatile("s_waitcnt vmcnt(0)" ::: "memory"); __syncthreads();
        const int p = F.lane, dir = F.wave & 1;
        const float* lp = (const float*)(P.ws + WS_LAML) + ((size_t)((jo * 2 + dir) * S5G + g) * 64 + p) * 2;
        const float lr = lp[0], li = lp[1];
        const float* Er = ET + (size_t)(dir * 128 + p) * S5ROWS;
        bf16* Ug = UAg + 256 + dir * 128 + p;
        float sr = 0.f, si = 0.f;
        if (F.wave < 2) {
            f32x4 cr[4], ci[4];
#pragma unroll
            for (int k = 0; k < 4; ++k) { cr[k] = *(const f32x4*)(Er + rc0 + 4 * k); ci[k] = *(const f32x4*)(Er + 64 * S5ROWS + rc0 + 4 * k); }
#pragma unroll
            for (int q = 0; q < 16; ++q) { const int qq = dir == 0 ? q : 15 - q; const int row = rc0 + qq;
                Ug[(size_t)row * S5K] = (bf16)f2bf(sr); Ug[(size_t)row * S5K + 64] = (bf16)f2bf(si);
                const float xr = dir == 0 ? cr[q >> 2][q & 3] : cr[(15 - q) >> 2][(15 - q) & 3], xi = dir == 0 ? ci[q >> 2][q & 3] : ci[(15 - q) >> 2][(15 - q) & 3];
                const float nr = lr * sr - li * si + xr, ni = lr * si + li * sr + xi; sr = nr; si = ni; } }
        asm volatile("s_waitcnt vmcnt(0)" ::: "memory"); __syncthreads();
        if (F.wave < 2) {
#define S5BLK(bq) (dir == 0 ? rl0 + 4 * (bq) : rl0 + 508 - 4 * (bq))
            f32x4 er[8], ei[8];
#pragma unroll
            for (int k = 0; k < 8; ++k) { const int row = S5BLK(k); er[k] = *(const f32x4*)(Er + row); ei[k] = *(const f32x4*)(Er + 64 * S5ROWS + row); }
#pragma unroll 1
            for (int b0 = 0; b0 < 128; b0 += 8) {
                f32x4 nr_[8], ni_[8];
#pragma unroll
                for (int k = 0; k < 8; ++k) { const int bq = b0 + 8 + k; if (bq < 128) { const int row = S5BLK(bq); nr_[k] = *(const f32x4*)(Er + row); ni_[k] = *(const f32x4*)(Er + 64 * S5ROWS + row); } else { nr_[k] = (f32x4){0.f, 0.f, 0.f, 0.f}; ni_[k] = nr_[k]; } }
#pragma unroll
                for (int k = 0; k < 8; ++k) { const int row0 = S5BLK(b0 + k);
#pragma unroll
                    for (int e = 0; e < 4; ++e) { const int ee = dir == 0 ? e : 3 - e; const int row = row0 + ee;
                        Ug[(size_t)row * S5K] = (bf16)f2bf(sr); Ug[(size_t)row * S5K + 64] = (bf16)f2bf(si);
                        const float xr = dir == 0 ? er[k][e] : er[k][3 - e], xi = dir == 0 ? ei[k][e] : ei[k][3 - e];
                        const float nr = lr * sr - li * si + xr, ni = lr * si + li * sr + xi; sr = nr; si = ni; } }
#pragma unroll
                for (int k = 0; k < 8; ++k) { er[k] = nr_[k]; ei[k] = ni_[k]; }
            }
#undef S5BLK
        } else {
            bf16* G2c = (bf16*)(P.ws + WS_Y) + ((size_t)g * S5ROWS + rc0) * 256;
#pragma unroll 1
            for (int mt = F.wave - 2; mt < 16; mt += NWAVES - 2) { pg8::f32x4 acc = {0.f, 0.f, 0.f, 0.f};
#pragma unroll
                for (int ks = 0; ks < 16; ++ks) { const bf16x8 a = *(const bf16x8*)(TTg + (size_t)(mt * 16 + fr) * 512 + 32 * ks + 8 * fq), bq = *(const bf16x8*)(UAc + (size_t)fr * S5K + 32 * ks + 8 * fq);
                    acc = __builtin_amdgcn_mfma_f32_16x16x32_bf16(a, bq, acc, 0, 0, 0); }
                u32x2 w; w.x = pk2(gelu_tanh(acc[0]), gelu_tanh(acc[1])); w.y = pk2(gelu_tanh(acc[2]), gelu_tanh(acc[3]));
                *(u32x2*)(G2c + (size_t)fr * 256 + mt * 16 + 4 * fq) = w; }
        }
        __syncthreads();
    }
}
constexpr int N_PHASES = 3 + 4 * 8;
#ifndef WGM_C2
#define WGM_C2 8
#endif
#ifndef WGM_E1
#define WGM_E1 4
#endif
#ifndef WGM_O4
#define WGM_O4 4
#endif
#ifndef WGM_C4
#define WGM_C4 4
#endif
#ifndef DUP_MASK_VALUE
#define DUP_MASK_VALUE 0ull
#endif
constexpr unsigned long long DUP_MASK = DUP_MASK_VALUE;
#ifndef DUP_SUB
#define DUP_SUB 0
#endif
typedef const Params __attribute__((address_space(4)))* ParamsK;
__global__ void __launch_bounds__(NTHR, 2) hybrid_fwd(Params Parg) {
    extern __shared__ __attribute__((aligned(16))) unsigned char lds_raw[];
    Frame F0; F0.lds = (LAS unsigned char*)lds_raw; F0.tid = threadIdx.x; F0.lane = F0.tid & 63; F0.wave = __builtin_amdgcn_readfirstlane(F0.tid >> 6); F0.G = gridDim.x; F0.bid = blockIdx.x;
    for (int u = F0.tid; u < (LDS_BYTES - LDSCTL_OFF) / 4; u += NTHR) ((LAS unsigned*)(F0.lds + LDSCTL_OFF))[u] = 0u;
    __syncthreads();
    XcdBarrier bar = xcd_barrier_post((unsigned*)(Parg.ws + WS_CTL) + CW_BAR, (volatile LAS unsigned*)(F0.lds + LDSCTL_OFF + 64));
    const int lo = Parg.lo, hi = Parg.hi; int ph = 0;
#define RUNP() (lo <= ph && ph < hi)
#define PHASE_BEGIN for (int rep_ = 0; RUNP() && rep_ < (((DUP_MASK >> ph) & 1ull) ? 2 : 1); ++rep_)
#define SEAM() do { if (lo <= ph && ph + 1 < hi) { XcdBarrier bl_ = bar; asm volatile("" : "+s"(bl_.x)); xcd_barrier(bl_); if (DUP_SUB == 6) xcd_barrier(bl_); } ++ph; } while (0)
#define LOCALS() Frame F = F0; { int t_ = F0.tid; asm volatile("" : "+v"(t_)); F.tid = t_; F.lane = t_ & 63; F.wave = __builtin_amdgcn_readfirstlane(t_ >> 6); int b_ = F0.bid, g_ = F0.G; asm volatile("" : "+s"(b_), "+s"(g_)); F.bid = b_; F.G = g_; } \
    ParamsK pk_ = (ParamsK)__builtin_amdgcn_kernarg_segment_ptr(); asm volatile("" : "+s"(pk_)); Params P; _Pragma("unroll") for (int i_ = 0; i_ < 33; ++i_) P.in[i_] = pk_->in[i_]; P.out = pk_->out; P.ws = pk_->ws; P.lo = 0; P.hi = 0; P.pad0 = 0; P.pad1 = 0; unsigned char* const ws = P.ws; (void)ws
#define W_MOD ((float*)(ws + WS_MOD))
#define W_XC ((float*)(ws + WS_XC))
#define W_HM ((bf16*)(ws + WS_HM))
#define W_YAB ((bf16*)(ws + WS_YAB))
#define W_Y ((bf16*)(ws + WS_Y))
#define W_PART ((float*)(ws + WS_PART))
#define W_A5 ((bf16*)(ws + WS_A5))
#define W_U ((bf16*)(ws + WS_U))
#define W_ZBT ((bf16*)(ws + WS_U + 50 * MiB))
#define W_F32U ((float*)(ws + WS_U))

    PHASE_BEGIN { LOCALS(); p0_prologue(F, P); }
    SEAM();
    PHASE_BEGIN { LOCALS(); p1_phase(F, P); }
    SEAM();
    PHASE_BEGIN { LOCALS(); row_phase<0>(F, nullptr, nullptr, 0, MROWS, P.in[0], P.in[2], nullptr, nullptr, nullptr, nullptr, 0, true, P.in[6], W_MOD, 0, 1, W_HM, nullptr); }
    SEAM();
    { constexpr int layer = 0;
        constexpr int jj = layer >> 1; constexpr bool LASTL = (layer == DEPTH - 1); constexpr int NROWS_L = LASTL ? NLAT : MROWS;
        if ((layer & 1) == 0) {
            PHASE_BEGIN { LOCALS();
                pg8::OrderE1 S{F.G, F.bid, (const char*)W_HM, (const char*)(ws + WS_WIN + jj * SZ_WIN)};
                typedef pg8::EpiQKVZ<(DUP_SUB == 5 && layer == 0) ? 3 : 1> EpiE1; EpiE1 E{W_U, W_ZBT, (const float*)(ws + WS_TAB)};
                pg8::gemm_phase<EpiE1, pg8::OrderE1, true>(F.lds, F.tid, pg8::Gemm{DM, DM}, S, E);
            }
            SEAM();
            PHASE_BEGIN { LOCALS();
                for (int rr_ = 0; rr_ < ((DUP_SUB == 1 && layer == 0) ? 2 : 1); ++rr_) for (int c = F.bid; c < 1024; c += F.G) hyena_unit(F, P, jj, c);
                for (int rr_ = 0; rr_ < ((DUP_SUB == 2 && layer == 0) ? 2 : 1); ++rr_) for (int au = F.bid; au < 528; au += F.G) attn_unit(F, P, jj, au);
            }
            SEAM();
            PHASE_BEGIN { LOCALS(); ybt_transpose_phase(F, P); }
            SEAM();
            PHASE_BEGIN { LOCALS();
                pg8::OrderSplit S; S.init(W_YAB, ws + WS_WOUT + jj * SZ_WOUT, DM, DM, DM, DM, 1, F.G, F.bid);
                pg8::EpiYb E{W_Y, DM, nullptr, W_PART};
                pg8::gemm_phase<pg8::EpiYb, pg8::OrderSplit, true>(F.lds, F.tid, pg8::Gemm{DM, DM}, S, E);
            }
            SEAM();
        } else {
            PHASE_BEGIN { LOCALS();
                pg8::OrderS5 S{F.G, F.bid, 256 / 64, (const char*)W_A5, (const char*)(ws + WS_WW + (size_t)jj * S5G * 256 * 256 * 2), (size_t)256 * 256 * 2, 1};
                pg8::EpiF32g E{W_F32U, S5ROWS, nullptr};
                pg8::gemm_phase<pg8::EpiF32g, pg8::OrderS5, true>(F.lds, F.tid, pg8::Gemm{256, S5K}, S, E);
            }
            SEAM();
            PHASE_BEGIN { LOCALS(); s5_carry_phase(F, P, jj); }
            SEAM();
            PHASE_BEGIN { LOCALS();
                pg8::OrderS5 S{F.G, F.bid, S5K / 64, (const char*)W_A5, (const char*)(ws + WS_TT + (size_t)jj * S5G * 256 * 512 * 2), (size_t)256 * 512 * 2, 0};
                pg8::EpiS5G E{W_Y};
                pg8::gemm_phase<pg8::EpiS5G, pg8::OrderS5, true>(F.lds, F.tid, pg8::Gemm{S5K, S5K}, S, E);
            }
            SEAM();
            PHASE_BEGIN { LOCALS();
                pg8::OrderSplit S; S.init(W_Y, ws + WS_WGLU + jj * SZ_WGLU, 2 * DM, DM, DM, DM, LASTL ? 0 : 1, F.G, F.bid, 1, WGM_O4);
                pg8::EpiYb E{W_U, 2 * DM, P.in[32] + (size_t)jj * 2 * DM, W_PART};
                pg8::gemm_phase<pg8::EpiYb, pg8::OrderSplit, true, 1>(F.lds, F.tid, pg8::Gemm{DM, DM}, S, E);
            }
            SEAM();
        }
        PHASE_BEGIN { LOCALS();
            const float* modl = W_MOD + (size_t)layer * 3 * NMOD * DM; const float* ngl = P.in[6] + (size_t)layer * 4 * DM;
            const float* xl = layer == 0 ? P.in[0] : P.out; const float* xc = layer == 0 ? P.in[2] : W_XC;
            if (DUP_SUB == 4 && layer == 0) row_phase<1>(F, W_Y, W_PART, 8, NROWS_L, xl, xc, (float*)(ws + WS_U), (float*)(ws + WS_U + 140 * MiB), ngl + 1 * DM, modl, 2, true, ngl + 2 * DM, modl, 3, 4, (bf16*)(ws + WS_U + 200 * MiB), nullptr);
            if ((layer & 1) == 0) row_phase<1>(F, W_Y, W_PART, 8, NROWS_L, xl, xc, P.out, W_XC, ngl + 1 * DM, modl, 2, true, ngl + 2 * DM, modl, 3, 4, W_HM, nullptr);
            else row_phase<2>(F, W_U, W_PART, 8, NROWS_L, xl, xc, P.out, W_XC, ngl + 1 * DM, modl, 2, true, ngl + 2 * DM, modl, 3, 4, W_HM, nullptr);
        }
        SEAM();
        PHASE_BEGIN { LOCALS();
            pg8::OrderUp S{F.G, F.bid, LASTL ? 66 : 70, (const char*)W_HM, (const char*)(ws + WS_WUP + layer * SZ_WUP), WGM_C2};
            typedef pg8::EpiUpGlu<(DUP_SUB == 3 && layer == 0) ? 2 : 1> EpiUp; EpiUp E{W_A5, P.in[8] + (size_t)layer * 3 * DFF2, P.in[9] + (size_t)layer * DFF2, (LAS float*)(F.lds + AUX_OFF)};
            pg8::gemm_phase<EpiUp, pg8::OrderUp, true>(F.lds, F.tid, pg8::Gemm{DM, DM}, S, E);
        }
        SEAM();
        PHASE_BEGIN { LOCALS();
            pg8::OrderSplit S; S.init(W_A5, ws + WS_WDOWN + layer * SZ_WDOWN, DM, DFF, DFF, DFF, LASTL ? 0 : 1, F.G, F.bid, 0, WGM_C4);
            pg8::EpiYb E{W_Y, DM, nullptr, W_PART};
            pg8::gemm_phase<pg8::EpiYb, pg8::OrderSplit, true>(F.lds, F.tid, pg8::Gemm{DFF, DFF}, S, E);
        }
        SEAM();
        PHASE_BEGIN { LOCALS();
            const float* modl = W_MOD + (size_t)layer * 3 * NMOD * DM; const float* ngl = P.in[6] + (size_t)layer * 4 * DM;
            row_phase<1>(F, W_Y, W_PART, 15, NROWS_L, P.out, W_XC, P.out, W_XC, ngl + 3 * DM, modl, 5, !LASTL, ngl + 4 * DM, modl + 3 * NMOD * DM, 0, 1, ((layer & 1) == 0) ? nullptr : W_HM, ((layer & 1) == 0) ? W_A5 : nullptr);
        }
        SEAM();
    }
    { constexpr int layer = 1;
        constexpr int jj = layer >> 1; constexpr bool LASTL = (layer == DEPTH - 1); constexpr int NROWS_L = LASTL ? NLAT : MROWS;
        if ((layer & 1) == 0) {
            PHASE_BEGIN { LOCALS();
                pg8::OrderE1 S{F.G, F.bid, (const char*)W_HM, (const char*)(ws + WS_WIN + jj * SZ_WIN)};
                typedef pg8::EpiQKVZ<(DUP_SUB == 5 && layer == 0) ? 3 : 1> EpiE1; EpiE1 E{W_U, W_ZBT, (const float*)(ws + WS_TAB)};
                pg8::gemm_phase<EpiE1, pg8::OrderE1, true>(F.lds, F.tid, pg8::Gemm{DM, DM}, S, E);
            }
            SEAM();
            PHASE_BEGIN { LOCALS();
                for (int rr_ = 0; rr_ < ((DUP_SUB == 1 && layer == 0) ? 2 : 1); ++rr_) for (int c = F.bid; c < 1024; c += F.G) hyena_unit(F, P, jj, c);
                for (int rr_ = 0; rr_ < ((DUP_SUB == 2 && layer == 0) ? 2 : 1); ++rr_) for (int au = F.bid; au < 528; au += F.G) attn_unit(F, P, jj, au);
            }
            SEAM();
            PHASE_BEGIN { LOCALS(); ybt_transpose_phase(F, P); }
            SEAM();
            PHASE_BEGIN { LOCALS();
                pg8::OrderSplit S; S.init(W_YAB, ws + WS_WOUT + jj * SZ_WOUT, DM, DM, DM, DM, 1, F.G, F.bid);
                pg8::EpiYb E{W_Y, DM, nullptr, W_PART};
                pg8::gemm_phase<pg8::EpiYb, pg8::OrderSplit, true>(F.lds, F.tid, pg8::Gemm{DM, DM}, S, E);
            }
            SEAM();
        } else {
            PHASE_BEGIN { LOCALS();
                pg8::OrderS5 S{F.G, F.bid, 256 / 64, (const char*)W_A5, (const char*)(ws + WS_WW + (size_t)jj * S5G * 256 * 256 * 2), (size_t)256 * 256 * 2, 1};
                pg8::EpiF32g E{W_F32U, S5ROWS, nullptr};
                pg8::gemm_phase<pg8::EpiF32g, pg8::OrderS5, true>(F.lds, F.tid, pg8::Gemm{256, S5K}, S, E);
            }
            SEAM();
            PHASE_BEGIN { LOCALS(); s5_carry_phase(F, P, jj); }
            SEAM();
            PHASE_BEGIN { LOCALS();
                pg8::OrderS5 S{F.G, F.bid, S5K / 64, (const char*)W_A5, (const char*)(ws + WS_TT + (size_t)jj * S5G * 256 * 512 * 2), (size_t)256 * 512 * 2, 0};
                pg8::EpiS5G E{W_Y};
                pg8::gemm_phase<pg8::EpiS5G, pg8::OrderS5, true>(F.lds, F.tid, pg8::Gemm{S5K, S5K}, S, E);
            }
            SEAM();
            PHASE_BEGIN { LOCALS();
                pg8::OrderSplit S; S.init(W_Y, ws + WS_WGLU + jj * SZ_WGLU, 2 * DM, DM, DM, DM, LASTL ? 0 : 1, F.G, F.bid, 1, WGM_O4);
                pg8::EpiYb E{W_U, 2 * DM, P.in[32] + (size_t)jj * 2 * DM, W_PART};
                pg8::gemm_phase<pg8::EpiYb, pg8::OrderSplit, true, 1>(F.lds, F.tid, pg8::Gemm{DM, DM}, S, E);
            }
            SEAM();
        }
        PHASE_BEGIN { LOCALS();
            const float* modl = W_MOD + (size_t)layer * 3 * NMOD * DM; const float* ngl = P.in[6] + (size_t)layer * 4 * DM;
            const float* xl = layer == 0 ? P.in[0] : P.out; const float* xc = layer == 0 ? P.in[2] : W_XC;
            if (DUP_SUB == 4 && layer == 0) row_phase<1>(F, W_Y, W_PART, 8, NROWS_L, xl, xc, (float*)(ws + WS_U), (float*)(ws + WS_U + 140 * MiB), ngl + 1 * DM, modl, 2, true, ngl + 2 * DM, modl, 3, 4, (bf16*)(ws + WS_U + 200 * MiB), nullptr);
            if ((layer & 1) == 0) row_phase<1>(F, W_Y, W_PART, 8, NROWS_L, xl, xc, P.out, W_XC, ngl + 1 * DM, modl, 2, true, ngl + 2 * DM, modl, 3, 4, W_HM, nullptr);
            else row_phase<2>(F, W_U, W_PART, 8, NROWS_L, xl, xc, P.out, W_XC, ngl + 1 * DM, modl, 2, true, ngl + 2 * DM, modl, 3, 4, W_HM, nullptr);
        }
        SEAM();
        PHASE_BEGIN { LOCALS();
            pg8::OrderUp S{F.G, F.bid, LASTL ? 66 : 70, (const char*)W_HM, (const char*)(ws + WS_WUP + layer * SZ_WUP), WGM_C2};
            typedef pg8::EpiUpGlu<(DUP_SUB == 3 && layer == 0) ? 2 : 1> EpiUp; EpiUp E{W_A5, P.in[8] + (size_t)layer * 3 * DFF2, P.in[9] + (size_t)layer * DFF2, (LAS float*)(F.lds + AUX_OFF)};
            pg8::gemm_phase<EpiUp, pg8::OrderUp, true>(F.lds, F.tid, pg8::Gemm{DM, DM}, S, E);
        }
        SEAM();
        PHASE_BEGIN { LOCALS();
            pg8::OrderSplit S; S.init(W_A5, ws + WS_WDOWN + layer * SZ_WDOWN, DM, DFF, DFF, DFF, LASTL ? 0 : 1, F.G, F.bid, 0, WGM_C4);
            pg8::EpiYb E{W_Y, DM, nullptr, W_PART};
            pg8::gemm_phase<pg8::EpiYb, pg8::OrderSplit, true>(F.lds, F.tid, pg8::Gemm{DFF, DFF}, S, E);
        }
        SEAM();
        PHASE_BEGIN { LOCALS();
            const float* modl = W_MOD + (size_t)layer * 3 * NMOD * DM; const float* ngl = P.in[6] + (size_t)layer * 4 * DM;
            row_phase<1>(F, W_Y, W_PART, 15, NROWS_L, P.out, W_XC, P.out, W_XC, ngl + 3 * DM, modl, 5, !LASTL, ngl + 4 * DM, modl + 3 * NMOD * DM, 0, 1, ((layer & 1) == 0) ? nullptr : W_HM, ((layer & 1) == 0) ? W_A5 : nullptr);
        }
        SEAM();
    }
    { constexpr int layer = 2;
        constexpr int jj = layer >> 1; constexpr bool LASTL = (layer == DEPTH - 1); constexpr int NROWS_L = LASTL ? NLAT : MROWS;
        if ((layer & 1) == 0) {
            PHASE_BEGIN { LOCALS();
                pg8::OrderE1 S{F.G, F.bid, (const char*)W_HM, (const char*)(ws + WS_WIN + jj * SZ_WIN)};
                typedef pg8::EpiQKVZ<(DUP_SUB == 5 && layer == 0) ? 3 : 1> EpiE1; EpiE1 E{W_U, W_ZBT, (const float*)(ws + WS_TAB)};
                pg8::gemm_phase<EpiE1, pg8::OrderE1, true>(F.lds, F.tid, pg8::Gemm{DM, DM}, S, E);
            }
            SEAM();
            PHASE_BEGIN { LOCALS();
                for (int rr_ = 0; rr_ < ((DUP_SUB == 1 && layer == 0) ? 2 : 1); ++rr_) for (int c = F.bid; c < 1024; c += F.G) hyena_unit(F, P, jj, c);
                for (int rr_ = 0; rr_ < ((DUP_SUB == 2 && layer == 0) ? 2 : 1); ++rr_) for (int au = F.bid; au < 528; au += F.G) attn_unit(F, P, jj, au);
            }
            SEAM();
            PHASE_BEGIN { LOCALS(); ybt_transpose_phase(F, P); }
            SEAM();
            PHASE_BEGIN { LOCALS();
                pg8::OrderSplit S; S.init(W_YAB, ws + WS_WOUT + jj * SZ_WOUT, DM, DM, DM, DM, 1, F.G, F.bid);
                pg8::EpiYb E{W_Y, DM, nullptr, W_PART};
                pg8::gemm_phase<pg8::EpiYb, pg8::OrderSplit, true>(F.lds, F.tid, pg8::Gemm{DM, DM}, S, E);
            }
            SEAM();
        } else {
            PHASE_BEGIN { LOCALS();
                pg8::OrderS5 S{F.G, F.bid, 256 / 64, (const char*)W_A5, (const char*)(ws + WS_WW + (size_t)jj * S5G * 256 * 256 * 2), (size_t)256 * 256 * 2, 1};
                pg8::EpiF32g E{W_F32U, S5ROWS, nullptr};
                pg8::gemm_phase<pg8::EpiF32g, pg8::OrderS5, true>(F.lds, F.tid, pg8::Gemm{256, S5K}, S, E);
            }
            SEAM();
            PHASE_BEGIN { LOCALS(); s5_carry_phase(F, P, jj); }
            SEAM();
            PHASE_BEGIN { LOCALS();
                pg8::OrderS5 S{F.G, F.bid, S5K / 64, (const char*)W_A5, (const char*)(ws + WS_TT + (size_t)jj * S5G * 256 * 512 * 2), (size_t)256 * 512 * 2, 0};
                pg8::EpiS5G E{W_Y};
                pg8::gemm_phase<pg8::EpiS5G, pg8::OrderS5, true>(F.lds, F.tid, pg8::Gemm{S5K, S5K}, S, E);
            }
            SEAM();
            PHASE_BEGIN { LOCALS();
                pg8::OrderSplit S; S.init(W_Y, ws + WS_WGLU + jj * SZ_WGLU, 2 * DM, DM, DM, DM, LASTL ? 0 : 1, F.G, F.bid, 1, WGM_O4);
                pg8::EpiYb E{W_U, 2 * DM, P.in[32] + (size_t)jj * 2 * DM, W_PART};
                pg8::gemm_phase<pg8::EpiYb, pg8::OrderSplit, true, 1>(F.lds, F.tid, pg8::Gemm{DM, DM}, S, E);
            }
            SEAM();
        }
        PHASE_BEGIN { LOCALS();
            const float* modl = W_MOD + (size_t)layer * 3 * NMOD * DM; const float* ngl = P.in[6] + (size_t)layer * 4 * DM;
            const float* xl = layer == 0 ? P.in[0] : P.out; const float* xc = layer == 0 ? P.in[2] : W_XC;
            if (DUP_SUB == 4 && layer == 0) row_phase<1>(F, W_Y, W_PART, 8, NROWS_L, xl, xc, (float*)(ws + WS_U), (float*)(ws + WS_U + 140 * MiB), ngl + 1 * DM, modl, 2, true, ngl + 2 * DM, modl, 3, 4, (bf16*)(ws + WS_U + 200 * MiB), nullptr);
            if ((layer & 1) == 0) row_phase<1>(F, W_Y, W_PART, 8, NROWS_L, xl, xc, P.out, W_XC, ngl + 1 * DM, modl, 2, true, ngl + 2 * DM, modl, 3, 4, W_HM, nullptr);
            else row_phase<2>(F, W_U, W_PART, 8, NROWS_L, xl, xc, P.out, W_XC, ngl + 1 * DM, modl, 2, true, ngl + 2 * DM, modl, 3, 4, W_HM, nullptr);
        }
        SEAM();
        PHASE_BEGIN { LOCALS();
            pg8::OrderUp S{F.G, F.bid, LASTL ? 66 : 70, (const char*)W_HM, (const char*)(ws + WS_WUP + layer * SZ_WUP), WGM_C2};
            typedef pg8::EpiUpGlu<(DUP_SUB == 3 && layer == 0) ? 2 : 1> EpiUp; EpiUp E{W_A5, P.in[8] + (size_t)layer * 3 * DFF2, P.in[9] + (size_t)layer * DFF2, (LAS float*)(F.lds + AUX_OFF)};
            pg8::gemm_phase<EpiUp, pg8::OrderUp, true>(F.lds, F.tid, pg8::Gemm{DM, DM}, S, E);
        }
        SEAM();
        PHASE_BEGIN { LOCALS();
            pg8::OrderSplit S; S.init(W_A5, ws + WS_WDOWN + layer * SZ_WDOWN, DM, DFF, DFF, DFF, LASTL ? 0 : 1, F.G, F.bid, 0, WGM_C4);
            pg8::EpiYb E{W_Y, DM, nullptr, W_PART};
            pg8::gemm_phase<pg8::EpiYb, pg8::OrderSplit, true>(F.lds, F.tid, pg8::Gemm{DFF, DFF}, S, E);
        }
        SEAM();
        PHASE_BEGIN { LOCALS();
            const float* modl = W_MOD + (size_t)layer * 3 * NMOD * DM; const float* ngl = P.in[6] + (size_t)layer * 4 * DM;
            row_phase<1>(F, W_Y, W_PART, 15, NROWS_L, P.out, W_XC, P.out, W_XC, ngl + 3 * DM, modl, 5, !LASTL, ngl + 4 * DM, modl + 3 * NMOD * DM, 0, 1, ((layer & 1) == 0) ? nullptr : W_HM, ((layer & 1) == 0) ? W_A5 : nullptr);
        }
        SEAM();
    }
    { constexpr int layer = 3;
        constexpr int jj = layer >> 1; constexpr bool LASTL = (layer == DEPTH - 1); constexpr int NROWS_L = LASTL ? NLAT : MROWS;
        if ((layer & 1) == 0) {
            PHASE_BEGIN { LOCALS();
                pg8::OrderE1 S{F.G, F.bid, (const char*)W_HM, (const char*)(ws + WS_WIN + jj * SZ_WIN)};
                typedef pg8::EpiQKVZ<(DUP_SUB == 5 && layer == 0) ? 3 : 1> EpiE1; EpiE1 E{W_U, W_ZBT, (const float*)(ws + WS_TAB)};
                pg8::gemm_phase<EpiE1, pg8::OrderE1, true>(F.lds, F.tid, pg8::Gemm{DM, DM}, S, E);
            }
            SEAM();
            PHASE_BEGIN { LOCALS();
                for (int rr_ = 0; rr_ < ((DUP_SUB == 1 && layer == 0) ? 2 : 1); ++rr_) for (int c = F.bid; c < 1024; c += F.G) hyena_unit(F, P, jj, c);
                for (int rr_ = 0; rr_ < ((DUP_SUB == 2 && layer == 0) ? 2 : 1); ++rr_) for (int au = F.bid; au < 528; au += F.G) attn_unit(F, P, jj, au);
            }
            SEAM();
            PHASE_BEGIN { LOCALS(); ybt_transpose_phase(F, P); }
            SEAM();
            PHASE_BEGIN { LOCALS();
                pg8::OrderSplit S; S.init(W_YAB, ws + WS_WOUT + jj * SZ_WOUT, DM, DM, DM, DM, 1, F.G, F.bid);
                pg8::EpiYb E{W_Y, DM, nullptr, W_PART};
                pg8::gemm_phase<pg8::EpiYb, pg8::OrderSplit, true>(F.lds, F.tid, pg8::Gemm{DM, DM}, S, E);
            }
            SEAM();
        } else {
            PHASE_BEGIN { LOCALS();
                pg8::OrderS5 S{F.G, F.bid, 256 / 64, (const char*)W_A5, (const char*)(ws + WS_WW + (size_t)jj * S5G * 256 * 256 * 2), (size_t)256 * 256 * 2, 1};
                pg8::EpiF32g E{W_F32U, S5ROWS, nullptr};
                pg8::gemm_phase<pg8::EpiF32g, pg8::OrderS5, true>(F.lds, F.tid, pg8::Gemm{256, S5K}, S, E);
            }
            SEAM();
            PHASE_BEGIN { LOCALS(); s5_carry_phase(F, P, jj); }
            SEAM();
            PHASE_BEGIN { LOCALS();
                pg8::OrderS5 S{F.G, F.bid, S5K / 64, (const char*)W_A5, (const char*)(ws + WS_TT + (size_t)jj * S5G * 256 * 512 * 2), (size_t)256 * 512 * 2, 0};
                pg8::EpiS5G E{W_Y};
                pg8::gemm_phase<pg8::EpiS5G, pg8::OrderS5, true>(F.lds, F.tid, pg8::Gemm{S5K, S5K}, S, E);
            }
            SEAM();
            PHASE_BEGIN { LOCALS();
                pg8::OrderSplit S; S.init(W_Y, ws + WS_WGLU + jj * SZ_WGLU, 2 * DM, DM, DM, DM, LASTL ? 0 : 1, F.G, F.bid, 1, WGM_O4);
                pg8::EpiYb E{W_U, 2 * DM, P.in[32] + (size_t)jj * 2 * DM, W_PART};
                pg8::gemm_phase<pg8::EpiYb, pg8::OrderSplit, true, 1>(F.lds, F.tid, pg8::Gemm{DM, DM}, S, E);
            }
            SEAM();
        }
        PHASE_BEGIN { LOCALS();
            const float* modl = W_MOD + (size_t)layer * 3 * NMOD * DM; const float* ngl = P.in[6] + (size_t)layer * 4 * DM;
            const float* xl = layer == 0 ? P.in[0] : P.out; const float* xc = layer == 0 ? P.in[2] : W_XC;
            if (DUP_SUB == 4 && layer == 0) row_phase<1>(F, W_Y, W_PART, 8, NROWS_L, xl, xc, (float*)(ws + WS_U), (float*)(ws + WS_U + 140 * MiB), ngl + 1 * DM, modl, 2, true, ngl + 2 * DM, modl, 3, 4, (bf16*)(ws + WS_U + 200 * MiB), nullptr);
            if ((layer & 1) == 0) row_phase<1>(F, W_Y, W_PART, 8, NROWS_L, xl, xc, P.out, W_XC, ngl + 1 * DM, modl, 2, true, ngl + 2 * DM, modl, 3, 4, W_HM, nullptr);
            else row_phase<2>(F, W_U, W_PART, 8, NROWS_L, xl, xc, P.out, W_XC, ngl + 1 * DM, modl, 2, true, ngl + 2 * DM, modl, 3, 4, W_HM, nullptr);
        }
        SEAM();
        PHASE_BEGIN { LOCALS();
            pg8::OrderUp S{F.G, F.bid, LASTL ? 66 : 70, (const char*)W_HM, (const char*)(ws + WS_WUP + layer * SZ_WUP), WGM_C2};
            typedef pg8::EpiUpGlu<(DUP_SUB == 3 && layer == 0) ? 2 : 1> EpiUp; EpiUp E{W_A5, P.in[8] + (size_t)layer * 3 * DFF2, P.in[9] + (size_t)layer * DFF2, (LAS float*)(F.lds + AUX_OFF)};
            pg8::gemm_phase<EpiUp, pg8::OrderUp, true>(F.lds, F.tid, pg8::Gemm{DM, DM}, S, E);
        }
        SEAM();
        PHASE_BEGIN { LOCALS();
            pg8::OrderSplit S; S.init(W_A5, ws + WS_WDOWN + layer * SZ_WDOWN, DM, DFF, DFF, DFF, LASTL ? 0 : 1, F.G, F.bid, 0, WGM_C4);
            pg8::EpiYb E{W_Y, DM, nullptr, W_PART};
            pg8::gemm_phase<pg8::EpiYb, pg8::OrderSplit, true>(F.lds, F.tid, pg8::Gemm{DFF, DFF}, S, E);
        }
        SEAM();
        PHASE_BEGIN { LOCALS();
            const float* modl = W_MOD + (size_t)layer * 3 * NMOD * DM; const float* ngl = P.in[6] + (size_t)layer * 4 * DM;
            row_phase<1>(F, W_Y, W_PART, 15, NROWS_L, P.out, W_XC, P.out, W_XC, ngl + 3 * DM, modl, 5, !LASTL, ngl + 4 * DM, modl + 3 * NMOD * DM, 0, 1, ((layer & 1) == 0) ? nullptr : W_HM, ((layer & 1) == 0) ? W_A5 : nullptr);
        }
        SEAM();
    }
#undef RUNP
#undef SEAM
}

extern "C" void kernel_launch(void* const* d_in, const int* in_sizes, int n_in, void* d_out, int out_size, void* d_ws, size_t ws_size, hipStream_t stream) {
    static int grid = 0;
    if (grid == 0) {
        if (n_in != 33 || out_size != NLAT * DM || ws_size < WS_END) { fprintf(stderr, "kernel_launch: unexpected problem (n_in %d, out %d, ws %zu < %zu)\n", n_in, out_size, ws_size, (size_t)WS_END); grid = -1; return; }
        int dev = 0, cus = 0, per_cu = 0;
        if (hipGetDevice(&dev) != hipSuccess || hipDeviceGetAttribute(&cus, hipDeviceAttributeMultiprocessorCount, dev) != hipSuccess) { grid = -1; return; }
        if (hipFuncSetAttribute((const void*)hybrid_fwd, hipFuncAttributeMaxDynamicSharedMemorySize, LDS_BYTES) != hipSuccess) { fprintf(stderr, "kernel_launch: hipFuncSetAttribute failed\n"); grid = -1; return; }
        if (hipOccupancyMaxActiveBlocksPerMultiprocessor(&per_cu, (const void*)hybrid_fwd, NTHR, LDS_BYTES) != hipSuccess || per_cu < 1) fprintf(stderr, "kernel_launch: occupancy query reports %d blocks per CU\n", per_cu);
        (void)hipGetLastError();
        grid = cus;
    }
    if (grid < 0) return;
    if (hipMemsetAsync((char*)d_ws + WS_CTL, 0, CTL_BYTES, stream) != hipSuccess) return;
    Params p{};
    for (int i = 0; i < 33; ++i) p.in[i] = (const float*)d_in[i];
    p.out = (float*)d_out; p.ws = (unsigned char*)d_ws; p.pad0 = 0; p.pad1 = 0;
#ifdef MK_PER_PHASE
    for (int ph = 0; ph < N_PHASES; ++ph) { p.lo = ph; p.hi = ph + 1; hipLaunchKernelGGL(hybrid_fwd, dim3(grid), dim3(NTHR), LDS_BYTES, stream, p); }
#else
    p.lo = 0; p.hi = N_PHASES;
    hipLaunchKernelGGL(hybrid_fwd, dim3(grid), dim3(NTHR), LDS_BYTES, stream, p);
#endif
    const hipError_t le = hipPeekAtLastError();
    if (le != hipSuccess) fprintf(stderr, "kernel_launch: launch failed: %s\n", hipGetErrorName(le));
}
```

```cpp
#include <hip/hip_runtime.h>
#include <cstdio>
#include <cstdint>
namespace pg8 {
#define PG8_LAS __attribute__((address_space(3)))
typedef unsigned short bf16_t;
typedef short bf16x8 __attribute__((ext_vector_type(8)));
typedef float f32x4 __attribute__((ext_vector_type(4)));
typedef unsigned u32x4 __attribute__((ext_vector_type(4)));
typedef unsigned u32x2 __attribute__((ext_vector_type(2)));
constexpr int BM = 256, BK = 64, HALF = 128, HTB = HALF * BK * 2  , STAGE_BYTES = 8 * HTB, NXCD = 8, WGM = 4;

__host__ __device__ __forceinline__ int lds_byte(int r, int c) { const int st = (r >> 4) * 2 + (c >> 5), rr = r & 15, cc = c & 31, ob = rr * 64 + cc * 2; return st * 1024 + (ob ^ (((ob >> 9) & 1) << 5)); }
__host__ __device__ __forceinline__ void stage_rc(int b, int& R, int& C) { const int st = b / 1024, sb = b % 1024, swz = sb ^ (((sb >> 9) & 1) << 5); R = (st >> 1) * 16 + swz / 64; C = (st & 1) * 32 + (swz % 64) / 2; }
__host__ __device__ __forceinline__ int perm32(int rho) { const int n = rho >> 4, i = rho & 15; return 8 * (i >> 2) + 4 * n + (i & 3); }

struct Unit { int pm, pn, kind, nt; const char* a; const char* b; };
struct Gemm { int lda, ldb; };

__host__ __device__ __forceinline__ void tile_map(int wgid, int nM, int nN, int& pm, int& pn, const int wgm = WGM) {
    const int nwg = nM * nN;
    { const int q = nwg / NXCD, r = nwg % NXCD, xcd = wgid % NXCD, off = wgid / NXCD; wgid = (xcd < r ? xcd * (q + 1) : r * (q + 1) + (xcd - r) * q) + off; }
    const int nig = wgm * nN, gid = wgid / nig, fm = gid * wgm, gsz = (nM - fm) < wgm ? (nM - fm) : wgm;
    pm = fm + ((wgid % nig) % gsz); pn = (wgid % nig) / gsz;
}
struct StaticOrder {
    int nM, nN, nwg, G, c, nt; const char* A; const char* Bt; size_t ta, tb;
    __device__ void init(const void* A_, const void* Bt_, int M, int N, int K, int lda, int ldb, int G_, int c_) { nt = K / BK; nM = M / BM; nN = N / BM; nwg = nM * nN; G = G_; c = c_; A = (const char*)A_; Bt = (const char*)Bt_; ta = (size_t)BM * lda * 2; tb = (size_t)BM * ldb * 2; }
    __device__ bool next(int i, Unit& u) const {
        const long L = (long)i * G + c; if (L >= nwg) return false;
        tile_map((int)L, nM, nN, u.pm, u.pn); u.kind = 0; u.nt = nt; u.a = A + (size_t)u.pm * ta; u.b = Bt + (size_t)u.pn * tb; return true;
    }
};

__device__ __forceinline__ unsigned cvt_pk_bf16(float lo, float hi) { unsigned r; asm volatile("v_cvt_pk_bf16_f32 %0, %1, %2" : "=v"(r) : "v"(lo), "v"(hi)); return r; }

template <class Epi, class Sched, bool ALIGN_EPI, int AMODE = 0>
__device__ __forceinline__ void gemm_phase(PG8_LAS unsigned char* lds, const int tid, const Gemm g, const Sched& S, const Epi& E) {
    const int wid = __builtin_amdgcn_readfirstlane(tid >> 6), lane = tid & 63, wr = wid >> 2, wc = wid & 3, fr = lane & 15, fq = lane >> 4;
    unsigned voffA[2], voffB[2];
#pragma unroll
    for (int i = 0; i < 2; ++i) { int R, C; stage_rc(tid * 16 + i * 8192, R, C); const int Rb = Epi::PERM ? ((R & ~31) + perm32(R & 31)) : R;
        voffA[i] = AMODE == 1 ? (unsigned)((C >> 4) * (1280 * 256) + (R >> 4) * 256 + (R & 15) * 16 + (C & 15)) * 2u : (unsigned)(R * g.lda + C) * 2u; voffB[i] = (unsigned)(Rb * g.ldb + C) * 2u; }
    const size_t kstepB = (size_t)(BK * 2), kstepA = AMODE == 1 ? (size_t)4 * 1280 * 256 * 2 : (size_t)(BK * 2);
    const size_t hstepA = AMODE == 1 ? (size_t)8 * 256 * 2 : (size_t)HALF * g.lda * 2, hstepB = (size_t)HALF * g.ldb * 2;
    const unsigned ldsw = (unsigned)wid * 1024u;
    const int aoff = lds_byte(wr * 64 + fr, fq * 8), boff = lds_byte(wc * 32 + fr, fq * 8);
#define PG8_SA(b, h) (((b) * 2 + (h)) * HTB)
#define PG8_SB(b, h) ((4 + (b) * 2 + (h)) * HTB)
#define PG8_STAGE(bufoff, gbase, voff) do { _Pragma("unroll") for (int _i = 0; _i < 2; ++_i) \
        __builtin_amdgcn_global_load_lds((const unsigned*)((const char*)(gbase) + (voff)[_i]), (PG8_LAS unsigned*)(lds + (bufoff) + ldsw + _i * 8192), 16, 0, 0); } while (0)
#define PG8_LDA(dst, b, h) do { _Pragma("unroll") for (int m = 0; m < 4; ++m) _Pragma("unroll") for (int k = 0; k < 2; ++k) dst[m][k] = *(const PG8_LAS bf16x8*)(lds + PG8_SA(b, h) + aoff + m * 2048 + k * 1024); } while (0)
#define PG8_LDB(dst, b, h) do { _Pragma("unroll") for (int n = 0; n < 2; ++n) _Pragma("unroll") for (int k = 0; k < 2; ++k) dst[n][k] = *(const PG8_LAS bf16x8*)(lds + PG8_SB(b, h) + boff + n * 2048 + k * 1024); } while (0)
#define PG8_MMA(ai, bj, At, Bt) do { __builtin_amdgcn_s_setprio(1); _Pragma("unroll") for (int m = 0; m < 4; ++m) _Pragma("unroll") for (int n = 0; n < 2; ++n) _Pragma("unroll") for (int k = 0; k < 2; ++k) \
        acc[ai][bj][m][n] = __builtin_amdgcn_mfma_f32_16x16x32_bf16(Bt[n][k], At[m][k], acc[ai][bj][m][n], 0, 0, 0); __builtin_amdgcn_s_setprio(0); } while (0)
#define PG8_WAIT_V(n) asm volatile("s_waitcnt vmcnt(" #n ")" ::: "memory")
#define PG8_WAIT_L(n) asm volatile("s_waitcnt lgkmcnt(" #n ")" ::: "memory")
#define PG8_BAR __builtin_amdgcn_s_barrier()
#define PG8_SCHED __builtin_amdgcn_sched_barrier(0)
    Unit cur, nxt; int ui = 0;
    if (!S.next(0, cur)) return;
    f32x4 acc[2][2][4][2];
#pragma unroll
    for (int a = 0; a < 2; ++a)
#pragma unroll
        for (int b = 0; b < 2; ++b)
#pragma unroll
            for (int m = 0; m < 4; ++m)
#pragma unroll
                for (int n = 0; n < 2; ++n) acc[a][b][m][n] = (f32x4){0.f, 0.f, 0.f, 0.f};
    bf16x8 At[4][2], B0[2][2], B1[2][2];
    const char* cA = cur.a; const char* cB = cur.b;
    PG8_STAGE(PG8_SB(0, 0), cB, voffB); PG8_STAGE(PG8_SB(0, 1), cB + hstepB, voffB); PG8_STAGE(PG8_SA(0, 0), cA, voffA); PG8_STAGE(PG8_SA(0, 1), cA + hstepA, voffA);
    if (wr == 1) PG8_BAR;
    PG8_WAIT_V(2); PG8_BAR;
    PG8_STAGE(PG8_SB(1, 0), cB + kstepB, voffB); PG8_STAGE(PG8_SA(1, 0), cA + kstepA, voffA); PG8_STAGE(PG8_SB(1, 1), cB + hstepB + kstepB, voffB);
    PG8_WAIT_V(6); PG8_BAR;
    for (;;) {
        const bool has_next = S.next(ui + 1, nxt);
        const char* nA = has_next ? nxt.a : cA; const char* nB = has_next ? nxt.b : cB;
        const int nt = cur.nt;
        for (int t = 0; t < nt; t += 2) {
            const bool last = (t == nt - 2);
            const char* a1 = cA + (size_t)(t + 1) * kstepA;
            const char* a2 = last ? nA : cA + (size_t)(t + 2) * kstepA; const char* b2 = last ? nB : cB + (size_t)(t + 2) * kstepB;
            const char* a3 = a2 + kstepA; const char* b3 = b2 + kstepB;
            PG8_LDB(B0, 0, 0); PG8_LDB(B1, 0, 1); PG8_SCHED; PG8_LDA(At, 0, 0); PG8_STAGE(PG8_SA(1, 1), a1 + hstepA, voffA);
            PG8_WAIT_V(8); PG8_WAIT_L(0); PG8_BAR; PG8_MMA(0, 0, At, B0); PG8_MMA(0, 1, At, B1); PG8_BAR; PG8_SCHED;
            PG8_LDA(At, 0, 1); PG8_STAGE(PG8_SB(0, 0), b2, voffB); PG8_STAGE(PG8_SB(0, 1), b2 + hstepB, voffB); PG8_STAGE(PG8_SA(0, 0), a2, voffA);
            PG8_WAIT_V(8); PG8_WAIT_L(0); PG8_BAR; PG8_MMA(1, 0, At, B0); PG8_MMA(1, 1, At, B1); PG8_BAR; PG8_SCHED;
            PG8_LDB(B0, 1, 0); PG8_LDB(B1, 1, 1); PG8_SCHED; PG8_LDA(At, 1, 0); PG8_STAGE(PG8_SA(0, 1), a2 + hstepA, voffA);
            PG8_WAIT_V(8); PG8_WAIT_L(0); PG8_BAR; PG8_MMA(0, 0, At, B0); PG8_MMA(0, 1, At, B1); PG8_BAR; PG8_SCHED;
            PG8_LDA(At, 1, 1); PG8_STAGE(PG8_SB(1, 0), b3, voffB); PG8_STAGE(PG8_SB(1, 1), b3 + hstepB, voffB); PG8_STAGE(PG8_SA(1, 0), a3, voffA);
            PG8_WAIT_V(8); PG8_WAIT_L(0); PG8_BAR; PG8_MMA(1, 0, At, B0); PG8_MMA(1, 1, At, B1); PG8_BAR; PG8_SCHED;
        }
        if constexpr (ALIGN_EPI) { if (wr == 0) PG8_BAR; }
        { int fr_ = fr, fq_ = fq; asm volatile("" : "+v"(fr_), "+v"(fq_)); if constexpr (Epi::REP == 1) E(acc, cur, wr, wc, fr_, fq_); else { int nrep_ = Epi::REP; asm volatile("" : "+s"(nrep_)); _Pragma("unroll 1") for (int rep_e = 0; rep_e < nrep_; ++rep_e) E(acc, cur, wr, wc, fr_, fq_); } }
        if (!has_next) break;
#pragma unroll
        for (int a = 0; a < 2; ++a)
#pragma unroll
            for (int b = 0; b < 2; ++b)
#pragma unroll
                for (int m = 0; m < 4; ++m)
#pragma unroll
                    for (int n = 0; n < 2; ++n) acc[a][b][m][n] = (f32x4){0.f, 0.f, 0.f, 0.f};
        cur = nxt; cA = nA; cB = nB; ++ui;
        if constexpr (ALIGN_EPI) { if (wr == 1) PG8_BAR; }
    }
    PG8_WAIT_V(0);
    if constexpr (!ALIGN_EPI) { if (wr == 0) PG8_BAR; }
    PG8_BAR;
#undef PG8_SA
#undef PG8_SB
#undef PG8_STAGE
#undef PG8_LDA
#undef PG8_LDB
#undef PG8_MMA
#undef PG8_WAIT_V
#undef PG8_WAIT_L
#undef PG8_BAR
#undef PG8_SCHED
}
}
#ifndef WGM_E1
#define WGM_E1 4
#endif
constexpr int DM = 2048, NBATCH = 2, SEQ = 8192, DEPTH = 4, CTXL = 256;
constexpr int NLAT = NBATCH * SEQ, NCTX = NBATCH * CTXL, MROWS = NLAT + NCTX;
constexpr int DFF = 5504, DFF2 = 11008, NMOD = 6;
constexpr int QCOLS = 1024, KVC = 256, HYC = 3072, INCOLS = 4608, QKVC = 1536, HD = 128;
constexpr int S5G = 128, S5P = 64, S5J = 16, S5L = 16, S5ROWS = 1280, S5K = 512;
constexpr float RMS_EPS = 1e-6f;
constexpr float LOG2E = 1.4426950408889634f;
constexpr float QSCALE = 0.08838834764831845f * LOG2E;

typedef unsigned short bf16;
typedef float f32x4 __attribute__((ext_vector_type(4)));
typedef float f32x2 __attribute__((ext_vector_type(2)));
typedef float f32x16 __attribute__((ext_vector_type(16)));
typedef unsigned u32x4 __attribute__((ext_vector_type(4)));
typedef unsigned u32x2 __attribute__((ext_vector_type(2)));
typedef short bf16x8 __attribute__((ext_vector_type(8)));
typedef short s16x4 __attribute__((ext_vector_type(4)));
#define GAS __attribute__((address_space(1)))
#define LAS __attribute__((address_space(3)))
#define DI __device__ __forceinline__

DI unsigned f2bf(float f) { unsigned u = __builtin_bit_cast(unsigned, f); return (u + 0x7fffu + ((u >> 16) & 1u)) >> 16; }
DI unsigned pk2(float lo, float hi) { return pg8::cvt_pk_bf16(lo, hi); }
DI float bf2f(unsigned short b) { return __builtin_bit_cast(float, ((unsigned)b) << 16); }
DI float bflo(unsigned w) { return __builtin_bit_cast(float, w << 16); }
DI float bfhi(unsigned w) { return __builtin_bit_cast(float, w & 0xffff0000u); }
DI float fast_exp(float x) { return __builtin_amdgcn_exp2f(x * LOG2E); }
DI float sigmoidf_(float x) { return __builtin_amdgcn_rcpf(1.0f + fast_exp(-x)); }
DI float siluf_(float x) { return x * sigmoidf_(x); }
DI float gelu_tanh(float x) { const float z = 0.7978845608028654f * (x + 0.044715f * x * x * x); const float e = fast_exp(2.0f * z); const float th = 1.0f - 2.0f * __builtin_amdgcn_rcpf(e + 1.0f); return 0.5f * x * (1.0f + th); }

namespace pg8 {
struct EpiF32g {
    static constexpr bool PERM = false; static constexpr int REP = 1;
    float* C; int ldc; const float* bias;
    __device__ __forceinline__ void operator()(const f32x4 (&acc)[2][2][4][2], const Unit& u, int wr, int wc, int fr, int fq) const {
        const int row0 = u.pm * BM + wr * 64 + fr, col0 = u.pn * BM + wc * 32 + 4 * fq;
        f32x4 bv[2][2];
#pragma unroll
        for (int bj = 0; bj < 2; ++bj)
#pragma unroll
            for (int n = 0; n < 2; ++n) bv[bj][n] = bias ? *(const f32x4*)(bias + col0 + bj * HALF + n * 16) : (f32x4){0.f, 0.f, 0.f, 0.f};
#pragma unroll
        for (int ai = 0; ai < 2; ++ai)
#pragma unroll
            for (int m = 0; m < 4; ++m) { float* rowp = C + (size_t)(row0 + ai * HALF + m * 16) * ldc + col0;
#pragma unroll
                for (int bj = 0; bj < 2; ++bj)
#pragma unroll
                    for (int n = 0; n < 2; ++n) *(f32x4*)(rowp + bj * HALF + n * 16) = acc[ai][bj][m][n] + bv[bj][n]; }
    }
};
struct EpiBf16g {
    static constexpr bool PERM = true; static constexpr int REP = 1;
    bf16_t* O; int ldc;
    __device__ __forceinline__ void operator()(const f32x4 (&acc)[2][2][4][2], const Unit& u, int wr, int wc, int fr, int fq) const {
        const int row0 = u.pm * BM + wr * 64 + fr, col0 = u.pn * BM + wc * 32 + 8 * fq;
#pragma unroll
        for (int ai = 0; ai < 2; ++ai)
#pragma unroll
            for (int m = 0; m < 4; ++m) { bf16_t* rowp = O + (size_t)(row0 + ai * HALF + m * 16) * ldc + col0;
#pragma unroll
                for (int bj = 0; bj < 2; ++bj) { const f32x4 v0 = acc[ai][bj][m][0], v1 = acc[ai][bj][m][1];
                    u32x4 w; w.x = cvt_pk_bf16(v0[0], v0[1]); w.y = cvt_pk_bf16(v0[2], v0[3]); w.z = cvt_pk_bf16(v1[0], v1[1]); w.w = cvt_pk_bf16(v1[2], v1[3]);
                    *(u32x4*)(rowp + bj * HALF) = w; } }
    }
};
struct EpiYb {
    static constexpr bool PERM = true; static constexpr int REP = 1;
    bf16_t* O; int ldc; const float* bias; float* part;
    __device__ __forceinline__ void operator()(const f32x4 (&acc)[2][2][4][2], const Unit& u, int wr, int wc, int fr, int fq) const {
        const int col0 = u.pn * BM + wc * 32 + 8 * fq;
        const bool addb = bias != nullptr && (u.kind == 0 || u.kind == 16);
        f32x4 bv[2][2];
#pragma unroll
        for (int bj = 0; bj < 2; ++bj)
#pragma unroll
            for (int n = 0; n < 2; ++n) bv[bj][n] = addb ? *(const f32x4*)(bias + col0 + bj * HALF + 4 * n) : (f32x4){0.f, 0.f, 0.f, 0.f};
        if (u.kind >= 16) {
            float* base = part + ((size_t)(u.kind - 16) * NCTX + (size_t)(u.pm - NLAT / BM) * BM + wr * 64 + fr) * ldc + col0;
#pragma unroll
            for (int ai = 0; ai < 2; ++ai)
#pragma unroll
                for (int m = 0; m < 4; ++m) { float* rowp = base + (size_t)(ai * HALF + m * 16) * ldc;
#pragma unroll
                    for (int bj = 0; bj < 2; ++bj) { *(f32x4*)(rowp + bj * HALF) = acc[ai][bj][m][0] + bv[bj][0]; *(f32x4*)(rowp + bj * HALF + 4) = acc[ai][bj][m][1] + bv[bj][1]; } }
        } else {
            const int row0 = u.pm * BM + wr * 64 + fr;
#pragma unroll
            for (int ai = 0; ai < 2; ++ai)
#pragma unroll
                for (int m = 0; m < 4; ++m) { bf16_t* rowp = O + (size_t)(row0 + ai * HALF + m * 16) * ldc + col0;
#pragma unroll
                    for (int bj = 0; bj < 2; ++bj) { const f32x4 v0 = acc[ai][bj][m][0] + bv[bj][0], v1 = acc[ai][bj][m][1] + bv[bj][1];
                        u32x4 w; w.x = cvt_pk_bf16(v0[0], v0[1]); w.y = cvt_pk_bf16(v0[2], v0[3]); w.z = cvt_pk_bf16(v1[0], v1[1]); w.w = cvt_pk_bf16(v1[2], v1[3]);
                        *(u32x4*)(rowp + bj * HALF) = w; } }
        }
    }
};
struct OrderSplit {
    int nN, G, c, nt_full, nmain, nchunk, split, ktype, amode, wgm, rev; const char* A; const char* Bt; size_t ta, tb;
    __device__ size_t aoff(int pm, int k0) const { if (!amode) return (size_t)pm * ta + (size_t)k0 * BK * 2; const int cr0 = pm < 64 ? ((pm >> 5) * 512 + (pm & 31) * 16) : (1024 + (pm - 64) * 16); return (size_t)cr0 * 512 + (size_t)k0 * (4 * 1280 * 256 * 2); }
    __device__ void init(const void* A_, const void* Bt_, int N, int K, int lda, int ldb, int split_, int G_, int c_, int amode_ = 0, int wgm_ = WGM, int rev_ = 0) { amode = amode_; wgm = wgm_; rev = rev_; nN = N / BM; G = G_; c = c_; nt_full = K / BK; nmain = (NLAT / BM) * nN; ktype = (K == 2048) ? 0 : 1; nchunk = ktype ? 15 : 8; split = split_;
        A = (const char*)A_; Bt = (const char*)Bt_; ta = (size_t)BM * lda * 2; tb = (size_t)BM * ldb * 2; }
    __device__ bool next(int i, Unit& u) const {
        const long L = (long)i * G + c;
        if (L < nmain) { tile_map((int)L, NLAT / BM, nN, u.pm, u.pn, wgm); if (rev) u.pm = NLAT / BM - 1 - u.pm; u.kind = 0; u.nt = nt_full; u.a = A + aoff(u.pm, 0); u.b = Bt + (size_t)u.pn * tb; return true; }
        if (!split) return false;
        const int s = (int)(L - nmain); if (s >= 2 * nN * nchunk) return false;
        const int tile = s / nchunk, chunk = s - tile * nchunk; const int pmc = tile / nN; u.pn = tile - pmc * nN; u.pm = NLAT / BM + pmc; u.kind = 16 + chunk;
        int k0, ntc; if (ktype == 0) { k0 = chunk * 4; ntc = 4; } else if (chunk < 13) { k0 = chunk * 6; ntc = 6; } else { k0 = 78 + (chunk - 13) * 4; ntc = 4; }
        u.nt = ntc; u.a = A + aoff(u.pm, k0); u.b = Bt + (size_t)u.pn * tb + (size_t)k0 * BK * 2; return true;
    }
};
typedef __bf16 bf16x2v_ __attribute__((ext_vector_type(2)));
__device__ __forceinline__ unsigned cvt_pk_c(float lo, float hi) { const f32x2 v = {lo, hi}; const bf16x2v_ b = __builtin_convertvector(v, bf16x2v_); return __builtin_bit_cast(unsigned, b); }
#define DPP0(src, ctrl) __builtin_bit_cast(float, __builtin_amdgcn_update_dpp(0, __builtin_bit_cast(int, (float)(src)), (ctrl), 0xf, 0xf, true))
__device__ __forceinline__ void up_panel(int pm, int& seq0, int& seqlen, int& g0) {
    int p; if (pm < 66) { const int b = pm / 33; p = pm - 33 * b; seq0 = b * SEQ; seqlen = SEQ; } else { const int c = pm - 66; p = c & 1; seq0 = NLAT + (c >> 1) * CTXL; seqlen = CTXL; }
    g0 = seq0 + 254 * p - 1;
}
template <int REP_ = 1> struct EpiUpGlu {
    static constexpr bool PERM = true; static constexpr int REP = REP_;
    bf16_t* A5; const float* cw; const float* cb; PG8_LAS float* halo;
    __device__ __forceinline__ void operator()(f32x4 (&acc)[2][2][4][2], const Unit& u, int wr, int wc, int fr, int fq) const {
        int seq0, seqlen, g0; up_panel(u.pm, seq0, seqlen, g0);
        const int send = seq0 + seqlen;
        const int cl = wc * 32 + 8 * fq;
        if (g0 < seq0 || g0 + BM > send) {
#pragma unroll
            for (int ai = 0; ai < 2; ++ai)
#pragma unroll
                for (int m = 0; m < 4; ++m) { const int g = g0 + ai * HALF + wr * 64 + m * 16 + fr; const bool in = g >= seq0 && g < send;
#pragma unroll
                    for (int bj = 0; bj < 2; ++bj)
#pragma unroll
                        for (int n = 0; n < 2; ++n)
#pragma unroll
                            for (int e = 0; e < 4; ++e) acc[ai][bj][m][n][e] = in ? acc[ai][bj][m][n][e] : 0.f; } }
#pragma unroll
        for (int ai = 0; ai < 2; ++ai)
#pragma unroll
            for (int bj = 0; bj < 2; ++bj)
#pragma unroll
                for (int n = 0; n < 2; ++n) {
                    if (fr == 0) *(PG8_LAS f32x4*)(halo + (2 * ai + wr) * 512 + bj * 128 + cl + 4 * n) = acc[ai][bj][0][n];
                    if (fr == 15) *(PG8_LAS f32x4*)(halo + (2 * ai + wr) * 512 + 256 + bj * 128 + cl + 4 * n) = acc[ai][bj][3][n]; }
        asm volatile("s_waitcnt lgkmcnt(0)" ::: "memory"); __builtin_amdgcn_s_barrier(); asm volatile("" ::: "memory");
#pragma unroll
        for (int bj = 0; bj < 2; ++bj) {
            const int ch0 = 128 * u.pn + 64 * bj + 16 * wc + 4 * fq;
            f32x4 wg[3], wv[3];
#pragma unroll
            for (int k = 0; k < 3; ++k) { wg[k] = *(const f32x4*)(cw + (size_t)k * DFF2 + ch0); wv[k] = *(const f32x4*)(cw + (size_t)k * DFF2 + DFF + ch0); }
            const f32x4 bg = *(const f32x4*)(cb + ch0), bv = *(const f32x4*)(cb + DFF + ch0);
#pragma unroll
            for (int ai = 0; ai < 2; ++ai) { const int blk = 2 * ai + wr;
                f32x4 hag = (f32x4){0.f, 0.f, 0.f, 0.f}, hav = hag, hbg = hag, hbv = hag;
                if (blk > 0) { hag = *(const PG8_LAS f32x4*)(halo + (blk - 1) * 512 + 256 + bj * 128 + cl); hav = *(const PG8_LAS f32x4*)(halo + (blk - 1) * 512 + 256 + bj * 128 + cl + 4); }
                if (blk < 3) { hbg = *(const PG8_LAS f32x4*)(halo + (blk + 1) * 512 + bj * 128 + cl); hbv = *(const PG8_LAS f32x4*)(halo + (blk + 1) * 512 + bj * 128 + cl + 4); }
                u32x2 pk[4];
#pragma unroll
                for (int m = 0; m < 4; ++m) {
                    const f32x4 cg = acc[ai][bj][m][0], cv = acc[ai][bj][m][1];
                    const f32x4 pbg = m > 0 ? acc[ai][bj][m > 0 ? m - 1 : 0][0] : hag, pbv = m > 0 ? acc[ai][bj][m > 0 ? m - 1 : 0][1] : hav;
                    const f32x4 nbg = m < 3 ? acc[ai][bj][m < 3 ? m + 1 : 3][0] : hbg, nbv = m < 3 ? acc[ai][bj][m < 3 ? m + 1 : 3][1] : hbv;
                    float o[4];
#pragma unroll
                    for (int ep = 0; ep < 2; ++ep) { const int e0 = 2 * ep, e1 = 2 * ep + 1;
                        const f32x2 w0g = {wg[0][e0], wg[0][e1]}, w1g = {wg[1][e0], wg[1][e1]}, w2g = {wg[2][e0], wg[2][e1]};
                        const f32x2 w0v = {wv[0][e0], wv[0][e1]}, w1v = {wv[1][e0], wv[1][e1]}, w2v = {wv[2][e0], wv[2][e1]};
                        f32x2 gate = (f32x2){bg[e0], bg[e1]} + (f32x2){cg[e0], cg[e1]} * w1g;
                        gate += (f32x2){DPP0(cg[e0], 0x111), DPP0(cg[e1], 0x111)} * w0g; gate += (f32x2){DPP0(pbg[e0], 0x10f), DPP0(pbg[e1], 0x10f)} * w0g;
                        gate += (f32x2){DPP0(cg[e0], 0x101), DPP0(cg[e1], 0x101)} * w2g; gate += (f32x2){DPP0(nbg[e0], 0x11f), DPP0(nbg[e1], 0x11f)} * w2g;
                        f32x2 val = (f32x2){bv[e0], bv[e1]} + (f32x2){cv[e0], cv[e1]} * w1v;
                        val += (f32x2){DPP0(cv[e0], 0x111), DPP0(cv[e1], 0x111)} * w0v; val += (f32x2){DPP0(pbv[e0], 0x10f), DPP0(pbv[e1], 0x10f)} * w0v;
                        val += (f32x2){DPP0(cv[e0], 0x101), DPP0(cv[e1], 0x101)} * w2v; val += (f32x2){DPP0(nbv[e0], 0x11f), DPP0(nbv[e1], 0x11f)} * w2v;
                        const f32x2 ex = gate * (-LOG2E);
                        const f32x2 den = (f32x2){__builtin_amdgcn_exp2f(ex[0]), __builtin_amdgcn_exp2f(ex[1])} + 1.0f;
                        const f32x2 sg = {__builtin_amdgcn_rcpf(den[0]), __builtin_amdgcn_rcpf(den[1])};
                        const f32x2 ov = gate * sg * val; o[e0] = ov[0]; o[e1] = ov[1]; }
                    pk[m].x = cvt_pk_c(o[0], o[1]); pk[m].y = cvt_pk_c(o[2], o[3]);
                }
#pragma unroll
                for (int m2 = 0; m2 < 4; m2 += 2) {
                    const auto rx = __builtin_amdgcn_permlane16_swap(pk[m2].x, pk[m2 + 1].x, false, false);
                    const auto ry = __builtin_amdgcn_permlane16_swap(pk[m2].y, pk[m2 + 1].y, false, false);
                    const int r = ai * HALF + wr * 64 + (m2 + (fq & 1)) * 16 + fr, g = g0 + r;
                    if (r >= 1 && r <= 254 && g >= seq0 && g < send) *(u32x4*)(A5 + (size_t)g * DFF + ch0 - 4 * (fq & 1)) = (u32x4){rx[0], ry[0], rx[1], ry[1]};
                }
            }
        }
    }
};
struct OrderUp {
    int G, c, nP; const char* HM; const char* W; int wgm;
    __device__ bool next(int i, Unit& u) const {
        const long L = (long)i * G + c; if (L >= (long)nP * 43) return false;
        tile_map((int)L, nP, 43, u.pm, u.pn, wgm); u.kind = 0; u.nt = DM / BK;
        int seq0, seqlen, g0; up_panel(u.pm, seq0, seqlen, g0);
        u.a = HM + (long)g0 * (DM * 2); u.b = W + (size_t)u.pn * BM * DM * 2; return true;
    }
};
template <int REP_ = 1> struct EpiQKVZ {
    static constexpr bool PERM = true; static constexpr int REP = REP_;
    bf16_t* QKV; bf16_t* ZBT; const float* tab;
    __device__ __forceinline__ void operator()(const f32x4 (&acc)[2][2][4][2], const Unit& u, int wr, int wc, int fr, int fq) const {
        const int row0 = u.pm * BM + wr * 64 + fr, col0 = u.pn * BM + wc * 32 + 8 * fq;
        if (u.kind == 1) {
#pragma unroll
            for (int ai = 0; ai < 2; ++ai)
#pragma unroll
                for (int m = 0; m < 4; ++m) { bf16_t* rowp = ZBT + (size_t)(row0 + ai * HALF + m * 16) * MROWS + col0;
#pragma unroll
                    for (int bj = 0; bj < 2; ++bj) { const f32x4 v0 = acc[ai][bj][m][0], v1 = acc[ai][bj][m][1];
                        u32x4 w; w.x = cvt_pk_bf16(v0[0], v0[1]); w.y = cvt_pk_bf16(v0[2], v0[3]); w.z = cvt_pk_bf16(v1[0], v1[1]); w.w = cvt_pk_bf16(v1[2], v1[3]);
                        *(u32x4*)(rowp + bj * HALF) = w; } }
        } else {
            const bool rope = (u.pn < 5) && (u.pm < 64);
            const float sc = (u.pn < 4) ? QSCALE : 1.0f;
            const int gi = 4 * wc + fq, f0 = 4 * (gi & 7); const bool rowang = gi < 8;
#pragma unroll
            for (int ai = 0; ai < 2; ++ai)
#pragma unroll
                for (int m = 0; m < 4; ++m) { const int r = row0 + ai * HALF + m * 16;
                    f32x4 cs0 = (f32x4){1.f, 0.f, 1.f, 0.f}, cs1 = cs0;
                    if (rope) { const int tok = r & (SEQ - 1); const int pos = rowang ? (tok >> 6) : (tok & 63); const f32x4* tp = (const f32x4*)(tab + (size_t)(pos * 32 + f0) * 2); cs0 = tp[0]; cs1 = tp[1]; }
                    const f32x4 cv = (f32x4){cs0[0], cs0[2], cs1[0], cs1[2]}, sv = (f32x4){cs0[1], cs0[3], cs1[1], cs1[3]};
                    bf16_t* rowp = QKV + (size_t)r * QKVC + col0;
#pragma unroll
                    for (int bj = 0; bj < 2; ++bj) { const f32x4 a0 = acc[ai][bj][m][0], a1 = acc[ai][bj][m][1];
                        const f32x4 v0 = (a0 * cv - a1 * sv) * sc, v1 = (a1 * cv + a0 * sv) * sc;
                        u32x4 w; w.x = cvt_pk_bf16(v0[0], v0[1]); w.y = cvt_pk_bf16(v0[2], v0[3]); w.z = cvt_pk_bf16(v1[0], v1[1]); w.w = cvt_pk_bf16(v1[2], v1[3]);
                        *(u32x4*)(rowp + bj * HALF) = w; } }
        }
    }
};
struct EpiS5G {
    static constexpr bool PERM = true; static constexpr int REP = 1;
    bf16_t* O;
    __device__ __forceinline__ void operator()(const f32x4 (&acc)[2][2][4][2], const Unit& u, int wr, int wc, int fr, int fq) const {
        const int row0 = u.pm * BM + wr * 64 + fr, col0 = wc * 32 + 8 * fq;
#pragma unroll
        for (int ai = 0; ai < 2; ++ai)
#pragma unroll
            for (int m = 0; m < 4; ++m) { bf16_t* rowp = O + (size_t)(row0 + ai * HALF + m * 16) * 256 + col0;
#pragma unroll
                for (int bj = 0; bj < 2; ++bj) { const f32x4 a0 = acc[ai][bj][m][0], a1 = acc[ai][bj][m][1];
                    u32x4 w; w.x = cvt_pk_bf16(gelu_tanh(a0[0]), gelu_tanh(a0[1])); w.y = cvt_pk_bf16(gelu_tanh(a0[2]), gelu_tanh(a0[3]));
                    w.z = cvt_pk_bf16(gelu_tanh(a1[0]), gelu_tanh(a1[1])); w.w = cvt_pk_bf16(gelu_tanh(a1[2]), gelu_tanh(a1[3]));
                    *(u32x4*)(rowp + bj * HALF) = w; } }
    }
};
struct OrderE1 {
    int G, c; const char* HM; const char* Win;
    __device__ bool next(int i, Unit& u) const {
        const long L = (long)i * G + c; if (L >= 1188) return false;
        if (L < 792) { tile_map((int)L, 12, 66, u.pm, u.pn, WGM_E1); u.kind = 1; u.nt = DM / BK; u.a = Win + (size_t)(QKVC + u.pm * BM) * DM * 2; u.b = HM + (size_t)u.pn * BM * DM * 2; }
        else { tile_map((int)L - 792, 66, 6, u.pm, u.pn, WGM_E1); u.kind = 0; u.nt = DM / BK; u.a = HM + (size_t)u.pm * BM * DM * 2; u.b = Win + (size_t)u.pn * BM * DM * 2; }
        return true;
    }
};
struct OrderS5 {
    int G, c, nt; const char* UA; const char* Bm; size_t bstride; int swapped;
    __device__ bool next(int i, Unit& u) const {
        const long L0 = (long)i * G + c; if (L0 >= S5G * 4) return false;
        const int L = (int)(L0 % NXCD) * (S5G * 4 / NXCD) + (int)(L0 / NXCD);
        const int g = L >> 2, pml = L & 3;
        u.kind = 0; u.nt = nt; const char* ua = UA + ((size_t)g * S5ROWS + (size_t)pml * BM) * S5K * 2; const char* bm = Bm + (size_t)g * bstride;
        if (swapped) { u.pm = g; u.pn = pml; u.a = bm; u.b = ua; } else { u.pm = 5 * g + pml; u.pn = 0; u.a = ua; u.b = bm; }
        return true;
    }
};
}
#define XB_TMO      128
#define XB_XCNT(j)  (256  + 64 * (j))
#define XB_XSUB(j)  (1280 + 64 * (j))
#define XB_XGEN(j)  (2304 + 64 * (j))
#define XB_TOP      3328
#define XB_TOPGEN   3392
#define XCD_BAR_WORDS 3456
#define XB_SPIN_CAP (1u << 22)

__device__ __forceinline__ unsigned xb_ld(unsigned* p)              { return __hip_atomic_load(p, __ATOMIC_RELAXED, __HIP_MEMORY_SCOPE_AGENT); }
__device__ __forceinline__ unsigned xb_add(unsigned* p, unsigned v) { return __hip_atomic_fetch_add(p, v, __ATOMIC_RELAXED, __HIP_MEMORY_SCOPE_AGENT); }
__device__ __forceinline__ unsigned xb_xcc_id() { return (unsigned)__builtin_amdgcn_s_getreg((3 << 11) | 20) & 0xFu; }
#define XB_SPIN(cond, bar) do { unsigned _sp = 0; while (cond) { __builtin_amdgcn_s_sleep(1); \
    if ((++_sp & 255u) == 0u) { if (xb_ld(&(bar)[XB_TMO])) break; if (_sp > XB_SPIN_CAP) { atomicAdd(&(bar)[XB_TMO], 1u); break; } } } } while (0)

struct XcdBarrier {
    unsigned* bar; unsigned x;
    volatile LAS unsigned* st;
};

__device__ __forceinline__ XcdBarrier xcd_barrier_post(unsigned* bar, volatile LAS unsigned* st) {
    XcdBarrier b; b.bar = bar; b.x = xb_xcc_id(); b.st = st;
    if (threadIdx.x == 0) (void)xb_add(&bar[XB_XCNT(b.x)], 1u);
    return b;
}
__device__ __forceinline__ void xcd_barrier_complete(unsigned* bar, unsigned x, unsigned& nloc, unsigned& nx) {
    const unsigned G = gridDim.x * gridDim.y * gridDim.z;
    unsigned sum, cnt, mine, sp = 0u;
    for (;;) {
        sum = 0u; cnt = 0u; mine = 0u;
#pragma unroll
        for (unsigned j = 0; j < 16; ++j) { const unsigned c = xb_ld(&bar[XB_XCNT(j)]); sum += c; cnt += (c > 0u) ? 1u : 0u; mine = (j == x) ? c : mine; }
        if (sum == G) break;
        __builtin_amdgcn_s_sleep(1);
        if ((++sp & 255u) == 0u) { if (xb_ld(&bar[XB_TMO])) break; if (sp > XB_SPIN_CAP) { atomicAdd(&bar[XB_TMO], 1u); break; } }
    }
    nloc = mine > 0u ? mine : 1u; nx = cnt > 0u ? cnt : 1u;
}

__device__ __forceinline__ void xcd_barrier(const XcdBarrier& b) {
    asm volatile("s_waitcnt vmcnt(0)" ::: "memory");
    __syncthreads();
    if (threadIdx.x == 0) {
        unsigned* bar = b.bar;
        __builtin_amdgcn_s_waitcnt(0);
        unsigned nloc = b.st[0], nx = b.st[1];
        if (nloc == 0u) { xcd_barrier_complete(bar, b.x, nloc, nx); b.st[0] = nloc; b.st[1] = nx; }
        const unsigned old = xb_add(&bar[XB_XSUB(b.x)], 1u);
        const unsigned gen = old / nloc;
        if (old + 1u == (gen + 1u) * nloc) {
            __builtin_amdgcn_fence(__ATOMIC_RELEASE, "agent");
            asm volatile("s_waitcnt vmcnt(0)" ::: "memory");
            const unsigned og = xb_add(&bar[XB_TOP], 1u);
            const unsigned tg = og / nx;
            if (og + 1u == (tg + 1u) * nx) xb_add(&bar[XB_TOPGEN], 1u);
            else XB_SPIN(xb_ld(&bar[XB_TOPGEN]) == tg, bar);
            __builtin_amdgcn_fence(__ATOMIC_ACQUIRE, "agent");
            xb_add(&bar[XB_XGEN(b.x)], 1u);
            asm volatile("s_waitcnt vmcnt(0)" ::: "memory");
        } else {
            XB_SPIN(xb_ld(&bar[XB_XGEN(b.x)]) == gen, bar);
            __builtin_amdgcn_fence(__ATOMIC_ACQUIRE, "agent");
            asm volatile("s_waitcnt vmcnt(0)" ::: "memory");
        }
    }
    __syncthreads();
}

#ifndef DUP_SUB
#define DUP_SUB 0
#endif
typedef __bf16 bf16x2w_ __attribute__((ext_vector_type(2)));
DI unsigned cvtpk_c2(float lo, float hi) { const f32x2 v = {lo, hi}; const bf16x2w_ b = __builtin_convertvector(v, bf16x2w_); return __builtin_bit_cast(unsigned, b); }
constexpr size_t MiB = 1u << 20;
constexpr size_t WS_CTL = 0, CTL_BYTES = 1 * MiB;
constexpr size_t WS_MOD = 1 * MiB;
constexpr size_t WS_MODP = 2 * MiB;
constexpr size_t WS_TAB = 7 * MiB;
constexpr size_t WS_HID = 8 * MiB;
constexpr size_t WS_LAML = 13 * MiB;
constexpr size_t WS_XC = 14 * MiB;
constexpr size_t WS_FILTC = 18 * MiB;
constexpr size_t WS_FILT = 22 * MiB;
constexpr size_t WS_TT = 150 * MiB;
constexpr size_t WS_WW = 214 * MiB;
constexpr size_t WS_WUP = 246 * MiB;
constexpr size_t WS_WDOWN = 418 * MiB;
constexpr size_t WS_WIN = 504 * MiB;
constexpr size_t WS_WOUT = 540 * MiB;
constexpr size_t WS_WGLU = 556 * MiB;
constexpr size_t WS_HM = 588 * MiB;
constexpr size_t WS_YAB = 654 * MiB;
constexpr size_t WS_Y = 720 * MiB;
constexpr size_t WS_A5 = 852 * MiB;
constexpr size_t WS_U = 1030 * MiB;
constexpr size_t WS_PART = 1385 * MiB;
constexpr size_t WS_END = 1453 * MiB;
constexpr size_t SZ_WUP = (size_t)DFF2 * DM * 2, SZ_WDOWN = (size_t)DM * DFF * 2, SZ_WIN = (size_t)INCOLS * DM * 2, SZ_WOUT = (size_t)DM * DM * 2, SZ_WGLU = (size_t)2 * DM * DM * 2;
constexpr int CW_BAR = 4096;

constexpr int RING_BYTES = 131072, AUX_OFF = 131072, AUX_BYTES = 16384, LDSCTL_OFF = AUX_OFF + AUX_BYTES, LDS_BYTES = LDSCTL_OFF + 512;
constexpr int NWAVES = 8, NTHR = 512;

struct Params { const float* in[33]; float* out; unsigned char* ws; int lo, hi, pad0, pad1; };
struct Frame { LAS unsigned char* lds; int tid, lane, wave, G, bid; };

DI void sincos_rr(float x, float& sn, float& cs) {
    double r = (double)x * 0.15915494309189535; r = r - floor(r); const float rf = (float)r; sn = __builtin_amdgcn_sinf(rf); cs = __builtin_amdgcn_cosf(rf); }
DI float wave_sum(float v) {
#pragma unroll
    for (int o = 1; o < 64; o <<= 1) v += __shfl_xor(v, o);
    return v;
}
DI float block_sum(const Frame& F, float v, LAS float* red) {
    v = wave_sum(v);
    __syncthreads();
    if (F.lane == 0) red[F.wave] = v;
    __syncthreads();
    float t = 0.f;
#pragma unroll
    for (int i = 0; i < NWAVES; ++i) t += red[i];
    return t;
}

DI void transpose_item1(const Frame& F, const float* W, int K, int N, bf16* WT, int item, int mode) {
    const int nb = N >> 7; const int kb = item / nb, nbk = item - kb * nb; const int k0 = kb * 64, n0 = nbk * 128;
    LAS unsigned short* tile = (LAS unsigned short*)F.lds;
    const int tn = (F.tid & 31) * 4, tk = (F.tid >> 5) * 4;
    const int nd = n0 + tn; int ns = nd;
    if (mode == 2) { const int tile = nd >> 8, pp = nd & 255; ns = ((pp >> 2) & 1) * DFF + 128 * tile + 4 * (pp >> 3); }
    if (mode == 1 && nd < 1280) { const int d = nd & 127, gi = d >> 3, n = (d >> 2) & 1; ns = (nd & ~127) + ((gi < 8) ? 0 : 64) + 32 * n + 4 * (gi & 7); }
    f32x4 v[4];
#pragma unroll
    for (int i = 0; i < 4; ++i) v[i] = *(const f32x4*)(W + (size_t)(k0 + tk + i) * N + ns);
#pragma unroll
    for (int e = 0; e < 4; ++e) { u32x2 w; w.x = pk2(v[0][e], v[1][e]); w.y = pk2(v[2][e], v[3][e]); *(LAS u32x2*)(tile + (tn + e) * 72 + tk) = w; }
    __syncthreads();
#pragma unroll
    for (int i = 0; i < 2; ++i) { const int p = F.tid + 512 * i, n = p >> 3, kc = p & 7;
        const u32x4 w = *(const LAS u32x4*)(tile + n * 72 + kc * 8);
        *(u32x4*)(WT + (size_t)(n0 + n) * K + k0 + kc * 8) = w; }
    __syncthreads();
}
DI void transpose_item(const Frame& F, const float* W, int K, int N, bf16* WT, int item, int mode) { transpose_item1(F, W, K, N, WT, item, mode); if (DUP_SUB == 9) transpose_item1(F, W, K, N, WT, item, mode); }
DI void modp_unit(const Frame& F, const Params& P, int u) {
    const int cb = u % 24, lk = u / 24, kc = lk & 7, l = lk >> 3;
    LAS float* sv = (LAS float*)F.lds;
    for (int i = F.tid; i < 768; i += NTHR) { const int r = i >> 8, k = i & 255, kk = kc * 256 + k; const float v = (r < 2) ? P.in[1][r * DM + kk] : P.in[3][kk]; sv[i] = v / (1.0f + expf(-v)); }
    __syncthreads();
    const int j = cb * 512 + F.tid; const float* w = P.in[4] + ((size_t)l * DM + kc * 256) * (NMOD * DM) + j;
    float a0 = 0.f, a1 = 0.f, a2 = 0.f;
#pragma unroll 1
    for (int k0 = 0; k0 < 256; k0 += 32) { float wv[32];
#pragma unroll
        for (int k = 0; k < 32; ++k) wv[k] = __builtin_nontemporal_load(w + (size_t)(k0 + k) * (NMOD * DM));
#pragma unroll
        for (int k = 0; k < 32; ++k) { a0 += sv[k0 + k] * wv[k]; a1 += sv[256 + k0 + k] * wv[k]; a2 += sv[512 + k0 + k] * wv[k]; } }
    float* mp = (float*)(P.ws + WS_MODP) + (size_t)(l * 8 + kc) * 3 * (NMOD * DM) + j;
    mp[0] = a0; mp[NMOD * DM] = a1; mp[2 * NMOD * DM] = a2;
    __syncthreads();
}
DI void hid_unit(const Frame& F, const Params& P, int u) {
    int l, n, tb; float* dst;
    if (u < 256) { l = u >> 7; n = SEQ; tb = u & 127; dst = (float*)(P.ws + WS_HID) + (size_t)l * SEQ * 64; }
    else { const int v = u - 256; l = v >> 2; n = CTXL; tb = v & 3; dst = (float*)(P.ws + WS_HID + 4 * MiB) + (size_t)l * CTXL * 64; }
    LAS float* zs = (LAS float*)F.lds; LAS float* h1 = zs + 64 * 33;
    const int pos0 = tb * 64;
    const float wstep = 6.283185307179586f / (float)n;
    for (int i = F.tid; i < 64 * 33; i += NTHR) { const int pos = i / 33, k = i - pos * 33; const int ti = pos0 + pos; float val;
        if (k == 0) val = (float)ti / (float)(n - 1);
        else { const int kb = (k - 1) & 15; const float band = 1e-4f + (float)kb * ((15.0f - 1e-4f) / 15.0f); const float ang = (wstep * (float)ti) * band; float sn, cs; sincos_rr(ang, sn, cs); val = (k <= 16) ? cs : -sn; }
        zs[i] = val; }
    __syncthreads();
    const int pos = F.tid >> 3, h0 = (F.tid & 7) * 8;
    const float* w1 = P.in[16] + (size_t)l * 33 * 64; const float* b1 = P.in[17] + l * 64; const float* w2 = P.in[18] + (size_t)l * 64 * 64; const float* b2 = P.in[19] + l * 64; const float* fr = P.in[21] + l * 64;
    float acc[8];
#pragma unroll
    for (int e = 0; e < 8; ++e) acc[e] = b1[h0 + e];
#pragma unroll 1
    for (int k = 0; k < 33; ++k) { const float zv = zs[pos * 33 + k];
#pragma unroll
        for (int e = 0; e < 8; ++e) acc[e] += zv * w1[k * 64 + h0 + e]; }
#pragma unroll
    for (int e = 0; e < 8; ++e) { float sn, cs; sincos_rr(fr[h0 + e] * acc[e], sn, cs); h1[pos * 65 + h0 + e] = sn; }
    __syncthreads();
#pragma unroll
    for (int e = 0; e < 8; ++e) acc[e] = b2[h0 + e];
#pragma unroll 1
    for (int k = 0; k < 64; ++k) { const float hv = h1[pos * 65 + k];
#pragma unroll
        for (int e = 0; e < 8; ++e) acc[e] += hv * w2[k * 64 + h0 + e]; }
#pragma unroll
    for (int e = 0; e < 8; ++e) { float sn, cs; sincos_rr(fr[h0 + e] * acc[e], sn, cs); dst[(size_t)(pos0 + pos) * 64 + h0 + e] = sn; }
    __syncthreads();
}
DI void tab_unit(const Frame& F, const Params& P) {
    float* tab = (float*)(P.ws + WS_TAB);
    for (int i = F.tid; i < 4096; i += NTHR) { const int pos = i >> 5, f = i & 31; const float inv = exp2f(-(float)(2 * f) * (13.287712379549449f / 64.0f)); const float ang = (float)pos * inv; float sn, cs; sincos_rr(ang, sn, cs); tab[2 * i] = cs; tab[2 * i + 1] = sn; }
}
DI void s5_unit(const Frame& F, const Params& P, int u) {
    const int jo = u >> 7, g = u & 127;
    LAS float* pw = (LAS float*)F.lds;
    LAS float* bb = pw + 2 * 64 * 17 * 2;
    LAS float* cc = bb + 2 * 64 * 16 * 2;
    LAS float* Kt = cc + 2 * 16 * 64 * 2;
    if (F.tid < 128) { const int dir = F.tid >> 6, p = F.tid & 63; const int gi = ((jo * 2 + dir) * S5G + g);
        const float lr = P.in[23][(size_t)gi * 64 + p], li = P.in[24][(size_t)gi * 64 + p]; const float st = expf(P.in[25][gi]);
        float pr1 = 1.f, pi1 = 0.f;
        for (int d = 0; d <= 16; ++d) { const float a = lr * st * (float)d, b = li * st * (float)d; const float mag = expf(a); float sn, cs; sincos_rr(b, sn, cs);
            pw[((dir * 64 + p) * 17 + d) * 2] = mag * cs; pw[((dir * 64 + p) * 17 + d) * 2 + 1] = mag * sn; if (d == 1) { pr1 = mag * cs; pi1 = mag * sn; } }
        float* lamL = (float*)(P.ws + WS_LAML) + ((size_t)gi * 64 + p) * 2; lamL[0] = pw[((dir * 64 + p) * 17 + 16) * 2]; lamL[1] = pw[((dir * 64 + p) * 17 + 16) * 2 + 1];
        const float den = 1.0f / (lr * lr + li * li); const float nr = pr1 - 1.0f, ni = pi1; const float qr = (nr * lr + ni * li) * den, qi = (ni * lr - nr * li) * den;
        for (int j = 0; j < 16; ++j) { const float br = P.in[26][((size_t)gi * 64 + p) * 16 + j], bi = P.in[27][((size_t)gi * 64 + p) * 16 + j];
            bb[((dir * 64 + p) * 16 + j) * 2] = qr * br - qi * bi; bb[((dir * 64 + p) * 16 + j) * 2 + 1] = qr * bi + qi * br; } }
    for (int i = F.tid; i < 2048; i += NTHR) { const int dir = i >> 10, j = (i >> 6) & 15, p = i & 63; const size_t si = (((size_t)(jo * 2 + dir) * S5G + g) * 16 + j) * 64 + p;
        cc[i * 2] = P.in[28][si]; cc[i * 2 + 1] = P.in[29][si]; }
    __syncthreads();
    { const int dir = F.tid >> 8, d = (F.tid >> 4) & 15, j = F.tid & 15; float s16[16];
#pragma unroll
        for (int jp = 0; jp < 16; ++jp) s16[jp] = 0.f;
#pragma unroll 2
        for (int p = 0; p < 64; ++p) { const float cr = cc[((dir * 16 + j) * 64 + p) * 2], ci = cc[((dir * 16 + j) * 64 + p) * 2 + 1];
            const float wr_ = pw[((dir * 64 + p) * 17 + d) * 2], wi_ = pw[((dir * 64 + p) * 17 + d) * 2 + 1];
            const float xr = cr * wr_ - ci * wi_, xi = cr * wi_ + ci * wr_;
#pragma unroll
            for (int jp = 0; jp < 16; ++jp) s16[jp] += xr * bb[((dir * 64 + p) * 16 + jp) * 2] - xi * bb[((dir * 64 + p) * 16 + jp) * 2 + 1]; }
#pragma unroll
        for (int jp = 0; jp < 16; ++jp) Kt[((dir * 16 + d) * 16 + j) * 16 + jp] = s16[jp]; }
    __syncthreads();
    bf16* TT = (bf16*)(P.ws + WS_TT) + ((size_t)(jo * S5G + g) * 256) * 512;
    const float* dv = P.in[30] + (size_t)jo * DM + g * 16;
    for (int q = F.tid; q < 256 * 64; q += NTHR) { const int row = q >> 6, k0 = (q & 63) * 8; const int t = row >> 4, j = row & 15; float v[8];
        if (k0 < 256) { const int s = k0 >> 4, jp0 = k0 & 15;
#pragma unroll
            for (int e = 0; e < 8; ++e) { float x = 0.f; if (s <= t) x += Kt[((0 * 16 + (t - s)) * 16 + j) * 16 + jp0 + e]; if (s >= t) x += Kt[((1 * 16 + (s - t)) * 16 + j) * 16 + jp0 + e];
                if (s == t && j == jp0 + e) x += dv[j]; v[e] = x; } }
        else { const int region = (k0 - 256) >> 6, p0 = (k0 - 256) & 63, dir = region >> 1, pwr = dir == 0 ? t + 1 : 16 - t;
#pragma unroll
            for (int e = 0; e < 8; ++e) { const int p = p0 + e; const float cr = cc[((dir * 16 + j) * 64 + p) * 2], ci = cc[((dir * 16 + j) * 64 + p) * 2 + 1];
                const float wr_ = pw[((dir * 64 + p) * 17 + pwr) * 2], wi_ = pw[((dir * 64 + p) * 17 + pwr) * 2 + 1];
                v[e] = (region & 1) ? -(cr * wi_ + ci * wr_) : (cr * wr_ - ci * wi_); } }
        u32x4 w; w.x = pk2(v[0], v[1]); w.y = pk2(v[2], v[3]); w.z = pk2(v[4], v[5]); w.w = pk2(v[6], v[7]);
        *(u32x4*)(TT + (size_t)row * 512 + k0) = w; }
    bf16* WW = (bf16*)(P.ws + WS_WW) + ((size_t)(jo * S5G + g) * 256) * 256;
    for (int q = F.tid; q < 256 * 32; q += NTHR) { const int row = q >> 5, k0 = (q & 31) * 8; const int s = k0 >> 4, jp0 = k0 & 15; const int region = row >> 6, p = row & 63, dir = region >> 1, pwr = dir == 0 ? 15 - s : s; float v[8];
        const float wr_ = pw[((dir * 64 + p) * 17 + pwr) * 2], wi_ = pw[((dir * 64 + p) * 17 + pwr) * 2 + 1];
#pragma unroll
        for (int e = 0; e < 8; ++e) { const float br = bb[((dir * 64 + p) * 16 + jp0 + e) * 2], bi = bb[((dir * 64 + p) * 16 + jp0 + e) * 2 + 1];
            v[e] = (region & 1) ? (wr_ * bi + wi_ * br) : (wr_ * br - wi_ * bi); }
        u32x4 w; w.x = pk2(v[0], v[1]); w.y = pk2(v[2], v[3]); w.z = pk2(v[4], v[5]); w.w = pk2(v[6], v[7]);
        *(u32x4*)(WW + (size_t)row * 256 + k0) = w; }
    __syncthreads();
}
DI void p0_prologue(const Frame& F, const Params& P) {
    constexpr int IT_UP = (DM / 64) * (DFF2 / 128), IT_DOWN = (DFF / 64) * (DM / 128), IT_IN = (DM / 64) * (INCOLS / 128), IT_OUT = (DM / 64) * (DM / 128), IT_GLU = (DM / 64) * (2 * DM / 128);
    constexpr int NT = 4 * (IT_UP + IT_DOWN) + 2 * (IT_IN + IT_OUT + IT_GLU);
    constexpr int N_S5 = 256, N_MODP = 768, N_HID = 264;
    constexpr int TOTAL = N_S5 + N_MODP + N_HID + 1 + NT;
    for (int it = F.bid; it < TOTAL; it += F.G) {
        int r = it;
        if (r < N_S5) { s5_unit(F, P, r); if (DUP_SUB == 7) s5_unit(F, P, r); continue; } r -= N_S5;
        if (r < N_MODP) { modp_unit(F, P, r); if (DUP_SUB == 8) modp_unit(F, P, r); continue; } r -= N_MODP;
        if (r < N_HID) { hid_unit(F, P, r); continue; } r -= N_HID;
        if (r < 1) { tab_unit(F, P); continue; } r -= 1;
        if (r < 4 * (IT_UP + IT_DOWN)) { const int l = r / (IT_UP + IT_DOWN); r -= l * (IT_UP + IT_DOWN);
            if (r < IT_UP) transpose_item(F, P.in[7] + (size_t)l * DM * DFF2, DM, DFF2, (bf16*)(P.ws + WS_WUP + l * SZ_WUP), r, 2);
            else transpose_item(F, P.in[10] + (size_t)l * DFF * DM, DFF, DM, (bf16*)(P.ws + WS_WDOWN + l * SZ_WDOWN), r - IT_UP, 0);
            continue; }
        r -= 4 * (IT_UP + IT_DOWN);
        { const int j = r / (IT_IN + IT_OUT + IT_GLU); r -= j * (IT_IN + IT_OUT + IT_GLU);
            if (r < IT_IN) transpose_item(F, P.in[11] + (size_t)j * DM * INCOLS, DM, INCOLS, (bf16*)(P.ws + WS_WIN + j * SZ_WIN), r, 1);
            else if (r < IT_IN + IT_OUT) transpose_item(F, P.in[12] + (size_t)j * DM * DM, DM, DM, (bf16*)(P.ws + WS_WOUT + j * SZ_WOUT), r - IT_IN, 0);
            else transpose_item(F, P.in[31] + (size_t)j * DM * 2 * DM, DM, 2 * DM, (bf16*)(P.ws + WS_WGLU + j * SZ_WGLU), r - IT_IN - IT_OUT, 0); }
    }
}
DI void filt_unit(const Frame& F, const Params& P, int u) {
    int l, n, tb, ct; const float* hid; bf16* dst;
    if (u < 2048) { l = u >> 10; tb = (u >> 3) & 127; ct = u & 7; n = SEQ; hid = (const float*)(P.ws + WS_HID) + (size_t)l * SEQ * 64; dst = (bf16*)(P.ws + WS_FILT) + (size_t)l * 2 * 1024 * SEQ; }
    else { const int v = u - 2048; l = v >> 5; tb = (v >> 3) & 3; ct = v & 7; n = CTXL; hid = (const float*)(P.ws + WS_HID + 4 * MiB) + (size_t)l * CTXL * 64; dst = (bf16*)(P.ws + WS_FILTC) + (size_t)l * 2 * 1024 * CTXL; }
    LAS unsigned short* hsb = (LAS unsigned short*)F.lds;
    LAS unsigned short* w3t = hsb + 64 * 72;
    const int t0 = tb * 64;
    { const int pos = F.tid >> 3, k8 = (F.tid & 7) * 8; const f32x4 a = *(const f32x4*)(hid + (size_t)(t0 + pos) * 64 + k8), bq = *(const f32x4*)(hid + (size_t)(t0 + pos) * 64 + k8 + 4);
        u32x4 w; w.x = pk2(a[0], a[1]); w.y = pk2(a[2], a[3]); w.z = pk2(bq[0], bq[1]); w.w = pk2(bq[2], bq[3]); *(LAS u32x4*)(hsb + pos * 72 + k8) = w; }
    const float* w3 = P.in[20] + (size_t)l * 64 * 2048;
    { const int c4 = (F.tid & 63) * 4, k4 = (F.tid >> 6) * 4;
#pragma unroll
        for (int half = 0; half < 2; ++half) { f32x4 v[4];
#pragma unroll
            for (int i = 0; i < 4; ++i) v[i] = *(const f32x4*)(w3 + (size_t)(32 * half + k4 + i) * 2048 + ct * 256 + c4);
#pragma unroll
            for (int e = 0; e < 4; ++e) { u32x2 w; w.x = pk2(v[0][e], v[1][e]); w.y = pk2(v[2][e], v[3][e]); *(LAS u32x2*)(w3t + (c4 + e) * 72 + 32 * half + k4) = w; } } }
    __syncthreads();
    const int r = F.lane & 31, h = F.lane >> 5;
    f32x16 acc[2];
#pragma unroll
    for (int nt = 0; nt < 2; ++nt)
#pragma unroll
        for (int i = 0; i < 16; ++i) acc[nt][i] = 0.f;
#pragma unroll
    for (int s = 0; s < 4; ++s) { const bf16x8 a = *(const LAS bf16x8*)(w3t + (32 * F.wave + r) * 72 + 16 * s + 8 * h);
#pragma unroll
        for (int nt = 0; nt < 2; ++nt) { const bf16x8 bq = *(const LAS bf16x8*)(hsb + (nt * 32 + r) * 72 + 16 * s + 8 * h); acc[nt] = __builtin_amdgcn_mfma_f32_32x32x16_bf16(bq, a, acc[nt], 0, 0, 0); } }
    const int col = ct * 256 + 32 * F.wave + r, dir = col >> 10, c = col & 1023;
    const float delta = 3.0701134573253945f + (float)c * (12.280453829301578f / 1023.0f);
    bf16* drow = dst + ((size_t)(dir * 1024 + c)) * n + t0;
    const float tsc = -delta / (float)(n - 1);
#pragma unroll
    for (int nt = 0; nt < 2; ++nt)
#pragma unroll
        for (int kp = 0; kp < 4; kp += 2) {
            unsigned g[2][2];
#pragma unroll
            for (int q = 0; q < 2; ++q) { float v[4];
#pragma unroll
                for (int e = 0; e < 4; ++e) { const int t = t0 + nt * 32 + 8 * (kp + q) + 4 * h + e; v[e] = acc[nt][4 * (kp + q) + e] * fast_exp((float)t * tsc); }
                g[q][0] = cvtpk_c2(v[0], v[1]); g[q][1] = cvtpk_c2(v[2], v[3]); }
            const auto rx = __builtin_amdgcn_permlane32_swap(g[0][0], g[1][0], false, false);
            const auto ry = __builtin_amdgcn_permlane32_swap(g[0][1], g[1][1], false, false);
            *(u32x4*)(drow + nt * 32 + 8 * kp + (h ? 8 : 0)) = (u32x4){rx[0], ry[0], rx[1], ry[1]}; }
    __syncthreads();
}
DI void p1_phase(const Frame& F, const Params& P) {
    for (int u = F.bid; u < 2048 + 64; u += F.G) filt_unit(F, P, u);
    const float* mp = (const float*)(P.ws + WS_MODP); float* mo = (float*)(P.ws + WS_MOD);
    for (int i = F.bid * NTHR + F.tid; i < DEPTH * 3 * NMOD * DM; i += F.G * NTHR) { const int j = i % (NMOD * DM), lr = i / (NMOD * DM), l = lr / 3, r = lr - 3 * l;
        float s = P.in[5][(size_t)l * NMOD * DM + j];
#pragma unroll
        for (int kc = 0; kc < 8; ++kc) s += mp[((size_t)(l * 8 + kc) * 3 + r) * (NMOD * DM) + j];
        mo[i] = s; }
}
typedef short v4i16_t __attribute__((ext_vector_type(4)));
DI s16x4 vtr(const LAS unsigned char* p) { return __builtin_bit_cast(s16x4, __builtin_amdgcn_ds_read_tr16_b64_v4i16((LAS v4i16_t*)p)); }
DI void ld8f(const float* p, float (&v)[8]) { const f32x4 a = *(const f32x4*)p, b = *(const f32x4*)(p + 4); v[0] = a[0]; v[1] = a[1]; v[2] = a[2]; v[3] = a[3]; v[4] = b[0]; v[5] = b[1]; v[6] = b[2]; v[7] = b[3]; }
DI void st8f(float* p, const float (&v)[8]) { *(f32x4*)p = (f32x4){v[0], v[1], v[2], v[3]}; *(f32x4*)(p + 4) = (f32x4){v[4], v[5], v[6], v[7]}; }
DI void ld8b(const bf16* p, float (&v)[8]) { const u32x4 w = *(const u32x4*)p; v[0] = bflo(w.x); v[1] = bfhi(w.x); v[2] = bflo(w.y); v[3] = bfhi(w.y); v[4] = bflo(w.z); v[5] = bfhi(w.z); v[6] = bflo(w.w); v[7] = bfhi(w.w); }
template <int SRC>
DI void row_phase(const Frame& F, const bf16* ysrc, const float* part, int nparts, int nrows, const float* xin_lat, const float* xin_ctx, float* xout_lat, float* xout_ctx,
                  const float* gA, const float* modA, int mA, bool do_mod, const float* gB, const float* modB, int shiftc, int scalec, bf16* HM, bf16* UA) {
    const int gw = F.bid * NWAVES + F.wave, NGW = F.G * NWAVES;
    constexpr int LDY = (SRC == 2) ? 2 * DM : DM;
    for (int r = gw; r < nrows; r += NGW) {
        const int set = r < SEQ ? 0 : (r < NLAT ? 1 : 2);
        const float* xr = r < NLAT ? xin_lat + (size_t)r * DM : xin_ctx + (size_t)(r - NLAT) * DM;
        float x[4][8];
#pragma unroll
        for (int j = 0; j < 4; ++j) ld8f(xr + 8 * F.lane + 512 * j, x[j]);
        if (SRC != 0) {
            float y[4][8];
            if (r >= NLAT && nparts > 0) {
#pragma unroll
                for (int j = 0; j < 4; ++j)
#pragma unroll
                    for (int e = 0; e < 8; ++e) y[j][e] = 0.f;
                float g[4][8];
                if (SRC == 2) {
#pragma unroll
                    for (int j = 0; j < 4; ++j)
#pragma unroll
                        for (int e = 0; e < 8; ++e) g[j][e] = 0.f; }
#pragma unroll 1
                for (int k = 0; k < nparts; ++k) { const float* pr = part + ((size_t)k * NCTX + (r - NLAT)) * LDY + 8 * F.lane;
#pragma unroll
                    for (int j = 0; j < 4; ++j) { float t[8]; ld8f(pr + 512 * j, t);
#pragma unroll
                        for (int e = 0; e < 8; ++e) y[j][e] += t[e];
                        if (SRC == 2) { ld8f(pr + DM + 512 * j, t);
#pragma unroll
                            for (int e = 0; e < 8; ++e) g[j][e] += t[e]; } } }
                if (SRC == 2) {
#pragma unroll
                    for (int j = 0; j < 4; ++j)
#pragma unroll
                        for (int e = 0; e < 8; ++e) y[j][e] *= sigmoidf_(g[j][e]); }
            } else {
                const bf16* yr = ysrc + (size_t)r * LDY + 8 * F.lane;
#pragma unroll
                for (int j = 0; j < 4; ++j) ld8b(yr + 512 * j, y[j]);
                if (SRC == 2) {
#pragma unroll
                    for (int j = 0; j < 4; ++j) { float t[8]; ld8b(yr + DM + 512 * j, t);
#pragma unroll
                        for (int e = 0; e < 8; ++e) y[j][e] *= sigmoidf_(t[e]); } }
            }
            float ss = 0.f;
#pragma unroll
            for (int j = 0; j < 4; ++j)
#pragma unroll
                for (int e = 0; e < 8; ++e) ss += y[j][e] * y[j][e];
            ss = wave_sum(ss);
            const float rs = __builtin_amdgcn_rsqf(ss * (1.0f / DM) + RMS_EPS);
            const float* mm = modA + (size_t)set * (NMOD * DM) + mA * DM;
            float* xo = r < NLAT ? xout_lat + (size_t)r * DM : xout_ctx + (size_t)(r - NLAT) * DM;
#pragma unroll
            for (int j = 0; j < 4; ++j) { const int c = 8 * F.lane + 512 * j; float ga[8], mv[8]; ld8f(gA + c, ga); ld8f(mm + c, mv);
#pragma unroll
                for (int e = 0; e < 8; ++e) x[j][e] += mv[e] * (y[j][e] * rs * ga[e]);
                st8f(xo + c, x[j]); }
        }
        if (do_mod) {
            float ss = 0.f;
#pragma unroll
            for (int j = 0; j < 4; ++j)
#pragma unroll
                for (int e = 0; e < 8; ++e) ss += x[j][e] * x[j][e];
            ss = wave_sum(ss);
            const float rs = __builtin_amdgcn_rsqf(ss * (1.0f / DM) + RMS_EPS);
            const float* mb = modB + (size_t)set * (NMOD * DM);
            bf16* hr = HM + (size_t)r * DM;
            int cr = 0; if (UA) cr = r < NLAT ? ((r >> 13) * 512 + ((r & (SEQ - 1)) >> 4)) : (1024 + ((r - NLAT) >> 4));
#pragma unroll
            for (int j = 0; j < 4; ++j) { const int c = 8 * F.lane + 512 * j; float gb[8], sc[8], sh[8]; ld8f(gB + c, gb); ld8f(mb + scalec * DM + c, sc); ld8f(mb + shiftc * DM + c, sh);
                float h[8];
#pragma unroll
                for (int e = 0; e < 8; ++e) h[e] = (x[j][e] * rs * gb[e]) * (sc[e] + 1.0f) + sh[e];
                u32x4 w; w.x = pk2(h[0], h[1]); w.y = pk2(h[2], h[3]); w.z = pk2(h[4], h[5]); w.w = pk2(h[6], h[7]);
                if (HM) *(u32x4*)(hr + c) = w;
                if (UA) *(u32x4*)(UA + ((size_t)(c >> 4) * S5ROWS + cr) * S5K + (r & 15) * 16 + (c & 15)) = w; }
        }
    }
}
DI void load8(const bf16* p, float (&v)[8]) { const u32x4 w = *(const u32x4*)p; v[0] = bflo(w.x); v[1] = bfhi(w.x); v[2] = bflo(w.y); v[3] = bfhi(w.y); v[4] = bflo(w.z); v[5] = bfhi(w.z); v[6] = bflo(w.w); v[7] = bfhi(w.w); }
DI void convglu_phase(const Frame& F, const bf16* U, bf16* A5, const float* cw, const float* cb, int nrows) {
    const int gw = F.bid * NWAVES + F.wave, NGW = F.G * NWAVES;
    constexpr int NCC = 11; const int NRC = nrows / 32;
    for (int wu = gw; wu < NRC * NCC; wu += NGW) {
        const int cc = wu % NCC, rc = wu / NCC; const int c0 = cc * 512 + F.lane * 8; const int r0 = rc * 32;
        if (c0 < DFF) {
            float wg[3][8], wv[3][8], bg[8], bv[8];
#pragma unroll
            for (int k = 0; k < 3; ++k)
#pragma unroll
                for (int e = 0; e < 8; ++e) { wg[k][e] = cw[(size_t)k * DFF2 + c0 + e]; wv[k][e] = cw[(size_t)k * DFF2 + DFF + c0 + e]; }
#pragma unroll
            for (int e = 0; e < 8; ++e) { bg[e] = cb[c0 + e]; bv[e] = cb[DFF + c0 + e]; }
            const int seqlen = r0 < NLAT ? SEQ : CTXL; const int rs0 = r0 < NLAT ? (r0 & (SEQ - 1)) : ((r0 - NLAT) & (CTXL - 1));
            float pg[8], pv[8], cg[8], cv[8], ng[8], nv[8];
            if (rs0 > 0) { load8(U + (size_t)(r0 - 1) * DFF2 + c0, pg); load8(U + (size_t)(r0 - 1) * DFF2 + DFF + c0, pv); }
            else {
#pragma unroll
                for (int e = 0; e < 8; ++e) { pg[e] = 0.f; pv[e] = 0.f; } }
            load8(U + (size_t)r0 * DFF2 + c0, cg); load8(U + (size_t)r0 * DFF2 + DFF + c0, cv);
            for (int i = 0; i < 32; ++i) { const int r = r0 + i;
                if (rs0 + i + 1 < seqlen) { load8(U + (size_t)(r + 1) * DFF2 + c0, ng); load8(U + (size_t)(r + 1) * DFF2 + DFF + c0, nv); }
                else {
#pragma unroll
                    for (int e = 0; e < 8; ++e) { ng[e] = 0.f; nv[e] = 0.f; } }
                float o[8];
#pragma unroll
                for (int e = 0; e < 8; ++e) { const float g = pg[e] * wg[0][e] + cg[e] * wg[1][e] + ng[e] * wg[2][e] + bg[e]; const float v = pv[e] * wv[0][e] + cv[e] * wv[1][e] + nv[e] * wv[2][e] + bv[e]; o[e] = siluf_(g) * v; }
                u32x4 w; w.x = pk2(o[0], o[1]); w.y = pk2(o[2], o[3]); w.z = pk2(o[4], o[5]); w.w = pk2(o[6], o[7]);
                *(u32x4*)(A5 + (size_t)r * DFF + c0) = w;
#pragma unroll
                for (int e = 0; e < 8; ++e) { pg[e] = cg[e]; pv[e] = cv[e]; cg[e] = ng[e]; cv[e] = nv[e]; } }
        }
    }
}
#define ZP(i) ((i) + ((i) >> 4))
DI f32x2 cmul(f32x2 a, f32x2 b) { return (f32x2){a[0] * b[0] - a[1] * b[1], a[0] * b[1] + a[1] * b[0]}; }
DI f32x2 cmulc(f32x2 a, f32x2 b) { return (f32x2){a[0] * b[0] + a[1] * b[1], a[1] * b[0] - a[0] * b[1]}; }
DI f32x2 mulmi(f32x2 a) { return (f32x2){a[1], -a[0]}; }
DI f32x2 mulpi(f32x2 a) { return (f32x2){-a[1], a[0]}; }
#define BFLY_F(x0, x1, x2, x3, y0, y1, y2, y3) do { const f32x2 t0_ = (x0) + (x2), t1_ = (x0) - (x2), t2_ = (x1) + (x3), t3_ = mulmi((x1) - (x3)); y0 = t0_ + t2_; y1 = t1_ + t3_; y2 = t0_ - t2_; y3 = t1_ - t3_; } while (0)
#define BFLY_I(x0, x1, x2, x3, y0, y1, y2, y3) do { const f32x2 t0_ = (x0) + (x2), t1_ = (x0) - (x2), t2_ = (x1) + (x3), t3_ = mulpi((x1) - (x3)); y0 = t0_ + t2_; y1 = t1_ + t3_; y2 = t0_ - t2_; y3 = t1_ - t3_; } while (0)
#define W16_1 ((f32x2){0.92387953251128674f, -0.38268343236508977f})
#define W16_2 ((f32x2){0.70710678118654752f, -0.70710678118654752f})
#define W16_3 ((f32x2){0.38268343236508977f, -0.92387953251128674f})
#define W16_6 ((f32x2){-0.70710678118654752f, -0.70710678118654752f})
#define W16_9 ((f32x2){-0.92387953251128674f, 0.38268343236508977f})
template <int Q2> DI void fft_pass16_fwd(const Frame& F, LAS f32x2* Z) {
    constexpr int L = 16 * Q2, ST = Q2 >= 16 ? Q2 + Q2 / 16 : Q2; constexpr float invL = 1.0f / (float)L;
#pragma unroll 1
    for (int g = F.tid; g < 1024; g += NTHR) { const int j = g & (Q2 - 1), base = ((g - j) << 4) + j;
        LAS f32x2* zp = Z + ZP(base);
        f32x2 x[16];
#pragma unroll
        for (int m = 0; m < 16; ++m) x[m] = zp[m * ST];
        const float rev = (float)j * invL; const f32x2 t1 = {__builtin_amdgcn_cosf(rev), -__builtin_amdgcn_sinf(rev)};
        const f32x2 t2 = cmul(t1, t1), t3 = cmul(t2, t1), t4 = cmul(t2, t2), t8 = cmul(t4, t4), t12 = cmul(t8, t4);
        BFLY_F(x[0], x[4], x[8], x[12], x[0], x[4], x[8], x[12]);          x[4] = cmul(x[4], t1); x[8] = cmul(x[8], t2); x[12] = cmul(x[12], t3);
        BFLY_F(x[1], x[5], x[9], x[13], x[1], x[5], x[9], x[13]);          x[5] = cmul(cmul(x[5], W16_1), t1); x[9] = cmul(cmul(x[9], W16_2), t2); x[13] = cmul(cmul(x[13], W16_3), t3);
        BFLY_F(x[2], x[6], x[10], x[14], x[2], x[6], x[10], x[14]);        x[6] = cmul(cmul(x[6], W16_2), t1); x[10] = cmul(mulmi(x[10]), t2); x[14] = cmul(cmul(x[14], W16_6), t3);
        BFLY_F(x[3], x[7], x[11], x[15], x[3], x[7], x[11], x[15]);        x[7] = cmul(cmul(x[7], W16_3), t1); x[11] = cmul(cmul(x[11], W16_6), t2); x[15] = cmul(cmul(x[15], W16_9), t3);
#pragma unroll
        for (int ap = 0; ap < 4; ++ap) { f32x2 z0, z1, z2, z3; BFLY_F(x[4 * ap], x[4 * ap + 1], x[4 * ap + 2], x[4 * ap + 3], z0, z1, z2, z3);
            zp[(4 * ap) * ST] = z0; zp[(4 * ap + 1) * ST] = cmul(z1, t4); zp[(4 * ap + 2) * ST] = cmul(z2, t8); zp[(4 * ap + 3) * ST] = cmul(z3, t12); } }
    __syncthreads();
}
template <int Q2> DI void fft_pass16_inv(const Frame& F, LAS f32x2* Z) {
    constexpr int L = 16 * Q2, ST = Q2 >= 16 ? Q2 + Q2 / 16 : Q2; constexpr float invL = 1.0f / (float)L;
#pragma unroll 1
    for (int g = F.tid; g < 1024; g += NTHR) { const int j = g & (Q2 - 1), base = ((g - j) << 4) + j;
        LAS f32x2* zp = Z + ZP(base);
        f32x2 v[16];
#pragma unroll
        for (int m = 0; m < 16; ++m) v[m] = zp[m * ST];
        const float rev = (float)j * invL; const f32x2 t1 = {__builtin_amdgcn_cosf(rev), -__builtin_amdgcn_sinf(rev)};
        const f32x2 t2 = cmul(t1, t1), t3 = cmul(t2, t1), t4 = cmul(t2, t2), t8 = cmul(t4, t4), t12 = cmul(t8, t4);
#pragma unroll
        for (int ap = 0; ap < 4; ++ap) BFLY_I(v[4 * ap], cmulc(v[4 * ap + 1], t4), cmulc(v[4 * ap + 2], t8), cmulc(v[4 * ap + 3], t12), v[4 * ap], v[4 * ap + 1], v[4 * ap + 2], v[4 * ap + 3]);
        f32x2 o0, o1, o2, o3;
        BFLY_I(v[0], cmulc(v[4], t1), cmulc(v[8], t2), cmulc(v[12], t3), o0, o1, o2, o3);
        zp[0] = o0; zp[4 * ST] = o1; zp[8 * ST] = o2; zp[12 * ST] = o3;
        BFLY_I(v[1], cmulc(cmulc(v[5], t1), W16_1), cmulc(cmulc(v[9], t2), W16_2), cmulc(cmulc(v[13], t3), W16_3), o0, o1, o2, o3);
        zp[ST] = o0; zp[5 * ST] = o1; zp[9 * ST] = o2; zp[13 * ST] = o3;
        BFLY_I(v[2], cmulc(cmulc(v[6], t1), W16_2), mulpi(cmulc(v[10], t2)), cmulc(cmulc(v[14], t3), W16_6), o0, o1, o2, o3);
        zp[2 * ST] = o0; zp[6 * ST] = o1; zp[10 * ST] = o2; zp[14 * ST] = o3;
        BFLY_I(v[3], cmulc(cmulc(v[7], t1), W16_3), cmulc(cmulc(v[11], t2), W16_6), cmulc(cmulc(v[15], t3), W16_9), o0, o1, o2, o3);
        zp[3 * ST] = o0; zp[7 * ST] = o1; zp[11 * ST] = o2; zp[15 * ST] = o3; }
    __syncthreads();
}
DI void fft_fwd(const Frame& F0, LAS f32x2* Z) {
    Frame F = F0; { int t_ = F0.tid; asm volatile("" : "+v"(t_)); F.tid = t_; }
#pragma unroll 2
    for (int u = F.tid; u < 4096; u += NTHR) { const int j = u; LAS f32x2* zp = Z + ZP(j);
        const f32x2 a0 = zp[0], a1 = zp[4352], a2 = zp[8704], a3 = zp[13056];
        f32x2 y0, y1, y2, y3; BFLY_F(a0, a1, a2, a3, y0, y1, y2, y3);
        const float rev = (float)j * (1.0f / 16384.0f); const f32x2 w1 = {__builtin_amdgcn_cosf(rev), -__builtin_amdgcn_sinf(rev)}; const f32x2 w2 = cmul(w1, w1), w3 = cmul(w2, w1);
        zp[0] = y0; zp[4352] = cmul(y1, w1); zp[8704] = cmul(y2, w2); zp[13056] = cmul(y3, w3); }
    __syncthreads();
    fft_pass16_fwd<256>(F, Z); fft_pass16_fwd<16>(F, Z); fft_pass16_fwd<1>(F, Z);
}
DI void fft_inv(const Frame& F0, LAS f32x2* Z) {
    Frame F = F0; { int t_ = F0.tid; asm volatile("" : "+v"(t_)); F.tid = t_; }
    fft_pass16_inv<1>(F, Z); fft_pass16_inv<16>(F, Z); fft_pass16_inv<256>(F, Z);
#pragma unroll 2
    for (int u = F.tid; u < 4096; u += NTHR) { const int j = u; LAS f32x2* zp = Z + ZP(j);
        const float rev = (float)j * (1.0f / 16384.0f); const f32x2 w1 = {__builtin_amdgcn_cosf(rev), -__builtin_amdgcn_sinf(rev)}; const f32x2 w2 = cmul(w1, w1), w3 = cmul(w2, w1);
        const f32x2 a0 = zp[0], a1 = cmulc(zp[4352], w1), a2 = cmulc(zp[8704], w2), a3 = cmulc(zp[13056], w3);
        f32x2 x0, x1, x2, x3; BFLY_I(a0, a1, a2, a3, x0, x1, x2, x3);
        zp[0] = x0; zp[4352] = x1; zp[8704] = x2; zp[13056] = x3; }
    __syncthreads();
}
DI float dw3(const LAS unsigned short* row, int t, int n, float w0, float w1, float w2, float b) {
    const float m = bf2f(row[t]); const float l = t > 0 ? bf2f(row[t - 1]) : 0.f; const float r = t + 1 < n ? bf2f(row[t + 1]) : 0.f;
    return l * w0 + m * w1 + r * w2 + b;
}
DI void dw3x4(const LAS unsigned short* row, int t, int n, float w0, float w1, float w2, float b, float (&o)[4]) {
    const u32x2 m = *(const LAS u32x2*)(row + t);
    const float c0 = bflo(m.x), c1 = bfhi(m.x), c2 = bflo(m.y), c3 = bfhi(m.y);
    const float l = t > 0 ? bf2f(row[t - 1]) : 0.f; const float r = t + 4 < n ? bf2f(row[t + 4]) : 0.f;
    o[0] = l * w0 + c0 * w1 + c1 * w2 + b; o[1] = c0 * w0 + c1 * w1 + c2 * w2 + b; o[2] = c1 * w0 + c2 * w1 + c3 * w2 + b; o[3] = c2 * w0 + c3 * w1 + r * w2 + b;
}
DI void hyena_unit(const Frame& F0, const Params& P, int je, int c) {
    Frame F = F0; { int t_ = F0.tid; asm volatile("" : "+v"(t_)); F.tid = t_; F.lane = t_ & 63; }
    LAS f32x2* Z = (LAS f32x2*)F.lds;
    LAS float* aux = (LAS float*)(F.lds + AUX_OFF + 8192);
    LAS float* red = aux + 1536;
    const bf16* ZBT = (const bf16*)(P.ws + WS_U + 50 * MiB);
    bf16* YBT = (bf16*)(P.ws + WS_U + 150 * MiB);
    const bf16* filt = (const bf16*)(P.ws + WS_FILT) + (size_t)je * 2 * 1024 * SEQ;
    const bf16* ff = filt + (size_t)c * SEQ; const bf16* fb = filt + (size_t)(1024 + c) * SEQ;
    const float* hw = P.in[14] + (size_t)je * 3 * HYC; const float* hb = P.in[15] + (size_t)je * HYC;
    float l1 = 0.f;
    {
        u32x4 wf[2], wb[2];
#pragma unroll
        for (int q = 0; q < 2; ++q) { const int pc = F.tid + 512 * q; wf[q] = *(const u32x4*)(ff + 8 * pc); wb[q] = *(const u32x4*)(fb + 8184 - 8 * pc); }
#pragma unroll
        for (int q = 0; q < 2; ++q) { const int pc = F.tid + 512 * q; float v[8];
            v[0] = bflo(wf[q].x); v[1] = bfhi(wf[q].x); v[2] = bflo(wf[q].y); v[3] = bfhi(wf[q].y); v[4] = bflo(wf[q].z); v[5] = bfhi(wf[q].z); v[6] = bflo(wf[q].w); v[7] = bfhi(wf[q].w);
            LAS f32x2* zp = Z + ZP(8 * pc);
#pragma unroll
            for (int e = 0; e < 8; ++e) { l1 += fabsf(v[e]); zp[e] = (f32x2){v[e], 0.f}; }
            v[0] = bflo(wb[q].x); v[1] = bfhi(wb[q].x); v[2] = bflo(wb[q].y); v[3] = bfhi(wb[q].y); v[4] = bflo(wb[q].z); v[5] = bfhi(wb[q].z); v[6] = bflo(wb[q].w); v[7] = bfhi(wb[q].w);
#pragma unroll
            for (int e = 0; e < 8; ++e) { const int i = 8193 + 8 * pc + e; if (i < 16384) { l1 += fabsf(v[7 - e]); Z[ZP(i)] = (f32x2){v[7 - e], 0.f}; } } }
        if (F.tid == 0) Z[ZP(SEQ)] = (f32x2){0.f, 0.f};
    }
    l1 = block_sum(F, l1, red);
    fft_fwd(F, Z);
    const float bias = P.in[22][(size_t)je * 1024 + c];
    const float hscale = 1.0f / (l1 * 16384.0f), hadd = bias * (1.0f / 16384.0f);
    f32x2 hs[32];
#pragma unroll
    for (int k = 0; k < 32; ++k) { const f32x2 z = Z[ZP(F.tid + 512 * k)]; hs[k] = (f32x2){z[0] * hscale + hadd, z[1] * hscale}; }
    __syncthreads();
    LAS unsigned short* raw = (LAS unsigned short*)(F.lds + 69632);
    for (int i = F.tid; i < 4096; i += NTHR) { const int rr = i >> 10, piece = i & 1023; const int b = rr & 1, which = rr >> 1;
        *(LAS u32x4*)(raw + rr * SEQ + piece * 8) = *(const u32x4*)(ZBT + (size_t)((which ? 2048 : 1024) + c) * MROWS + b * SEQ + piece * 8); }
    __syncthreads();
    const float wx10 = hw[1024 + c], wx11 = hw[HYC + 1024 + c], wx12 = hw[2 * HYC + 1024 + c], bx1 = hb[1024 + c];
    const float wv0 = hw[2048 + c], wv1 = hw[HYC + 2048 + c], wv2 = hw[2 * HYC + 2048 + c], bv = hb[2048 + c];
    const float wx00 = hw[c], wx01 = hw[HYC + c], wx02 = hw[2 * HYC + c], bx0 = hb[c];
#pragma unroll 1
    for (int k = 0; k < 4; ++k) { const int t = 4 * (k * 512 + F.tid);
        float pv0[4], px0[4], pv1[4], px1[4];
        dw3x4(raw + 2 * SEQ, t, SEQ, wv0, wv1, wv2, bv, pv0); dw3x4(raw, t, SEQ, wx10, wx11, wx12, bx1, px0);
        dw3x4(raw + 3 * SEQ, t, SEQ, wv0, wv1, wv2, bv, pv1); dw3x4(raw + SEQ, t, SEQ, wx10, wx11, wx12, bx1, px1);
        LAS f32x2* zp = Z + ZP(t);
#pragma unroll
        for (int e = 0; e < 4; ++e) zp[e] = (f32x2){pv0[e] * px0[e], pv1[e] * px1[e]}; }
    __syncthreads();
#pragma unroll 4
    for (int k = 0; k < 16; ++k) Z[ZP(SEQ + k * 512 + F.tid)] = (f32x2){0.f, 0.f};
    __syncthreads();
    fft_fwd(F, Z);
#pragma unroll
    for (int k = 0; k < 32; ++k) { const f32x2 z = Z[ZP(F.tid + 512 * k)]; Z[ZP(F.tid + 512 * k)] = (f32x2){z[0] * hs[k][0] - z[1] * hs[k][1], z[0] * hs[k][1] + z[1] * hs[k][0]}; }
    __syncthreads();
    fft_inv(F, Z);
    for (int i = F.tid; i < 2048; i += NTHR) { const int b = i >> 10, piece = i & 1023;
        *(LAS u32x4*)(raw + b * SEQ + piece * 8) = *(const u32x4*)(ZBT + (size_t)c * MROWS + b * SEQ + piece * 8); }
    __syncthreads();
#pragma unroll 1
    for (int k = 0; k < 4; ++k) { const int t = 4 * (k * 512 + F.tid);
        float g0[4], g1[4]; dw3x4(raw, t, SEQ, wx00, wx01, wx02, bx0, g0); dw3x4(raw + SEQ, t, SEQ, wx00, wx01, wx02, bx0, g1);
        const LAS f32x2* zp = Z + ZP(t); const f32x2 z0 = zp[0], z1 = zp[1], z2 = zp[2], z3 = zp[3];
        u32x2 w0_, w1_; w0_.x = pk2(z0[0] * g0[0], z1[0] * g0[1]); w0_.y = pk2(z2[0] * g0[2], z3[0] * g0[3]); w1_.x = pk2(z0[1] * g1[0], z1[1] * g1[1]); w1_.y = pk2(z2[1] * g1[2], z3[1] * g1[3]);
        *(u32x2*)(YBT + (size_t)c * MROWS + t) = w0_; *(u32x2*)(YBT + (size_t)c * MROWS + SEQ + t) = w1_; }
    const bf16* fc = (const bf16*)(P.ws + WS_FILTC) + (size_t)je * 2 * 1024 * CTXL;
    LAS float* hc = aux; LAS float* vvc = aux + 512; LAS float* x0c = aux + 1024;
    __syncthreads();
    { const int i = F.tid; float v;
        if (i >= 255 && i < 511) v = bf2f(fc[(size_t)c * CTXL + (i - 255)]); else if (i < 255) v = bf2f(fc[(size_t)(1024 + c) * CTXL + (255 - i)]); else v = 0.f;
        hc[i] = v; float l1c = block_sum(F, fabsf(v), red);
        const int b = i >> 8, t = i & 255;
        LAS unsigned short* crow = (LAS unsigned short*)(F.lds + 16384);
        if (i < 192) { const int rw = i >> 5, pc = i & 31; const int bb2 = rw / 3, which = rw - 3 * bb2;
            const u32x4 w = *(const u32x4*)(ZBT + (size_t)(which * 1024 + c) * MROWS + NLAT + bb2 * CTXL + pc * 8);
            LAS unsigned short* d = crow + rw * 272 + 1 + pc * 8;
            d[0] = (unsigned short)(w.x & 0xffff); d[1] = (unsigned short)(w.x >> 16); d[2] = (unsigned short)(w.y & 0xffff); d[3] = (unsigned short)(w.y >> 16);
            d[4] = (unsigned short)(w.z & 0xffff); d[5] = (unsigned short)(w.z >> 16); d[6] = (unsigned short)(w.w & 0xffff); d[7] = (unsigned short)(w.w >> 16); }
        else if (i < 204) { const int k = i - 192; crow[(k >> 1) * 272 + ((k & 1) ? 257 : 0)] = 0; }
        __syncthreads();
        auto rd = [&](int which, int tt) -> float { return bf2f(crow[(3 * b + which) * 272 + 1 + tt]); };
        const float pv_ = rd(2, t - 1) * wv0 + rd(2, t) * wv1 + rd(2, t + 1) * wv2 + bv;
        const float px1 = rd(1, t - 1) * wx10 + rd(1, t) * wx11 + rd(1, t + 1) * wx12 + bx1;
        const float px0 = rd(0, t - 1) * wx00 + rd(0, t) * wx01 + rd(0, t + 1) * wx02 + bx0;
        vvc[i] = pv_ * px1; x0c[i] = px0;
        __syncthreads();
        { LAS float* part = (LAS float*)F.lds;
            const int t4 = (F.tid & 63) * 4, bb = (F.tid >> 6) & 1, sq = F.tid >> 7;
            float a0 = 0.f, a1 = 0.f, a2 = 0.f, a3 = 0.f;
            int d = t4 - sq * 64 + 255;
            float h1 = hc[d + 1], h2 = hc[d + 2], h3 = hc[d + 3];
#pragma unroll 8
            for (int s = 0; s < 64; ++s) { const float h0 = hc[d - s]; const float v = vvc[bb * 256 + sq * 64 + s];
                a0 += h0 * v; a1 += h1 * v; a2 += h2 * v; a3 += h3 * v; h3 = h2; h2 = h1; h1 = h0; }
            *(LAS f32x4*)(part + (sq * 2 + bb) * 256 + t4) = (f32x4){a0, a1, a2, a3}; }
        __syncthreads();
        { const LAS float* part = (const LAS float*)F.lds;
            float s = (part[(0 * 2 + b) * 256 + t] + part[(1 * 2 + b) * 256 + t]) + (part[(2 * 2 + b) * 256 + t] + part[(3 * 2 + b) * 256 + t]);
            s = s / l1c;
            YBT[(size_t)c * MROWS + NLAT + i] = (bf16)f2bf((s + vvc[i] * bias) * x0c[i]); }
    }
    __syncthreads();
}
DI void ybt_transpose_phase(const Frame& F, const Params& P) {
    const bf16* YBT = (const bf16*)(P.ws + WS_U + 150 * MiB); bf16* YAB = (bf16*)(P.ws + WS_YAB);
    LAS unsigned char* tile = F.lds + F.wave * 16384;
    const int gw = F.bid * NWAVES + F.wave, NGW = F.G * NWAVES;
    const int rr = F.lane >> 3, piece = F.lane & 7;
    const int i16 = F.lane & 15, tq = i16 >> 2, tp = i16 & 3, g16 = F.lane >> 4;
    for (int tu = gw; tu < 16 * (MROWS / 64); tu += NGW) { const int cb = tu & 15, tb = tu >> 4; const int c0 = cb * 64, t0 = tb * 64;
        u32x4 v[8];
#pragma unroll
        for (int i = 0; i < 8; ++i) v[i] = *(const u32x4*)(YBT + (size_t)(c0 + 8 * i + rr) * MROWS + t0 + piece * 8);
#pragma unroll
        for (int i = 0; i < 8; ++i) *(LAS u32x4*)(tile + (8 * i + rr) * 192 + piece * 16) = v[i];
        asm volatile("s_waitcnt lgkmcnt(0)" ::: "memory");
        bf16* dst = YAB + (size_t)(t0 + F.lane) * DM + 1024 + c0;
#pragma unroll
        for (int k = 0; k < 8; ++k) {
            const LAS unsigned char* ap = tile + (8 * k + tq) * 192 + 32 * g16 + 8 * tp;
            const s16x4 lo = vtr(ap), hi = vtr(ap + 4 * 192);
            const bf16x8 o = __builtin_shufflevector(lo, hi, 0, 1, 2, 3, 4, 5, 6, 7);
            *(bf16x8*)(dst + 8 * k) = o; }
        asm volatile("s_waitcnt lgkmcnt(0)" ::: "memory");
    }
}
typedef __bf16 bf16x2_t __attribute__((ext_vector_type(2)));
DI unsigned cvtpk_s(float lo, float hi) { const f32x2 v = {lo, hi}; const bf16x2_t b = __builtin_convertvector(v, bf16x2_t); return __builtin_bit_cast(unsigned, b); }
DI int crow(int i, int h) { return (i & 3) + 8 * (i >> 2) + 4 * h; }
#define MFMA32(a, b, c) __builtin_amdgcn_mfma_f32_32x32x16_bf16((a), (b), (c), 0, 0, 0)
constexpr int KPITCH = 272, VPITCH = 320, VS_OFF = 128 * KPITCH;

DI void attn_unit(const Frame& F, const Params& P, int je, int au) {
    int b, qb, hk, hp; bool isctx;
    if (au < 512) { isctx = false; const int idx = (au & 7) * 64 + (au >> 3);
        hp = idx & 1; qb = (idx >> 1) & 63; hk = (idx >> 7) & 1; b = idx >> 8; }
    else { const int v = au - 512; isctx = true; hp = v & 1; hk = (v >> 1) & 1; qb = (v >> 2) & 1; b = v >> 3; }
    const bf16* QKV = (const bf16*)(P.ws + WS_U); bf16* YAB = (bf16*)(P.ws + WS_YAB);
    const int r = F.lane & 31, h = F.lane >> 5;
    const int qsub = F.wave & 3, head = hk * 4 + hp * 2 + (F.wave >> 2);
    const int seqbase = isctx ? (NLAT + b * CTXL) : b * SEQ;
    const int qrow = seqbase + qb * 128 + qsub * 32 + r;
    const bf16* qbase = QKV + (size_t)qrow * QKVC + head * HD + 8 * h;
    bf16x8 qf[8];
#pragma unroll
    for (int s = 0; s < 8; ++s) qf[s] = *(const bf16x8*)(qbase + 16 * s);
    float m = P.in[13][je * 8 + head] * LOG2E, l = (h == 0) ? 1.0f : 0.0f;
    f32x16 O[4];
#pragma unroll
    for (int dt = 0; dt < 4; ++dt)
#pragma unroll
        for (int i = 0; i < 16; ++i) O[dt][i] = 0.f;
    const LAS unsigned char* Ks = F.lds; const LAS unsigned char* Vs = F.lds + VS_OFF;
    const int ql = qsub * 32 + r;
    const int i16 = F.lane & 15, tq = i16 >> 2, tp = i16 & 3, blk = (F.lane >> 4) & 1;
    int nb = 0, brow[5], btype[5];
#pragma unroll
    for (int bi = 0; bi < 5; ++bi) { int krow0, type; bool ok;
        if (bi < 3) { const int kb = qb - 1 + bi; ok = !isctx && kb >= 0 && kb < SEQ / 128; krow0 = b * SEQ + kb * 128; type = bi; }
        else { ok = true; krow0 = NLAT + b * CTXL + (bi - 3) * 128; type = 1; }
        if (ok) {
#pragma unroll
            for (int q = 0; q < 5; ++q) if (q == nb) { brow[q] = krow0; btype[q] = type; }
            ++nb; } }
    u32x4 kreg[4], vreg[4];
    const int pkey = F.tid >> 4, ppc = F.tid & 15;
#define ATT_PREFETCH(krow0_) do { const bf16* src_ = QKV + (size_t)((krow0_) + pkey) * QKVC + hk * HD + ppc * 8 + QCOLS; \
        _Pragma("unroll") for (int i_ = 0; i_ < 4; ++i_) { kreg[i_] = *(const u32x4*)(src_ + (size_t)i_ * 32 * QKVC); vreg[i_] = *(const u32x4*)(src_ + (size_t)i_ * 32 * QKVC + KVC); } } while (0)
    ATT_PREFETCH(brow[0]);
    for (int bi = 0; bi < nb; ++bi) {
        int krow_next = 0, type = 1;
#pragma unroll
        for (int q = 0; q < 5; ++q) { if (q == bi) type = btype[q]; if (q == bi + 1) krow_next = brow[q]; }
        __syncthreads();
#pragma unroll
        for (int i = 0; i < 4; ++i) { *(LAS u32x4*)(F.lds + (pkey + 32 * i) * KPITCH + ppc * 16) = kreg[i]; *(LAS u32x4*)(F.lds + VS_OFF + (pkey + 32 * i) * VPITCH + ppc * 16) = vreg[i]; }
        __syncthreads();
        if (bi + 1 < nb) ATT_PREFETCH(krow_next);
#pragma unroll 1
        for (int hb = 0; hb < 2; ++hb) {
            f32x16 st[2];
#pragma unroll
            for (int k2 = 0; k2 < 2; ++k2) { const int kt = 2 * hb + k2;
#pragma unroll
                for (int i = 0; i < 16; ++i) st[k2][i] = 0.f;
#pragma unroll
                for (int s = 0; s < 8; ++s) { const bf16x8 kf = *(const LAS bf16x8*)(Ks + (kt * 32 + r) * KPITCH + (16 * s + 8 * h) * 2); st[k2] = MFMA32(kf, qf[s], st[k2]); }
                __builtin_amdgcn_sched_barrier(0); }
            if (type != 1) { int qlv = ql; asm volatile("" : "+v"(qlv));
#pragma unroll
                for (int k2 = 0; k2 < 2; ++k2)
#pragma unroll
                    for (int i = 0; i < 16; ++i) { const int kl = (2 * hb + k2) * 32 + crow(i, h); const bool ok = (type == 0) ? (kl >= qlv) : (kl <= qlv); st[k2][i] = ok ? st[k2][i] : -1e30f; } }
            float mx = st[0][0];
#pragma unroll
            for (int k2 = 0; k2 < 2; ++k2)
#pragma unroll
                for (int i = 0; i < 16; ++i) mx = fmaxf(mx, st[k2][i]);
            mx = fmaxf(mx, __shfl_xor(mx, 32));
            const float mnew = fmaxf(m, mx), alpha = __builtin_amdgcn_exp2f(m - mnew); m = mnew;
            float ls = 0.f;
#pragma unroll
            for (int k2 = 0; k2 < 2; ++k2)
#pragma unroll
                for (int i = 0; i < 16; ++i) { const float pe = __builtin_amdgcn_exp2f(st[k2][i] - mnew); st[k2][i] = pe; ls += pe; }
            l = l * alpha + ls;
#pragma unroll
            for (int dt = 0; dt < 4; ++dt)
#pragma unroll
                for (int i = 0; i < 16; ++i) O[dt][i] *= alpha;
#pragma unroll
            for (int k2 = 0; k2 < 2; ++k2)
#pragma unroll
                for (int s = 0; s < 2; ++s) { const int kt = 2 * hb + k2;
                    u32x4 pw; pw.x = cvtpk_s(st[k2][8 * s + 0], st[k2][8 * s + 1]); pw.y = cvtpk_s(st[k2][8 * s + 2], st[k2][8 * s + 3]); pw.z = cvtpk_s(st[k2][8 * s + 4], st[k2][8 * s + 5]); pw.w = cvtpk_s(st[k2][8 * s + 6], st[k2][8 * s + 7]);
                    const bf16x8 pf = __builtin_bit_cast(bf16x8, pw);
#pragma unroll
                    for (int dt = 0; dt < 4; ++dt) {
                        const LAS unsigned char* vp = Vs + (kt * 32 + 16 * s + 4 * h + tq) * VPITCH + 64 * dt + 32 * blk + 8 * tp;
                        const s16x4 lo = vtr(vp), hi = vtr(vp + 8 * VPITCH);
                        const bf16x8 vf = __builtin_shufflevector(lo, hi, 0, 1, 2, 3, 4, 5, 6, 7);
                        O[dt] = MFMA32(vf, pf, O[dt]); }
                    __builtin_amdgcn_sched_barrier(0); }
        }
    }
#undef ATT_PREFETCH
    const float lt = l + __shfl_xor(l, 32); const float inv = 1.0f / lt;
    bf16* orow = YAB + (size_t)qrow * DM + head * HD;
#pragma unroll
    for (int dt = 0; dt < 4; ++dt)
#pragma unroll
        for (int ig = 0; ig < 4; ++ig) { u32x2 w; w.x = cvtpk_s(O[dt][4 * ig] * inv, O[dt][4 * ig + 1] * inv); w.y = cvtpk_s(O[dt][4 * ig + 2] * inv, O[dt][4 * ig + 3] * inv);
            *(u32x2*)(orow + dt * 32 + 8 * ig + 4 * h) = w; }
    __syncthreads();
}
DI void s5_carry_phase(const Frame& F, const Params& P, int jo) {
    const int fr = F.lane & 15, fq = F.lane >> 4;
    for (int blk = F.bid; blk < 2 * S5G; blk += F.G) {
        const int g = blk & 127, b = blk >> 7;
        float* ET = (float*)(P.ws + WS_U) + (size_t)g * 256 * S5ROWS;
        bf16* UAg = (bf16*)(P.ws + WS_A5) + (size_t)g * S5ROWS * S5K;
        const bf16* UAc = UAg + (size_t)(1024 + b * 16) * S5K;
        const bf16* WWg = (const bf16*)(P.ws + WS_WW) + (size_t)(jo * S5G + g) * 256 * 256;
        const bf16* TTg = (const bf16*)(P.ws + WS_TT) + (size_t)(jo * S5G + g) * 256 * 512;
        const int rc0 = 1024 + b * 16, rl0 = b * 512;
#pragma unroll 1
        for (int mt = F.wave; mt < 16; mt += NWAVES) { pg8::f32x4 acc = {0.f, 0.f, 0.f, 0.f};
#pragma unroll
            for (int ks = 0; ks < 8; ++ks) { const bf16x8 a = *(const bf16x8*)(WWg + (size_t)(mt * 16 + fr) * 256 + 32 * ks + 8 * fq), bq = *(const bf16x8*)(UAc + (size_t)fr * S5K + 32 * ks + 8 * fq);
                acc = __builtin_amdgcn_mfma_f32_16x16x32_bf16(a, bq, acc, 0, 0, 0); }
#pragma unroll
            for (int j = 0; j < 4; ++j) ET[(size_t)(mt * 16 + 4 * fq + j) * S5ROWS + rc0 + fr] = acc[j]; }
        asm volatile("s_waitcnt vmcnt(0)" ::: "memory"); __syncthreads();
        const int p = F.lane, dir = F.wave & 1;
        const float* lp = (const float*)(P.ws + WS_LAML) + ((size_t)((jo * 2 + dir) * S5G + g) * 64 + p) * 2;
        const float lr = lp[0], li = lp[1];
        const float* Er = ET + (size_t)(dir * 128 + p) * S5ROWS;
        bf16* Ug = UAg + 256 + dir * 128 + p;
        float sr = 0.f, si = 0.f;
        if (F.wave < 2) {
            f32x4 cr[4], ci[4];
#pragma unroll
            for (int k = 0; k < 4; ++k) { cr[k] = *(const f32x4*)(Er + rc0 + 4 * k); ci[k] = *(const f32x4*)(Er + 64 * S5ROWS + rc0 + 4 * k); }
#pragma unroll
            for (int q = 0; q < 16; ++q) { const int qq = dir == 0 ? q : 15 - q; const int row = rc0 + qq;
                Ug[(size_t)row * S5K] = (bf16)f2bf(sr); Ug[(size_t)row * S5K + 64] = (bf16)f2bf(si);
                const float xr = dir == 0 ? cr[q >> 2][q & 3] : cr[(15 - q) >> 2][(15 - q) & 3], xi = dir == 0 ? ci[q >> 2][q & 3] : ci[(15 - q) >> 2][(15 - q) & 3];
                const float nr = lr * sr - li * si + xr, ni = lr * si + li * sr + xi; sr = nr; si = ni; } }
        asm volatile("s_waitcnt vmcnt(0)" ::: "memory"); __syncthreads();
        if (F.wave < 2) {
#define S5BLK(bq) (dir == 0 ? rl0 + 4 * (bq) : rl0 + 508 - 4 * (bq))
            f32x4 er[8], ei[8];
#pragma unroll
            for (int k = 0; k < 8; ++k) { const int row = S5BLK(k); er[k] = *(const f32x4*)(Er + row); ei[k] = *(const f32x4*)(Er + 64 * S5ROWS + row); }
#pragma unroll 1
            for (int b0 = 0; b0 < 128; b0 += 8) {
                f32x4 nr_[8], ni_[8];
#pragma unroll
                for (int k = 0; k < 8; ++k) { const int bq = b0 + 8 + k; if (bq < 128) { const int row = S5BLK(bq); nr_[k] = *(const f32x4*)(Er + row); ni_[k] = *(const f32x4*)(Er + 64 * S5ROWS + row); } else { nr_[k] = (f32x4){0.f, 0.f, 0.f, 0.f}; ni_[k] = nr_[k]; } }
#pragma unroll
                for (int k = 0; k < 8; ++k) { const int row0 = S5BLK(b0 + k);
#pragma unroll
                    for (int e = 0; e < 4; ++e) { const int ee = dir == 0 ? e : 3 - e; const int row = row0 + ee;
                        Ug[(size_t)row * S5K] = (bf16)f2bf(sr); Ug[(size_t)row * S5K + 64] = (bf16)f2bf(si);
                        const float xr = dir == 0 ? er[k][e] : er[k][3 - e], xi = dir == 0 ? ei[k][e] : ei[k][3 - e];
                        const float nr = lr * sr - li * si + xr, ni = lr * si + li * sr + xi; sr = nr; si = ni; } }
#pragma unroll
                for (int k = 0; k < 8; ++k) { er[k] = nr_[k]; ei[k] = ni_[k]; }
            }
#undef S5BLK
        } else {
            bf16* G2c = (bf16*)(P.ws + WS_Y) + ((size_t)g * S5ROWS + rc0) * 256;
#pragma unroll 1
            for (int mt = F.wave - 2; mt < 16; mt += NWAVES - 2) { pg8::f32x4 acc = {0.f, 0.f, 0.f, 0.f};
#pragma unroll
                for (int ks = 0; ks < 16; ++ks) { const bf16x8 a = *(const bf16x8*)(TTg + (size_t)(mt * 16 + fr) * 512 + 32 * ks + 8 * fq), bq = *(const bf16x8*)(UAc + (size_t)fr * S5K + 32 * ks + 8 * fq);
                    acc = __builtin_amdgcn_mfma_f32_16x16x32_bf16(a, bq, acc, 0, 0, 0); }
                u32x2 w; w.x = pk2(gelu_tanh(acc[0]), gelu_tanh(acc[1])); w.y = pk2(gelu_tanh(acc[2]), gelu_tanh(acc[3]));
                *(u32x2*)(G2c + (size_t)fr * 256 + mt * 16 + 4 * fq) = w; }
        }
        __syncthreads();
    }
}
constexpr int N_PHASES = 3 + 4 * 8;
#ifndef WGM_C2
#define WGM_C2 8
#endif
#ifndef WGM_E1
#define WGM_E1 4
#endif
#ifndef REV_C4
#define REV_C4 0
#endif
#ifndef WGM_O4
#define WGM_O4 4
#endif
#ifndef WGM_C4
#define WGM_C4 4
#endif
#ifndef DUP_MASK_VALUE
#define DUP_MASK_VALUE 0ull
#endif
constexpr unsigned long long DUP_MASK = DUP_MASK_VALUE;
#ifndef DUP_SUB
#define DUP_SUB 0
#endif
typedef const Params __attribute__((address_space(4)))* ParamsK;
__global__ void __launch_bounds__(NTHR, 2) hybrid_fwd(Params Parg) {
    extern __shared__ __attribute__((aligned(16))) unsigned char lds_raw[];
    Frame F0; F0.lds = (LAS unsigned char*)lds_raw; F0.tid = threadIdx.x; F0.lane = F0.tid & 63; F0.wave = __builtin_amdgcn_readfirstlane(F0.tid >> 6); F0.G = gridDim.x; F0.bid = blockIdx.x;
    for (int u = F0.tid; u < (LDS_BYTES - LDSCTL_OFF) / 4; u += NTHR) ((LAS unsigned*)(F0.lds + LDSCTL_OFF))[u] = 0u;
    __syncthreads();
    XcdBarrier bar = xcd_barrier_post((unsigned*)(Parg.ws + WS_CTL) + CW_BAR, (volatile LAS unsigned*)(F0.lds + LDSCTL_OFF + 64));
    const int lo = Parg.lo, hi = Parg.hi; int ph = 0;
#define RUNP() (lo <= ph && ph < hi)
#define PHASE_BEGIN for (int rep_ = 0; RUNP() && rep_ < (((DUP_MASK >> ph) & 1ull) ? 2 : 1); ++rep_)
#define SEAM() do { if (lo <= ph && ph + 1 < hi) { XcdBarrier bl_ = bar; asm volatile("" : "+s"(bl_.x)); xcd_barrier(bl_); if (DUP_SUB == 6) xcd_barrier(bl_); } ++ph; } while (0)
#define LOCALS() Frame F = F0; { int t_ = F0.tid; asm volatile("" : "+v"(t_)); F.tid = t_; F.lane = t_ & 63; F.wave = __builtin_amdgcn_readfirstlane(t_ >> 6); int b_ = F0.bid, g_ = F0.G; asm volatile("" : "+s"(b_), "+s"(g_)); F.bid = b_; F.G = g_; } \
    ParamsK pk_ = (ParamsK)__builtin_amdgcn_kernarg_segment_ptr(); asm volatile("" : "+s"(pk_)); Params P; _Pragma("unroll") for (int i_ = 0; i_ < 33; ++i_) P.in[i_] = pk_->in[i_]; P.out = pk_->out; P.ws = pk_->ws; P.lo = 0; P.hi = 0; P.pad0 = 0; P.pad1 = 0; unsigned char* const ws = P.ws; (void)ws
#define W_MOD ((float*)(ws + WS_MOD))
#define W_XC ((float*)(ws + WS_XC))
#define W_HM ((bf16*)(ws + WS_HM))
#define W_YAB ((bf16*)(ws + WS_YAB))
#define W_Y ((bf16*)(ws + WS_Y))
#define W_PART ((float*)(ws + WS_PART))
#define W_A5 ((bf16*)(ws + WS_A5))
#define W_U ((bf16*)(ws + WS_U))
#define W_ZBT ((bf16*)(ws + WS_U + 50 * MiB))
#define W_F32U ((float*)(ws + WS_U))

    PHASE_BEGIN { LOCALS(); p0_prologue(F, P); }
    SEAM();
    PHASE_BEGIN { LOCALS(); p1_phase(F, P); }
    SEAM();
    PHASE_BEGIN { LOCALS(); row_phase<0>(F, nullptr, nullptr, 0, MROWS, P.in[0], P.in[2], nullptr, nullptr, nullptr, nullptr, 0, true, P.in[6], W_MOD, 0, 1, W_HM, nullptr); }
    SEAM();
    { constexpr int layer = 0;
        constexpr int jj = layer >> 1; constexpr bool LASTL = (layer == DEPTH - 1); constexpr int NROWS_L = LASTL ? NLAT : MROWS;
        if ((layer & 1) == 0) {
            PHASE_BEGIN { LOCALS();
                pg8::OrderE1 S{F.G, F.bid, (const char*)W_HM, (const char*)(ws + WS_WIN + jj * SZ_WIN)};
                typedef pg8::EpiQKVZ<(DUP_SUB == 5 && layer == 0) ? 3 : 1> EpiE1; EpiE1 E{W_U, W_ZBT, (const float*)(ws + WS_TAB)};
                pg8::gemm_phase<EpiE1, pg8::OrderE1, true>(F.lds, F.tid, pg8::Gemm{DM, DM}, S, E);
            }
            SEAM();
            PHASE_BEGIN { LOCALS();
                for (int rr_ = 0; rr_ < ((DUP_SUB == 1 && layer == 0) ? 2 : 1); ++rr_) for (int c = F.bid; c < 1024; c += F.G) hyena_unit(F, P, jj, c);
                for (int rr_ = 0; rr_ < ((DUP_SUB == 2 && layer == 0) ? 2 : 1); ++rr_) for (int au = F.bid; au < 528; au += F.G) attn_unit(F, P, jj, au);
            }
            SEAM();
            PHASE_BEGIN { LOCALS(); ybt_transpose_phase(F, P); }
            SEAM();
            PHASE_BEGIN { LOCALS();
                pg8::OrderSplit S; S.init(W_YAB, ws + WS_WOUT + jj * SZ_WOUT, DM, DM, DM, DM, 1, F.G, F.bid);
                pg8::EpiYb E{W_Y, DM, nullptr, W_PART};
                pg8::gemm_phase<pg8::EpiYb, pg8::OrderSplit, true>(F.lds, F.tid, pg8::Gemm{DM, DM}, S, E);
            }
            SEAM();
        } else {
            PHASE_BEGIN { LOCALS();
                pg8::OrderS5 S{F.G, F.bid, 256 / 64, (const char*)W_A5, (const char*)(ws + WS_WW + (size_t)jj * S5G * 256 * 256 * 2), (size_t)256 * 256 * 2, 1};
                pg8::EpiF32g E{W_F32U, S5ROWS, nullptr};
                pg8::gemm_phase<pg8::EpiF32g, pg8::OrderS5, true>(F.lds, F.tid, pg8::Gemm{256, S5K}, S, E);
            }
            SEAM();
            PHASE_BEGIN { LOCALS(); s5_carry_phase(F, P, jj); }
            SEAM();
            PHASE_BEGIN { LOCALS();
                pg8::OrderS5 S{F.G, F.bid, S5K / 64, (const char*)W_A5, (const char*)(ws + WS_TT + (size_t)jj * S5G * 256 * 512 * 2), (size_t)256 * 512 * 2, 0};
                pg8::EpiS5G E{W_Y};
                pg8::gemm_phase<pg8::EpiS5G, pg8::OrderS5, true>(F.lds, F.tid, pg8::Gemm{S5K, S5K}, S, E);
            }
            SEAM();
            PHASE_BEGIN { LOCALS();
                pg8::OrderSplit S; S.init(W_Y, ws + WS_WGLU + jj * SZ_WGLU, 2 * DM, DM, DM, DM, LASTL ? 0 : 1, F.G, F.bid, 1, WGM_O4);
                pg8::EpiYb E{W_U, 2 * DM, P.in[32] + (size_t)jj * 2 * DM, W_PART};
                pg8::gemm_phase<pg8::EpiYb, pg8::OrderSplit, true, 1>(F.lds, F.tid, pg8::Gemm{DM, DM}, S, E);
            }
            SEAM();
        }
        PHASE_BEGIN { LOCALS();
            const float* modl = W_MOD + (size_t)layer * 3 * NMOD * DM; const float* ngl = P.in[6] + (size_t)layer * 4 * DM;
            const float* xl = layer == 0 ? P.in[0] : P.out; const float* xc = layer == 0 ? P.in[2] : W_XC;
            if (DUP_SUB == 4 && layer == 0) row_phase<1>(F, W_Y, W_PART, 8, NROWS_L, xl, xc, (float*)(ws + WS_U), (float*)(ws + WS_U + 140 * MiB), ngl + 1 * DM, modl, 2, true, ngl + 2 * DM, modl, 3, 4, (bf16*)(ws + WS_U + 200 * MiB), nullptr);
            if ((layer & 1) == 0) row_phase<1>(F, W_Y, W_PART, 8, NROWS_L, xl, xc, P.out, W_XC, ngl + 1 * DM, modl, 2, true, ngl + 2 * DM, modl, 3, 4, W_HM, nullptr);
            else row_phase<2>(F, W_U, W_PART, 8, NROWS_L, xl, xc, P.out, W_XC, ngl + 1 * DM, modl, 2, true, ngl + 2 * DM, modl, 3, 4, W_HM, nullptr);
        }
        SEAM();
        PHASE_BEGIN { LOCALS();
            pg8::OrderUp S{F.G, F.bid, LASTL ? 66 : 70, (const char*)W_HM, (const char*)(ws + WS_WUP + layer * SZ_WUP), WGM_C2};
            typedef pg8::EpiUpGlu<(DUP_SUB == 3 && layer == 0) ? 2 : 1> EpiUp; EpiUp E{W_A5, P.in[8] + (size_t)layer * 3 * DFF2, P.in[9] + (size_t)layer * DFF2, (LAS float*)(F.lds + AUX_OFF)};
            pg8::gemm_phase<EpiUp, pg8::OrderUp, true>(F.lds, F.tid, pg8::Gemm{DM, DM}, S, E);
        }
        SEAM();
        PHASE_BEGIN { LOCALS();
            pg8::OrderSplit S; S.init(W_A5, ws + WS_WDOWN + layer * SZ_WDOWN, DM, DFF, DFF, DFF, LASTL ? 0 : 1, F.G, F.bid, 0, WGM_C4, REV_C4);
            pg8::EpiYb E{W_Y, DM, nullptr, W_PART};
            pg8::gemm_phase<pg8::EpiYb, pg8::OrderSplit, true>(F.lds, F.tid, pg8::Gemm{DFF, DFF}, S, E);
        }
        SEAM();
        PHASE_BEGIN { LOCALS();
            const float* modl = W_MOD + (size_t)layer * 3 * NMOD * DM; const float* ngl = P.in[6] + (size_t)layer * 4 * DM;
            row_phase<1>(F, W_Y, W_PART, 15, NROWS_L, P.out, W_XC, P.out, W_XC, ngl + 3 * DM, modl, 5, !LASTL, ngl + 4 * DM, modl + 3 * NMOD * DM, 0, 1, ((layer & 1) == 0) ? nullptr : W_HM, ((layer & 1) == 0) ? W_A5 : nullptr);
        }
        SEAM();
    }
    { constexpr int layer = 1;
        constexpr int jj = layer >> 1; constexpr bool LASTL = (layer == DEPTH - 1); constexpr int NROWS_L = LASTL ? NLAT : MROWS;
        if ((layer & 1) == 0) {
            PHASE_BEGIN { LOCALS();
                pg8::OrderE1 S{F.G, F.bid, (const char*)W_HM, (const char*)(ws + WS_WIN + jj * SZ_WIN)};
                typedef pg8::EpiQKVZ<(DUP_SUB == 5 && layer == 0) ? 3 : 1> EpiE1; EpiE1 E{W_U, W_ZBT, (const float*)(ws + WS_TAB)};
                pg8::gemm_phase<EpiE1, pg8::OrderE1, true>(F.lds, F.tid, pg8::Gemm{DM, DM}, S, E);
            }
            SEAM();
            PHASE_BEGIN { LOCALS();
                for (int rr_ = 0; rr_ < ((DUP_SUB == 1 && layer == 0) ? 2 : 1); ++rr_) for (int c = F.bid; c < 1024; c += F.G) hyena_unit(F, P, jj, c);
                for (int rr_ = 0; rr_ < ((DUP_SUB == 2 && layer == 0) ? 2 : 1); ++rr_) for (int au = F.bid; au < 528; au += F.G) attn_unit(F, P, jj, au);
            }
            SEAM();
            PHASE_BEGIN { LOCALS(); ybt_transpose_phase(F, P); }
            SEAM();
            PHASE_BEGIN { LOCALS();
                pg8::OrderSplit S; S.init(W_YAB, ws + WS_WOUT + jj * SZ_WOUT, DM, DM, DM, DM, 1, F.G, F.bid);
                pg8::EpiYb E{W_Y, DM, nullptr, W_PART};
                pg8::gemm_phase<pg8::EpiYb, pg8::OrderSplit, true>(F.lds, F.tid, pg8::Gemm{DM, DM}, S, E);
            }
            SEAM();
        } else {
            PHASE_BEGIN { LOCALS();
                pg8::OrderS5 S{F.G, F.bid, 256 / 64, (const char*)W_A5, (const char*)(ws + WS_WW + (size_t)jj * S5G * 256 * 256 * 2), (size_t)256 * 256 * 2, 1};
                pg8::EpiF32g E{W_F32U, S5ROWS, nullptr};
                pg8::gemm_phase<pg8::EpiF32g, pg8::OrderS5, true>(F.lds, F.tid, pg8::Gemm{256, S5K}, S, E);
            }
            SEAM();
            PHASE_BEGIN { LOCALS(); s5_carry_phase(F, P, jj); }
            SEAM();
            PHASE_BEGIN { LOCALS();
                pg8::OrderS5 S{F.G, F.bid, S5K / 64, (const char*)W_A5, (const char*)(ws + WS_TT + (size_t)jj * S5G * 256 * 512 * 2), (size_t)256 * 512 * 2, 0};
                pg8::EpiS5G E{W_Y};
                pg8::gemm_phase<pg8::EpiS5G, pg8::OrderS5, true>(F.lds, F.tid, pg8::Gemm{S5K, S5K}, S, E);
            }
            SEAM();
            PHASE_BEGIN { LOCALS();
                pg8::OrderSplit S; S.init(W_Y, ws + WS_WGLU + jj * SZ_WGLU, 2 * DM, DM, DM, DM, LASTL ? 0 : 1, F.G, F.bid, 1, WGM_O4);
                pg8::EpiYb E{W_U, 2 * DM, P.in[32] + (size_t)jj * 2 * DM, W_PART};
                pg8::gemm_phase<pg8::EpiYb, pg8::OrderSplit, true, 1>(F.lds, F.tid, pg8::Gemm{DM, DM}, S, E);
            }
            SEAM();
        }
        PHASE_BEGIN { LOCALS();
            const float* modl = W_MOD + (size_t)layer * 3 * NMOD * DM; const float* ngl = P.in[6] + (size_t)layer * 4 * DM;
            const float* xl = layer == 0 ? P.in[0] : P.out; const float* xc = layer == 0 ? P.in[2] : W_XC;
            if (DUP_SUB == 4 && layer == 0) row_phase<1>(F, W_Y, W_PART, 8, NROWS_L, xl, xc, (float*)(ws + WS_U), (float*)(ws + WS_U + 140 * MiB), ngl + 1 * DM, modl, 2, true, ngl + 2 * DM, modl, 3, 4, (bf16*)(ws + WS_U + 200 * MiB), nullptr);
            if ((layer & 1) == 0) row_phase<1>(F, W_Y, W_PART, 8, NROWS_L, xl, xc, P.out, W_XC, ngl + 1 * DM, modl, 2, true, ngl + 2 * DM, modl, 3, 4, W_HM, nullptr);
            else row_phase<2>(F, W_U, W_PART, 8, NROWS_L, xl, xc, P.out, W_XC, ngl + 1 * DM, modl, 2, true, ngl + 2 * DM, modl, 3, 4, W_HM, nullptr);
        }
        SEAM();
        PHASE_BEGIN { LOCALS();
            pg8::OrderUp S{F.G, F.bid, LASTL ? 66 : 70, (const char*)W_HM, (const char*)(ws + WS_WUP + layer * SZ_WUP), WGM_C2};
            typedef pg8::EpiUpGlu<(DUP_SUB == 3 && layer == 0) ? 2 : 1> EpiUp; EpiUp E{W_A5, P.in[8] + (size_t)layer * 3 * DFF2, P.in[9] + (size_t)layer * DFF2, (LAS float*)(F.lds + AUX_OFF)};
            pg8::gemm_phase<EpiUp, pg8::OrderUp, true>(F.lds, F.tid, pg8::Gemm{DM, DM}, S, E);
        }
        SEAM();
        PHASE_BEGIN { LOCALS();
            pg8::OrderSplit S; S.init(W_A5, ws + WS_WDOWN + layer * SZ_WDOWN, DM, DFF, DFF, DFF, LASTL ? 0 : 1, F.G, F.bid, 0, WGM_C4, REV_C4);
            pg8::EpiYb E{W_Y, DM, nullptr, W_PART};
            pg8::gemm_phase<pg8::EpiYb, pg8::OrderSplit, true>(F.lds, F.tid, pg8::Gemm{DFF, DFF}, S, E);
        }
        SEAM();
        PHASE_BEGIN { LOCALS();
            const float* modl = W_MOD + (size_t)layer * 3 * NMOD * DM; const float* ngl = P.in[6] + (size_t)layer * 4 * DM;
            row_phase<1>(F, W_Y, W_PART, 15, NROWS_L, P.out, W_XC, P.out, W_XC, ngl + 3 * DM, modl, 5, !LASTL, ngl + 4 * DM, modl + 3 * NMOD * DM, 0, 1, ((layer & 1) == 0) ? nullptr : W_HM, ((layer & 1) == 0) ? W_A5 : nullptr);
        }
        SEAM();
    }
    { constexpr int layer = 2;
        constexpr int jj = layer >> 1; constexpr bool LASTL = (layer == DEPTH - 1); constexpr int NROWS_L = LASTL ? NLAT : MROWS;
        if ((layer & 1) == 0) {
            PHASE_BEGIN { LOCALS();
                pg8::OrderE1 S{F.G, F.bid, (const char*)W_HM, (const char*)(ws + WS_WIN + jj * SZ_WIN)};
                typedef pg8::EpiQKVZ<(DUP_SUB == 5 && layer == 0) ? 3 : 1> EpiE1; EpiE1 E{W_U, W_ZBT, (const float*)(ws + WS_TAB)};
                pg8::gemm_phase<EpiE1, pg8::OrderE1, true>(F.lds, F.tid, pg8::Gemm{DM, DM}, S, E);
            }
            SEAM();
            PHASE_BEGIN { LOCALS();
                for (int rr_ = 0; rr_ < ((DUP_SUB == 1 && layer == 0) ? 2 : 1); ++rr_) for (int c = F.bid; c < 1024; c += F.G) hyena_unit(F, P, jj, c);
                for (int rr_ = 0; rr_ < ((DUP_SUB == 2 && layer == 0) ? 2 : 1); ++rr_) for (int au = F.bid; au < 528; au += F.G) attn_unit(F, P, jj, au);
            }
            SEAM();
            PHASE_BEGIN { LOCALS(); ybt_transpose_phase(F, P); }
            SEAM();
            PHASE_BEGIN { LOCALS();
                pg8::OrderSplit S; S.init(W_YAB, ws + WS_WOUT + jj * SZ_WOUT, DM, DM, DM, DM, 1, F.G, F.bid);
                pg8::EpiYb E{W_Y, DM, nullptr, W_PART};
                pg8::gemm_phase<pg8::EpiYb, pg8::OrderSplit, true>(F.lds, F.tid, pg8::Gemm{DM, DM}, S, E);
            }
            SEAM();
        } else {
            PHASE_BEGIN { LOCALS();
                pg8::OrderS5 S{F.G, F.bid, 256 / 64, (const char*)W_A5, (const char*)(ws + WS_WW + (size_t)jj * S5G * 256 * 256 * 2), (size_t)256 * 256 * 2, 1};
                pg8::EpiF32g E{W_F32U, S5ROWS, nullptr};
                pg8::gemm_phase<pg8::EpiF32g, pg8::OrderS5, true>(F.lds, F.tid, pg8::Gemm{256, S5K}, S, E);
            }
            SEAM();
            PHASE_BEGIN { LOCALS(); s5_carry_phase(F, P, jj); }
            SEAM();
            PHASE_BEGIN { LOCALS();
                pg8::OrderS5 S{F.G, F.bid, S5K / 64, (const char*)W_A5, (const char*)(ws + WS_TT + (size_t)jj * S5G * 256 * 512 * 2), (size_t)256 * 512 * 2, 0};
                pg8::EpiS5G E{W_Y};
                pg8::gemm_phase<pg8::EpiS5G, pg8::OrderS5, true>(F.lds, F.tid, pg8::Gemm{S5K, S5K}, S, E);
            }
            SEAM();
            PHASE_BEGIN { LOCALS();
                pg8::OrderSplit S; S.init(W_Y, ws + WS_WGLU + jj * SZ_WGLU, 2 * DM, DM, DM, DM, LASTL ? 0 : 1, F.G, F.bid, 1, WGM_O4);
                pg8::EpiYb E{W_U, 2 * DM, P.in[32] + (size_t)jj * 2 * DM, W_PART};
                pg8::gemm_phase<pg8::EpiYb, pg8::OrderSplit, true, 1>(F.lds, F.tid, pg8::Gemm{DM, DM}, S, E);
            }
            SEAM();
        }
        PHASE_BEGIN { LOCALS();
            const float* modl = W_MOD + (size_t)layer * 3 * NMOD * DM; const float* ngl = P.in[6] + (size_t)layer * 4 * DM;
            const float* xl = layer == 0 ? P.in[0] : P.out; const float* xc = layer == 0 ? P.in[2] : W_XC;
            if (DUP_SUB == 4 && layer == 0) row_phase<1>(F, W_Y, W_PART, 8, NROWS_L, xl, xc, (float*)(ws + WS_U), (float*)(ws + WS_U + 140 * MiB), ngl + 1 * DM, modl, 2, true, ngl + 2 * DM, modl, 3, 4, (bf16*)(ws + WS_U + 200 * MiB), nullptr);
            if ((layer & 1) == 0) row_phase<1>(F, W_Y, W_PART, 8, NROWS_L, xl, xc, P.out, W_XC, ngl + 1 * DM, modl, 2, true, ngl + 2 * DM, modl, 3, 4, W_HM, nullptr);
            else row_phase<2>(F, W_U, W_PART, 8, NROWS_L, xl, xc, P.out, W_XC, ngl + 1 * DM, modl, 2, true, ngl + 2 * DM, modl, 3, 4, W_HM, nullptr);
        }
        SEAM();
        PHASE_BEGIN { LOCALS();
            pg8::OrderUp S{F.G, F.bid, LASTL ? 66 : 70, (const char*)W_HM, (const char*)(ws + WS_WUP + layer * SZ_WUP), WGM_C2};
            typedef pg8::EpiUpGlu<(DUP_SUB == 3 && layer == 0) ? 2 : 1> EpiUp; EpiUp E{W_A5, P.in[8] + (size_t)layer * 3 * DFF2, P.in[9] + (size_t)layer * DFF2, (LAS float*)(F.lds + AUX_OFF)};
            pg8::gemm_phase<EpiUp, pg8::OrderUp, true>(F.lds, F.tid, pg8::Gemm{DM, DM}, S, E);
        }
        SEAM();
        PHASE_BEGIN { LOCALS();
            pg8::OrderSplit S; S.init(W_A5, ws + WS_WDOWN + layer * SZ_WDOWN, DM, DFF, DFF, DFF, LASTL ? 0 : 1, F.G, F.bid, 0, WGM_C4, REV_C4);
            pg8::EpiYb E{W_Y, DM, nullptr, W_PART};
            pg8::gemm_phase<pg8::EpiYb, pg8::OrderSplit, true>(F.lds, F.tid, pg8::Gemm{DFF, DFF}, S, E);
        }
        SEAM();
        PHASE_BEGIN { LOCALS();
            const float* modl = W_MOD + (size_t)layer * 3 * NMOD * DM; const float* ngl = P.in[6] + (size_t)layer * 4 * DM;
            row_phase<1>(F, W_Y, W_PART, 15, NROWS_L, P.out, W_XC, P.out, W_XC, ngl + 3 * DM, modl, 5, !LASTL, ngl + 4 * DM, modl + 3 * NMOD * DM, 0, 1, ((layer & 1) == 0) ? nullptr : W_HM, ((layer & 1) == 0) ? W_A5 : nullptr);
        }
        SEAM();
    }
    { constexpr int layer = 3;
        constexpr int jj = layer >> 1; constexpr bool LASTL = (layer == DEPTH - 1); constexpr int NROWS_L = LASTL ? NLAT : MROWS;
        if ((layer & 1) == 0) {
            PHASE_BEGIN { LOCALS();
                pg8::OrderE1 S{F.G, F.bid, (const char*)W_HM, (const char*)(ws + WS_WIN + jj * SZ_WIN)};
                typedef pg8::EpiQKVZ<(DUP_SUB == 5 && layer == 0) ? 3 : 1> EpiE1; EpiE1 E{W_U, W_ZBT, (const float*)(ws + WS_TAB)};
                pg8::gemm_phase<EpiE1, pg8::OrderE1, true>(F.lds, F.tid, pg8::Gemm{DM, DM}, S, E);
            }
            SEAM();
            PHASE_BEGIN { LOCALS();
                for (int rr_ = 0; rr_ < ((DUP_SUB == 1 && layer == 0) ? 2 : 1); ++rr_) for (int c = F.bid; c < 1024; c += F.G) hyena_unit(F, P, jj, c);
                for (int rr_ = 0; rr_ < ((DUP_SUB == 2 && layer == 0) ? 2 : 1); ++rr_) for (int au = F.bid; au < 528; au += F.G) attn_unit(F, P, jj, au);
            }
            SEAM();
            PHASE_BEGIN { LOCALS(); ybt_transpose_phase(F, P); }
            SEAM();
            PHASE_BEGIN { LOCALS();
                pg8::OrderSplit S; S.init(W_YAB, ws + WS_WOUT + jj * SZ_WOUT, DM, DM, DM, DM, 1, F.G, F.bid);
                pg8::EpiYb E{W_Y, DM, nullptr, W_PART};
                pg8::gemm_phase<pg8::EpiYb, pg8::OrderSplit, true>(F.lds, F.tid, pg8::Gemm{DM, DM}, S, E);
            }
            SEAM();
        } else {
            PHASE_BEGIN { LOCALS();
                pg8::OrderS5 S{F.G, F.bid, 256 / 64, (const char*)W_A5, (const char*)(ws + WS_WW + (size_t)jj * S5G * 256 * 256 * 2), (size_t)256 * 256 * 2, 1};
                pg8::EpiF32g E{W_F32U, S5ROWS, nullptr};
                pg8::gemm_phase<pg8::EpiF32g, pg8::OrderS5, true>(F.lds, F.tid, pg8::Gemm{256, S5K}, S, E);
            }
            SEAM();
            PHASE_BEGIN { LOCALS(); s5_carry_phase(F, P, jj); }
            SEAM();
            PHASE_BEGIN { LOCALS();
                pg8::OrderS5 S{F.G, F.bid, S5K / 64, (const char*)W_A5, (const char*)(ws + WS_TT + (size_t)jj * S5G * 256 * 512 * 2), (size_t)256 * 512 * 2, 0};
                pg8::EpiS5G E{W_Y};
                pg8::gemm_phase<pg8::EpiS5G, pg8::OrderS5, true>(F.lds, F.tid, pg8::Gemm{S5K, S5K}, S, E);
            }
            SEAM();
            PHASE_BEGIN { LOCALS();
                pg8::OrderSplit S; S.init(W_Y, ws + WS_WGLU + jj * SZ_WGLU, 2 * DM, DM, DM, DM, LASTL ? 0 : 1, F.G, F.bid, 1, WGM_O4);
                pg8::EpiYb E{W_U, 2 * DM, P.in[32] + (size_t)jj * 2 * DM, W_PART};
                pg8::gemm_phase<pg8::EpiYb, pg8::OrderSplit, true, 1>(F.lds, F.tid, pg8::Gemm{DM, DM}, S, E);
            }
            SEAM();
        }
        PHASE_BEGIN { LOCALS();
            const float* modl = W_MOD + (size_t)layer * 3 * NMOD * DM; const float* ngl = P.in[6] + (size_t)layer * 4 * DM;
            const float* xl = layer == 0 ? P.in[0] : P.out; const float* xc = layer == 0 ? P.in[2] : W_XC;
            if (DUP_SUB == 4 && layer == 0) row_phase<1>(F, W_Y, W_PART, 8, NROWS_L, xl, xc, (float*)(ws + WS_U), (float*)(ws + WS_U + 140 * MiB), ngl + 1 * DM, modl, 2, true, ngl + 2 * DM, modl, 3, 4, (bf16*)(ws + WS_U + 200 * MiB), nullptr);
            if ((layer & 1) == 0) row_phase<1>(F, W_Y, W_PART, 8, NROWS_L, xl, xc, P.out, W_XC, ngl + 1 * DM, modl, 2, true, ngl + 2 * DM, modl, 3, 4, W_HM, nullptr);
            else row_phase<2>(F, W_U, W_PART, 8, NROWS_L, xl, xc, P.out, W_XC, ngl + 1 * DM, modl, 2, true, ngl + 2 * DM, modl, 3, 4, W_HM, nullptr);
        }
        SEAM();
        PHASE_BEGIN { LOCALS();
            pg8::OrderUp S{F.G, F.bid, LASTL ? 66 : 70, (const char*)W_HM, (const char*)(ws + WS_WUP + layer * SZ_WUP), WGM_C2};
            typedef pg8::EpiUpGlu<(DUP_SUB == 3 && layer == 0) ? 2 : 1> EpiUp; EpiUp E{W_A5, P.in[8] + (size_t)layer * 3 * DFF2, P.in[9] + (size_t)layer * DFF2, (LAS float*)(F.lds + AUX_OFF)};
            pg8::gemm_phase<EpiUp, pg8::OrderUp, true>(F.lds, F.tid, pg8::Gemm{DM, DM}, S, E);
        }
        SEAM();
        PHASE_BEGIN { LOCALS();
            pg8::OrderSplit S; S.init(W_A5, ws + WS_WDOWN + layer * SZ_WDOWN, DM, DFF, DFF, DFF, LASTL ? 0 : 1, F.G, F.bid, 0, WGM_C4, REV_C4);
            pg8::EpiYb E{W_Y, DM, nullptr, W_PART};
            pg8::gemm_phase<pg8::EpiYb, pg8::OrderSplit, true>(F.lds, F.tid, pg8::Gemm{DFF, DFF}, S, E);
        }
        SEAM();
        PHASE_BEGIN { LOCALS();
            const float* modl = W_MOD + (size_t)layer * 3 * NMOD * DM; const float* ngl = P.in[6] + (size_t)layer * 4 * DM;
            row_phase<1>(F, W_Y, W_PART, 15, NROWS_L, P.out, W_XC, P.out, W_XC, ngl + 3 * DM, modl, 5, !LASTL, ngl + 4 * DM, modl + 3 * NMOD * DM, 0, 1, ((layer & 1) == 0) ? nullptr : W_HM, ((layer & 1) == 0) ? W_A5 : nullptr);
        }
        SEAM();
    }
#undef RUNP
#undef SEAM
}

extern "C" void kernel_launch(void* const* d_in, const int* in_sizes, int n_in, void* d_out, int out_size, void* d_ws, size_t ws_size, hipStream_t stream) {
    static int grid = 0;
    if (grid == 0) {
        if (n_in != 33 || out_size != NLAT * DM || ws_size < WS_END) { fprintf(stderr, "kernel_launch: unexpected problem (n_in %d, out %d, ws %zu < %zu)\n", n_in, out_size, ws_size, (size_t)WS_END); grid = -1; return; }
        int dev = 0, cus = 0, per_cu = 0;
        if (hipGetDevice(&dev) != hipSuccess || hipDeviceGetAttribute(&cus, hipDeviceAttributeMultiprocessorCount, dev) != hipSuccess) { grid = -1; return; }
        if (hipFuncSetAttribute((const void*)hybrid_fwd, hipFuncAttributeMaxDynamicSharedMemorySize, LDS_BYTES) != hipSuccess) { fprintf(stderr, "kernel_launch: hipFuncSetAttribute failed\n"); grid = -1; return; }
        if (hipOccupancyMaxActiveBlocksPerMultiprocessor(&per_cu, (const void*)hybrid_fwd, NTHR, LDS_BYTES) != hipSuccess || per_cu < 1) fprintf(stderr, "kernel_launch: occupancy query reports %d blocks per CU\n", per_cu);
        (void)hipGetLastError();
        grid = cus;
    }
    if (grid < 0) return;
    if (hipMemsetAsync((char*)d_ws + WS_CTL, 0, CTL_BYTES, stream) != hipSuccess) return;
    Params p{};
    for (int i = 0; i < 33; ++i) p.in[i] = (const float*)d_in[i];
    p.out = (float*)d_out; p.ws = (unsigned char*)d_ws; p.pad0 = 0; p.pad1 = 0;
#ifdef MK_PER_PHASE
    for (int ph = 0; ph < N_PHASES; ++ph) { p.lo = ph; p.hi = ph + 1; hipLaunchKernelGGL(hybrid_fwd, dim3(grid), dim3(NTHR), LDS_BYTES, stream, p); }
#else
    p.lo = 0; p.hi = N_PHASES;
    hipLaunchKernelGGL(hybrid_fwd, dim3(grid), dim3(NTHR), LDS_BYTES, stream, p);
#endif
    const hipError_t le = hipPeekAtLastError();
    if (le != hipSuccess) fprintf(stderr, "kernel_launch: launch failed: %s\n", hipGetErrorName(le));
}
```

```cpp
#define KLOOP_PAD 12
#include <hip/hip_runtime.h>
#include <cstdio>
#include <cstdint>
namespace pg8 {
#define PG8_STR_(x) #x
#define PG8_STR(x) PG8_STR_(x)
#define PG8_LAS __attribute__((address_space(3)))
typedef unsigned short bf16_t;
typedef short bf16x8 __attribute__((ext_vector_type(8)));
typedef float f32x4 __attribute__((ext_vector_type(4)));
typedef unsigned u32x4 __attribute__((ext_vector_type(4)));
typedef unsigned u32x2 __attribute__((ext_vector_type(2)));
constexpr int BM = 256, BK = 64, HALF = 128, HTB = HALF * BK * 2  , STAGE_BYTES = 8 * HTB, NXCD = 8, WGM = 4;

__host__ __device__ __forceinline__ int lds_byte(int r, int c) { const int st = (r >> 4) * 2 + (c >> 5), rr = r & 15, cc = c & 31, ob = rr * 64 + cc * 2; return st * 1024 + (ob ^ (((ob >> 9) & 1) << 5)); }
__host__ __device__ __forceinline__ void stage_rc(int b, int& R, int& C) { const int st = b / 1024, sb = b % 1024, swz = sb ^ (((sb >> 9) & 1) << 5); R = (st >> 1) * 16 + swz / 64; C = (st & 1) * 32 + (swz % 64) / 2; }
__host__ __device__ __forceinline__ int perm32(int rho) { const int n = rho >> 4, i = rho & 15; return 8 * (i >> 2) + 4 * n + (i & 3); }

struct Unit { int pm, pn, kind, nt; const char* a; const char* b; };
struct Gemm { int lda, ldb; };

__host__ __device__ __forceinline__ void tile_map(int wgid, int nM, int nN, int& pm, int& pn, const int wgm = WGM) {
    const int nwg = nM * nN;
    { const int q = nwg / NXCD, r = nwg % NXCD, xcd = wgid % NXCD, off = wgid / NXCD; wgid = (xcd < r ? xcd * (q + 1) : r * (q + 1) + (xcd - r) * q) + off; }
    const int nig = wgm * nN, gid = wgid / nig, fm = gid * wgm, gsz = (nM - fm) < wgm ? (nM - fm) : wgm;
    pm = fm + ((wgid % nig) % gsz); pn = (wgid % nig) / gsz;
}
struct StaticOrder {
    int nM, nN, nwg, G, c, nt; const char* A; const char* Bt; size_t ta, tb;
    __device__ void init(const void* A_, const void* Bt_, int M, int N, int K, int lda, int ldb, int G_, int c_) { nt = K / BK; nM = M / BM; nN = N / BM; nwg = nM * nN; G = G_; c = c_; A = (const char*)A_; Bt = (const char*)Bt_; ta = (size_t)BM * lda * 2; tb = (size_t)BM * ldb * 2; }
    __device__ bool next(int i, Unit& u) const {
        const long L = (long)i * G + c; if (L >= nwg) return false;
        tile_map((int)L, nM, nN, u.pm, u.pn); u.kind = 0; u.nt = nt; u.a = A + (size_t)u.pm * ta; u.b = Bt + (size_t)u.pn * tb; return true;
    }
};

__device__ __forceinline__ unsigned cvt_pk_bf16(float lo, float hi) { unsigned r; asm volatile("v_cvt_pk_bf16_f32 %0, %1, %2" : "=v"(r) : "v"(lo), "v"(hi)); return r; }

template <class Epi, class Sched, bool ALIGN_EPI, int AMODE = 0>
__device__ __forceinline__ void gemm_phase(PG8_LAS unsigned char* lds, const int tid, const Gemm g, const Sched& S, const Epi& E) {
    const int wid = __builtin_amdgcn_readfirstlane(tid >> 6), lane = tid & 63, wr = wid >> 2, wc = wid & 3, fr = lane & 15, fq = lane >> 4;
    unsigned voffA[2], voffB[2];
#pragma unroll
    for (int i = 0; i < 2; ++i) { int R, C; stage_rc(tid * 16 + i * 8192, R, C); const int Rb = Epi::PERM ? ((R & ~31) + perm32(R & 31)) : R;
        voffA[i] = AMODE == 1 ? (unsigned)((C >> 4) * (1280 * 256) + (R >> 4) * 256 + (R & 15) * 16 + (C & 15)) * 2u : (unsigned)(R * g.lda + C) * 2u; voffB[i] = (unsigned)(Rb * g.ldb + C) * 2u; }
    const size_t kstepB = (size_t)(BK * 2), kstepA = AMODE == 1 ? (size_t)4 * 1280 * 256 * 2 : (size_t)(BK * 2);
    const size_t hstepA = AMODE == 1 ? (size_t)8 * 256 * 2 : (size_t)HALF * g.lda * 2, hstepB = (size_t)HALF * g.ldb * 2;
    const unsigned ldsw = (unsigned)wid * 1024u;
    const int aoff = lds_byte(wr * 64 + fr, fq * 8), boff = lds_byte(wc * 32 + fr, fq * 8);
#define PG8_SA(b, h) (((b) * 2 + (h)) * HTB)
#define PG8_SB(b, h) ((4 + (b) * 2 + (h)) * HTB)
#define PG8_STAGE(bufoff, gbase, voff) do { _Pragma("unroll") for (int _i = 0; _i < 2; ++_i) \
        __builtin_amdgcn_global_load_lds((const unsigned*)((const char*)(gbase) + (voff)[_i]), (PG8_LAS unsigned*)(lds + (bufoff) + ldsw + _i * 8192), 16, 0, 0); } while (0)
#define PG8_LDA(dst, b, h) do { _Pragma("unroll") for (int m = 0; m < 4; ++m) _Pragma("unroll") for (int k = 0; k < 2; ++k) dst[m][k] = *(const PG8_LAS bf16x8*)(lds + PG8_SA(b, h) + aoff + m * 2048 + k * 1024); } while (0)
#define PG8_LDB(dst, b, h) do { _Pragma("unroll") for (int n = 0; n < 2; ++n) _Pragma("unroll") for (int k = 0; k < 2; ++k) dst[n][k] = *(const PG8_LAS bf16x8*)(lds + PG8_SB(b, h) + boff + n * 2048 + k * 1024); } while (0)
#define PG8_MMA(ai, bj, At, Bt) do { __builtin_amdgcn_s_setprio(1); _Pragma("unroll") for (int m = 0; m < 4; ++m) _Pragma("unroll") for (int n = 0; n < 2; ++n) _Pragma("unroll") for (int k = 0; k < 2; ++k) \
        acc[ai][bj][m][n] = __builtin_amdgcn_mfma_f32_16x16x32_bf16(Bt[n][k], At[m][k], acc[ai][bj][m][n], 0, 0, 0); __builtin_amdgcn_s_setprio(0); } while (0)
#define PG8_WAIT_V(n) asm volatile("s_waitcnt vmcnt(" #n ")" ::: "memory")
#define PG8_WAIT_L(n) asm volatile("s_waitcnt lgkmcnt(" #n ")" ::: "memory")
#define PG8_BAR __builtin_amdgcn_s_barrier()
#define PG8_SCHED __builtin_amdgcn_sched_barrier(0)
    Unit cur, nxt; int ui = 0;
    if (!S.next(0, cur)) return;
    f32x4 acc[2][2][4][2];
#pragma unroll
    for (int a = 0; a < 2; ++a)
#pragma unroll
        for (int b = 0; b < 2; ++b)
#pragma unroll
            for (int m = 0; m < 4; ++m)
#pragma unroll
                for (int n = 0; n < 2; ++n) acc[a][b][m][n] = (f32x4){0.f, 0.f, 0.f, 0.f};
    bf16x8 At[4][2], B0[2][2], B1[2][2];
    const char* cA = cur.a; const char* cB = cur.b;
    PG8_STAGE(PG8_SB(0, 0), cB, voffB); PG8_STAGE(PG8_SB(0, 1), cB + hstepB, voffB); PG8_STAGE(PG8_SA(0, 0), cA, voffA); PG8_STAGE(PG8_SA(0, 1), cA + hstepA, voffA);
    if (wr == 1) PG8_BAR;
    PG8_WAIT_V(2); PG8_BAR;
    PG8_STAGE(PG8_SB(1, 0), cB + kstepB, voffB); PG8_STAGE(PG8_SA(1, 0), cA + kstepA, voffA); PG8_STAGE(PG8_SB(1, 1), cB + hstepB + kstepB, voffB);
    PG8_WAIT_V(6); PG8_BAR;
    for (;;) {
        const bool has_next = S.next(ui + 1, nxt);
        const char* nA = has_next ? nxt.a : cA; const char* nB = has_next ? nxt.b : cB;
        const int nt = cur.nt;
#ifdef KLOOP_PAD
        asm volatile(".p2align 7\n .rept " PG8_STR(KLOOP_PAD) "\n s_nop 0\n .endr" ::: "memory");
#endif
        for (int t = 0; t < nt; t += 2) {
            const bool last = (t == nt - 2);
            const char* a1 = cA + (size_t)(t + 1) * kstepA;
            const char* a2 = last ? nA : cA + (size_t)(t + 2) * kstepA; const char* b2 = last ? nB : cB + (size_t)(t + 2) * kstepB;
            const char* a3 = a2 + kstepA; const char* b3 = b2 + kstepB;
            PG8_LDB(B0, 0, 0); PG8_LDB(B1, 0, 1); PG8_SCHED; PG8_LDA(At, 0, 0); PG8_STAGE(PG8_SA(1, 1), a1 + hstepA, voffA);
            PG8_WAIT_V(8); PG8_WAIT_L(0); PG8_BAR; PG8_MMA(0, 0, At, B0); PG8_MMA(0, 1, At, B1); PG8_BAR; PG8_SCHED;
            PG8_LDA(At, 0, 1); PG8_STAGE(PG8_SB(0, 0), b2, voffB); PG8_STAGE(PG8_SB(0, 1), b2 + hstepB, voffB); PG8_STAGE(PG8_SA(0, 0), a2, voffA);
            PG8_WAIT_V(8); PG8_WAIT_L(0); PG8_BAR; PG8_MMA(1, 0, At, B0); PG8_MMA(1, 1, At, B1); PG8_BAR; PG8_SCHED;
            PG8_LDB(B0, 1, 0); PG8_LDB(B1, 1, 1); PG8_SCHED; PG8_LDA(At, 1, 0); PG8_STAGE(PG8_SA(0, 1), a2 + hstepA, voffA);
            PG8_WAIT_V(8); PG8_WAIT_L(0); PG8_BAR; PG8_MMA(0, 0, At, B0); PG8_MMA(0, 1, At, B1); PG8_BAR; PG8_SCHED;
            PG8_LDA(At, 1, 1); PG8_STAGE(PG8_SB(1, 0), b3, voffB); PG8_STAGE(PG8_SB(1, 1), b3 + hstepB, voffB); PG8_STAGE(PG8_SA(1, 0), a3, voffA);
            PG8_WAIT_V(8); PG8_WAIT_L(0); PG8_BAR; PG8_MMA(1, 0, At, B0); PG8_MMA(1, 1, At, B1); PG8_BAR; PG8_SCHED;
        }
        if constexpr (ALIGN_EPI) { if (wr == 0) PG8_BAR; }
        { int fr_ = fr, fq_ = fq; asm volatile("" : "+v"(fr_), "+v"(fq_)); if constexpr (Epi::REP == 1) E(acc, cur, wr, wc, fr_, fq_); else { int nrep_ = Epi::REP; asm volatile("" : "+s"(nrep_)); _Pragma("unroll 1") for (int rep_e = 0; rep_e < nrep_; ++rep_e) E(acc, cur, wr, wc, fr_, fq_); } }
        if (!has_next) break;
#pragma unroll
        for (int a = 0; a < 2; ++a)
#pragma unroll
            for (int b = 0; b < 2; ++b)
#pragma unroll
                for (int m = 0; m < 4; ++m)
#pragma unroll
                    for (int n = 0; n < 2; ++n) acc[a][b][m][n] = (f32x4){0.f, 0.f, 0.f, 0.f};
        cur = nxt; cA = nA; cB = nB; ++ui;
        if constexpr (ALIGN_EPI) { if (wr == 1) PG8_BAR; }
    }
    PG8_WAIT_V(0);
    if constexpr (!ALIGN_EPI) { if (wr == 0) PG8_BAR; }
    PG8_BAR;
#undef PG8_SA
#undef PG8_SB
#undef PG8_STAGE
#undef PG8_LDA
#undef PG8_LDB
#undef PG8_MMA
#undef PG8_WAIT_V
#undef PG8_WAIT_L
#undef PG8_BAR
#undef PG8_SCHED
}
}
#ifndef WGM_E1
#define WGM_E1 4
#endif
constexpr int DM = 2048, NBATCH = 2, SEQ = 8192, DEPTH = 4, CTXL = 256;
constexpr int NLAT = NBATCH * SEQ, NCTX = NBATCH * CTXL, MROWS = NLAT + NCTX;
constexpr int DFF = 5504, DFF2 = 11008, NMOD = 6;
constexpr int QCOLS = 1024, KVC = 256, HYC = 3072, INCOLS = 4608, QKVC = 1536, HD = 128;
constexpr int S5G = 128, S5P = 64, S5J = 16, S5L = 16, S5ROWS = 1280, S5K = 512;
constexpr float RMS_EPS = 1e-6f;
constexpr float LOG2E = 1.4426950408889634f;
constexpr float QSCALE = 0.08838834764831845f * LOG2E;

typedef unsigned short bf16;
typedef float f32x4 __attribute__((ext_vector_type(4)));
typedef float f32x2 __attribute__((ext_vector_type(2)));
typedef float f32x16 __attribute__((ext_vector_type(16)));
typedef unsigned u32x4 __attribute__((ext_vector_type(4)));
typedef unsigned u32x2 __attribute__((ext_vector_type(2)));
typedef short bf16x8 __attribute__((ext_vector_type(8)));
typedef short s16x4 __attribute__((ext_vector_type(4)));
#define GAS __attribute__((address_space(1)))
#define LAS __attribute__((address_space(3)))
#define DI __device__ __forceinline__

DI unsigned f2bf(float f) { unsigned u = __builtin_bit_cast(unsigned, f); return (u + 0x7fffu + ((u >> 16) & 1u)) >> 16; }
DI unsigned pk2(float lo, float hi) { return pg8::cvt_pk_bf16(lo, hi); }
DI float bf2f(unsigned short b) { return __builtin_bit_cast(float, ((unsigned)b) << 16); }
DI float bflo(unsigned w) { return __builtin_bit_cast(float, w << 16); }
DI float bfhi(unsigned w) { return __builtin_bit_cast(float, w & 0xffff0000u); }
DI float fast_exp(float x) { return __builtin_amdgcn_exp2f(x * LOG2E); }
DI float sigmoidf_(float x) { return __builtin_amdgcn_rcpf(1.0f + fast_exp(-x)); }
DI float siluf_(float x) { return x * sigmoidf_(x); }
DI float gelu_tanh(float x) { const float z = 0.7978845608028654f * (x + 0.044715f * x * x * x); const float e = fast_exp(2.0f * z); const float th = 1.0f - 2.0f * __builtin_amdgcn_rcpf(e + 1.0f); return 0.5f * x * (1.0f + th); }

namespace pg8 {
typedef __bf16 bf16x2v_ __attribute__((ext_vector_type(2)));
__device__ __forceinline__ unsigned cvt_pk_c(float lo, float hi) { const f32x2 v = {lo, hi}; const bf16x2v_ b = __builtin_convertvector(v, bf16x2v_); return __builtin_bit_cast(unsigned, b); }
struct EpiF32g {
    static constexpr bool PERM = false; static constexpr int REP = 1;
    float* C; int ldc; const float* bias;
    __device__ __forceinline__ void operator()(const f32x4 (&acc)[2][2][4][2], const Unit& u, int wr, int wc, int fr, int fq) const {
        const int row0 = u.pm * BM + wr * 64 + fr, col0 = u.pn * BM + wc * 32 + 4 * fq;
        f32x4 bv[2][2];
#pragma unroll
        for (int bj = 0; bj < 2; ++bj)
#pragma unroll
            for (int n = 0; n < 2; ++n) bv[bj][n] = bias ? *(const f32x4*)(bias + col0 + bj * HALF + n * 16) : (f32x4){0.f, 0.f, 0.f, 0.f};
#pragma unroll
        for (int ai = 0; ai < 2; ++ai)
#pragma unroll
            for (int m = 0; m < 4; ++m) { float* rowp = C + (size_t)(row0 + ai * HALF + m * 16) * ldc + col0;
#pragma unroll
                for (int bj = 0; bj < 2; ++bj)
#pragma unroll
                    for (int n = 0; n < 2; ++n) *(f32x4*)(rowp + bj * HALF + n * 16) = acc[ai][bj][m][n] + bv[bj][n]; }
    }
};
struct EpiBf16g {
    static constexpr bool PERM = true; static constexpr int REP = 1;
    bf16_t* O; int ldc;
    __device__ __forceinline__ void operator()(const f32x4 (&acc)[2][2][4][2], const Unit& u, int wr, int wc, int fr, int fq) const {
        const int row0 = u.pm * BM + wr * 64 + fr, col0 = u.pn * BM + wc * 32 + 8 * fq;
#pragma unroll
        for (int ai = 0; ai < 2; ++ai)
#pragma unroll
            for (int m = 0; m < 4; ++m) { bf16_t* rowp = O + (size_t)(row0 + ai * HALF + m * 16) * ldc + col0;
#pragma unroll
                for (int bj = 0; bj < 2; ++bj) { const f32x4 v0 = acc[ai][bj][m][0], v1 = acc[ai][bj][m][1];
                    u32x4 w; w.x = cvt_pk_bf16(v0[0], v0[1]); w.y = cvt_pk_bf16(v0[2], v0[3]); w.z = cvt_pk_bf16(v1[0], v1[1]); w.w = cvt_pk_bf16(v1[2], v1[3]);
                    *(u32x4*)(rowp + bj * HALF) = w; } }
    }
};
struct EpiYb {
    static constexpr bool PERM = true; static constexpr int REP = 1;
    bf16_t* O; int ldc; const float* bias; bf16_t* part;
    __device__ __forceinline__ void operator()(const f32x4 (&acc)[2][2][4][2], const Unit& u, int wr, int wc, int fr, int fq) const {
        const int col0 = u.pn * BM + wc * 32 + 8 * fq;
        const bool addb = bias != nullptr && (u.kind == 0 || u.kind == 16);
        f32x4 bv[2][2];
#pragma unroll
        for (int bj = 0; bj < 2; ++bj)
#pragma unroll
            for (int n = 0; n < 2; ++n) bv[bj][n] = addb ? *(const f32x4*)(bias + col0 + bj * HALF + 4 * n) : (f32x4){0.f, 0.f, 0.f, 0.f};
        if (u.kind >= 16) {
            bf16_t* base = part + ((size_t)(u.kind - 16) * NCTX + (size_t)(u.pm - NLAT / BM) * BM + wr * 64 + fr) * ldc + col0;
#pragma unroll
            for (int ai = 0; ai < 2; ++ai)
#pragma unroll
                for (int m = 0; m < 4; ++m) { bf16_t* rowp = base + (size_t)(ai * HALF + m * 16) * ldc;
#pragma unroll
                    for (int bj = 0; bj < 2; ++bj) { const f32x4 v0 = acc[ai][bj][m][0] + bv[bj][0], v1 = acc[ai][bj][m][1] + bv[bj][1];
                        u32x4 w; w.x = cvt_pk_bf16(v0[0], v0[1]); w.y = cvt_pk_bf16(v0[2], v0[3]); w.z = cvt_pk_bf16(v1[0], v1[1]); w.w = cvt_pk_bf16(v1[2], v1[3]);
                        *(u32x4*)(rowp + bj * HALF) = w; } }
        } else {
            const int row0 = u.pm * BM + wr * 64 + fr;
#pragma unroll
            for (int ai = 0; ai < 2; ++ai)
#pragma unroll
                for (int m = 0; m < 4; ++m) { bf16_t* rowp = O + (size_t)(row0 + ai * HALF + m * 16) * ldc + col0;
#pragma unroll
                    for (int bj = 0; bj < 2; ++bj) { const f32x4 v0 = acc[ai][bj][m][0] + bv[bj][0], v1 = acc[ai][bj][m][1] + bv[bj][1];
                        u32x4 w; w.x = cvt_pk_bf16(v0[0], v0[1]); w.y = cvt_pk_bf16(v0[2], v0[3]); w.z = cvt_pk_bf16(v1[0], v1[1]); w.w = cvt_pk_bf16(v1[2], v1[3]);
                        *(u32x4*)(rowp + bj * HALF) = w; } }
        }
    }
};
struct EpiGlu {
    static constexpr bool PERM = true; static constexpr int REP = 1;
    bf16_t* O; const float* bias; bf16_t* part;
    __device__ __forceinline__ void operator()(const f32x4 (&acc)[2][2][4][2], const Unit& u, int wr, int wc, int fr, int fq) const {
        const int col0 = u.pn * BM + wc * 32 + 8 * fq;
        const bool addb = (u.kind == 0 || u.kind == 16);
        f32x4 ba[2], bg[2];
#pragma unroll
        for (int bj = 0; bj < 2; ++bj) { const int ch = (col0 + bj * HALF) >> 1; ba[bj] = addb ? *(const f32x4*)(bias + ch) : (f32x4){0.f, 0.f, 0.f, 0.f}; bg[bj] = addb ? *(const f32x4*)(bias + DM + ch) : (f32x4){0.f, 0.f, 0.f, 0.f}; }
        if (u.kind >= 16) {
            bf16_t* base = part + ((size_t)(u.kind - 16) * NCTX + (size_t)(u.pm - NLAT / BM) * BM + wr * 64 + fr) * (2 * DM) + col0;
#pragma unroll
            for (int ai = 0; ai < 2; ++ai)
#pragma unroll
                for (int m = 0; m < 4; ++m) { bf16_t* rowp = base + (size_t)(ai * HALF + m * 16) * (2 * DM);
#pragma unroll
                    for (int bj = 0; bj < 2; ++bj) { const f32x4 v0 = acc[ai][bj][m][0] + ba[bj], v1 = acc[ai][bj][m][1] + bg[bj];
                        u32x4 w; w.x = cvt_pk_bf16(v0[0], v0[1]); w.y = cvt_pk_bf16(v0[2], v0[3]); w.z = cvt_pk_bf16(v1[0], v1[1]); w.w = cvt_pk_bf16(v1[2], v1[3]);
                        *(u32x4*)(rowp + bj * HALF) = w; } }
        } else {
            const int row0 = u.pm * BM + wr * 64 + fr;
#pragma unroll
            for (int ai = 0; ai < 2; ++ai)
#pragma unroll
                for (int bj = 0; bj < 2; ++bj) { const int ch0 = (col0 + bj * HALF) >> 1;
                    u32x2 pk[4];
#pragma unroll
                    for (int m = 0; m < 4; ++m) { const f32x4 a = acc[ai][bj][m][0] + ba[bj], g = acc[ai][bj][m][1] + bg[bj]; float o[4];
#pragma unroll
                        for (int e = 0; e < 4; ++e) o[e] = a[e] * sigmoidf_(g[e]);
                        pk[m].x = cvt_pk_c(o[0], o[1]); pk[m].y = cvt_pk_c(o[2], o[3]); }
#pragma unroll
                    for (int m2 = 0; m2 < 4; m2 += 2) {
                        const auto rx = __builtin_amdgcn_permlane16_swap(pk[m2].x, pk[m2 + 1].x, false, false);
                        const auto ry = __builtin_amdgcn_permlane16_swap(pk[m2].y, pk[m2 + 1].y, false, false);
                        const int r = row0 + ai * HALF + (m2 + (fq & 1)) * 16;
                        *(u32x4*)(O + (size_t)r * DM + ch0 - 4 * (fq & 1)) = (u32x4){rx[0], ry[0], rx[1], ry[1]}; } }
        }
    }
};
struct OrderSplit {
    int nN, G, c, nt_full, nmain, nchunk, split, ktype, amode, wgm, rev; const char* A; const char* Bt; size_t ta, tb;
    __device__ size_t aoff(int pm, int k0) const { if (!amode) return (size_t)pm * ta + (size_t)k0 * BK * 2; const int cr0 = pm < 64 ? ((pm >> 5) * 512 + (pm & 31) * 16) : (1024 + (pm - 64) * 16); return (size_t)cr0 * 512 + (size_t)k0 * (4 * 1280 * 256 * 2); }
    __device__ void init(const void* A_, const void* Bt_, int N, int K, int lda, int ldb, int split_, int G_, int c_, int amode_ = 0, int wgm_ = WGM, int rev_ = 0) { amode = amode_; wgm = wgm_; rev = rev_; nN = N / BM; G = G_; c = c_; nt_full = K / BK; nmain = (NLAT / BM) * nN; ktype = (K == 2048) ? 0 : 1; nchunk = ktype ? 15 : 8; split = split_;
        A = (const char*)A_; Bt = (const char*)Bt_; ta = (size_t)BM * lda * 2; tb = (size_t)BM * ldb * 2; }
    __device__ bool next(int i, Unit& u) const {
        const long L = (long)i * G + c;
        if (L < nmain) { tile_map((int)L, NLAT / BM, nN, u.pm, u.pn, wgm); if (rev) u.pm = NLAT / BM - 1 - u.pm; u.kind = 0; u.nt = nt_full; u.a = A + aoff(u.pm, 0); u.b = Bt + (size_t)u.pn * tb; return true; }
        if (!split) return false;
        const int s = (int)(L - nmain); if (s >= 2 * nN * nchunk) return false;
        const int tile = s / nchunk, chunk = s - tile * nchunk; const int pmc = tile / nN; u.pn = tile - pmc * nN; u.pm = NLAT / BM + pmc; u.kind = 16 + chunk;
        int k0, ntc; if (ktype == 0) { k0 = chunk * 4; ntc = 4; } else if (chunk < 13) { k0 = chunk * 6; ntc = 6; } else { k0 = 78 + (chunk - 13) * 4; ntc = 4; }
        u.nt = ntc; u.a = A + aoff(u.pm, k0); u.b = Bt + (size_t)u.pn * tb + (size_t)k0 * BK * 2; return true;
    }
};
#define DPP0(src, ctrl) __builtin_bit_cast(float, __builtin_amdgcn_update_dpp(0, __builtin_bit_cast(int, (float)(src)), (ctrl), 0xf, 0xf, true))
__device__ __forceinline__ void up_panel(int pm, int& seq0, int& seqlen, int& g0) {
    int p; if (pm < 66) { const int b = pm / 33; p = pm - 33 * b; seq0 = b * SEQ; seqlen = SEQ; } else { const int c = pm - 66; p = c & 1; seq0 = NLAT + (c >> 1) * CTXL; seqlen = CTXL; }
    g0 = seq0 + 254 * p - 1;
}
template <int REP_ = 1> struct EpiUpGlu {
    static constexpr bool PERM = true; static constexpr int REP = REP_;
    bf16_t* A5; const float* cw; const float* cb; PG8_LAS float* halo;
    __device__ __forceinline__ void operator()(f32x4 (&acc)[2][2][4][2], const Unit& u, int wr, int wc, int fr, int fq) const {
        int seq0, seqlen, g0; up_panel(u.pm, seq0, seqlen, g0);
        const int send = seq0 + seqlen;
        const int cl = wc * 32 + 8 * fq;
        if (g0 < seq0 || g0 + BM > send) {
#pragma unroll
            for (int ai = 0; ai < 2; ++ai)
#pragma unroll
                for (int m = 0; m < 4; ++m) { const int g = g0 + ai * HALF + wr * 64 + m * 16 + fr; const bool in = g >= seq0 && g < send;
#pragma unroll
                    for (int bj = 0; bj < 2; ++bj)
#pragma unroll
                        for (int n = 0; n < 2; ++n)
#pragma unroll
                            for (int e = 0; e < 4; ++e) acc[ai][bj][m][n][e] = in ? acc[ai][bj][m][n][e] : 0.f; } }
#pragma unroll
        for (int ai = 0; ai < 2; ++ai)
#pragma unroll
            for (int bj = 0; bj < 2; ++bj)
#pragma unroll
                for (int n = 0; n < 2; ++n) {
                    if (fr == 0) *(PG8_LAS f32x4*)(halo + (2 * ai + wr) * 512 + bj * 128 + cl + 4 * n) = acc[ai][bj][0][n];
                    if (fr == 15) *(PG8_LAS f32x4*)(halo + (2 * ai + wr) * 512 + 256 + bj * 128 + cl + 4 * n) = acc[ai][bj][3][n]; }
        asm volatile("s_waitcnt lgkmcnt(0)" ::: "memory"); __builtin_amdgcn_s_barrier(); asm volatile("" ::: "memory");
#pragma unroll
        for (int bj = 0; bj < 2; ++bj) {
            const int ch0 = 128 * u.pn + 64 * bj + 16 * wc + 4 * fq;
            f32x4 wg[3], wv[3];
#pragma unroll
            for (int k = 0; k < 3; ++k) { wg[k] = *(const f32x4*)(cw + (size_t)k * DFF2 + ch0); wv[k] = *(const f32x4*)(cw + (size_t)k * DFF2 + DFF + ch0); }
            const f32x4 bg = *(const f32x4*)(cb + ch0), bv = *(const f32x4*)(cb + DFF + ch0);
#pragma unroll
            for (int ai = 0; ai < 2; ++ai) { const int blk = 2 * ai + wr;
                f32x4 hag = (f32x4){0.f, 0.f, 0.f, 0.f}, hav = hag, hbg = hag, hbv = hag;
                if (blk > 0) { hag = *(const PG8_LAS f32x4*)(halo + (blk - 1) * 512 + 256 + bj * 128 + cl); hav = *(const PG8_LAS f32x4*)(halo + (blk - 1) * 512 + 256 + bj * 128 + cl + 4); }
                if (blk < 3) { hbg = *(const PG8_LAS f32x4*)(halo + (blk + 1) * 512 + bj * 128 + cl); hbv = *(const PG8_LAS f32x4*)(halo + (blk + 1) * 512 + bj * 128 + cl + 4); }
                u32x2 pk[4];
#pragma unroll
                for (int m = 0; m < 4; ++m) {
                    const f32x4 cg = acc[ai][bj][m][0], cv = acc[ai][bj][m][1];
                    const f32x4 pbg = m > 0 ? acc[ai][bj][m > 0 ? m - 1 : 0][0] : hag, pbv = m > 0 ? acc[ai][bj][m > 0 ? m - 1 : 0][1] : hav;
                    const f32x4 nbg = m < 3 ? acc[ai][bj][m < 3 ? m + 1 : 3][0] : hbg, nbv = m < 3 ? acc[ai][bj][m < 3 ? m + 1 : 3][1] : hbv;
                    float o[4];
#pragma unroll
                    for (int ep = 0; ep < 2; ++ep) { const int e0 = 2 * ep, e1 = 2 * ep + 1;
                        const f32x2 w0g = {wg[0][e0], wg[0][e1]}, w1g = {wg[1][e0], wg[1][e1]}, w2g = {wg[2][e0], wg[2][e1]};
                        const f32x2 w0v = {wv[0][e0], wv[0][e1]}, w1v = {wv[1][e0], wv[1][e1]}, w2v = {wv[2][e0], wv[2][e1]};
                        f32x2 gate = (f32x2){bg[e0], bg[e1]} + (f32x2){cg[e0], cg[e1]} * w1g;
                        gate += (f32x2){DPP0(cg[e0], 0x111), DPP0(cg[e1], 0x111)} * w0g; gate += (f32x2){DPP0(pbg[e0], 0x10f), DPP0(pbg[e1], 0x10f)} * w0g;
                        gate += (f32x2){DPP0(cg[e0], 0x101), DPP0(cg[e1], 0x101)} * w2g; gate += (f32x2){DPP0(nbg[e0], 0x11f), DPP0(nbg[e1], 0x11f)} * w2g;
                        f32x2 val = (f32x2){bv[e0], bv[e1]} + (f32x2){cv[e0], cv[e1]} * w1v;
                        val += (f32x2){DPP0(cv[e0], 0x111), DPP0(cv[e1], 0x111)} * w0v; val += (f32x2){DPP0(pbv[e0], 0x10f), DPP0(pbv[e1], 0x10f)} * w0v;
                        val += (f32x2){DPP0(cv[e0], 0x101), DPP0(cv[e1], 0x101)} * w2v; val += (f32x2){DPP0(nbv[e0], 0x11f), DPP0(nbv[e1], 0x11f)} * w2v;
                        const f32x2 ex = gate * (-LOG2E);
                        const f32x2 den = (f32x2){__builtin_amdgcn_exp2f(ex[0]), __builtin_amdgcn_exp2f(ex[1])} + 1.0f;
                        const f32x2 sg = {__builtin_amdgcn_rcpf(den[0]), __builtin_amdgcn_rcpf(den[1])};
                        const f32x2 ov = gate * sg * val; o[e0] = ov[0]; o[e1] = ov[1]; }
                    pk[m].x = cvt_pk_c(o[0], o[1]); pk[m].y = cvt_pk_c(o[2], o[3]);
                }
#pragma unroll
                for (int m2 = 0; m2 < 4; m2 += 2) {
                    const auto rx = __builtin_amdgcn_permlane16_swap(pk[m2].x, pk[m2 + 1].x, false, false);
                    const auto ry = __builtin_amdgcn_permlane16_swap(pk[m2].y, pk[m2 + 1].y, false, false);
                    const int r = ai * HALF + wr * 64 + (m2 + (fq & 1)) * 16 + fr, g = g0 + r;
                    if (r >= 1 && r <= 254 && g >= seq0 && g < send) *(u32x4*)(A5 + (size_t)g * DFF + ch0 - 4 * (fq & 1)) = (u32x4){rx[0], ry[0], rx[1], ry[1]};
                }
            }
        }
    }
};
struct OrderUp {
    int G, c, nP; const char* HM; const char* W; int wgm;
    __device__ bool next(int i, Unit& u) const {
        const long L = (long)i * G + c; if (L >= (long)nP * 43) return false;
        tile_map((int)L, nP, 43, u.pm, u.pn, wgm); u.kind = 0; u.nt = DM / BK;
        int seq0, seqlen, g0; up_panel(u.pm, seq0, seqlen, g0);
        u.a = HM + (long)g0 * (DM * 2); u.b = W + (size_t)u.pn * BM * DM * 2; return true;
    }
};
template <int REP_ = 1> struct EpiQKVZ {
    static constexpr bool PERM = true; static constexpr int REP = REP_;
    bf16_t* QKV; bf16_t* ZBT; const float* tab;
    __device__ __forceinline__ void operator()(const f32x4 (&acc)[2][2][4][2], const Unit& u, int wr, int wc, int fr, int fq) const {
        const int row0 = u.pm * BM + wr * 64 + fr, col0 = u.pn * BM + wc * 32 + 8 * fq;
        if (u.kind == 1) {
#pragma unroll
            for (int ai = 0; ai < 2; ++ai)
#pragma unroll
                for (int m = 0; m < 4; ++m) { bf16_t* rowp = ZBT + (size_t)(row0 + ai * HALF + m * 16) * MROWS + col0;
#pragma unroll
                    for (int bj = 0; bj < 2; ++bj) { const f32x4 v0 = acc[ai][bj][m][0], v1 = acc[ai][bj][m][1];
                        u32x4 w; w.x = cvt_pk_bf16(v0[0], v0[1]); w.y = cvt_pk_bf16(v0[2], v0[3]); w.z = cvt_pk_bf16(v1[0], v1[1]); w.w = cvt_pk_bf16(v1[2], v1[3]);
                        *(u32x4*)(rowp + bj * HALF) = w; } }
        } else {
            const bool rope = (u.pn < 5) && (u.pm < 64);
            const float sc = (u.pn < 4) ? QSCALE : 1.0f;
            const int gi = 4 * wc + fq, f0 = 4 * (gi & 7); const bool rowang = gi < 8;
#pragma unroll
            for (int ai = 0; ai < 2; ++ai)
#pragma unroll
                for (int m = 0; m < 4; ++m) { const int r = row0 + ai * HALF + m * 16;
                    f32x4 cs0 = (f32x4){1.f, 0.f, 1.f, 0.f}, cs1 = cs0;
                    if (rope) { const int tok = r & (SEQ - 1); const int pos = rowang ? (tok >> 6) : (tok & 63); const f32x4* tp = (const f32x4*)(tab + (size_t)(pos * 32 + f0) * 2); cs0 = tp[0]; cs1 = tp[1]; }
                    const f32x4 cv = (f32x4){cs0[0], cs0[2], cs1[0], cs1[2]}, sv = (f32x4){cs0[1], cs0[3], cs1[1], cs1[3]};
                    bf16_t* rowp = QKV + (size_t)r * QKVC + col0;
#pragma unroll
                    for (int bj = 0; bj < 2; ++bj) { const f32x4 a0 = acc[ai][bj][m][0], a1 = acc[ai][bj][m][1];
                        const f32x4 v0 = (a0 * cv - a1 * sv) * sc, v1 = (a1 * cv + a0 * sv) * sc;
                        u32x4 w; w.x = cvt_pk_bf16(v0[0], v0[1]); w.y = cvt_pk_bf16(v0[2], v0[3]); w.z = cvt_pk_bf16(v1[0], v1[1]); w.w = cvt_pk_bf16(v1[2], v1[3]);
                        *(u32x4*)(rowp + bj * HALF) = w; } }
        }
    }
};
struct EpiS5G {
    static constexpr bool PERM = true; static constexpr int REP = 1;
    bf16_t* O;
    __device__ __forceinline__ void operator()(const f32x4 (&acc)[2][2][4][2], const Unit& u, int wr, int wc, int fr, int fq) const {
        const int row0 = u.pm * BM + wr * 64 + fr, col0 = wc * 32 + 8 * fq;
#pragma unroll
        for (int ai = 0; ai < 2; ++ai)
#pragma unroll
            for (int m = 0; m < 4; ++m) { bf16_t* rowp = O + (size_t)(row0 + ai * HALF + m * 16) * 256 + col0;
#pragma unroll
                for (int bj = 0; bj < 2; ++bj) { const f32x4 a0 = acc[ai][bj][m][0], a1 = acc[ai][bj][m][1];
                    u32x4 w; w.x = cvt_pk_bf16(gelu_tanh(a0[0]), gelu_tanh(a0[1])); w.y = cvt_pk_bf16(gelu_tanh(a0[2]), gelu_tanh(a0[3]));
                    w.z = cvt_pk_bf16(gelu_tanh(a1[0]), gelu_tanh(a1[1])); w.w = cvt_pk_bf16(gelu_tanh(a1[2]), gelu_tanh(a1[3]));
                    *(u32x4*)(rowp + bj * HALF) = w; } }
    }
};
struct OrderE1 {
    int G, c; const char* HM; const char* Win;
    __device__ bool next(int i, Unit& u) const {
        const long L = (long)i * G + c; if (L >= 1188) return false;
        if (L < 792) { tile_map((int)L, 12, 66, u.pm, u.pn, WGM_E1); u.kind = 1; u.nt = DM / BK; u.a = Win + (size_t)(QKVC + u.pm * BM) * DM * 2; u.b = HM + (size_t)u.pn * BM * DM * 2; }
        else { tile_map((int)L - 792, 66, 6, u.pm, u.pn, WGM_E1); u.kind = 0; u.nt = DM / BK; u.a = HM + (size_t)u.pm * BM * DM * 2; u.b = Win + (size_t)u.pn * BM * DM * 2; }
        return true;
    }
};
struct OrderS5 {
    int G, c, nt; const char* UA; const char* Bm; size_t bstride; int swapped;
    __device__ bool next(int i, Unit& u) const {
        const long L0 = (long)i * G + c; if (L0 >= S5G * 4) return false;
        const int L = (int)(L0 % NXCD) * (S5G * 4 / NXCD) + (int)(L0 / NXCD);
        const int g = L >> 2, pml = L & 3;
        u.kind = 0; u.nt = nt; const char* ua = UA + ((size_t)g * S5ROWS + (size_t)pml * BM) * S5K * 2; const char* bm = Bm + (size_t)g * bstride;
        if (swapped) { u.pm = g; u.pn = pml; u.a = bm; u.b = ua; } else { u.pm = 5 * g + pml; u.pn = 0; u.a = ua; u.b = bm; }
        return true;
    }
};
}
#define XB_TMO      128
#define XB_XCNT(j)  (256  + 64 * (j))
#define XB_XSUB(j)  (1280 + 64 * (j))
#define XB_XGEN(j)  (2304 + 64 * (j))
#define XB_TOP      3328
#define XB_TOPGEN   3392
#define XCD_BAR_WORDS 3456
#define XB_SPIN_CAP (1u << 22)

__device__ __forceinline__ unsigned xb_ld(unsigned* p)              { return __hip_atomic_load(p, __ATOMIC_RELAXED, __HIP_MEMORY_SCOPE_AGENT); }
__device__ __forceinline__ unsigned xb_add(unsigned* p, unsigned v) { return __hip_atomic_fetch_add(p, v, __ATOMIC_RELAXED, __HIP_MEMORY_SCOPE_AGENT); }
__device__ __forceinline__ unsigned xb_xcc_id() { return (unsigned)__builtin_amdgcn_s_getreg((3 << 11) | 20) & 0xFu; }
#define XB_SPIN(cond, bar) do { unsigned _sp = 0; while (cond) { __builtin_amdgcn_s_sleep(1); \
    if ((++_sp & 255u) == 0u) { if (xb_ld(&(bar)[XB_TMO])) break; if (_sp > XB_SPIN_CAP) { atomicAdd(&(bar)[XB_TMO], 1u); break; } } } } while (0)

struct XcdBarrier {
    unsigned* bar; unsigned x;
    volatile LAS unsigned* st;
};

__device__ __forceinline__ XcdBarrier xcd_barrier_post(unsigned* bar, volatile LAS unsigned* st) {
    XcdBarrier b; b.bar = bar; b.x = xb_xcc_id(); b.st = st;
    if (threadIdx.x == 0) (void)xb_add(&bar[XB_XCNT(b.x)], 1u);
    return b;
}
__device__ __forceinline__ void xcd_barrier_complete(unsigned* bar, unsigned x, unsigned& nloc, unsigned& nx) {
    const unsigned G = gridDim.x * gridDim.y * gridDim.z;
    unsigned sum, cnt, mine, sp = 0u;
    for (;;) {
        sum = 0u; cnt = 0u; mine = 0u;
#pragma unroll
        for (unsigned j = 0; j < 16; ++j) { const unsigned c = xb_ld(&bar[XB_XCNT(j)]); sum += c; cnt += (c > 0u) ? 1u : 0u; mine = (j == x) ? c : mine; }
        if (sum == G) break;
        __builtin_amdgcn_s_sleep(1);
        if ((++sp & 255u) == 0u) { if (xb_ld(&bar[XB_TMO])) break; if (sp > XB_SPIN_CAP) { atomicAdd(&bar[XB_TMO], 1u); break; } }
    }
    nloc = mine > 0u ? mine : 1u; nx = cnt > 0u ? cnt : 1u;
}

__device__ __forceinline__ void xcd_barrier(const XcdBarrier& b) {
    asm volatile("s_waitcnt vmcnt(0)" ::: "memory");
    __syncthreads();
    if (threadIdx.x == 0) {
        unsigned* bar = b.bar;
        __builtin_amdgcn_s_waitcnt(0);
        unsigned nloc = b.st[0], nx = b.st[1];
        if (nloc == 0u) { xcd_barrier_complete(bar, b.x, nloc, nx); b.st[0] = nloc; b.st[1] = nx; }
        const unsigned old = xb_add(&bar[XB_XSUB(b.x)], 1u);
        const unsigned gen = old / nloc;
        if (old + 1u == (gen + 1u) * nloc) {
            __builtin_amdgcn_fence(__ATOMIC_RELEASE, "agent");
            asm volatile("s_waitcnt vmcnt(0)" ::: "memory");
            const unsigned og = xb_add(&bar[XB_TOP], 1u);
            const unsigned tg = og / nx;
            if (og + 1u == (tg + 1u) * nx) xb_add(&bar[XB_TOPGEN], 1u);
            else XB_SPIN(xb_ld(&bar[XB_TOPGEN]) == tg, bar);
            __builtin_amdgcn_fence(__ATOMIC_ACQUIRE, "agent");
            xb_add(&bar[XB_XGEN(b.x)], 1u);
            asm volatile("s_waitcnt vmcnt(0)" ::: "memory");
        } else {
            XB_SPIN(xb_ld(&bar[XB_XGEN(b.x)]) == gen, bar);
            __builtin_amdgcn_fence(__ATOMIC_ACQUIRE, "agent");
            asm volatile("s_waitcnt vmcnt(0)" ::: "memory");
        }
    }
    __syncthreads();
}

#ifndef DUP_SUB
#define DUP_SUB 0
#endif
typedef __bf16 bf16x2w_ __attribute__((ext_vector_type(2)));
DI unsigned cvtpk_c2(float lo, float hi) { const f32x2 v = {lo, hi}; const bf16x2w_ b = __builtin_convertvector(v, bf16x2w_); return __builtin_bit_cast(unsigned, b); }
constexpr size_t MiB = 1u << 20;
constexpr size_t WS_CTL = 0, CTL_BYTES = 1 * MiB;
constexpr size_t WS_MOD = 1 * MiB;
constexpr size_t WS_MODP = 2 * MiB;
constexpr size_t WS_TAB = 7 * MiB;
constexpr size_t WS_HID = 8 * MiB;
constexpr size_t WS_LAML = 13 * MiB;
constexpr size_t WS_XC = 14 * MiB;
constexpr size_t WS_FILTC = 18 * MiB;
constexpr size_t WS_FILT = 22 * MiB;
constexpr size_t WS_TT = 150 * MiB;
constexpr size_t WS_WW = 214 * MiB;
constexpr size_t WS_WUP = 246 * MiB;
constexpr size_t WS_WDOWN = 418 * MiB;
constexpr size_t WS_WIN = 504 * MiB;
constexpr size_t WS_WOUT = 540 * MiB;
constexpr size_t WS_WGLU = 556 * MiB;
constexpr size_t WS_HM = 588 * MiB;
constexpr size_t WS_YAB = 654 * MiB;
constexpr size_t WS_Y = 720 * MiB;
constexpr size_t WS_A5 = 852 * MiB;
constexpr size_t WS_U = 1030 * MiB;
constexpr size_t WS_PART = 1385 * MiB;
constexpr size_t WS_XB = 1453 * MiB;
constexpr size_t WS_END = 1519 * MiB;
constexpr size_t SZ_WUP = (size_t)DFF2 * DM * 2, SZ_WDOWN = (size_t)DM * DFF * 2, SZ_WIN = (size_t)INCOLS * DM * 2, SZ_WOUT = (size_t)DM * DM * 2, SZ_WGLU = (size_t)2 * DM * DM * 2;
constexpr int CW_BAR = 4096;

constexpr int RING_BYTES = 131072, AUX_OFF = 131072, AUX_BYTES = 16384, LDSCTL_OFF = AUX_OFF + AUX_BYTES, LDS_BYTES = LDSCTL_OFF + 512;
constexpr int NWAVES = 8, NTHR = 512;

struct Params { const float* in[33]; float* out; unsigned char* ws; int lo, hi, pad0, pad1; };
struct Frame { LAS unsigned char* lds; int tid, lane, wave, G, bid; };

DI void sincos_rr(float x, float& sn, float& cs) {
    double r = (double)x * 0.15915494309189535; r = r - floor(r); const float rf = (float)r; sn = __builtin_amdgcn_sinf(rf); cs = __builtin_amdgcn_cosf(rf); }
DI float wave_sum(float v) {
#pragma unroll
    for (int o = 1; o < 64; o <<= 1) v += __shfl_xor(v, o);
    return v;
}
DI float block_sum(const Frame& F, float v, LAS float* red) {
    v = wave_sum(v);
    __syncthreads();
    if (F.lane == 0) red[F.wave] = v;
    __syncthreads();
    float t = 0.f;
#pragma unroll
    for (int i = 0; i < NWAVES; ++i) t += red[i];
    return t;
}

DI void transpose_item1(const Frame& F, const float* W, int K, int N, bf16* WT, int item, int mode) {
    const int nb = N >> 7; const int kb = item / nb, nbk = item - kb * nb; const int k0 = kb * 64, n0 = nbk * 128;
    LAS unsigned short* tile = (LAS unsigned short*)F.lds;
    const int tn = (F.tid & 31) * 4, tk = (F.tid >> 5) * 4;
    const int nd = n0 + tn; int ns = nd;
    if (mode == 2) { const int tile = nd >> 8, pp = nd & 255; ns = ((pp >> 2) & 1) * DFF + 128 * tile + 4 * (pp >> 3); }
    if (mode == 3) ns = ((nd >> 2) & 1) * DM + 4 * (nd >> 3);
    if (mode == 1 && nd < 1280) { const int d = nd & 127, gi = d >> 3, n = (d >> 2) & 1; ns = (nd & ~127) + ((gi < 8) ? 0 : 64) + 32 * n + 4 * (gi & 7); }
    f32x4 v[4];
#pragma unroll
    for (int i = 0; i < 4; ++i) v[i] = *(const f32x4*)(W + (size_t)(k0 + tk + i) * N + ns);
#pragma unroll
    for (int e = 0; e < 4; ++e) { u32x2 w; w.x = pk2(v[0][e], v[1][e]); w.y = pk2(v[2][e], v[3][e]); *(LAS u32x2*)(tile + (tn + e) * 72 + tk) = w; }
    __syncthreads();
#pragma unroll
    for (int i = 0; i < 2; ++i) { const int p = F.tid + 512 * i, n = p >> 3, kc = p & 7;
        const u32x4 w = *(const LAS u32x4*)(tile + n * 72 + kc * 8);
        *(u32x4*)(WT + (size_t)(n0 + n) * K + k0 + kc * 8) = w; }
    __syncthreads();
}
DI void transpose_item(const Frame& F, const float* W, int K, int N, bf16* WT, int item, int mode) { transpose_item1(F, W, K, N, WT, item, mode); if (DUP_SUB == 9) transpose_item1(F, W, K, N, WT, item, mode); }
DI void modp_unit(const Frame& F, const Params& P, int u) {
    const int cb = u % 24, lk = u / 24, kc = lk & 7, l = lk >> 3;
    LAS float* sv = (LAS float*)F.lds;
    for (int i = F.tid; i < 768; i += NTHR) { const int r = i >> 8, k = i & 255, kk = kc * 256 + k; const float v = (r < 2) ? P.in[1][r * DM + kk] : P.in[3][kk]; sv[i] = v / (1.0f + expf(-v)); }
    __syncthreads();
    const int j = cb * 512 + F.tid; const float* w = P.in[4] + ((size_t)l * DM + kc * 256) * (NMOD * DM) + j;
    float a0 = 0.f, a1 = 0.f, a2 = 0.f;
#pragma unroll 1
    for (int k0 = 0; k0 < 256; k0 += 32) { float wv[32];
#pragma unroll
        for (int k = 0; k < 32; ++k) wv[k] = __builtin_nontemporal_load(w + (size_t)(k0 + k) * (NMOD * DM));
#pragma unroll
        for (int k = 0; k < 32; ++k) { a0 += sv[k0 + k] * wv[k]; a1 += sv[256 + k0 + k] * wv[k]; a2 += sv[512 + k0 + k] * wv[k]; } }
    float* mp = (float*)(P.ws + WS_MODP) + (size_t)(l * 8 + kc) * 3 * (NMOD * DM) + j;
    mp[0] = a0; mp[NMOD * DM] = a1; mp[2 * NMOD * DM] = a2;
    __syncthreads();
}
DI void hid_unit(const Frame& F, const Params& P, int u) {
    int l, n, tb; float* dst;
    if (u < 256) { l = u >> 7; n = SEQ; tb = u & 127; dst = (float*)(P.ws + WS_HID) + (size_t)l * SEQ * 64; }
    else { const int v = u - 256; l = v >> 2; n = CTXL; tb = v & 3; dst = (float*)(P.ws + WS_HID + 4 * MiB) + (size_t)l * CTXL * 64; }
    LAS float* zs = (LAS float*)F.lds; LAS float* h1 = zs + 64 * 33;
    const int pos0 = tb * 64;
    const float wstep = 6.283185307179586f / (float)n;
    for (int i = F.tid; i < 64 * 33; i += NTHR) { const int pos = i / 33, k = i - pos * 33; const int ti = pos0 + pos; float val;
        if (k == 0) val = (float)ti / (float)(n - 1);
        else { const int kb = (k - 1) & 15; const float band = 1e-4f + (float)kb * ((15.0f - 1e-4f) / 15.0f); const float ang = (wstep * (float)ti) * band; float sn, cs; sincos_rr(ang, sn, cs); val = (k <= 16) ? cs : -sn; }
        zs[i] = val; }
    __syncthreads();
    const int pos = F.tid >> 3, h0 = (F.tid & 7) * 8;
    const float* w1 = P.in[16] + (size_t)l * 33 * 64; const float* b1 = P.in[17] + l * 64; const float* w2 = P.in[18] + (size_t)l * 64 * 64; const float* b2 = P.in[19] + l * 64; const float* fr = P.in[21] + l * 64;
    float acc[8];
#pragma unroll
    for (int e = 0; e < 8; ++e) acc[e] = b1[h0 + e];
#pragma unroll 1
    for (int k = 0; k < 33; ++k) { const float zv = zs[pos * 33 + k];
#pragma unroll
        for (int e = 0; e < 8; ++e) acc[e] += zv * w1[k * 64 + h0 + e]; }
#pragma unroll
    for (int e = 0; e < 8; ++e) { float sn, cs; sincos_rr(fr[h0 + e] * acc[e], sn, cs); h1[pos * 65 + h0 + e] = sn; }
    __syncthreads();
#pragma unroll
    for (int e = 0; e < 8; ++e) acc[e] = b2[h0 + e];
#pragma unroll 1
    for (int k = 0; k < 64; ++k) { const float hv = h1[pos * 65 + k];
#pragma unroll
        for (int e = 0; e < 8; ++e) acc[e] += hv * w2[k * 64 + h0 + e]; }
#pragma unroll
    for (int e = 0; e < 8; ++e) { float sn, cs; sincos_rr(fr[h0 + e] * acc[e], sn, cs); dst[(size_t)(pos0 + pos) * 64 + h0 + e] = sn; }
    __syncthreads();
}
DI void tab_unit(const Frame& F, const Params& P) {
    float* tab = (float*)(P.ws + WS_TAB);
    for (int i = F.tid; i < 4096; i += NTHR) { const int pos = i >> 5, f = i & 31; const float inv = exp2f(-(float)(2 * f) * (13.287712379549449f / 64.0f)); const float ang = (float)pos * inv; float sn, cs; sincos_rr(ang, sn, cs); tab[2 * i] = cs; tab[2 * i + 1] = sn; }
}
DI void s5_unit(const Frame& F, const Params& P, int u) {
    const int jo = u >> 7, g = u & 127;
    LAS float* pw = (LAS float*)F.lds;
    LAS float* bb = pw + 2 * 64 * 17 * 2;
    LAS float* cc = bb + 2 * 64 * 16 * 2;
    LAS float* Kt = cc + 2 * 16 * 64 * 2;
    if (F.tid < 128) { const int dir = F.tid >> 6, p = F.tid & 63; const int gi = ((jo * 2 + dir) * S5G + g);
        const float lr = P.in[23][(size_t)gi * 64 + p], li = P.in[24][(size_t)gi * 64 + p]; const float st = expf(P.in[25][gi]);
        float pr1 = 1.f, pi1 = 0.f;
        for (int d = 0; d <= 16; ++d) { const float a = lr * st * (float)d, b = li * st * (float)d; const float mag = expf(a); float sn, cs; sincos_rr(b, sn, cs);
            pw[((dir * 64 + p) * 17 + d) * 2] = mag * cs; pw[((dir * 64 + p) * 17 + d) * 2 + 1] = mag * sn; if (d == 1) { pr1 = mag * cs; pi1 = mag * sn; } }
        float* lamL = (float*)(P.ws + WS_LAML) + ((size_t)gi * 64 + p) * 2; lamL[0] = pw[((dir * 64 + p) * 17 + 16) * 2]; lamL[1] = pw[((dir * 64 + p) * 17 + 16) * 2 + 1];
        const float den = 1.0f / (lr * lr + li * li); const float nr = pr1 - 1.0f, ni = pi1; const float qr = (nr * lr + ni * li) * den, qi = (ni * lr - nr * li) * den;
        for (int j = 0; j < 16; ++j) { const float br = P.in[26][((size_t)gi * 64 + p) * 16 + j], bi = P.in[27][((size_t)gi * 64 + p) * 16 + j];
            bb[((dir * 64 + p) * 16 + j) * 2] = qr * br - qi * bi; bb[((dir * 64 + p) * 16 + j) * 2 + 1] = qr * bi + qi * br; } }
    for (int i = F.tid; i < 2048; i += NTHR) { const int dir = i >> 10, j = (i >> 6) & 15, p = i & 63; const size_t si = (((size_t)(jo * 2 + dir) * S5G + g) * 16 + j) * 64 + p;
        cc[i * 2] = P.in[28][si]; cc[i * 2 + 1] = P.in[29][si]; }
    __syncthreads();
    { const int dir = F.tid >> 8, d = (F.tid >> 4) & 15, j = F.tid & 15; float s16[16];
#pragma unroll
        for (int jp = 0; jp < 16; ++jp) s16[jp] = 0.f;
#pragma unroll 2
        for (int p = 0; p < 64; ++p) { const float cr = cc[((dir * 16 + j) * 64 + p) * 2], ci = cc[((dir * 16 + j) * 64 + p) * 2 + 1];
            const float wr_ = pw[((dir * 64 + p) * 17 + d) * 2], wi_ = pw[((dir * 64 + p) * 17 + d) * 2 + 1];
            const float xr = cr * wr_ - ci * wi_, xi = cr * wi_ + ci * wr_;
#pragma unroll
            for (int jp = 0; jp < 16; ++jp) s16[jp] += xr * bb[((dir * 64 + p) * 16 + jp) * 2] - xi * bb[((dir * 64 + p) * 16 + jp) * 2 + 1]; }
#pragma unroll
        for (int jp = 0; jp < 16; ++jp) Kt[((dir * 16 + d) * 16 + j) * 16 + jp] = s16[jp]; }
    __syncthreads();
    bf16* TT = (bf16*)(P.ws + WS_TT) + ((size_t)(jo * S5G + g) * 256) * 512;
    const float* dv = P.in[30] + (size_t)jo * DM + g * 16;
    for (int q = F.tid; q < 256 * 64; q += NTHR) { const int row = q >> 6, k0 = (q & 63) * 8; const int t = row >> 4, j = row & 15; float v[8];
        if (k0 < 256) { const int s = k0 >> 4, jp0 = k0 & 15;
#pragma unroll
            for (int e = 0; e < 8; ++e) { float x = 0.f; if (s <= t) x += Kt[((0 * 16 + (t - s)) * 16 + j) * 16 + jp0 + e]; if (s >= t) x += Kt[((1 * 16 + (s - t)) * 16 + j) * 16 + jp0 + e];
                if (s == t && j == jp0 + e) x += dv[j]; v[e] = x; } }
        else { const int region = (k0 - 256) >> 6, p0 = (k0 - 256) & 63, dir = region >> 1, pwr = dir == 0 ? t + 1 : 16 - t;
#pragma unroll
            for (int e = 0; e < 8; ++e) { const int p = p0 + e; const float cr = cc[((dir * 16 + j) * 64 + p) * 2], ci = cc[((dir * 16 + j) * 64 + p) * 2 + 1];
                const float wr_ = pw[((dir * 64 + p) * 17 + pwr) * 2], wi_ = pw[((dir * 64 + p) * 17 + pwr) * 2 + 1];
                v[e] = (region & 1) ? -(cr * wi_ + ci * wr_) : (cr * wr_ - ci * wi_); } }
        u32x4 w; w.x = pk2(v[0], v[1]); w.y = pk2(v[2], v[3]); w.z = pk2(v[4], v[5]); w.w = pk2(v[6], v[7]);
        *(u32x4*)(TT + (size_t)row * 512 + k0) = w; }
    bf16* WW = (bf16*)(P.ws + WS_WW) + ((size_t)(jo * S5G + g) * 256) * 256;
    for (int q = F.tid; q < 256 * 32; q += NTHR) { const int row = q >> 5, k0 = (q & 31) * 8; const int s = k0 >> 4, jp0 = k0 & 15; const int region = row >> 6, p = row & 63, dir = region >> 1, pwr = dir == 0 ? 15 - s : s; float v[8];
        const float wr_ = pw[((dir * 64 + p) * 17 + pwr) * 2], wi_ = pw[((dir * 64 + p) * 17 + pwr) * 2 + 1];
#pragma unroll
        for (int e = 0; e < 8; ++e) { const float br = bb[((dir * 64 + p) * 16 + jp0 + e) * 2], bi = bb[((dir * 64 + p) * 16 + jp0 + e) * 2 + 1];
            v[e] = (region & 1) ? (wr_ * bi + wi_ * br) : (wr_ * br - wi_ * bi); }
        u32x4 w; w.x = pk2(v[0], v[1]); w.y = pk2(v[2], v[3]); w.z = pk2(v[4], v[5]); w.w = pk2(v[6], v[7]);
        *(u32x4*)(WW + (size_t)row * 256 + k0) = w; }
    __syncthreads();
}
struct TrJob { const float* src; bf16* dst; int N, K; };
DI void tr_decode(const Frame& F, const Params& P, int r, TrJob& J) {
    constexpr int IT_UP = (DM / 64) * (DFF2 / 128), IT_DOWN = (DFF / 64) * (DM / 128), IT_IN = (DM / 64) * (INCOLS / 128), IT_OUT = (DM / 64) * (DM / 128), IT_GLU = (DM / 64) * (2 * DM / 128);
    const float* W; bf16* WT; int K, N, mode;
    if (r < 4 * (IT_UP + IT_DOWN)) { const int l = r / (IT_UP + IT_DOWN); r -= l * (IT_UP + IT_DOWN);
        if (r < IT_UP) { W = P.in[7] + (size_t)l * DM * DFF2; K = DM; N = DFF2; WT = (bf16*)(P.ws + WS_WUP + l * SZ_WUP); mode = 2; }
        else { W = P.in[10] + (size_t)l * DFF * DM; K = DFF; N = DM; WT = (bf16*)(P.ws + WS_WDOWN + l * SZ_WDOWN); r -= IT_UP; mode = 0; } }
    else { r -= 4 * (IT_UP + IT_DOWN); const int j = r / (IT_IN + IT_OUT + IT_GLU); r -= j * (IT_IN + IT_OUT + IT_GLU);
        if (r < IT_IN) { W = P.in[11] + (size_t)j * DM * INCOLS; K = DM; N = INCOLS; WT = (bf16*)(P.ws + WS_WIN + j * SZ_WIN); mode = 1; }
        else if (r < IT_IN + IT_OUT) { W = P.in[12] + (size_t)j * DM * DM; K = DM; N = DM; WT = (bf16*)(P.ws + WS_WOUT + j * SZ_WOUT); r -= IT_IN; mode = 0; }
        else { W = P.in[31] + (size_t)j * DM * 2 * DM; K = DM; N = 2 * DM; WT = (bf16*)(P.ws + WS_WGLU + j * SZ_WGLU); r -= IT_IN + IT_OUT; mode = 3; } }
    const int nb = N >> 7; const int kb = r / nb, nbk = r - kb * nb; const int k0 = kb * 64, n0 = nbk * 128;
    const int tn = (F.tid & 31) * 4, tk = (F.tid >> 5) * 4;
    const int nd = n0 + tn; int ns = nd;
    if (mode == 2) { const int tile = nd >> 8, pp = nd & 255; ns = ((pp >> 2) & 1) * DFF + 128 * tile + 4 * (pp >> 3); }
    if (mode == 3) ns = ((nd >> 2) & 1) * DM + 4 * (nd >> 3);
    if (mode == 1 && nd < 1280) { const int d = nd & 127, gi = d >> 3, n = (d >> 2) & 1; ns = (nd & ~127) + ((gi < 8) ? 0 : 64) + 32 * n + 4 * (gi & 7); }
    J.src = W + (size_t)(k0 + tk) * N + ns; J.N = N; J.K = K; J.dst = WT + (size_t)(n0 + (F.tid >> 3)) * K + k0 + (F.tid & 7) * 8;
}
DI void tr_load(const TrJob& J, f32x4 (&v)[4]) {
#pragma unroll
    for (int i = 0; i < 4; ++i) v[i] = *(const f32x4*)(J.src + (size_t)i * J.N);
}
DI void tr_store(const Frame& F, const TrJob& J, const f32x4 (&v)[4], int buf) {
    LAS unsigned short* tile = (LAS unsigned short*)F.lds + buf * (128 * 72);
    const int tn = (F.tid & 31) * 4, tk = (F.tid >> 5) * 4;
#pragma unroll
    for (int e = 0; e < 4; ++e) { u32x2 w; w.x = pk2(v[0][e], v[1][e]); w.y = pk2(v[2][e], v[3][e]); *(LAS u32x2*)(tile + (tn + e) * 72 + tk) = w; }
    __syncthreads();
    const int n = F.tid >> 3, kc = F.tid & 7;
    const u32x4 w0 = *(const LAS u32x4*)(tile + n * 72 + kc * 8), w1 = *(const LAS u32x4*)(tile + (n + 64) * 72 + kc * 8);
    *(u32x4*)(J.dst) = w0; *(u32x4*)(J.dst + (size_t)64 * J.K) = w1;
}
DI void tr_run(const Frame& F, const Params& P, int r, const int rend) {
    if (r >= rend) return;
    TrJob J0, J1, J2; f32x4 v0[4], v1[4], v2[4];
    tr_decode(F, P, r, J0); tr_load(J0, v0);
    const int rb = (r + F.G < rend) ? r + F.G : r; tr_decode(F, P, rb, J1); tr_load(J1, v1);
    int buf = 0;
#pragma unroll 1
    for (; r < rend; r += F.G) {
        const int rc = (r + 2 * F.G < rend) ? r + 2 * F.G : r; tr_decode(F, P, rc, J2); tr_load(J2, v2);
        tr_store(F, J0, v0, buf); buf ^= 1;
        J0 = J1; J1 = J2;
#pragma unroll
        for (int i = 0; i < 4; ++i) { v0[i] = v1[i]; v1[i] = v2[i]; }
    }
    __syncthreads();
}
DI void p0_prologue(const Frame& F, const Params& P) {
    constexpr int IT_UP = (DM / 64) * (DFF2 / 128), IT_DOWN = (DFF / 64) * (DM / 128), IT_IN = (DM / 64) * (INCOLS / 128), IT_OUT = (DM / 64) * (DM / 128), IT_GLU = (DM / 64) * (2 * DM / 128);
    constexpr int NT = 4 * (IT_UP + IT_DOWN) + 2 * (IT_IN + IT_OUT + IT_GLU);
    constexpr int N_S5 = 256, N_MODP = 768, N_HID = 264;
    constexpr int NPRE = N_MODP + N_HID + 1;
    int it = F.bid;
    for (; it < NPRE; it += F.G) {
        int r = it;
        if (r < N_MODP) { modp_unit(F, P, r); if (DUP_SUB == 8) modp_unit(F, P, r); continue; } r -= N_MODP;
        if (r < N_HID) { hid_unit(F, P, r); continue; } r -= N_HID;
        tab_unit(F, P);
    }
    const int r0 = it - NPRE; const int nmine = r0 < NT ? (NT - r0 + F.G - 1) / F.G : 0;
    const int cut = r0 + F.G * ((nmine * (F.bid & 3)) / 3);
    tr_run(F, P, r0, cut < NT ? cut : NT);
    for (int u = F.bid; u < N_S5; u += F.G) { s5_unit(F, P, u); if (DUP_SUB == 7) s5_unit(F, P, u); }
    tr_run(F, P, cut, NT);
}
DI void filt_unit(const Frame& F, const Params& P, int u) {
    int l, n, tb, ct; const float* hid; bf16* dst;
    if (u < 2048) { l = u >> 10; tb = (u >> 3) & 127; ct = u & 7; n = SEQ; hid = (const float*)(P.ws + WS_HID) + (size_t)l * SEQ * 64; dst = (bf16*)(P.ws + WS_FILT) + (size_t)l * 2 * 1024 * SEQ; }
    else { const int v = u - 2048; l = v >> 5; tb = (v >> 3) & 3; ct = v & 7; n = CTXL; hid = (const float*)(P.ws + WS_HID + 4 * MiB) + (size_t)l * CTXL * 64; dst = (bf16*)(P.ws + WS_FILTC) + (size_t)l * 2 * 1024 * CTXL; }
    LAS unsigned short* hsb = (LAS unsigned short*)F.lds;
    LAS unsigned short* w3t = hsb + 64 * 72;
    const int t0 = tb * 64;
    { const int pos = F.tid >> 3, k8 = (F.tid & 7) * 8; const f32x4 a = *(const f32x4*)(hid + (size_t)(t0 + pos) * 64 + k8), bq = *(const f32x4*)(hid + (size_t)(t0 + pos) * 64 + k8 + 4);
        u32x4 w; w.x = pk2(a[0], a[1]); w.y = pk2(a[2], a[3]); w.z = pk2(bq[0], bq[1]); w.w = pk2(bq[2], bq[3]); *(LAS u32x4*)(hsb + pos * 72 + k8) = w; }
    const float* w3 = P.in[20] + (size_t)l * 64 * 2048;
    { const int c4 = (F.tid & 63) * 4, k4 = (F.tid >> 6) * 4;
#pragma unroll
        for (int half = 0; half < 2; ++half) { f32x4 v[4];
#pragma unroll
            for (int i = 0; i < 4; ++i) v[i] = *(const f32x4*)(w3 + (size_t)(32 * half + k4 + i) * 2048 + ct * 256 + c4);
#pragma unroll
            for (int e = 0; e < 4; ++e) { u32x2 w; w.x = pk2(v[0][e], v[1][e]); w.y = pk2(v[2][e], v[3][e]); *(LAS u32x2*)(w3t + (c4 + e) * 72 + 32 * half + k4) = w; } } }
    __syncthreads();
    const int r = F.lane & 31, h = F.lane >> 5;
    f32x16 acc[2];
#pragma unroll
    for (int nt = 0; nt < 2; ++nt)
#pragma unroll
        for (int i = 0; i < 16; ++i) acc[nt][i] = 0.f;
#pragma unroll
    for (int s = 0; s < 4; ++s) { const bf16x8 a = *(const LAS bf16x8*)(w3t + (32 * F.wave + r) * 72 + 16 * s + 8 * h);
#pragma unroll
        for (int nt = 0; nt < 2; ++nt) { const bf16x8 bq = *(const LAS bf16x8*)(hsb + (nt * 32 + r) * 72 + 16 * s + 8 * h); acc[nt] = __builtin_amdgcn_mfma_f32_32x32x16_bf16(bq, a, acc[nt], 0, 0, 0); } }
    const int col = ct * 256 + 32 * F.wave + r, dir = col >> 10, c = col & 1023;
    const float delta = 3.0701134573253945f + (float)c * (12.280453829301578f / 1023.0f);
    bf16* drow = dst + ((size_t)(dir * 1024 + c)) * n + t0;
    const float tsc = -delta / (float)(n - 1);
#pragma unroll
    for (int nt = 0; nt < 2; ++nt)
#pragma unroll
        for (int kp = 0; kp < 4; kp += 2) {
            unsigned g[2][2];
#pragma unroll
            for (int q = 0; q < 2; ++q) { float v[4];
#pragma unroll
                for (int e = 0; e < 4; ++e) { const int t = t0 + nt * 32 + 8 * (kp + q) + 4 * h + e; v[e] = acc[nt][4 * (kp + q) + e] * fast_exp((float)t * tsc); }
                g[q][0] = cvtpk_c2(v[0], v[1]); g[q][1] = cvtpk_c2(v[2], v[3]); }
            const auto rx = __builtin_amdgcn_permlane32_swap(g[0][0], g[1][0], false, false);
            const auto ry = __builtin_amdgcn_permlane32_swap(g[0][1], g[1][1], false, false);
            *(u32x4*)(drow + nt * 32 + 8 * kp + (h ? 8 : 0)) = (u32x4){rx[0], ry[0], rx[1], ry[1]}; }
    __syncthreads();
}
DI void p1_phase(const Frame& F, const Params& P) {
    for (int u = F.bid; u < 2048 + 64; u += F.G) filt_unit(F, P, u);
    const float* mp = (const float*)(P.ws + WS_MODP); float* mo = (float*)(P.ws + WS_MOD);
    for (int i = F.bid * NTHR + F.tid; i < DEPTH * 3 * NMOD * DM; i += F.G * NTHR) { const int j = i % (NMOD * DM), lr = i / (NMOD * DM), l = lr / 3, r = lr - 3 * l;
        float s = P.in[5][(size_t)l * NMOD * DM + j];
#pragma unroll
        for (int kc = 0; kc < 8; ++kc) s += mp[((size_t)(l * 8 + kc) * 3 + r) * (NMOD * DM) + j];
        mo[i] = s; }
}
typedef short v4i16_t __attribute__((ext_vector_type(4)));
DI s16x4 vtr(const LAS unsigned char* p) { return __builtin_bit_cast(s16x4, __builtin_amdgcn_ds_read_tr16_b64_v4i16((LAS v4i16_t*)p)); }
DI void ld8f(const float* p, float (&v)[8]) { const f32x4 a = *(const f32x4*)p, b = *(const f32x4*)(p + 4); v[0] = a[0]; v[1] = a[1]; v[2] = a[2]; v[3] = a[3]; v[4] = b[0]; v[5] = b[1]; v[6] = b[2]; v[7] = b[3]; }
DI void st8f(float* p, const float (&v)[8]) { *(f32x4*)p = (f32x4){v[0], v[1], v[2], v[3]}; *(f32x4*)(p + 4) = (f32x4){v[4], v[5], v[6], v[7]}; }
DI void ld8b(const bf16* p, float (&v)[8]) { const u32x4 w = *(const u32x4*)p; v[0] = bflo(w.x); v[1] = bfhi(w.x); v[2] = bflo(w.y); v[3] = bfhi(w.y); v[4] = bflo(w.z); v[5] = bfhi(w.z); v[6] = bflo(w.w); v[7] = bfhi(w.w); }
template <int SRC, bool XIN_BF, bool XOUT_BF>
DI void row_phase(const Frame& F, const bf16* ysrc, const bf16* part, int nparts, int nrows, const void* xin_lat, const void* xin_ctx, void* xout_lat, void* xout_ctx,
                  const float* gA, const float* modA, int mA, bool do_mod, const float* gB, const float* modB, int shiftc, int scalec, bf16* HM, bf16* UA) {
    const int gw = F.bid * NWAVES + F.wave, NGW = F.G * NWAVES;
    constexpr int LDY = (SRC == 2) ? 2 * DM : DM;
    for (int r = gw; r < nrows; r += NGW) {
        const int set = r < SEQ ? 0 : (r < NLAT ? 1 : 2);
        float x[4][8];
        if (XIN_BF) { const bf16* xr = (const bf16*)xin_lat + (size_t)r * DM + 8 * F.lane;
#pragma unroll
            for (int j = 0; j < 4; ++j) ld8b(xr + 512 * j, x[j]); }
        else { const float* xr = r < NLAT ? (const float*)xin_lat + (size_t)r * DM : (const float*)xin_ctx + (size_t)(r - NLAT) * DM;
#pragma unroll
            for (int j = 0; j < 4; ++j) ld8f(xr + 8 * F.lane + 512 * j, x[j]); }
        if (SRC != 0) {
            float y[4][8];
            if (r >= NLAT && nparts > 0) {
#pragma unroll
                for (int j = 0; j < 4; ++j)
#pragma unroll
                    for (int e = 0; e < 8; ++e) y[j][e] = 0.f;
                float g[4][8];
                if (SRC == 2) {
#pragma unroll
                    for (int j = 0; j < 4; ++j)
#pragma unroll
                        for (int e = 0; e < 8; ++e) g[j][e] = 0.f; }
                if (SRC == 3) {
                    float g[4][8];
#pragma unroll
                    for (int j = 0; j < 4; ++j)
#pragma unroll
                        for (int e = 0; e < 8; ++e) g[j][e] = 0.f;
#pragma unroll 1
                    for (int k = 0; k < nparts; ++k) { const bf16* pr = part + ((size_t)k * NCTX + (r - NLAT)) * (2 * DM) + 16 * F.lane;
#pragma unroll
                        for (int j = 0; j < 4; ++j) { float t0[8], t1[8]; ld8b(pr + 1024 * j, t0); ld8b(pr + 1024 * j + 8, t1);
#pragma unroll
                            for (int e = 0; e < 4; ++e) { y[j][e] += t0[e]; g[j][e] += t0[4 + e]; y[j][4 + e] += t1[e]; g[j][4 + e] += t1[4 + e]; } } }
#pragma unroll
                    for (int j = 0; j < 4; ++j)
#pragma unroll
                        for (int e = 0; e < 8; ++e) y[j][e] *= sigmoidf_(g[j][e]);
                } else
#pragma unroll 1
                for (int k = 0; k < nparts; ++k) { const bf16* pr = part + ((size_t)k * NCTX + (r - NLAT)) * LDY + 8 * F.lane;
#pragma unroll
                    for (int j = 0; j < 4; ++j) { float t[8]; ld8b(pr + 512 * j, t);
#pragma unroll
                        for (int e = 0; e < 8; ++e) y[j][e] += t[e];
                        if (SRC == 2) { ld8b(pr + DM + 512 * j, t);
#pragma unroll
                            for (int e = 0; e < 8; ++e) g[j][e] += t[e]; } } }
                if (SRC == 2) {
#pragma unroll
                    for (int j = 0; j < 4; ++j)
#pragma unroll
                        for (int e = 0; e < 8; ++e) y[j][e] *= sigmoidf_(g[j][e]); }
            } else {
                const bf16* yr = ysrc + (size_t)r * LDY + 8 * F.lane;
#pragma unroll
                for (int j = 0; j < 4; ++j) ld8b(yr + 512 * j, y[j]);
                if (SRC == 2) {
#pragma unroll
                    for (int j = 0; j < 4; ++j) { float t[8]; ld8b(yr + DM + 512 * j, t);
#pragma unroll
                        for (int e = 0; e < 8; ++e) y[j][e] *= sigmoidf_(t[e]); } }
            }
            float ss = 0.f;
#pragma unroll
            for (int j = 0; j < 4; ++j)
#pragma unroll
                for (int e = 0; e < 8; ++e) ss += y[j][e] * y[j][e];
            ss = wave_sum(ss);
            const float rs = __builtin_amdgcn_rsqf(ss * (1.0f / DM) + RMS_EPS);
            const float* mm = modA + (size_t)set * (NMOD * DM) + mA * DM;
#pragma unroll
            for (int j = 0; j < 4; ++j) { const int c = 8 * F.lane + 512 * j; float ga[8], mv[8]; ld8f(gA + c, ga); ld8f(mm + c, mv);
#pragma unroll
                for (int e = 0; e < 8; ++e) x[j][e] += mv[e] * (y[j][e] * rs * ga[e]);
                if (XOUT_BF) { u32x4 w; w.x = pk2(x[j][0], x[j][1]); w.y = pk2(x[j][2], x[j][3]); w.z = pk2(x[j][4], x[j][5]); w.w = pk2(x[j][6], x[j][7]); *(u32x4*)((bf16*)xout_lat + (size_t)r * DM + c) = w; }
                else { float* xo = r < NLAT ? (float*)xout_lat + (size_t)r * DM : (float*)xout_ctx + (size_t)(r - NLAT) * DM; st8f(xo + c, x[j]); } }
        }
        if (do_mod) {
            float ss = 0.f;
#pragma unroll
            for (int j = 0; j < 4; ++j)
#pragma unroll
                for (int e = 0; e < 8; ++e) ss += x[j][e] * x[j][e];
            ss = wave_sum(ss);
            const float rs = __builtin_amdgcn_rsqf(ss * (1.0f / DM) + RMS_EPS);
            const float* mb = modB + (size_t)set * (NMOD * DM);
            bf16* hr = HM + (size_t)r * DM;
            int cr = 0; if (UA) cr = r < NLAT ? ((r >> 13) * 512 + ((r & (SEQ - 1)) >> 4)) : (1024 + ((r - NLAT) >> 4));
#pragma unroll
            for (int j = 0; j < 4; ++j) { const int c = 8 * F.lane + 512 * j; float gb[8], sc[8], sh[8]; ld8f(gB + c, gb); ld8f(mb + scalec * DM + c, sc); ld8f(mb + shiftc * DM + c, sh);
                float h[8];
#pragma unroll
                for (int e = 0; e < 8; ++e) h[e] = (x[j][e] * rs * gb[e]) * (sc[e] + 1.0f) + sh[e];
                u32x4 w; w.x = pk2(h[0], h[1]); w.y = pk2(h[2], h[3]); w.z = pk2(h[4], h[5]); w.w = pk2(h[6], h[7]);
                if (HM) *(u32x4*)(hr + c) = w;
                if (UA) *(u32x4*)(UA + ((size_t)(c >> 4) * S5ROWS + cr) * S5K + (r & 15) * 16 + (c & 15)) = w; }
        }
    }
}
DI void load8(const bf16* p, float (&v)[8]) { const u32x4 w = *(const u32x4*)p; v[0] = bflo(w.x); v[1] = bfhi(w.x); v[2] = bflo(w.y); v[3] = bfhi(w.y); v[4] = bflo(w.z); v[5] = bfhi(w.z); v[6] = bflo(w.w); v[7] = bfhi(w.w); }
DI void convglu_phase(const Frame& F, const bf16* U, bf16* A5, const float* cw, const float* cb, int nrows) {
    const int gw = F.bid * NWAVES + F.wave, NGW = F.G * NWAVES;
    constexpr int NCC = 11; const int NRC = nrows / 32;
    for (int wu = gw; wu < NRC * NCC; wu += NGW) {
        const int cc = wu % NCC, rc = wu / NCC; const int c0 = cc * 512 + F.lane * 8; const int r0 = rc * 32;
        if (c0 < DFF) {
            float wg[3][8], wv[3][8], bg[8], bv[8];
#pragma unroll
            for (int k = 0; k < 3; ++k)
#pragma unroll
                for (int e = 0; e < 8; ++e) { wg[k][e] = cw[(size_t)k * DFF2 + c0 + e]; wv[k][e] = cw[(size_t)k * DFF2 + DFF + c0 + e]; }
#pragma unroll
            for (int e = 0; e < 8; ++e) { bg[e] = cb[c0 + e]; bv[e] = cb[DFF + c0 + e]; }
            const int seqlen = r0 < NLAT ? SEQ : CTXL; const int rs0 = r0 < NLAT ? (r0 & (SEQ - 1)) : ((r0 - NLAT) & (CTXL - 1));
            float pg[8], pv[8], cg[8], cv[8], ng[8], nv[8];
            if (rs0 > 0) { load8(U + (size_t)(r0 - 1) * DFF2 + c0, pg); load8(U + (size_t)(r0 - 1) * DFF2 + DFF + c0, pv); }
            else {
#pragma unroll
                for (int e = 0; e < 8; ++e) { pg[e] = 0.f; pv[e] = 0.f; } }
            load8(U + (size_t)r0 * DFF2 + c0, cg); load8(U + (size_t)r0 * DFF2 + DFF + c0, cv);
            for (int i = 0; i < 32; ++i) { const int r = r0 + i;
                if (rs0 + i + 1 < seqlen) { load8(U + (size_t)(r + 1) * DFF2 + c0, ng); load8(U + (size_t)(r + 1) * DFF2 + DFF + c0, nv); }
                else {
#pragma unroll
                    for (int e = 0; e < 8; ++e) { ng[e] = 0.f; nv[e] = 0.f; } }
                float o[8];
#pragma unroll
                for (int e = 0; e < 8; ++e) { const float g = pg[e] * wg[0][e] + cg[e] * wg[1][e] + ng[e] * wg[2][e] + bg[e]; const float v = pv[e] * wv[0][e] + cv[e] * wv[1][e] + nv[e] * wv[2][e] + bv[e]; o[e] = siluf_(g) * v; }
                u32x4 w; w.x = pk2(o[0], o[1]); w.y = pk2(o[2], o[3]); w.z = pk2(o[4], o[5]); w.w = pk2(o[6], o[7]);
                *(u32x4*)(A5 + (size_t)r * DFF + c0) = w;
#pragma unroll
                for (int e = 0; e < 8; ++e) { pg[e] = cg[e]; pv[e] = cv[e]; cg[e] = ng[e]; cv[e] = nv[e]; } }
        }
    }
}
#define ZP(i) ((i) + ((i) >> 4))
DI f32x2 cmul(f32x2 a, f32x2 b) { return (f32x2){a[0] * b[0] - a[1] * b[1], a[0] * b[1] + a[1] * b[0]}; }
DI f32x2 cmulc(f32x2 a, f32x2 b) { return (f32x2){a[0] * b[0] + a[1] * b[1], a[1] * b[0] - a[0] * b[1]}; }
DI f32x2 mulmi(f32x2 a) { return (f32x2){a[1], -a[0]}; }
DI f32x2 mulpi(f32x2 a) { return (f32x2){-a[1], a[0]}; }
#define BFLY_F(x0, x1, x2, x3, y0, y1, y2, y3) do { const f32x2 t0_ = (x0) + (x2), t1_ = (x0) - (x2), t2_ = (x1) + (x3), t3_ = mulmi((x1) - (x3)); y0 = t0_ + t2_; y1 = t1_ + t3_; y2 = t0_ - t2_; y3 = t1_ - t3_; } while (0)
#define BFLY_I(x0, x1, x2, x3, y0, y1, y2, y3) do { const f32x2 t0_ = (x0) + (x2), t1_ = (x0) - (x2), t2_ = (x1) + (x3), t3_ = mulpi((x1) - (x3)); y0 = t0_ + t2_; y1 = t1_ + t3_; y2 = t0_ - t2_; y3 = t1_ - t3_; } while (0)
#define W16_1 ((f32x2){0.92387953251128674f, -0.38268343236508977f})
#define W16_2 ((f32x2){0.70710678118654752f, -0.70710678118654752f})
#define W16_3 ((f32x2){0.38268343236508977f, -0.92387953251128674f})
#define W16_6 ((f32x2){-0.70710678118654752f, -0.70710678118654752f})
#define W16_9 ((f32x2){-0.92387953251128674f, 0.38268343236508977f})
template <int Q2> DI void fft_pass16_fwd(const Frame& F, LAS f32x2* Z) {
    constexpr int L = 16 * Q2, ST = Q2 >= 16 ? Q2 + Q2 / 16 : Q2; constexpr float invL = 1.0f / (float)L;
#pragma unroll 1
    for (int g = F.tid; g < 1024; g += NTHR) { const int j = g & (Q2 - 1), base = ((g - j) << 4) + j;
        LAS f32x2* zp = Z + ZP(base);
        f32x2 x[16];
#pragma unroll
        for (int m = 0; m < 16; ++m) x[m] = zp[m * ST];
        const float rev = (float)j * invL; const f32x2 t1 = {__builtin_amdgcn_cosf(rev), -__builtin_amdgcn_sinf(rev)};
        const f32x2 t2 = cmul(t1, t1), t3 = cmul(t2, t1), t4 = cmul(t2, t2), t8 = cmul(t4, t4), t12 = cmul(t8, t4);
        BFLY_F(x[0], x[4], x[8], x[12], x[0], x[4], x[8], x[12]);          x[4] = cmul(x[4], t1); x[8] = cmul(x[8], t2); x[12] = cmul(x[12], t3);
        BFLY_F(x[1], x[5], x[9], x[13], x[1], x[5], x[9], x[13]);          x[5] = cmul(cmul(x[5], W16_1), t1); x[9] = cmul(cmul(x[9], W16_2), t2); x[13] = cmul(cmul(x[13], W16_3), t3);
        BFLY_F(x[2], x[6], x[10], x[14], x[2], x[6], x[10], x[14]);        x[6] = cmul(cmul(x[6], W16_2), t1); x[10] = cmul(mulmi(x[10]), t2); x[14] = cmul(cmul(x[14], W16_6), t3);
        BFLY_F(x[3], x[7], x[11], x[15], x[3], x[7], x[11], x[15]);        x[7] = cmul(cmul(x[7], W16_3), t1); x[11] = cmul(cmul(x[11], W16_6), t2); x[15] = cmul(cmul(x[15], W16_9), t3);
#pragma unroll
        for (int ap = 0; ap < 4; ++ap) { f32x2 z0, z1, z2, z3; BFLY_F(x[4 * ap], x[4 * ap + 1], x[4 * ap + 2], x[4 * ap + 3], z0, z1, z2, z3);
            zp[(4 * ap) * ST] = z0; zp[(4 * ap + 1) * ST] = cmul(z1, t4); zp[(4 * ap + 2) * ST] = cmul(z2, t8); zp[(4 * ap + 3) * ST] = cmul(z3, t12); } }
    __syncthreads();
}
template <int Q2> DI void fft_pass16_inv(const Frame& F, LAS f32x2* Z) {
    constexpr int L = 16 * Q2, ST = Q2 >= 16 ? Q2 + Q2 / 16 : Q2; constexpr float invL = 1.0f / (float)L;
#pragma unroll 1
    for (int g = F.tid; g < 1024; g += NTHR) { const int j = g & (Q2 - 1), base = ((g - j) << 4) + j;
        LAS f32x2* zp = Z + ZP(base);
        f32x2 v[16];
#pragma unroll
        for (int m = 0; m < 16; ++m) v[m] = zp[m * ST];
        const float rev = (float)j * invL; const f32x2 t1 = {__builtin_amdgcn_cosf(rev), -__builtin_amdgcn_sinf(rev)};
        const f32x2 t2 = cmul(t1, t1), t3 = cmul(t2, t1), t4 = cmul(t2, t2), t8 = cmul(t4, t4), t12 = cmul(t8, t4);
#pragma unroll
        for (int ap = 0; ap < 4; ++ap) BFLY_I(v[4 * ap], cmulc(v[4 * ap + 1], t4), cmulc(v[4 * ap + 2], t8), cmulc(v[4 * ap + 3], t12), v[4 * ap], v[4 * ap + 1], v[4 * ap + 2], v[4 * ap + 3]);
        f32x2 o0, o1, o2, o3;
        BFLY_I(v[0], cmulc(v[4], t1), cmulc(v[8], t2), cmulc(v[12], t3), o0, o1, o2, o3);
        zp[0] = o0; zp[4 * ST] = o1; zp[8 * ST] = o2; zp[12 * ST] = o3;
        BFLY_I(v[1], cmulc(cmulc(v[5], t1), W16_1), cmulc(cmulc(v[9], t2), W16_2), cmulc(cmulc(v[13], t3), W16_3), o0, o1, o2, o3);
        zp[ST] = o0; zp[5 * ST] = o1; zp[9 * ST] = o2; zp[13 * ST] = o3;
        BFLY_I(v[2], cmulc(cmulc(v[6], t1), W16_2), mulpi(cmulc(v[10], t2)), cmulc(cmulc(v[14], t3), W16_6), o0, o1, o2, o3);
        zp[2 * ST] = o0; zp[6 * ST] = o1; zp[10 * ST] = o2; zp[14 * ST] = o3;
        BFLY_I(v[3], cmulc(cmulc(v[7], t1), W16_3), cmulc(cmulc(v[11], t2), W16_6), cmulc(cmulc(v[15], t3), W16_9), o0, o1, o2, o3);
        zp[3 * ST] = o0; zp[7 * ST] = o1; zp[11 * ST] = o2; zp[15 * ST] = o3; }
    __syncthreads();
}
template <bool ZHALF = false> DI void fft_fwd(const Frame& F0, LAS f32x2* Z) {
    Frame F = F0; { int t_ = F0.tid; asm volatile("" : "+v"(t_)); F.tid = t_; }
#pragma unroll 2
    for (int u = F.tid; u < 4096; u += NTHR) { const int j = u; LAS f32x2* zp = Z + ZP(j);
        const f32x2 a0 = zp[0], a1 = zp[4352];
        f32x2 y0, y1, y2, y3;
        if (ZHALF) { const f32x2 m1 = mulmi(a1); y0 = a0 + a1; y1 = a0 + m1; y2 = a0 - a1; y3 = a0 - m1; }
        else { const f32x2 a2 = zp[8704], a3 = zp[13056]; BFLY_F(a0, a1, a2, a3, y0, y1, y2, y3); }
        const float rev = (float)j * (1.0f / 16384.0f); const f32x2 w1 = {__builtin_amdgcn_cosf(rev), -__builtin_amdgcn_sinf(rev)}; const f32x2 w2 = cmul(w1, w1), w3 = cmul(w2, w1);
        zp[0] = y0; zp[4352] = cmul(y1, w1); zp[8704] = cmul(y2, w2); zp[13056] = cmul(y3, w3); }
    __syncthreads();
    fft_pass16_fwd<256>(F, Z); fft_pass16_fwd<16>(F, Z); fft_pass16_fwd<1>(F, Z);
}
DI void fft_fwd_to_regs(const Frame& F0, LAS f32x2* Z, f32x2 (&hs)[32], const float sc, const float add) {
    Frame F = F0; { int t_ = F0.tid; asm volatile("" : "+v"(t_)); F.tid = t_; }
#pragma unroll 2
    for (int u = F.tid; u < 4096; u += NTHR) { const int j = u; LAS f32x2* zp = Z + ZP(j);
        const f32x2 a0 = zp[0], a1 = zp[4352], a2 = zp[8704], a3 = zp[13056];
        f32x2 y0, y1, y2, y3; BFLY_F(a0, a1, a2, a3, y0, y1, y2, y3);
        const float rev = (float)j * (1.0f / 16384.0f); const f32x2 w1 = {__builtin_amdgcn_cosf(rev), -__builtin_amdgcn_sinf(rev)}; const f32x2 w2 = cmul(w1, w1), w3 = cmul(w2, w1);
        zp[0] = y0; zp[4352] = cmul(y1, w1); zp[8704] = cmul(y2, w2); zp[13056] = cmul(y3, w3); }
    __syncthreads();
    fft_pass16_fwd<256>(F, Z); fft_pass16_fwd<16>(F, Z);
#pragma unroll
    for (int gi = 0; gi < 2; ++gi) { const int base = (F.tid + 512 * gi) << 4;
        const LAS f32x2* zp = Z + ZP(base);
        f32x2 x[16];
#pragma unroll
        for (int m = 0; m < 16; ++m) x[m] = zp[m];
        BFLY_F(x[0], x[4], x[8], x[12], x[0], x[4], x[8], x[12]);
        BFLY_F(x[1], x[5], x[9], x[13], x[1], x[5], x[9], x[13]);          x[5] = cmul(x[5], W16_1); x[9] = cmul(x[9], W16_2); x[13] = cmul(x[13], W16_3);
        BFLY_F(x[2], x[6], x[10], x[14], x[2], x[6], x[10], x[14]);        x[6] = cmul(x[6], W16_2); x[10] = mulmi(x[10]); x[14] = cmul(x[14], W16_6);
        BFLY_F(x[3], x[7], x[11], x[15], x[3], x[7], x[11], x[15]);        x[7] = cmul(x[7], W16_3); x[11] = cmul(x[11], W16_6); x[15] = cmul(x[15], W16_9);
#pragma unroll
        for (int ap = 0; ap < 4; ++ap) { f32x2 z0, z1, z2, z3; BFLY_F(x[4 * ap], x[4 * ap + 1], x[4 * ap + 2], x[4 * ap + 3], z0, z1, z2, z3);
            hs[16 * gi + 4 * ap] = (f32x2){z0[0] * sc + add, z0[1] * sc}; hs[16 * gi + 4 * ap + 1] = (f32x2){z1[0] * sc + add, z1[1] * sc};
            hs[16 * gi + 4 * ap + 2] = (f32x2){z2[0] * sc + add, z2[1] * sc}; hs[16 * gi + 4 * ap + 3] = (f32x2){z3[0] * sc + add, z3[1] * sc}; } }
    __syncthreads();
}
DI void fft_pass16_inv1_mul(const Frame& F, LAS f32x2* Z, const f32x2 (&hs)[32]) {
#pragma unroll
    for (int gi = 0; gi < 2; ++gi) { const int base = (F.tid + 512 * gi) << 4;
        LAS f32x2* zp = Z + ZP(base);
        f32x2 v[16];
#pragma unroll
        for (int m = 0; m < 16; ++m) v[m] = cmul(zp[m], hs[16 * gi + m]);
#pragma unroll
        for (int ap = 0; ap < 4; ++ap) BFLY_I(v[4 * ap], v[4 * ap + 1], v[4 * ap + 2], v[4 * ap + 3], v[4 * ap], v[4 * ap + 1], v[4 * ap + 2], v[4 * ap + 3]);
        f32x2 o0, o1, o2, o3;
        BFLY_I(v[0], v[4], v[8], v[12], o0, o1, o2, o3);
        zp[0] = o0; zp[4] = o1; zp[8] = o2; zp[12] = o3;
        BFLY_I(v[1], cmulc(v[5], W16_1), cmulc(v[9], W16_2), cmulc(v[13], W16_3), o0, o1, o2, o3);
        zp[1] = o0; zp[5] = o1; zp[9] = o2; zp[13] = o3;
        BFLY_I(v[2], cmulc(v[6], W16_2), mulpi(v[10]), cmulc(v[14], W16_6), o0, o1, o2, o3);
        zp[2] = o0; zp[6] = o1; zp[10] = o2; zp[14] = o3;
        BFLY_I(v[3], cmulc(v[7], W16_3), cmulc(v[11], W16_6), cmulc(v[15], W16_9), o0, o1, o2, o3);
        zp[3] = o0; zp[7] = o1; zp[11] = o2; zp[15] = o3; }
    __syncthreads();
}
DI void fft_inv_mul_lo(const Frame& F0, LAS f32x2* Z, const f32x2 (&hs)[32]) {
    Frame F = F0; { int t_ = F0.tid; asm volatile("" : "+v"(t_)); F.tid = t_; }
    fft_pass16_inv1_mul(F, Z, hs); fft_pass16_inv<16>(F, Z); fft_pass16_inv<256>(F, Z);
#pragma unroll 2
    for (int u = F.tid; u < 4096; u += NTHR) { const int j = u; LAS f32x2* zp = Z + ZP(j);
        const float rev = (float)j * (1.0f / 16384.0f); const f32x2 w1 = {__builtin_amdgcn_cosf(rev), -__builtin_amdgcn_sinf(rev)}; const f32x2 w2 = cmul(w1, w1), w3 = cmul(w2, w1);
        const f32x2 a0 = zp[0], a1 = cmulc(zp[4352], w1), a2 = cmulc(zp[8704], w2), a3 = cmulc(zp[13056], w3);
        f32x2 x0, x1, x2, x3; BFLY_I(a0, a1, a2, a3, x0, x1, x2, x3);
        zp[0] = x0; zp[4352] = x1; }
    __syncthreads();
}
DI float dw3(const LAS unsigned short* row, int t, int n, float w0, float w1, float w2, float b) {
    const float m = bf2f(row[t]); const float l = t > 0 ? bf2f(row[t - 1]) : 0.f; const float r = t + 1 < n ? bf2f(row[t + 1]) : 0.f;
    return l * w0 + m * w1 + r * w2 + b;
}
DI void dw3x4(const LAS unsigned short* row, int t, int n, float w0, float w1, float w2, float b, float (&o)[4]) {
    const u32x2 m = *(const LAS u32x2*)(row + t);
    const float c0 = bflo(m.x), c1 = bfhi(m.x), c2 = bflo(m.y), c3 = bfhi(m.y);
    const float l = t > 0 ? bf2f(row[t - 1]) : 0.f; const float r = t + 4 < n ? bf2f(row[t + 4]) : 0.f;
    o[0] = l * w0 + c0 * w1 + c1 * w2 + b; o[1] = c0 * w0 + c1 * w1 + c2 * w2 + b; o[2] = c1 * w0 + c2 * w1 + c3 * w2 + b; o[3] = c2 * w0 + c3 * w1 + r * w2 + b;
}
DI void hyena_unit(const Frame& F0, const Params& P, int je, int c) {
    Frame F = F0; { int t_ = F0.tid; asm volatile("" : "+v"(t_)); F.tid = t_; F.lane = t_ & 63; }
    LAS f32x2* Z = (LAS f32x2*)F.lds;
    LAS float* aux = (LAS float*)(F.lds + AUX_OFF + 8192);
    LAS float* red = aux + 1536;
    const bf16* ZBT = (const bf16*)(P.ws + WS_U + 50 * MiB);
    bf16* YBT = (bf16*)(P.ws + WS_U + 150 * MiB);
    const bf16* filt = (const bf16*)(P.ws + WS_FILT) + (size_t)je * 2 * 1024 * SEQ;
    const bf16* ff = filt + (size_t)c * SEQ; const bf16* fb = filt + (size_t)(1024 + c) * SEQ;
    const float* hw = P.in[14] + (size_t)je * 3 * HYC; const float* hb = P.in[15] + (size_t)je * HYC;
    float l1 = 0.f;
    u32x4 rawpf[8]; u32x4 cpf = {0u, 0u, 0u, 0u}; bf16 hcpf = 0;
    const bf16* fc = (const bf16*)(P.ws + WS_FILTC) + (size_t)je * 2 * 1024 * CTXL;
    {
        u32x4 wf[2], wb[2];
#pragma unroll
        for (int q = 0; q < 2; ++q) { const int pc = F.tid + 512 * q; wf[q] = *(const u32x4*)(ff + 8 * pc); wb[q] = *(const u32x4*)(fb + 8184 - 8 * pc); }
#pragma unroll
        for (int k = 0; k < 8; ++k) { const int i = F.tid + 512 * k, rr = i >> 10, piece = i & 1023; const int b = rr & 1, which = rr >> 1;
            rawpf[k] = *(const u32x4*)(ZBT + (size_t)((which ? 2048 : 1024) + c) * MROWS + b * SEQ + piece * 8); }
        { const int i = F.tid; if (i >= 255 && i < 511) hcpf = fc[(size_t)c * CTXL + (i - 255)]; else if (i < 255) hcpf = fc[(size_t)(1024 + c) * CTXL + (255 - i)];
            if (i < 192) { const int rw = i >> 5, pc = i & 31; const int bb2 = rw / 3, which = rw - 3 * bb2; cpf = *(const u32x4*)(ZBT + (size_t)(which * 1024 + c) * MROWS + NLAT + bb2 * CTXL + pc * 8); } }
#pragma unroll
        for (int q = 0; q < 2; ++q) { const int pc = F.tid + 512 * q; float v[8];
            v[0] = bflo(wf[q].x); v[1] = bfhi(wf[q].x); v[2] = bflo(wf[q].y); v[3] = bfhi(wf[q].y); v[4] = bflo(wf[q].z); v[5] = bfhi(wf[q].z); v[6] = bflo(wf[q].w); v[7] = bfhi(wf[q].w);
            LAS f32x2* zp = Z + ZP(8 * pc);
#pragma unroll
            for (int e = 0; e < 8; ++e) { l1 += fabsf(v[e]); zp[e] = (f32x2){v[e], 0.f}; }
            v[0] = bflo(wb[q].x); v[1] = bfhi(wb[q].x); v[2] = bflo(wb[q].y); v[3] = bfhi(wb[q].y); v[4] = bflo(wb[q].z); v[5] = bfhi(wb[q].z); v[6] = bflo(wb[q].w); v[7] = bfhi(wb[q].w);
#pragma unroll
            for (int e = 0; e < 8; ++e) { const int i = 8193 + 8 * pc + e; if (i < 16384) { l1 += fabsf(v[7 - e]); Z[ZP(i)] = (f32x2){v[7 - e], 0.f}; } } }
        if (F.tid == 0) Z[ZP(SEQ)] = (f32x2){0.f, 0.f};
    }
    l1 = block_sum(F, l1, red);
    const float bias = P.in[22][(size_t)je * 1024 + c];
    const float hscale = 1.0f / (l1 * 16384.0f), hadd = bias * (1.0f / 16384.0f);
    f32x2 hs[32];
    fft_fwd_to_regs(F, Z, hs, hscale, hadd);
    LAS unsigned short* raw = (LAS unsigned short*)(F.lds + 69632);
#pragma unroll
    for (int k = 0; k < 8; ++k) { const int i = F.tid + 512 * k, rr = i >> 10, piece = i & 1023; *(LAS u32x4*)(raw + rr * SEQ + piece * 8) = rawpf[k]; }
    __syncthreads();
    const float wx10 = hw[1024 + c], wx11 = hw[HYC + 1024 + c], wx12 = hw[2 * HYC + 1024 + c], bx1 = hb[1024 + c];
    const float wv0 = hw[2048 + c], wv1 = hw[HYC + 2048 + c], wv2 = hw[2 * HYC + 2048 + c], bv = hb[2048 + c];
    const float wx00 = hw[c], wx01 = hw[HYC + c], wx02 = hw[2 * HYC + c], bx0 = hb[c];
#pragma unroll 1
    for (int k = 0; k < 4; ++k) { const int t = 4 * (k * 512 + F.tid);
        float pv0[4], px0[4], pv1[4], px1[4];
        dw3x4(raw + 2 * SEQ, t, SEQ, wv0, wv1, wv2, bv, pv0); dw3x4(raw, t, SEQ, wx10, wx11, wx12, bx1, px0);
        dw3x4(raw + 3 * SEQ, t, SEQ, wv0, wv1, wv2, bv, pv1); dw3x4(raw + SEQ, t, SEQ, wx10, wx11, wx12, bx1, px1);
        LAS f32x2* zp = Z + ZP(t);
#pragma unroll
        for (int e = 0; e < 4; ++e) zp[e] = (f32x2){pv0[e] * px0[e], pv1[e] * px1[e]}; }
    __syncthreads();
    u32x4 x0pf[4];
#pragma unroll
    for (int k = 0; k < 4; ++k) { const int i = F.tid + 512 * k, b = i >> 10, piece = i & 1023; x0pf[k] = *(const u32x4*)(ZBT + (size_t)c * MROWS + b * SEQ + piece * 8); }
    fft_fwd<true>(F, Z);
    fft_inv_mul_lo(F, Z, hs);
#pragma unroll
    for (int k = 0; k < 4; ++k) { const int i = F.tid + 512 * k, b = i >> 10, piece = i & 1023; *(LAS u32x4*)(raw + b * SEQ + piece * 8) = x0pf[k]; }
    __syncthreads();
#pragma unroll 1
    for (int k = 0; k < 4; ++k) { const int t = 4 * (k * 512 + F.tid);
        float g0[4], g1[4]; dw3x4(raw, t, SEQ, wx00, wx01, wx02, bx0, g0); dw3x4(raw + SEQ, t, SEQ, wx00, wx01, wx02, bx0, g1);
        const LAS f32x2* zp = Z + ZP(t); const f32x2 z0 = zp[0], z1 = zp[1], z2 = zp[2], z3 = zp[3];
        u32x2 w0_, w1_; w0_.x = pk2(z0[0] * g0[0], z1[0] * g0[1]); w0_.y = pk2(z2[0] * g0[2], z3[0] * g0[3]); w1_.x = pk2(z0[1] * g1[0], z1[1] * g1[1]); w1_.y = pk2(z2[1] * g1[2], z3[1] * g1[3]);
        *(u32x2*)(YBT + (size_t)c * MROWS + t) = w0_; *(u32x2*)(YBT + (size_t)c * MROWS + SEQ + t) = w1_; }
    LAS float* hc = aux; LAS float* vvc = aux + 512; LAS float* x0c = aux + 1024;
    __syncthreads();
    { const int i = F.tid; float v;
        if (i < 511) v = bf2f(hcpf); else v = 0.f;
        hc[i] = v; float l1c = block_sum(F, fabsf(v), red);
        const int b = i >> 8, t = i & 255;
        LAS unsigned short* crow = (LAS unsigned short*)(F.lds + 16384);
        if (i < 192) { const int rw = i >> 5, pc = i & 31; const int bb2 = rw / 3, which = rw - 3 * bb2;
            const u32x4 w = cpf;
            LAS unsigned short* d = crow + rw * 272 + 1 + pc * 8;
            d[0] = (unsigned short)(w.x & 0xffff); d[1] = (unsigned short)(w.x >> 16); d[2] = (unsigned short)(w.y & 0xffff); d[3] = (unsigned short)(w.y >> 16);
            d[4] = (unsigned short)(w.z & 0xffff); d[5] = (unsigned short)(w.z >> 16); d[6] = (unsigned short)(w.w & 0xffff); d[7] = (unsigned short)(w.w >> 16); }
        else if (i < 204) { const int k = i - 192; crow[(k >> 1) * 272 + ((k & 1) ? 257 : 0)] = 0; }
        __syncthreads();
        auto rd = [&](int which, int tt) -> float { return bf2f(crow[(3 * b + which) * 272 + 1 + tt]); };
        const float pv_ = rd(2, t - 1) * wv0 + rd(2, t) * wv1 + rd(2, t + 1) * wv2 + bv;
        const float px1 = rd(1, t - 1) * wx10 + rd(1, t) * wx11 + rd(1, t + 1) * wx12 + bx1;
        const float px0 = rd(0, t - 1) * wx00 + rd(0, t) * wx01 + rd(0, t + 1) * wx02 + bx0;
        vvc[i] = pv_ * px1; x0c[i] = px0;
        __syncthreads();
        { LAS float* part = (LAS float*)F.lds;
            const int t4 = (F.tid & 63) * 4, bb = (F.tid >> 6) & 1, sq = F.tid >> 7;
            float a0 = 0.f, a1 = 0.f, a2 = 0.f, a3 = 0.f;
            int d = t4 - sq * 64 + 255;
            float h1 = hc[d + 1], h2 = hc[d + 2], h3 = hc[d + 3];
#pragma unroll 8
            for (int s = 0; s < 64; ++s) { const float h0 = hc[d - s]; const float v = vvc[bb * 256 + sq * 64 + s];
                a0 += h0 * v; a1 += h1 * v; a2 += h2 * v; a3 += h3 * v; h3 = h2; h2 = h1; h1 = h0; }
            *(LAS f32x4*)(part + (sq * 2 + bb) * 256 + t4) = (f32x4){a0, a1, a2, a3}; }
        __syncthreads();
        { const LAS float* part = (const LAS float*)F.lds;
            float s = (part[(0 * 2 + b) * 256 + t] + part[(1 * 2 + b) * 256 + t]) + (part[(2 * 2 + b) * 256 + t] + part[(3 * 2 + b) * 256 + t]);
            s = s / l1c;
            YBT[(size_t)c * MROWS + NLAT + i] = (bf16)f2bf((s + vvc[i] * bias) * x0c[i]); }
    }
    __syncthreads();
}
DI void ybt_transpose_phase(const Frame& F, const Params& P) {
    const bf16* YBT = (const bf16*)(P.ws + WS_U + 150 * MiB); bf16* YAB = (bf16*)(P.ws + WS_YAB);
    LAS unsigned char* tile = F.lds + F.wave * 16384;
    const int gw = F.bid * NWAVES + F.wave, NGW = F.G * NWAVES;
    const int rr = F.lane >> 3, piece = F.lane & 7;
    const int i16 = F.lane & 15, tq = i16 >> 2, tp = i16 & 3, g16 = F.lane >> 4;
    for (int tu = gw; tu < 16 * (MROWS / 64); tu += NGW) { const int cb = tu & 15, tb = tu >> 4; const int c0 = cb * 64, t0 = tb * 64;
        u32x4 v[8];
#pragma unroll
        for (int i = 0; i < 8; ++i) v[i] = *(const u32x4*)(YBT + (size_t)(c0 + 8 * i + rr) * MROWS + t0 + piece * 8);
#pragma unroll
        for (int i = 0; i < 8; ++i) *(LAS u32x4*)(tile + (8 * i + rr) * 192 + piece * 16) = v[i];
        asm volatile("s_waitcnt lgkmcnt(0)" ::: "memory");
        bf16* dst = YAB + (size_t)(t0 + F.lane) * DM + 1024 + c0;
#pragma unroll
        for (int k = 0; k < 8; ++k) {
            const LAS unsigned char* ap = tile + (8 * k + tq) * 192 + 32 * g16 + 8 * tp;
            const s16x4 lo = vtr(ap), hi = vtr(ap + 4 * 192);
            const bf16x8 o = __builtin_shufflevector(lo, hi, 0, 1, 2, 3, 4, 5, 6, 7);
            *(bf16x8*)(dst + 8 * k) = o; }
        asm volatile("s_waitcnt lgkmcnt(0)" ::: "memory");
    }
}
typedef __bf16 bf16x2_t __attribute__((ext_vector_type(2)));
DI unsigned cvtpk_s(float lo, float hi) { const f32x2 v = {lo, hi}; const bf16x2_t b = __builtin_convertvector(v, bf16x2_t); return __builtin_bit_cast(unsigned, b); }
DI int crow(int i, int h) { return (i & 3) + 8 * (i >> 2) + 4 * h; }
#define MFMA32(a, b, c) __builtin_amdgcn_mfma_f32_32x32x16_bf16((a), (b), (c), 0, 0, 0)
constexpr int KPITCH = 272, VPITCH = 320, VS_OFF = 128 * KPITCH;

DI void attn_unit(const Frame& F, const Params& P, int je, int au) {
    int b, qb, hk, hp; bool isctx;
    if (au < 512) { isctx = false; const int idx = (au & 7) * 64 + (au >> 3);
        hp = idx & 1; qb = (idx >> 1) & 63; hk = (idx >> 7) & 1; b = idx >> 8; }
    else { const int v = au - 512; isctx = true; hp = v & 1; hk = (v >> 1) & 1; qb = (v >> 2) & 1; b = v >> 3; }
    const bf16* QKV = (const bf16*)(P.ws + WS_U); bf16* YAB = (bf16*)(P.ws + WS_YAB);
    const int r = F.lane & 31, h = F.lane >> 5;
    const int qsub = F.wave & 3, head = hk * 4 + hp * 2 + (F.wave >> 2);
    const int seqbase = isctx ? (NLAT + b * CTXL) : b * SEQ;
    const int qrow = seqbase + qb * 128 + qsub * 32 + r;
    const bf16* qbase = QKV + (size_t)qrow * QKVC + head * HD + 8 * h;
    bf16x8 qf[8];
#pragma unroll
    for (int s = 0; s < 8; ++s) qf[s] = *(const bf16x8*)(qbase + 16 * s);
    float m = P.in[13][je * 8 + head] * LOG2E, l = (h == 0) ? 1.0f : 0.0f;
    f32x16 O[4];
#pragma unroll
    for (int dt = 0; dt < 4; ++dt)
#pragma unroll
        for (int i = 0; i < 16; ++i) O[dt][i] = 0.f;
    const LAS unsigned char* Ks = F.lds; const LAS unsigned char* Vs = F.lds + VS_OFF;
    const int ql = qsub * 32 + r;
    const int i16 = F.lane & 15, tq = i16 >> 2, tp = i16 & 3, blk = (F.lane >> 4) & 1;
    int nb = 0, brow[5], btype[5];
#pragma unroll
    for (int bi = 0; bi < 5; ++bi) { int krow0, type; bool ok;
        if (bi < 3) { const int kb = qb - 1 + bi; ok = !isctx && kb >= 0 && kb < SEQ / 128; krow0 = b * SEQ + kb * 128; type = bi; }
        else { ok = true; krow0 = NLAT + b * CTXL + (bi - 3) * 128; type = 1; }
        if (ok) {
#pragma unroll
            for (int q = 0; q < 5; ++q) if (q == nb) { brow[q] = krow0; btype[q] = type; }
            ++nb; } }
    u32x4 kreg[4], vreg[4];
    const int pkey = F.tid >> 4, ppc = F.tid & 15;
#define ATT_PREFETCH(krow0_) do { const bf16* src_ = QKV + (size_t)((krow0_) + pkey) * QKVC + hk * HD + ppc * 8 + QCOLS; \
        _Pragma("unroll") for (int i_ = 0; i_ < 4; ++i_) { kreg[i_] = *(const u32x4*)(src_ + (size_t)i_ * 32 * QKVC); vreg[i_] = *(const u32x4*)(src_ + (size_t)i_ * 32 * QKVC + KVC); } } while (0)
    ATT_PREFETCH(brow[0]);
    for (int bi = 0; bi < nb; ++bi) {
        int krow_next = 0, type = 1;
#pragma unroll
        for (int q = 0; q < 5; ++q) { if (q == bi) type = btype[q]; if (q == bi + 1) krow_next = brow[q]; }
        __syncthreads();
#pragma unroll
        for (int i = 0; i < 4; ++i) { *(LAS u32x4*)(F.lds + (pkey + 32 * i) * KPITCH + ppc * 16) = kreg[i]; *(LAS u32x4*)(F.lds + VS_OFF + (pkey + 32 * i) * VPITCH + ppc * 16) = vreg[i]; }
        __syncthreads();
        if (bi + 1 < nb) ATT_PREFETCH(krow_next);
#pragma unroll 1
        for (int hb = 0; hb < 2; ++hb) {
            f32x16 st[2];
#pragma unroll
            for (int k2 = 0; k2 < 2; ++k2) { const int kt = 2 * hb + k2;
#pragma unroll
                for (int i = 0; i < 16; ++i) st[k2][i] = 0.f;
#pragma unroll
                for (int s = 0; s < 8; ++s) { const bf16x8 kf = *(const LAS bf16x8*)(Ks + (kt * 32 + r) * KPITCH + (16 * s + 8 * h) * 2); st[k2] = MFMA32(kf, qf[s], st[k2]); }
                __builtin_amdgcn_sched_barrier(0); }
            if (type != 1) { int qlv = ql; asm volatile("" : "+v"(qlv));
#pragma unroll
                for (int k2 = 0; k2 < 2; ++k2)
#pragma unroll
                    for (int i = 0; i < 16; ++i) { const int kl = (2 * hb + k2) * 32 + crow(i, h); const bool ok = (type == 0) ? (kl >= qlv) : (kl <= qlv); st[k2][i] = ok ? st[k2][i] : -1e30f; } }
            float mx = st[0][0];
#pragma unroll
            for (int k2 = 0; k2 < 2; ++k2)
#pragma unroll
                for (int i = 0; i < 16; ++i) mx = fmaxf(mx, st[k2][i]);
            mx = fmaxf(mx, __shfl_xor(mx, 32));
            const float mnew = fmaxf(m, mx), alpha = __builtin_amdgcn_exp2f(m - mnew); m = mnew;
            float ls = 0.f;
#pragma unroll
            for (int k2 = 0; k2 < 2; ++k2)
#pragma unroll
                for (int i = 0; i < 16; ++i) { const float pe = __builtin_amdgcn_exp2f(st[k2][i] - mnew); st[k2][i] = pe; ls += pe; }
            l = l * alpha + ls;
#pragma unroll
            for (int dt = 0; dt < 4; ++dt)
#pragma unroll
                for (int i = 0; i < 16; ++i) O[dt][i] *= alpha;
#pragma unroll
            for (int k2 = 0; k2 < 2; ++k2)
#pragma unroll
                for (int s = 0; s < 2; ++s) { const int kt = 2 * hb + k2;
                    u32x4 pw; pw.x = cvtpk_s(st[k2][8 * s + 0], st[k2][8 * s + 1]); pw.y = cvtpk_s(st[k2][8 * s + 2], st[k2][8 * s + 3]); pw.z = cvtpk_s(st[k2][8 * s + 4], st[k2][8 * s + 5]); pw.w = cvtpk_s(st[k2][8 * s + 6], st[k2][8 * s + 7]);
                    const bf16x8 pf = __builtin_bit_cast(bf16x8, pw);
#pragma unroll
                    for (int dt = 0; dt < 4; ++dt) {
                        const LAS unsigned char* vp = Vs + (kt * 32 + 16 * s + 4 * h + tq) * VPITCH + 64 * dt + 32 * blk + 8 * tp;
                        const s16x4 lo = vtr(vp), hi = vtr(vp + 8 * VPITCH);
                        const bf16x8 vf = __builtin_shufflevector(lo, hi, 0, 1, 2, 3, 4, 5, 6, 7);
                        O[dt] = MFMA32(vf, pf, O[dt]); }
                    __builtin_amdgcn_sched_barrier(0); }
        }
    }
#undef ATT_PREFETCH
    const float lt = l + __shfl_xor(l, 32); const float inv = 1.0f / lt;
    bf16* orow = YAB + (size_t)qrow * DM + head * HD;
#pragma unroll
    for (int dt = 0; dt < 4; ++dt)
#pragma unroll
        for (int ig = 0; ig < 4; ++ig) { u32x2 w; w.x = cvtpk_s(O[dt][4 * ig] * inv, O[dt][4 * ig + 1] * inv); w.y = cvtpk_s(O[dt][4 * ig + 2] * inv, O[dt][4 * ig + 3] * inv);
            *(u32x2*)(orow + dt * 32 + 8 * ig + 4 * h) = w; }
    __syncthreads();
}
DI void unpack8(const u32x4 w, float (&v)[8]) { v[0] = bflo(w.x); v[1] = bfhi(w.x); v[2] = bflo(w.y); v[3] = bfhi(w.y); v[4] = bflo(w.z); v[5] = bfhi(w.z); v[6] = bflo(w.w); v[7] = bfhi(w.w); }
DI void s5_carry_phase(const Frame& F, const Params& P, int jo) {
    const int fr = F.lane & 15, fq = F.lane >> 4;
    for (int blk = F.bid; blk < 2 * S5G; blk += F.G) {
        const int g = blk & 127, b = blk >> 7;
        bf16* ET = (bf16*)(P.ws + WS_U) + (size_t)g * 256 * S5ROWS;
        bf16* UAg = (bf16*)(P.ws + WS_A5) + (size_t)g * S5ROWS * S5K;
        const bf16* UAc = UAg + (size_t)(1024 + b * 16) * S5K;
        const bf16* WWg = (const bf16*)(P.ws + WS_WW) + (size_t)(jo * S5G + g) * 256 * 256;
        const bf16* TTg = (const bf16*)(P.ws + WS_TT) + (size_t)(jo * S5G + g) * 256 * 512;
        const int rc0 = 1024 + b * 16, rl0 = b * 512;
#pragma unroll 1
        for (int mt = F.wave; mt < 16; mt += NWAVES) { pg8::f32x4 acc = {0.f, 0.f, 0.f, 0.f};
#pragma unroll
            for (int ks = 0; ks < 8; ++ks) { const bf16x8 a = *(const bf16x8*)(WWg + (size_t)(mt * 16 + fr) * 256 + 32 * ks + 8 * fq), bq = *(const bf16x8*)(UAc + (size_t)fr * S5K + 32 * ks + 8 * fq);
                acc = __builtin_amdgcn_mfma_f32_16x16x32_bf16(a, bq, acc, 0, 0, 0); }
#pragma unroll
            for (int j = 0; j < 4; ++j) ET[(size_t)(mt * 16 + 4 * fq + j) * S5ROWS + rc0 + fr] = (bf16)f2bf(acc[j]); }
        asm volatile("s_waitcnt vmcnt(0)" ::: "memory"); __syncthreads();
        const int p = F.lane, dir = F.wave & 1;
        const float* lp = (const float*)(P.ws + WS_LAML) + ((size_t)((jo * 2 + dir) * S5G + g) * 64 + p) * 2;
        const float lr = lp[0], li = lp[1];
        const bf16* Er = ET + (size_t)(dir * 128 + p) * S5ROWS;
        bf16* Ug = UAg + 256 + dir * 128 + p;
        float sr = 0.f, si = 0.f;
        if (F.wave < 2) {
            float cr[16], ci[16];
            { float t8[8]; unpack8(*(const u32x4*)(Er + rc0), t8);
#pragma unroll
              for (int e = 0; e < 8; ++e) cr[e] = t8[e];
              unpack8(*(const u32x4*)(Er + rc0 + 8), t8);
#pragma unroll
              for (int e = 0; e < 8; ++e) cr[8 + e] = t8[e];
              unpack8(*(const u32x4*)(Er + 64 * S5ROWS + rc0), t8);
#pragma unroll
              for (int e = 0; e < 8; ++e) ci[e] = t8[e];
              unpack8(*(const u32x4*)(Er + 64 * S5ROWS + rc0 + 8), t8);
#pragma unroll
              for (int e = 0; e < 8; ++e) ci[8 + e] = t8[e]; }
#pragma unroll
            for (int q = 0; q < 16; ++q) { const int qq = dir == 0 ? q : 15 - q; const int row = rc0 + qq;
                Ug[(size_t)row * S5K] = (bf16)f2bf(sr); Ug[(size_t)row * S5K + 64] = (bf16)f2bf(si);
                const float xr = dir == 0 ? cr[q] : cr[15 - q], xi = dir == 0 ? ci[q] : ci[15 - q];
                const float nr = lr * sr - li * si + xr, ni = lr * si + li * sr + xi; sr = nr; si = ni; } }
        asm volatile("s_waitcnt vmcnt(0)" ::: "memory"); __syncthreads();
        if (F.wave < 2) {
#define S5BLK(bq) (dir == 0 ? rl0 + 8 * (bq) : rl0 + 504 - 8 * (bq))
            u32x4 er[4], ei[4];
#pragma unroll
            for (int k = 0; k < 4; ++k) { const int row = S5BLK(k); er[k] = *(const u32x4*)(Er + row); ei[k] = *(const u32x4*)(Er + 64 * S5ROWS + row); }
#pragma unroll 1
            for (int b0 = 0; b0 < 64; b0 += 4) {
                u32x4 nr_[4], ni_[4];
#pragma unroll
                for (int k = 0; k < 4; ++k) { const int bq = b0 + 4 + k; if (bq < 64) { const int row = S5BLK(bq); nr_[k] = *(const u32x4*)(Er + row); ni_[k] = *(const u32x4*)(Er + 64 * S5ROWS + row); } else { nr_[k] = (u32x4){0u, 0u, 0u, 0u}; ni_[k] = nr_[k]; } }
#pragma unroll
                for (int k = 0; k < 4; ++k) { const int row0 = S5BLK(b0 + k); float vr[8], vi[8]; unpack8(er[k], vr); unpack8(ei[k], vi);
#pragma unroll
                    for (int e = 0; e < 8; ++e) { const int ee = dir == 0 ? e : 7 - e; const int row = row0 + ee;
                        Ug[(size_t)row * S5K] = (bf16)f2bf(sr); Ug[(size_t)row * S5K + 64] = (bf16)f2bf(si);
                        const float xr = dir == 0 ? vr[e] : vr[7 - e], xi = dir == 0 ? vi[e] : vi[7 - e];
                        const float nr = lr * sr - li * si + xr, ni = lr * si + li * sr + xi; sr = nr; si = ni; } }
#pragma unroll
                for (int k = 0; k < 4; ++k) { er[k] = nr_[k]; ei[k] = ni_[k]; }
            }
#undef S5BLK
        } else {
            bf16* G2c = (bf16*)(P.ws + WS_Y) + ((size_t)g * S5ROWS + rc0) * 256;
#pragma unroll 1
            for (int mt = F.wave - 2; mt < 16; mt += NWAVES - 2) { pg8::f32x4 acc = {0.f, 0.f, 0.f, 0.f};
#pragma unroll
                for (int ks = 0; ks < 16; ++ks) { const bf16x8 a = *(const bf16x8*)(TTg + (size_t)(mt * 16 + fr) * 512 + 32 * ks + 8 * fq), bq = *(const bf16x8*)(UAc + (size_t)fr * S5K + 32 * ks + 8 * fq);
                    acc = __builtin_amdgcn_mfma_f32_16x16x32_bf16(a, bq, acc, 0, 0, 0); }
                u32x2 w; w.x = pk2(gelu_tanh(acc[0]), gelu_tanh(acc[1])); w.y = pk2(gelu_tanh(acc[2]), gelu_tanh(acc[3]));
                *(u32x2*)(G2c + (size_t)fr * 256 + mt * 16 + 4 * fq) = w; }
        }
        __syncthreads();
    }
}
constexpr int N_PHASES = 3 + 4 * 8;
#ifndef WGM_C2
#define WGM_C2 8
#endif
#ifndef WGM_E1
#define WGM_E1 4
#endif
#ifndef STAGGER_US
#define STAGGER_US 0
#endif
#ifndef REV_C4
#define REV_C4 0
#endif
#ifndef WGM_O4
#define WGM_O4 4
#endif
#ifndef WGM_C4
#define WGM_C4 4
#endif
#ifndef DUP_MASK_VALUE
#define DUP_MASK_VALUE 0ull
#endif
constexpr unsigned long long DUP_MASK = DUP_MASK_VALUE;
#ifndef DUP_SUB
#define DUP_SUB 0
#endif
typedef const Params __attribute__((address_space(4)))* ParamsK;
__global__ void __launch_bounds__(NTHR, 2) hybrid_fwd(Params Parg) {
    extern __shared__ __attribute__((aligned(16))) unsigned char lds_raw[];
    Frame F0; F0.lds = (LAS unsigned char*)lds_raw; F0.tid = threadIdx.x; F0.lane = F0.tid & 63; F0.wave = __builtin_amdgcn_readfirstlane(F0.tid >> 6); F0.G = gridDim.x; F0.bid = blockIdx.x;
    for (int u = F0.tid; u < (LDS_BYTES - LDSCTL_OFF) / 4; u += NTHR) ((LAS unsigned*)(F0.lds + LDSCTL_OFF))[u] = 0u;
    __syncthreads();
    XcdBarrier bar = xcd_barrier_post((unsigned*)(Parg.ws + WS_CTL) + CW_BAR, (volatile LAS unsigned*)(F0.lds + LDSCTL_OFF + 64));
    const int lo = Parg.lo, hi = Parg.hi; int ph = 0;
#define RUNP() (lo <= ph && ph < hi)
#define PHASE_BEGIN for (int rep_ = 0; RUNP() && rep_ < (((DUP_MASK >> ph) & 1ull) ? 2 : 1); ++rep_)
#define SEAM() do { if (lo <= ph && ph + 1 < hi) { XcdBarrier bl_ = bar; asm volatile("" : "+s"(bl_.x)); xcd_barrier(bl_); if (DUP_SUB == 6) xcd_barrier(bl_); } ++ph; } while (0)
#define LOCALS() Frame F = F0; { int t_ = F0.tid; asm volatile("" : "+v"(t_)); F.tid = t_; F.lane = t_ & 63; F.wave = __builtin_amdgcn_readfirstlane(t_ >> 6); int b_ = F0.bid, g_ = F0.G; asm volatile("" : "+s"(b_), "+s"(g_)); F.bid = b_; F.G = g_; } \
    ParamsK pk_ = (ParamsK)__builtin_amdgcn_kernarg_segment_ptr(); asm volatile("" : "+s"(pk_)); Params P; _Pragma("unroll") for (int i_ = 0; i_ < 33; ++i_) P.in[i_] = pk_->in[i_]; P.out = pk_->out; P.ws = pk_->ws; P.lo = 0; P.hi = 0; P.pad0 = 0; P.pad1 = 0; unsigned char* const ws = P.ws; (void)ws
#define W_MOD ((float*)(ws + WS_MOD))
#define W_XC ((float*)(ws + WS_XC))
#define W_XB ((bf16*)(ws + WS_XB))
#define W_HM ((bf16*)(ws + WS_HM))
#define W_YAB ((bf16*)(ws + WS_YAB))
#define W_Y ((bf16*)(ws + WS_Y))
#define W_PART ((bf16*)(ws + WS_PART))
#define W_A5 ((bf16*)(ws + WS_A5))
#define W_U ((bf16*)(ws + WS_U))
#define W_ZBT ((bf16*)(ws + WS_U + 50 * MiB))
#define W_F32U ((float*)(ws + WS_U))

    PHASE_BEGIN { LOCALS(); p0_prologue(F, P); }
    SEAM();
    PHASE_BEGIN { LOCALS(); p1_phase(F, P); }
    SEAM();
    PHASE_BEGIN { LOCALS(); row_phase<0, false, false>(F, nullptr, nullptr, 0, MROWS, P.in[0], P.in[2], nullptr, nullptr, nullptr, nullptr, 0, true, P.in[6], W_MOD, 0, 1, W_HM, nullptr); }
    SEAM();
    { constexpr int layer = 0;
        constexpr int jj = layer >> 1; constexpr bool LASTL = (layer == DEPTH - 1); constexpr int NROWS_L = LASTL ? NLAT : MROWS;
        if ((layer & 1) == 0) {
            PHASE_BEGIN { LOCALS();
                pg8::OrderE1 S{F.G, F.bid, (const char*)W_HM, (const char*)(ws + WS_WIN + jj * SZ_WIN)};
                typedef pg8::EpiQKVZ<(DUP_SUB == 5 && layer == 0) ? 3 : 1> EpiE1; EpiE1 E{W_U, W_ZBT, (const float*)(ws + WS_TAB)};
                pg8::gemm_phase<EpiE1, pg8::OrderE1, true>(F.lds, F.tid, pg8::Gemm{DM, DM}, S, E);
            }
            SEAM();
            PHASE_BEGIN { LOCALS();
                for (int rr_ = 0; rr_ < ((DUP_SUB == 1 && layer == 0) ? 2 : 1); ++rr_) for (int c = F.bid; c < 1024; c += F.G) hyena_unit(F, P, jj, c);
                for (int rr_ = 0; rr_ < ((DUP_SUB == 2 && layer == 0) ? 2 : 1); ++rr_) for (int au = F.bid; au < 528; au += F.G) attn_unit(F, P, jj, au);
            }
            SEAM();
            PHASE_BEGIN { LOCALS(); ybt_transpose_phase(F, P); }
            SEAM();
            PHASE_BEGIN { LOCALS();
                pg8::OrderSplit S; S.init(W_YAB, ws + WS_WOUT + jj * SZ_WOUT, DM, DM, DM, DM, 1, F.G, F.bid);
                pg8::EpiYb E{W_Y, DM, nullptr, W_PART};
                pg8::gemm_phase<pg8::EpiYb, pg8::OrderSplit, true>(F.lds, F.tid, pg8::Gemm{DM, DM}, S, E);
            }
            SEAM();
        } else {
            PHASE_BEGIN { LOCALS();
                pg8::OrderS5 S{F.G, F.bid, 256 / 64, (const char*)W_A5, (const char*)(ws + WS_WW + (size_t)jj * S5G * 256 * 256 * 2), (size_t)256 * 256 * 2, 1};
                pg8::EpiBf16g E{W_U, S5ROWS};
                pg8::gemm_phase<pg8::EpiBf16g, pg8::OrderS5, true>(F.lds, F.tid, pg8::Gemm{256, S5K}, S, E);
            }
            SEAM();
            PHASE_BEGIN { LOCALS(); s5_carry_phase(F, P, jj); }
            SEAM();
            PHASE_BEGIN { LOCALS();
                pg8::OrderS5 S{F.G, F.bid, S5K / 64, (const char*)W_A5, (const char*)(ws + WS_TT + (size_t)jj * S5G * 256 * 512 * 2), (size_t)256 * 512 * 2, 0};
                pg8::EpiS5G E{W_Y};
                pg8::gemm_phase<pg8::EpiS5G, pg8::OrderS5, true>(F.lds, F.tid, pg8::Gemm{S5K, S5K}, S, E);
            }
            SEAM();
            PHASE_BEGIN { LOCALS();
                pg8::OrderSplit S; S.init(W_Y, ws + WS_WGLU + jj * SZ_WGLU, 2 * DM, DM, DM, DM, LASTL ? 0 : 1, F.G, F.bid, 1, WGM_O4);
                pg8::EpiGlu E{W_U, P.in[32] + (size_t)jj * 2 * DM, W_PART};
                pg8::gemm_phase<pg8::EpiGlu, pg8::OrderSplit, true, 1>(F.lds, F.tid, pg8::Gemm{DM, DM}, S, E);
            }
            SEAM();
        }
        PHASE_BEGIN { LOCALS();
            const float* modl = W_MOD + (size_t)layer * 3 * NMOD * DM; const float* ngl = P.in[6] + (size_t)layer * 4 * DM;
            if (layer == 0) { if ((layer & 1) == 0) row_phase<1, false, true>(F, W_Y, W_PART, 8, NROWS_L, P.in[0], P.in[2], W_XB, nullptr, ngl + 1 * DM, modl, 2, true, ngl + 2 * DM, modl, 3, 4, W_HM, nullptr); }
            else if ((layer & 1) == 0) row_phase<1, true, true>(F, W_Y, W_PART, 8, NROWS_L, W_XB, nullptr, W_XB, nullptr, ngl + 1 * DM, modl, 2, true, ngl + 2 * DM, modl, 3, 4, W_HM, nullptr);
            else row_phase<3, true, true>(F, W_U, W_PART, 8, NROWS_L, W_XB, nullptr, W_XB, nullptr, ngl + 1 * DM, modl, 2, true, ngl + 2 * DM, modl, 3, 4, W_HM, nullptr);
        }
        SEAM();
        PHASE_BEGIN { LOCALS();
            if (STAGGER_US > 0) { const unsigned long long t0_ = __builtin_amdgcn_s_memrealtime(); const unsigned long long dl_ = (unsigned long long)(((F.bid >> 3) & 3) * STAGGER_US * 100); while (__builtin_amdgcn_s_memrealtime() - t0_ < dl_) __builtin_amdgcn_s_sleep(4); }
            pg8::OrderUp S{F.G, F.bid, LASTL ? 66 : 70, (const char*)W_HM, (const char*)(ws + WS_WUP + layer * SZ_WUP), WGM_C2};
            typedef pg8::EpiUpGlu<(DUP_SUB == 3 && layer == 0) ? 2 : 1> EpiUp; EpiUp E{W_A5, P.in[8] + (size_t)layer * 3 * DFF2, P.in[9] + (size_t)layer * DFF2, (LAS float*)(F.lds + AUX_OFF)};
            pg8::gemm_phase<EpiUp, pg8::OrderUp, true>(F.lds, F.tid, pg8::Gemm{DM, DM}, S, E);
        }
        SEAM();
        PHASE_BEGIN { LOCALS();
            pg8::OrderSplit S; S.init(W_A5, ws + WS_WDOWN + layer * SZ_WDOWN, DM, DFF, DFF, DFF, LASTL ? 0 : 1, F.G, F.bid, 0, WGM_C4, REV_C4);
            pg8::EpiYb E{W_Y, DM, nullptr, W_PART};
            pg8::gemm_phase<pg8::EpiYb, pg8::OrderSplit, true>(F.lds, F.tid, pg8::Gemm{DFF, DFF}, S, E);
        }
        SEAM();
        PHASE_BEGIN { LOCALS();
            const float* modl = W_MOD + (size_t)layer * 3 * NMOD * DM; const float* ngl = P.in[6] + (size_t)layer * 4 * DM;
            if (LASTL) row_phase<1, true, false>(F, W_Y, W_PART, 15, NROWS_L, W_XB, nullptr, P.out, nullptr, ngl + 3 * DM, modl, 5, false, nullptr, nullptr, 0, 1, nullptr, nullptr);
            else row_phase<1, true, true>(F, W_Y, W_PART, 15, NROWS_L, W_XB, nullptr, W_XB, nullptr, ngl + 3 * DM, modl, 5, true, ngl + 4 * DM, modl + 3 * NMOD * DM, 0, 1, ((layer & 1) == 0) ? nullptr : W_HM, ((layer & 1) == 0) ? W_A5 : nullptr);
        }
        SEAM();
    }
    { constexpr int layer = 1;
        constexpr int jj = layer >> 1; constexpr bool LASTL = (layer == DEPTH - 1); constexpr int NROWS_L = LASTL ? NLAT : MROWS;
        if ((layer & 1) == 0) {
            PHASE_BEGIN { LOCALS();
                pg8::OrderE1 S{F.G, F.bid, (const char*)W_HM, (const char*)(ws + WS_WIN + jj * SZ_WIN)};
                typedef pg8::EpiQKVZ<(DUP_SUB == 5 && layer == 0) ? 3 : 1> EpiE1; EpiE1 E{W_U, W_ZBT, (const float*)(ws + WS_TAB)};
                pg8::gemm_phase<EpiE1, pg8::OrderE1, true>(F.lds, F.tid, pg8::Gemm{DM, DM}, S, E);
            }
            SEAM();
            PHASE_BEGIN { LOCALS();
                for (int rr_ = 0; rr_ < ((DUP_SUB == 1 && layer == 0) ? 2 : 1); ++rr_) for (int c = F.bid; c < 1024; c += F.G) hyena_unit(F, P, jj, c);
                for (int rr_ = 0; rr_ < ((DUP_SUB == 2 && layer == 0) ? 2 : 1); ++rr_) for (int au = F.bid; au < 528; au += F.G) attn_unit(F, P, jj, au);
            }
            SEAM();
            PHASE_BEGIN { LOCALS(); ybt_transpose_phase(F, P); }
            SEAM();
            PHASE_BEGIN { LOCALS();
                pg8::OrderSplit S; S.init(W_YAB, ws + WS_WOUT + jj * SZ_WOUT, DM, DM, DM, DM, 1, F.G, F.bid);
                pg8::EpiYb E{W_Y, DM, nullptr, W_PART};
                pg8::gemm_phase<pg8::EpiYb, pg8::OrderSplit, true>(F.lds, F.tid, pg8::Gemm{DM, DM}, S, E);
            }
            SEAM();
        } else {
            PHASE_BEGIN { LOCALS();
                pg8::OrderS5 S{F.G, F.bid, 256 / 64, (const char*)W_A5, (const char*)(ws + WS_WW + (size_t)jj * S5G * 256 * 256 * 2), (size_t)256 * 256 * 2, 1};
                pg8::EpiBf16g E{W_U, S5ROWS};
                pg8::gemm_phase<pg8::EpiBf16g, pg8::OrderS5, true>(F.lds, F.tid, pg8::Gemm{256, S5K}, S, E);
            }
            SEAM();
            PHASE_BEGIN { LOCALS(); s5_carry_phase(F, P, jj); }
            SEAM();
            PHASE_BEGIN { LOCALS();
                pg8::OrderS5 S{F.G, F.bid, S5K / 64, (const char*)W_A5, (const char*)(ws + WS_TT + (size_t)jj * S5G * 256 * 512 * 2), (size_t)256 * 512 * 2, 0};
                pg8::EpiS5G E{W_Y};
                pg8::gemm_phase<pg8::EpiS5G, pg8::OrderS5, true>(F.lds, F.tid, pg8::Gemm{S5K, S5K}, S, E);
            }
            SEAM();
            PHASE_BEGIN { LOCALS();
                pg8::OrderSplit S; S.init(W_Y, ws + WS_WGLU + jj * SZ_WGLU, 2 * DM, DM, DM, DM, LASTL ? 0 : 1, F.G, F.bid, 1, WGM_O4);
                pg8::EpiGlu E{W_U, P.in[32] + (size_t)jj * 2 * DM, W_PART};
                pg8::gemm_phase<pg8::EpiGlu, pg8::OrderSplit, true, 1>(F.lds, F.tid, pg8::Gemm{DM, DM}, S, E);
            }
            SEAM();
        }
        PHASE_BEGIN { LOCALS();
            const float* modl = W_MOD + (size_t)layer * 3 * NMOD * DM; const float* ngl = P.in[6] + (size_t)layer * 4 * DM;
            if (layer == 0) { if ((layer & 1) == 0) row_phase<1, false, true>(F, W_Y, W_PART, 8, NROWS_L, P.in[0], P.in[2], W_XB, nullptr, ngl + 1 * DM, modl, 2, true, ngl + 2 * DM, modl, 3, 4, W_HM, nullptr); }
            else if ((layer & 1) == 0) row_phase<1, true, true>(F, W_Y, W_PART, 8, NROWS_L, W_XB, nullptr, W_XB, nullptr, ngl + 1 * DM, modl, 2, true, ngl + 2 * DM, modl, 3, 4, W_HM, nullptr);
            else row_phase<3, true, true>(F, W_U, W_PART, 8, NROWS_L, W_XB, nullptr, W_XB, nullptr, ngl + 1 * DM, modl, 2, true, ngl + 2 * DM, modl, 3, 4, W_HM, nullptr);
        }
        SEAM();
        PHASE_BEGIN { LOCALS();
            if (STAGGER_US > 0) { const unsigned long long t0_ = __builtin_amdgcn_s_memrealtime(); const unsigned long long dl_ = (unsigned long long)(((F.bid >> 3) & 3) * STAGGER_US * 100); while (__builtin_amdgcn_s_memrealtime() - t0_ < dl_) __builtin_amdgcn_s_sleep(4); }
            pg8::OrderUp S{F.G, F.bid, LASTL ? 66 : 70, (const char*)W_HM, (const char*)(ws + WS_WUP + layer * SZ_WUP), WGM_C2};
            typedef pg8::EpiUpGlu<(DUP_SUB == 3 && layer == 0) ? 2 : 1> EpiUp; EpiUp E{W_A5, P.in[8] + (size_t)layer * 3 * DFF2, P.in[9] + (size_t)layer * DFF2, (LAS float*)(F.lds + AUX_OFF)};
            pg8::gemm_phase<EpiUp, pg8::OrderUp, true>(F.lds, F.tid, pg8::Gemm{DM, DM}, S, E);
        }
        SEAM();
        PHASE_BEGIN { LOCALS();
            pg8::OrderSplit S; S.init(W_A5, ws + WS_WDOWN + layer * SZ_WDOWN, DM, DFF, DFF, DFF, LASTL ? 0 : 1, F.G, F.bid, 0, WGM_C4, REV_C4);
            pg8::EpiYb E{W_Y, DM, nullptr, W_PART};
            pg8::gemm_phase<pg8::EpiYb, pg8::OrderSplit, true>(F.lds, F.tid, pg8::Gemm{DFF, DFF}, S, E);
        }
        SEAM();
        PHASE_BEGIN { LOCALS();
            const float* modl = W_MOD + (size_t)layer * 3 * NMOD * DM; const float* ngl = P.in[6] + (size_t)layer * 4 * DM;
            if (LASTL) row_phase<1, true, false>(F, W_Y, W_PART, 15, NROWS_L, W_XB, nullptr, P.out, nullptr, ngl + 3 * DM, modl, 5, false, nullptr, nullptr, 0, 1, nullptr, nullptr);
            else row_phase<1, true, true>(F, W_Y, W_PART, 15, NROWS_L, W_XB, nullptr, W_XB, nullptr, ngl + 3 * DM, modl, 5, true, ngl + 4 * DM, modl + 3 * NMOD * DM, 0, 1, ((layer & 1) == 0) ? nullptr : W_HM, ((layer & 1) == 0) ? W_A5 : nullptr);
        }
        SEAM();
    }
    { constexpr int layer = 2;
        constexpr int jj = layer >> 1; constexpr bool LASTL = (layer == DEPTH - 1); constexpr int NROWS_L = LASTL ? NLAT : MROWS;
        if ((layer & 1) == 0) {
            PHASE_BEGIN { LOCALS();
                pg8::OrderE1 S{F.G, F.bid, (const char*)W_HM, (const char*)(ws + WS_WIN + jj * SZ_WIN)};
                typedef pg8::EpiQKVZ<(DUP_SUB == 5 && layer == 0) ? 3 : 1> EpiE1; EpiE1 E{W_U, W_ZBT, (const float*)(ws + WS_TAB)};
                pg8::gemm_phase<EpiE1, pg8::OrderE1, true>(F.lds, F.tid, pg8::Gemm{DM, DM}, S, E);
            }
            SEAM();
            PHASE_BEGIN { LOCALS();
                for (int rr_ = 0; rr_ < ((DUP_SUB == 1 && layer == 0) ? 2 : 1); ++rr_) for (int c = F.bid; c < 1024; c += F.G) hyena_unit(F, P, jj, c);
                for (int rr_ = 0; rr_ < ((DUP_SUB == 2 && layer == 0) ? 2 : 1); ++rr_) for (int au = F.bid; au < 528; au += F.G) attn_unit(F, P, jj, au);
            }
            SEAM();
            PHASE_BEGIN { LOCALS(); ybt_transpose_phase(F, P); }
            SEAM();
            PHASE_BEGIN { LOCALS();
                pg8::OrderSplit S; S.init(W_YAB, ws + WS_WOUT + jj * SZ_WOUT, DM, DM, DM, DM, 1, F.G, F.bid);
                pg8::EpiYb E{W_Y, DM, nullptr, W_PART};
                pg8::gemm_phase<pg8::EpiYb, pg8::OrderSplit, true>(F.lds, F.tid, pg8::Gemm{DM, DM}, S, E);
            }
            SEAM();
        } else {
            PHASE_BEGIN { LOCALS();
                pg8::OrderS5 S{F.G, F.bid, 256 / 64, (const char*)W_A5, (const char*)(ws + WS_WW + (size_t)jj * S5G * 256 * 256 * 2), (size_t)256 * 256 * 2, 1};
                pg8::EpiBf16g E{W_U, S5ROWS};
                pg8::gemm_phase<pg8::EpiBf16g, pg8::OrderS5, true>(F.lds, F.tid, pg8::Gemm{256, S5K}, S, E);
            }
            SEAM();
            PHASE_BEGIN { LOCALS(); s5_carry_phase(F, P, jj); }
            SEAM();
            PHASE_BEGIN { LOCALS();
                pg8::OrderS5 S{F.G, F.bid, S5K / 64, (const char*)W_A5, (const char*)(ws + WS_TT + (size_t)jj * S5G * 256 * 512 * 2), (size_t)256 * 512 * 2, 0};
                pg8::EpiS5G E{W_Y};
                pg8::gemm_phase<pg8::EpiS5G, pg8::OrderS5, true>(F.lds, F.tid, pg8::Gemm{S5K, S5K}, S, E);
            }
            SEAM();
            PHASE_BEGIN { LOCALS();
                pg8::OrderSplit S; S.init(W_Y, ws + WS_WGLU + jj * SZ_WGLU, 2 * DM, DM, DM, DM, LASTL ? 0 : 1, F.G, F.bid, 1, WGM_O4);
                pg8::EpiGlu E{W_U, P.in[32] + (size_t)jj * 2 * DM, W_PART};
                pg8::gemm_phase<pg8::EpiGlu, pg8::OrderSplit, true, 1>(F.lds, F.tid, pg8::Gemm{DM, DM}, S, E);
            }
            SEAM();
        }
        PHASE_BEGIN { LOCALS();
            const float* modl = W_MOD + (size_t)layer * 3 * NMOD * DM; const float* ngl = P.in[6] + (size_t)layer * 4 * DM;
            if (layer == 0) { if ((layer & 1) == 0) row_phase<1, false, true>(F, W_Y, W_PART, 8, NROWS_L, P.in[0], P.in[2], W_XB, nullptr, ngl + 1 * DM, modl, 2, true, ngl + 2 * DM, modl, 3, 4, W_HM, nullptr); }
            else if ((layer & 1) == 0) row_phase<1, true, true>(F, W_Y, W_PART, 8, NROWS_L, W_XB, nullptr, W_XB, nullptr, ngl + 1 * DM, modl, 2, true, ngl + 2 * DM, modl, 3, 4, W_HM, nullptr);
            else row_phase<3, true, true>(F, W_U, W_PART, 8, NROWS_L, W_XB, nullptr, W_XB, nullptr, ngl + 1 * DM, modl, 2, true, ngl + 2 * DM, modl, 3, 4, W_HM, nullptr);
        }
        SEAM();
        PHASE_BEGIN { LOCALS();
            if (STAGGER_US > 0) { const unsigned long long t0_ = __builtin_amdgcn_s_memrealtime(); const unsigned long long dl_ = (unsigned long long)(((F.bid >> 3) & 3) * STAGGER_US * 100); while (__builtin_amdgcn_s_memrealtime() - t0_ < dl_) __builtin_amdgcn_s_sleep(4); }
            pg8::OrderUp S{F.G, F.bid, LASTL ? 66 : 70, (const char*)W_HM, (const char*)(ws + WS_WUP + layer * SZ_WUP), WGM_C2};
            typedef pg8::EpiUpGlu<(DUP_SUB == 3 && layer == 0) ? 2 : 1> EpiUp; EpiUp E{W_A5, P.in[8] + (size_t)layer * 3 * DFF2, P.in[9] + (size_t)layer * DFF2, (LAS float*)(F.lds + AUX_OFF)};
            pg8::gemm_phase<EpiUp, pg8::OrderUp, true>(F.lds, F.tid, pg8::Gemm{DM, DM}, S, E);
        }
        SEAM();
        PHASE_BEGIN { LOCALS();
            pg8::OrderSplit S; S.init(W_A5, ws + WS_WDOWN + layer * SZ_WDOWN, DM, DFF, DFF, DFF, LASTL ? 0 : 1, F.G, F.bid, 0, WGM_C4, REV_C4);
            pg8::EpiYb E{W_Y, DM, nullptr, W_PART};
            pg8::gemm_phase<pg8::EpiYb, pg8::OrderSplit, true>(F.lds, F.tid, pg8::Gemm{DFF, DFF}, S, E);
        }
        SEAM();
        PHASE_BEGIN { LOCALS();
            const float* modl = W_MOD + (size_t)layer * 3 * NMOD * DM; const float* ngl = P.in[6] + (size_t)layer * 4 * DM;
            if (LASTL) row_phase<1, true, false>(F, W_Y, W_PART, 15, NROWS_L, W_XB, nullptr, P.out, nullptr, ngl + 3 * DM, modl, 5, false, nullptr, nullptr, 0, 1, nullptr, nullptr);
            else row_phase<1, true, true>(F, W_Y, W_PART, 15, NROWS_L, W_XB, nullptr, W_XB, nullptr, ngl + 3 * DM, modl, 5, true, ngl + 4 * DM, modl + 3 * NMOD * DM, 0, 1, ((layer & 1) == 0) ? nullptr : W_HM, ((layer & 1) == 0) ? W_A5 : nullptr);
        }
        SEAM();
    }
    { constexpr int layer = 3;
        constexpr int jj = layer >> 1; constexpr bool LASTL = (layer == DEPTH - 1); constexpr int NROWS_L = LASTL ? NLAT : MROWS;
        if ((layer & 1) == 0) {
            PHASE_BEGIN { LOCALS();
                pg8::OrderE1 S{F.G, F.bid, (const char*)W_HM, (const char*)(ws + WS_WIN + jj * SZ_WIN)};
                typedef pg8::EpiQKVZ<(DUP_SUB == 5 && layer == 0) ? 3 : 1> EpiE1; EpiE1 E{W_U, W_ZBT, (const float*)(ws + WS_TAB)};
                pg8::gemm_phase<EpiE1, pg8::OrderE1, true>(F.lds, F.tid, pg8::Gemm{DM, DM}, S, E);
            }
            SEAM();
            PHASE_BEGIN { LOCALS();
                for (int rr_ = 0; rr_ < ((DUP_SUB == 1 && layer == 0) ? 2 : 1); ++rr_) for (int c = F.bid; c < 1024; c += F.G) hyena_unit(F, P, jj, c);
                for (int rr_ = 0; rr_ < ((DUP_SUB == 2 && layer == 0) ? 2 : 1); ++rr_) for (int au = F.bid; au < 528; au += F.G) attn_unit(F, P, jj, au);
            }
            SEAM();
            PHASE_BEGIN { LOCALS(); ybt_transpose_phase(F, P); }
            SEAM();
            PHASE_BEGIN { LOCALS();
                pg8::OrderSplit S; S.init(W_YAB, ws + WS_WOUT + jj * SZ_WOUT, DM, DM, DM, DM, 1, F.G, F.bid);
                pg8::EpiYb E{W_Y, DM, nullptr, W_PART};
                pg8::gemm_phase<pg8::EpiYb, pg8::OrderSplit, true>(F.lds, F.tid, pg8::Gemm{DM, DM}, S, E);
            }
            SEAM();
        } else {
            PHASE_BEGIN { LOCALS();
                pg8::OrderS5 S{F.G, F.bid, 256 / 64, (const char*)W_A5, (const char*)(ws + WS_WW + (size_t)jj * S5G * 256 * 256 * 2), (size_t)256 * 256 * 2, 1};
                pg8::EpiBf16g E{W_U, S5ROWS};
                pg8::gemm_phase<pg8::EpiBf16g, pg8::OrderS5, true>(F.lds, F.tid, pg8::Gemm{256, S5K}, S, E);
            }
            SEAM();
            PHASE_BEGIN { LOCALS(); s5_carry_phase(F, P, jj); }
            SEAM();
            PHASE_BEGIN { LOCALS();
                pg8::OrderS5 S{F.G, F.bid, S5K / 64, (const char*)W_A5, (const char*)(ws + WS_TT + (size_t)jj * S5G * 256 * 512 * 2), (size_t)256 * 512 * 2, 0};
                pg8::EpiS5G E{W_Y};
                pg8::gemm_phase<pg8::EpiS5G, pg8::OrderS5, true>(F.lds, F.tid, pg8::Gemm{S5K, S5K}, S, E);
            }
            SEAM();
            PHASE_BEGIN { LOCALS();
                pg8::OrderSplit S; S.init(W_Y, ws + WS_WGLU + jj * SZ_WGLU, 2 * DM, DM, DM, DM, LASTL ? 0 : 1, F.G, F.bid, 1, WGM_O4);
                pg8::EpiGlu E{W_U, P.in[32] + (size_t)jj * 2 * DM, W_PART};
                pg8::gemm_phase<pg8::EpiGlu, pg8::OrderSplit, true, 1>(F.lds, F.tid, pg8::Gemm{DM, DM}, S, E);
            }
            SEAM();
        }
        PHASE_BEGIN { LOCALS();
            const float* modl = W_MOD + (size_t)layer * 3 * NMOD * DM; const float* ngl = P.in[6] + (size_t)layer * 4 * DM;
            if (layer == 0) { if ((layer & 1) == 0) row_phase<1, false, true>(F, W_Y, W_PART, 8, NROWS_L, P.in[0], P.in[2], W_XB, nullptr, ngl + 1 * DM, modl, 2, true, ngl + 2 * DM, modl, 3, 4, W_HM, nullptr); }
            else if ((layer & 1) == 0) row_phase<1, true, true>(F, W_Y, W_PART, 8, NROWS_L, W_XB, nullptr, W_XB, nullptr, ngl + 1 * DM, modl, 2, true, ngl + 2 * DM, modl, 3, 4, W_HM, nullptr);
            else row_phase<3, true, true>(F, W_U, W_PART, 8, NROWS_L, W_XB, nullptr, W_XB, nullptr, ngl + 1 * DM, modl, 2, true, ngl + 2 * DM, modl, 3, 4, W_HM, nullptr);
        }
        SEAM();
        PHASE_BEGIN { LOCALS();
            if (STAGGER_US > 0) { const unsigned long long t0_ = __builtin_amdgcn_s_memrealtime(); const unsigned long long dl_ = (unsigned long long)(((F.bid >> 3) & 3) * STAGGER_US * 100); while (__builtin_amdgcn_s_memrealtime() - t0_ < dl_) __builtin_amdgcn_s_sleep(4); }
            pg8::OrderUp S{F.G, F.bid, LASTL ? 66 : 70, (const char*)W_HM, (const char*)(ws + WS_WUP + layer * SZ_WUP), WGM_C2};
            typedef pg8::EpiUpGlu<(DUP_SUB == 3 && layer == 0) ? 2 : 1> EpiUp; EpiUp E{W_A5, P.in[8] + (size_t)layer * 3 * DFF2, P.in[9] + (size_t)layer * DFF2, (LAS float*)(F.lds + AUX_OFF)};
            pg8::gemm_phase<EpiUp, pg8::OrderUp, true>(F.lds, F.tid, pg8::Gemm{DM, DM}, S, E);
        }
        SEAM();
        PHASE_BEGIN { LOCALS();
            pg8::OrderSplit S; S.init(W_A5, ws + WS_WDOWN + layer * SZ_WDOWN, DM, DFF, DFF, DFF, LASTL ? 0 : 1, F.G, F.bid, 0, WGM_C4, REV_C4);
            pg8::EpiYb E{W_Y, DM, nullptr, W_PART};
            pg8::gemm_phase<pg8::EpiYb, pg8::OrderSplit, true>(F.lds, F.tid, pg8::Gemm{DFF, DFF}, S, E);
        }
        SEAM();
        PHASE_BEGIN { LOCALS();
            const float* modl = W_MOD + (size_t)layer * 3 * NMOD * DM; const float* ngl = P.in[6] + (size_t)layer * 4 * DM;
            if (LASTL) row_phase<1, true, false>(F, W_Y, W_PART, 15, NROWS_L, W_XB, nullptr, P.out, nullptr, ngl + 3 * DM, modl, 5, false, nullptr, nullptr, 0, 1, nullptr, nullptr);
            else row_phase<1, true, true>(F, W_Y, W_PART, 15, NROWS_L, W_XB, nullptr, W_XB, nullptr, ngl + 3 * DM, modl, 5, true, ngl + 4 * DM, modl + 3 * NMOD * DM, 0, 1, ((layer & 1) == 0) ? nullptr : W_HM, ((layer & 1) == 0) ? W_A5 : nullptr);
        }
        SEAM();
    }
#undef RUNP
#undef SEAM
}

extern "C" void kernel_launch(void* const* d_in, const int* in_sizes, int n_in, void* d_out, int out_size, void* d_ws, size_t ws_size, hipStream_t stream) {
    static int grid = 0;
    if (grid == 0) {
        if (n_in != 33 || out_size != NLAT * DM || ws_size < WS_END) { fprintf(stderr, "kernel_launch: unexpected problem (n_in %d, out %d, ws %zu < %zu)\n", n_in, out_size, ws_size, (size_t)WS_END); grid = -1; return; }
        int dev = 0, cus = 0, per_cu = 0;
        if (hipGetDevice(&dev) != hipSuccess || hipDeviceGetAttribute(&cus, hipDeviceAttributeMultiprocessorCount, dev) != hipSuccess) { grid = -1; return; }
        if (hipFuncSetAttribute((const void*)hybrid_fwd, hipFuncAttributeMaxDynamicSharedMemorySize, LDS_BYTES) != hipSuccess) { fprintf(stderr, "kernel_launch: hipFuncSetAttribute failed\n"); grid = -1; return; }
        if (hipOccupancyMaxActiveBlocksPerMultiprocessor(&per_cu, (const void*)hybrid_fwd, NTHR, LDS_BYTES) != hipSuccess || per_cu < 1) fprintf(stderr, "kernel_launch: occupancy query reports %d blocks per CU\n", per_cu);
        (void)hipGetLastError();
        grid = cus;
    }
    if (grid < 0) return;
    if (hipMemsetAsync((char*)d_ws + WS_CTL, 0, CTL_BYTES, stream) != hipSuccess) return;
    Params p{};
    for (int i = 0; i < 33; ++i) p.in[i] = (const float*)d_in[i];
    p.out = (float*)d_out; p.ws = (unsigned char*)d_ws; p.pad0 = 0; p.pad1 = 0;
#ifdef MK_PER_PHASE
    for (int ph = 0; ph < N_PHASES; ++ph) { p.lo = ph; p.hi = ph + 1; hipLaunchKernelGGL(hybrid_fwd, dim3(grid), dim3(NTHR), LDS_BYTES, stream, p); }
#else
    p.lo = 0; p.hi = N_PHASES;
    hipLaunchKernelGGL(hybrid_fwd, dim3(grid), dim3(NTHR), LDS_BYTES, stream, p);
#endif
    const hipError_t le = hipPeekAtLastError();
    if (le != hipSuccess) fprintf(stderr, "kernel_launch: launch failed: %s\n", hipGetErrorName(le));
}
```

```cpp
#include <hip/hip_runtime.h>
#include <cstdio>
#include <cstdint>
namespace pg8 {
#define PG8_LAS __attribute__((address_space(3)))
typedef unsigned short bf16_t;
typedef short bf16x8 __attribute__((ext_vector_type(8)));
typedef float f32x4 __attribute__((ext_vector_type(4)));
typedef unsigned u32x4 __attribute__((ext_vector_type(4)));
typedef unsigned u32x2 __attribute__((ext_vector_type(2)));
constexpr int BM = 256, BK = 64, HALF = 128, HTB = HALF * BK * 2  , STAGE_BYTES = 8 * HTB, NXCD = 8, WGM = 4;

__host__ __device__ __forceinline__ int lds_byte(int r, int c) { const int st = (r >> 4) * 2 + (c >> 5), rr = r & 15, cc = c & 31, ob = rr * 64 + cc * 2; return st * 1024 + (ob ^ (((ob >> 9) & 1) << 5)); }
__host__ __device__ __forceinline__ void stage_rc(int b, int& R, int& C) { const int st = b / 1024, sb = b % 1024, swz = sb ^ (((sb >> 9) & 1) << 5); R = (st >> 1) * 16 + swz / 64; C = (st & 1) * 32 + (swz % 64) / 2; }
__host__ __device__ __forceinline__ int perm32(int rho) { const int n = rho >> 4, i = rho & 15; return 8 * (i >> 2) + 4 * n + (i & 3); }

struct Unit { int pm, pn, kind, nt; const char* a; const char* b; };
struct Gemm { int lda, ldb; };

__host__ __device__ __forceinline__ void tile_map(int wgid, int nM, int nN, int& pm, int& pn, const int wgm = WGM) {
    const int nwg = nM * nN;
    { const int q = nwg / NXCD, r = nwg % NXCD, xcd = wgid % NXCD, off = wgid / NXCD; wgid = (xcd < r ? xcd * (q + 1) : r * (q + 1) + (xcd - r) * q) + off; }
    const int nig = wgm * nN, gid = wgid / nig, fm = gid * wgm, gsz = (nM - fm) < wgm ? (nM - fm) : wgm;
    pm = fm + ((wgid % nig) % gsz); pn = (wgid % nig) / gsz;
}
struct StaticOrder {
    int nM, nN, nwg, G, c, nt; const char* A; const char* Bt; size_t ta, tb;
    __device__ void init(const void* A_, const void* Bt_, int M, int N, int K, int lda, int ldb, int G_, int c_) { nt = K / BK; nM = M / BM; nN = N / BM; nwg = nM * nN; G = G_; c = c_; A = (const char*)A_; Bt = (const char*)Bt_; ta = (size_t)BM * lda * 2; tb = (size_t)BM * ldb * 2; }
    __device__ bool next(int i, Unit& u) const {
        const long L = (long)i * G + c; if (L >= nwg) return false;
        tile_map((int)L, nM, nN, u.pm, u.pn); u.kind = 0; u.nt = nt; u.a = A + (size_t)u.pm * ta; u.b = Bt + (size_t)u.pn * tb; return true;
    }
};

__device__ __forceinline__ unsigned cvt_pk_bf16(float lo, float hi) { unsigned r; asm volatile("v_cvt_pk_bf16_f32 %0, %1, %2" : "=v"(r) : "v"(lo), "v"(hi)); return r; }

template <class Epi, class Sched, bool ALIGN_EPI, int AMODE = 0>
__device__ __forceinline__ void gemm_phase(PG8_LAS unsigned char* lds, const int tid, const Gemm g, const Sched& S, const Epi& E) {
    const int wid = __builtin_amdgcn_readfirstlane(tid >> 6), lane = tid & 63, wr = wid >> 2, wc = wid & 3, fr = lane & 15, fq = lane >> 4;
    unsigned voffA[2], voffB[2];
#pragma unroll
    for (int i = 0; i < 2; ++i) { int R, C; stage_rc(tid * 16 + i * 8192, R, C); const int Rb = Epi::PERM ? ((R & ~31) + perm32(R & 31)) : R;
        voffA[i] = AMODE == 1 ? (unsigned)((C >> 4) * (1280 * 256) + (R >> 4) * 256 + (R & 15) * 16 + (C & 15)) * 2u : (unsigned)(R * g.lda + C) * 2u; voffB[i] = (unsigned)(Rb * g.ldb + C) * 2u; }
    const size_t kstepB = (size_t)(BK * 2), kstepA = AMODE == 1 ? (size_t)4 * 1280 * 256 * 2 : (size_t)(BK * 2);
    const size_t hstepA = AMODE == 1 ? (size_t)8 * 256 * 2 : (size_t)HALF * g.lda * 2, hstepB = (size_t)HALF * g.ldb * 2;
    const unsigned ldsw = (unsigned)wid * 1024u;
    const int aoff = lds_byte(wr * 64 + fr, fq * 8), boff = lds_byte(wc * 32 + fr, fq * 8);
#define PG8_SA(b, h) (((b) * 2 + (h)) * HTB)
#define PG8_SB(b, h) ((4 + (b) * 2 + (h)) * HTB)
#define PG8_STAGE(bufoff, gbase, voff) do { _Pragma("unroll") for (int _i = 0; _i < 2; ++_i) \
        __builtin_amdgcn_global_load_lds((const unsigned*)((const char*)(gbase) + (voff)[_i]), (PG8_LAS unsigned*)(lds + (bufoff) + ldsw + _i * 8192), 16, 0, 0); } while (0)
#define PG8_LDA(dst, b, h) do { _Pragma("unroll") for (int m = 0; m < 4; ++m) _Pragma("unroll") for (int k = 0; k < 2; ++k) dst[m][k] = *(const PG8_LAS bf16x8*)(lds + PG8_SA(b, h) + aoff + m * 2048 + k * 1024); } while (0)
#define PG8_LDB(dst, b, h) do { _Pragma("unroll") for (int n = 0; n < 2; ++n) _Pragma("unroll") for (int k = 0; k < 2; ++k) dst[n][k] = *(const PG8_LAS bf16x8*)(lds + PG8_SB(b, h) + boff + n * 2048 + k * 1024); } while (0)
#define PG8_MMA(ai, bj, At, Bt) do { __builtin_amdgcn_s_setprio(1); _Pragma("unroll") for (int m = 0; m < 4; ++m) _Pragma("unroll") for (int n = 0; n < 2; ++n) _Pragma("unroll") for (int k = 0; k < 2; ++k) \
        acc[ai][bj][m][n] = __builtin_amdgcn_mfma_f32_16x16x32_bf16(Bt[n][k], At[m][k], acc[ai][bj][m][n], 0, 0, 0); __builtin_amdgcn_s_setprio(0); } while (0)
#define PG8_WAIT_V(n) asm volatile("s_waitcnt vmcnt(" #n ")" ::: "memory")
#define PG8_WAIT_L(n) asm volatile("s_waitcnt lgkmcnt(" #n ")" ::: "memory")
#define PG8_BAR __builtin_amdgcn_s_barrier()
#define PG8_SCHED __builtin_amdgcn_sched_barrier(0)
    Unit cur, nxt; int ui = 0;
    if (!S.next(0, cur)) return;
    f32x4 acc[2][2][4][2];
#pragma unroll
    for (int a = 0; a < 2; ++a)
#pragma unroll
        for (int b = 0; b < 2; ++b)
#pragma unroll
            for (int m = 0; m < 4; ++m)
#pragma unroll
                for (int n = 0; n < 2; ++n) acc[a][b][m][n] = (f32x4){0.f, 0.f, 0.f, 0.f};
    bf16x8 At[4][2], B0[2][2], B1[2][2];
    const char* cA = cur.a; const char* cB = cur.b;
    PG8_STAGE(PG8_SB(0, 0), cB, voffB); PG8_STAGE(PG8_SB(0, 1), cB + hstepB, voffB); PG8_STAGE(PG8_SA(0, 0), cA, voffA); PG8_STAGE(PG8_SA(0, 1), cA + hstepA, voffA);
    if (wr == 1) PG8_BAR;
    PG8_WAIT_V(2); PG8_BAR;
    PG8_STAGE(PG8_SB(1, 0), cB + kstepB, voffB); PG8_STAGE(PG8_SA(1, 0), cA + kstepA, voffA); PG8_STAGE(PG8_SB(1, 1), cB + hstepB + kstepB, voffB);
    PG8_WAIT_V(6); PG8_BAR;
    for (;;) {
        const bool has_next = S.next(ui + 1, nxt);
        const char* nA = has_next ? nxt.a : cA; const char* nB = has_next ? nxt.b : cB;
        const int nt = cur.nt;
        for (int t = 0; t < nt; t += 2) {
            const bool last = (t == nt - 2);
            const char* a1 = cA + (size_t)(t + 1) * kstepA;
            const char* a2 = last ? nA : cA + (size_t)(t + 2) * kstepA; const char* b2 = last ? nB : cB + (size_t)(t + 2) * kstepB;
            const char* a3 = a2 + kstepA; const char* b3 = b2 + kstepB;
            PG8_LDB(B0, 0, 0); PG8_LDB(B1, 0, 1); PG8_SCHED; PG8_LDA(At, 0, 0); PG8_STAGE(PG8_SA(1, 1), a1 + hstepA, voffA);
            PG8_WAIT_V(8); PG8_WAIT_L(0); PG8_BAR; PG8_MMA(0, 0, At, B0); PG8_MMA(0, 1, At, B1); PG8_BAR; PG8_SCHED;
            PG8_LDA(At, 0, 1); PG8_STAGE(PG8_SB(0, 0), b2, voffB); PG8_STAGE(PG8_SB(0, 1), b2 + hstepB, voffB); PG8_STAGE(PG8_SA(0, 0), a2, voffA);
            PG8_WAIT_V(8); PG8_WAIT_L(0); PG8_BAR; PG8_MMA(1, 0, At, B0); PG8_MMA(1, 1, At, B1); PG8_BAR; PG8_SCHED;
            PG8_LDB(B0, 1, 0); PG8_LDB(B1, 1, 1); PG8_SCHED; PG8_LDA(At, 1, 0); PG8_STAGE(PG8_SA(0, 1), a2 + hstepA, voffA);
            PG8_WAIT_V(8); PG8_WAIT_L(0); PG8_BAR; PG8_MMA(0, 0, At, B0); PG8_MMA(0, 1, At, B1); PG8_BAR; PG8_SCHED;
            PG8_LDA(At, 1, 1); PG8_STAGE(PG8_SB(1, 0), b3, voffB); PG8_STAGE(PG8_SB(1, 1), b3 + hstepB, voffB); PG8_STAGE(PG8_SA(1, 0), a3, voffA);
            PG8_WAIT_V(8); PG8_WAIT_L(0); PG8_BAR; PG8_MMA(1, 0, At, B0); PG8_MMA(1, 1, At, B1); PG8_BAR; PG8_SCHED;
        }
        if constexpr (ALIGN_EPI) { if (wr == 0) PG8_BAR; }
        { int fr_ = fr, fq_ = fq; asm volatile("" : "+v"(fr_), "+v"(fq_)); if constexpr (Epi::REP == 1) E(acc, cur, wr, wc, fr_, fq_); else { int nrep_ = Epi::REP; asm volatile("" : "+s"(nrep_)); _Pragma("unroll 1") for (int rep_e = 0; rep_e < nrep_; ++rep_e) E(acc, cur, wr, wc, fr_, fq_); } }
        if (!has_next) break;
#pragma unroll
        for (int a = 0; a < 2; ++a)
#pragma unroll
            for (int b = 0; b < 2; ++b)
#pragma unroll
                for (int m = 0; m < 4; ++m)
#pragma unroll
                    for (int n = 0; n < 2; ++n) acc[a][b][m][n] = (f32x4){0.f, 0.f, 0.f, 0.f};
        cur = nxt; cA = nA; cB = nB; ++ui;
        if constexpr (ALIGN_EPI) { if (wr == 1) PG8_BAR; }
    }
    PG8_WAIT_V(0);
    if constexpr (!ALIGN_EPI) { if (wr == 0) PG8_BAR; }
    PG8_BAR;
#undef PG8_SA
#undef PG8_SB
#undef PG8_STAGE
#undef PG8_LDA
#undef PG8_LDB
#undef PG8_MMA
#undef PG8_WAIT_V
#undef PG8_WAIT_L
#undef PG8_BAR
#undef PG8_SCHED
}
}
#ifndef WGM_E1
#define WGM_E1 4
#endif
constexpr int DM = 2048, NBATCH = 2, SEQ = 8192, DEPTH = 4, CTXL = 256;
constexpr int NLAT = NBATCH * SEQ, NCTX = NBATCH * CTXL, MROWS = NLAT + NCTX;
constexpr int DFF = 5504, DFF2 = 11008, NMOD = 6;
constexpr int QCOLS = 1024, KVC = 256, HYC = 3072, INCOLS = 4608, QKVC = 1536, HD = 128;
constexpr int S5G = 128, S5P = 64, S5J = 16, S5L = 16, S5ROWS = 1280, S5K = 512;
constexpr float RMS_EPS = 1e-6f;
constexpr float LOG2E = 1.4426950408889634f;
constexpr float QSCALE = 0.08838834764831845f * LOG2E;

typedef unsigned short bf16;
typedef float f32x4 __attribute__((ext_vector_type(4)));
typedef float f32x2 __attribute__((ext_vector_type(2)));
typedef float f32x16 __attribute__((ext_vector_type(16)));
typedef unsigned u32x4 __attribute__((ext_vector_type(4)));
typedef unsigned u32x2 __attribute__((ext_vector_type(2)));
typedef short bf16x8 __attribute__((ext_vector_type(8)));
typedef short s16x4 __attribute__((ext_vector_type(4)));
#define GAS __attribute__((address_space(1)))
#define LAS __attribute__((address_space(3)))
#define DI __device__ __forceinline__

DI unsigned f2bf(float f) { unsigned u = __builtin_bit_cast(unsigned, f); return (u + 0x7fffu + ((u >> 16) & 1u)) >> 16; }
DI unsigned pk2(float lo, float hi) { return pg8::cvt_pk_bf16(lo, hi); }
DI float bf2f(unsigned short b) { return __builtin_bit_cast(float, ((unsigned)b) << 16); }
DI float bflo(unsigned w) { return __builtin_bit_cast(float, w << 16); }
DI float bfhi(unsigned w) { return __builtin_bit_cast(float, w & 0xffff0000u); }
DI float fast_exp(float x) { return __builtin_amdgcn_exp2f(x * LOG2E); }
DI float sigmoidf_(float x) { return __builtin_amdgcn_rcpf(1.0f + fast_exp(-x)); }
DI float siluf_(float x) { return x * sigmoidf_(x); }
DI float gelu_tanh(float x) { const float z = 0.7978845608028654f * (x + 0.044715f * x * x * x); const float e = fast_exp(2.0f * z); const float th = 1.0f - 2.0f * __builtin_amdgcn_rcpf(e + 1.0f); return 0.5f * x * (1.0f + th); }

namespace pg8 {
typedef __bf16 bf16x2v_ __attribute__((ext_vector_type(2)));
__device__ __forceinline__ unsigned cvt_pk_c(float lo, float hi) { const f32x2 v = {lo, hi}; const bf16x2v_ b = __builtin_convertvector(v, bf16x2v_); return __builtin_bit_cast(unsigned, b); }
struct EpiF32g {
    static constexpr bool PERM = false; static constexpr int REP = 1;
    float* C; int ldc; const float* bias;
    __device__ __forceinline__ void operator()(const f32x4 (&acc)[2][2][4][2], const Unit& u, int wr, int wc, int fr, int fq) const {
        const int row0 = u.pm * BM + wr * 64 + fr, col0 = u.pn * BM + wc * 32 + 4 * fq;
        f32x4 bv[2][2];
#pragma unroll
        for (int bj = 0; bj < 2; ++bj)
#pragma unroll
            for (int n = 0; n < 2; ++n) bv[bj][n] = bias ? *(const f32x4*)(bias + col0 + bj * HALF + n * 16) : (f32x4){0.f, 0.f, 0.f, 0.f};
#pragma unroll
        for (int ai = 0; ai < 2; ++ai)
#pragma unroll
            for (int m = 0; m < 4; ++m) { float* rowp = C + (size_t)(row0 + ai * HALF + m * 16) * ldc + col0;
#pragma unroll
                for (int bj = 0; bj < 2; ++bj)
#pragma unroll
                    for (int n = 0; n < 2; ++n) *(f32x4*)(rowp + bj * HALF + n * 16) = acc[ai][bj][m][n] + bv[bj][n]; }
    }
};
struct EpiBf16g {
    static constexpr bool PERM = true; static constexpr int REP = 1;
    bf16_t* O; int ldc;
    __device__ __forceinline__ void operator()(const f32x4 (&acc)[2][2][4][2], const Unit& u, int wr, int wc, int fr, int fq) const {
        const int row0 = u.pm * BM + wr * 64 + fr, col0 = u.pn * BM + wc * 32 + 8 * fq;
#pragma unroll
        for (int ai = 0; ai < 2; ++ai)
#pragma unroll
            for (int m = 0; m < 4; ++m) { bf16_t* rowp = O + (size_t)(row0 + ai * HALF + m * 16) * ldc + col0;
#pragma unroll
                for (int bj = 0; bj < 2; ++bj) { const f32x4 v0 = acc[ai][bj][m][0], v1 = acc[ai][bj][m][1];
                    u32x4 w; w.x = cvt_pk_bf16(v0[0], v0[1]); w.y = cvt_pk_bf16(v0[2], v0[3]); w.z = cvt_pk_bf16(v1[0], v1[1]); w.w = cvt_pk_bf16(v1[2], v1[3]);
                    *(u32x4*)(rowp + bj * HALF) = w; } }
    }
};
struct EpiYb {
    static constexpr bool PERM = true; static constexpr int REP = 1;
    bf16_t* O; int ldc; const float* bias; bf16_t* part;
    __device__ __forceinline__ void operator()(const f32x4 (&acc)[2][2][4][2], const Unit& u, int wr, int wc, int fr, int fq) const {
        const int col0 = u.pn * BM + wc * 32 + 8 * fq;
        const bool addb = bias != nullptr && (u.kind == 0 || u.kind == 16);
        f32x4 bv[2][2];
#pragma unroll
        for (int bj = 0; bj < 2; ++bj)
#pragma unroll
            for (int n = 0; n < 2; ++n) bv[bj][n] = addb ? *(const f32x4*)(bias + col0 + bj * HALF + 4 * n) : (f32x4){0.f, 0.f, 0.f, 0.f};
        if (u.kind >= 16) {
            bf16_t* base = part + ((size_t)(u.kind - 16) * NCTX + (size_t)(u.pm - NLAT / BM) * BM + wr * 64 + fr) * ldc + col0;
#pragma unroll
            for (int ai = 0; ai < 2; ++ai)
#pragma unroll
                for (int m = 0; m < 4; ++m) { bf16_t* rowp = base + (size_t)(ai * HALF + m * 16) * ldc;
#pragma unroll
                    for (int bj = 0; bj < 2; ++bj) { const f32x4 v0 = acc[ai][bj][m][0] + bv[bj][0], v1 = acc[ai][bj][m][1] + bv[bj][1];
                        u32x4 w; w.x = cvt_pk_bf16(v0[0], v0[1]); w.y = cvt_pk_bf16(v0[2], v0[3]); w.z = cvt_pk_bf16(v1[0], v1[1]); w.w = cvt_pk_bf16(v1[2], v1[3]);
                        *(u32x4*)(rowp + bj * HALF) = w; } }
        } else {
            const int row0 = u.pm * BM + wr * 64 + fr;
#pragma unroll
            for (int ai = 0; ai < 2; ++ai)
#pragma unroll
                for (int m = 0; m < 4; ++m) { bf16_t* rowp = O + (size_t)(row0 + ai * HALF + m * 16) * ldc + col0;
#pragma unroll
                    for (int bj = 0; bj < 2; ++bj) { const f32x4 v0 = acc[ai][bj][m][0] + bv[bj][0], v1 = acc[ai][bj][m][1] + bv[bj][1];
                        u32x4 w; w.x = cvt_pk_bf16(v0[0], v0[1]); w.y = cvt_pk_bf16(v0[2], v0[3]); w.z = cvt_pk_bf16(v1[0], v1[1]); w.w = cvt_pk_bf16(v1[2], v1[3]);
                        *(u32x4*)(rowp + bj * HALF) = w; } }
        }
    }
};
struct EpiGlu {
    static constexpr bool PERM = true; static constexpr int REP = 1;
    bf16_t* O; const float* bias; bf16_t* part;
    __device__ __forceinline__ void operator()(const f32x4 (&acc)[2][2][4][2], const Unit& u, int wr, int wc, int fr, int fq) const {
        const int col0 = u.pn * BM + wc * 32 + 8 * fq;
        const bool addb = (u.kind == 0 || u.kind == 16);
        f32x4 ba[2], bg[2];
#pragma unroll
        for (int bj = 0; bj < 2; ++bj) { const int ch = (col0 + bj * HALF) >> 1; ba[bj] = addb ? *(const f32x4*)(bias + ch) : (f32x4){0.f, 0.f, 0.f, 0.f}; bg[bj] = addb ? *(const f32x4*)(bias + DM + ch) : (f32x4){0.f, 0.f, 0.f, 0.f}; }
        if (u.kind >= 16) {
            bf16_t* base = part + ((size_t)(u.kind - 16) * NCTX + (size_t)(u.pm - NLAT / BM) * BM + wr * 64 + fr) * (2 * DM) + col0;
#pragma unroll
            for (int ai = 0; ai < 2; ++ai)
#pragma unroll
                for (int m = 0; m < 4; ++m) { bf16_t* rowp = base + (size_t)(ai * HALF + m * 16) * (2 * DM);
#pragma unroll
                    for (int bj = 0; bj < 2; ++bj) { const f32x4 v0 = acc[ai][bj][m][0] + ba[bj], v1 = acc[ai][bj][m][1] + bg[bj];
                        u32x4 w; w.x = cvt_pk_bf16(v0[0], v0[1]); w.y = cvt_pk_bf16(v0[2], v0[3]); w.z = cvt_pk_bf16(v1[0], v1[1]); w.w = cvt_pk_bf16(v1[2], v1[3]);
                        *(u32x4*)(rowp + bj * HALF) = w; } }
        } else {
            const int row0 = u.pm * BM + wr * 64 + fr;
#pragma unroll
            for (int ai = 0; ai < 2; ++ai)
#pragma unroll
                for (int bj = 0; bj < 2; ++bj) { const int ch0 = (col0 + bj * HALF) >> 1;
                    u32x2 pk[4];
#pragma unroll
                    for (int m = 0; m < 4; ++m) { const f32x4 a = acc[ai][bj][m][0] + ba[bj], g = acc[ai][bj][m][1] + bg[bj]; float o[4];
#pragma unroll
                        for (int e = 0; e < 4; ++e) o[e] = a[e] * sigmoidf_(g[e]);
                        pk[m].x = cvt_pk_c(o[0], o[1]); pk[m].y = cvt_pk_c(o[2], o[3]); }
#pragma unroll
                    for (int m2 = 0; m2 < 4; m2 += 2) {
                        const auto rx = __builtin_amdgcn_permlane16_swap(pk[m2].x, pk[m2 + 1].x, false, false);
                        const auto ry = __builtin_amdgcn_permlane16_swap(pk[m2].y, pk[m2 + 1].y, false, false);
                        const int r = row0 + ai * HALF + (m2 + (fq & 1)) * 16;
                        *(u32x4*)(O + (size_t)r * DM + ch0 - 4 * (fq & 1)) = (u32x4){rx[0], ry[0], rx[1], ry[1]}; } }
        }
    }
};
struct OrderSplit {
    int nN, G, c, nt_full, nmain, nchunk, split, ktype, amode, wgm, rev; const char* A; const char* Bt; size_t ta, tb;
    __device__ size_t aoff(int pm, int k0) const { if (!amode) return (size_t)pm * ta + (size_t)k0 * BK * 2; const int cr0 = pm < 64 ? ((pm >> 5) * 512 + (pm & 31) * 16) : (1024 + (pm - 64) * 16); return (size_t)cr0 * 512 + (size_t)k0 * (4 * 1280 * 256 * 2); }
    __device__ void init(const void* A_, const void* Bt_, int N, int K, int lda, int ldb, int split_, int G_, int c_, int amode_ = 0, int wgm_ = WGM, int rev_ = 0) { amode = amode_; wgm = wgm_; rev = rev_; nN = N / BM; G = G_; c = c_; nt_full = K / BK; nmain = (NLAT / BM) * nN; ktype = (K == 2048) ? 0 : 1; nchunk = ktype ? 15 : 8; split = split_;
        A = (const char*)A_; Bt = (const char*)Bt_; ta = (size_t)BM * lda * 2; tb = (size_t)BM * ldb * 2; }
    __device__ bool next(int i, Unit& u) const {
        const long L = (long)i * G + c;
        if (L < nmain) { tile_map((int)L, NLAT / BM, nN, u.pm, u.pn, wgm); if (rev) u.pm = NLAT / BM - 1 - u.pm; u.kind = 0; u.nt = nt_full; u.a = A + aoff(u.pm, 0); u.b = Bt + (size_t)u.pn * tb; return true; }
        if (!split) return false;
        const int s = (int)(L - nmain); if (s >= 2 * nN * nchunk) return false;
        const int tile = s / nchunk, chunk = s - tile * nchunk; const int pmc = tile / nN; u.pn = tile - pmc * nN; u.pm = NLAT / BM + pmc; u.kind = 16 + chunk;
        int k0, ntc; if (ktype == 0) { k0 = chunk * 4; ntc = 4; } else if (chunk < 13) { k0 = chunk * 6; ntc = 6; } else { k0 = 78 + (chunk - 13) * 4; ntc = 4; }
        u.nt = ntc; u.a = A + aoff(u.pm, k0); u.b = Bt + (size_t)u.pn * tb + (size_t)k0 * BK * 2; return true;
    }
};
#define DPP0(src, ctrl) __builtin_bit_cast(float, __builtin_amdgcn_update_dpp(0, __builtin_bit_cast(int, (float)(src)), (ctrl), 0xf, 0xf, true))
__device__ __forceinline__ void up_panel(int pm, int& seq0, int& seqlen, int& g0) {
    int p; if (pm < 66) { const int b = pm / 33; p = pm - 33 * b; seq0 = b * SEQ; seqlen = SEQ; } else { const int c = pm - 66; p = c & 1; seq0 = NLAT + (c >> 1) * CTXL; seqlen = CTXL; }
    g0 = seq0 + 254 * p - 1;
}
template <int REP_ = 1> struct EpiUpGlu {
    static constexpr bool PERM = true; static constexpr int REP = REP_;
    bf16_t* A5; const float* cw; const float* cb; PG8_LAS float* halo;
    __device__ __forceinline__ void operator()(f32x4 (&acc)[2][2][4][2], const Unit& u, int wr, int wc, int fr, int fq) const {
        int seq0, seqlen, g0; up_panel(u.pm, seq0, seqlen, g0);
        const int send = seq0 + seqlen;
        const int cl = wc * 32 + 8 * fq;
        if (g0 < seq0 || g0 + BM > send) {
#pragma unroll
            for (int ai = 0; ai < 2; ++ai)
#pragma unroll
                for (int m = 0; m < 4; ++m) { const int g = g0 + ai * HALF + wr * 64 + m * 16 + fr; const bool in = g >= seq0 && g < send;
#pragma unroll
                    for (int bj = 0; bj < 2; ++bj)
#pragma unroll
                        for (int n = 0; n < 2; ++n)
#pragma unroll
                            for (int e = 0; e < 4; ++e) acc[ai][bj][m][n][e] = in ? acc[ai][bj][m][n][e] : 0.f; } }
#pragma unroll
        for (int ai = 0; ai < 2; ++ai)
#pragma unroll
            for (int bj = 0; bj < 2; ++bj)
#pragma unroll
                for (int n = 0; n < 2; ++n) {
                    if (fr == 0) *(PG8_LAS f32x4*)(halo + (2 * ai + wr) * 512 + bj * 128 + cl + 4 * n) = acc[ai][bj][0][n];
                    if (fr == 15) *(PG8_LAS f32x4*)(halo + (2 * ai + wr) * 512 + 256 + bj * 128 + cl + 4 * n) = acc[ai][bj][3][n]; }
        asm volatile("s_waitcnt lgkmcnt(0)" ::: "memory"); __builtin_amdgcn_s_barrier(); asm volatile("" ::: "memory");
#pragma unroll
        for (int bj = 0; bj < 2; ++bj) {
            const int ch0 = 128 * u.pn + 64 * bj + 16 * wc + 4 * fq;
            f32x4 wg[3], wv[3];
#pragma unroll
            for (int k = 0; k < 3; ++k) { wg[k] = *(const f32x4*)(cw + (size_t)k * DFF2 + ch0); wv[k] = *(const f32x4*)(cw + (size_t)k * DFF2 + DFF + ch0); }
            const f32x4 bg = *(const f32x4*)(cb + ch0), bv = *(const f32x4*)(cb + DFF + ch0);
#pragma unroll
            for (int ai = 0; ai < 2; ++ai) { const int blk = 2 * ai + wr;
                f32x4 hag = (f32x4){0.f, 0.f, 0.f, 0.f}, hav = hag, hbg = hag, hbv = hag;
                if (blk > 0) { hag = *(const PG8_LAS f32x4*)(halo + (blk - 1) * 512 + 256 + bj * 128 + cl); hav = *(const PG8_LAS f32x4*)(halo + (blk - 1) * 512 + 256 + bj * 128 + cl + 4); }
                if (blk < 3) { hbg = *(const PG8_LAS f32x4*)(halo + (blk + 1) * 512 + bj * 128 + cl); hbv = *(const PG8_LAS f32x4*)(halo + (blk + 1) * 512 + bj * 128 + cl + 4); }
                u32x2 pk[4];
#pragma unroll
                for (int m = 0; m < 4; ++m) {
                    const f32x4 cg = acc[ai][bj][m][0], cv = acc[ai][bj][m][1];
                    const f32x4 pbg = m > 0 ? acc[ai][bj][m > 0 ? m - 1 : 0][0] : hag, pbv = m > 0 ? acc[ai][bj][m > 0 ? m - 1 : 0][1] : hav;
                    const f32x4 nbg = m < 3 ? acc[ai][bj][m < 3 ? m + 1 : 3][0] : hbg, nbv = m < 3 ? acc[ai][bj][m < 3 ? m + 1 : 3][1] : hbv;
                    float o[4];
#pragma unroll
                    for (int ep = 0; ep < 2; ++ep) { const int e0 = 2 * ep, e1 = 2 * ep + 1;
                        const f32x2 w0g = {wg[0][e0], wg[0][e1]}, w1g = {wg[1][e0], wg[1][e1]}, w2g = {wg[2][e0], wg[2][e1]};
                        const f32x2 w0v = {wv[0][e0], wv[0][e1]}, w1v = {wv[1][e0], wv[1][e1]}, w2v = {wv[2][e0], wv[2][e1]};
                        f32x2 gate = (f32x2){bg[e0], bg[e1]} + (f32x2){cg[e0], cg[e1]} * w1g;
                        gate += (f32x2){DPP0(cg[e0], 0x111), DPP0(cg[e1], 0x111)} * w0g; gate += (f32x2){DPP0(pbg[e0], 0x10f), DPP0(pbg[e1], 0x10f)} * w0g;
                        gate += (f32x2){DPP0(cg[e0], 0x101), DPP0(cg[e1], 0x101)} * w2g; gate += (f32x2){DPP0(nbg[e0], 0x11f), DPP0(nbg[e1], 0x11f)} * w2g;
                        f32x2 val = (f32x2){bv[e0], bv[e1]} + (f32x2){cv[e0], cv[e1]} * w1v;
                        val += (f32x2){DPP0(cv[e0], 0x111), DPP0(cv[e1], 0x111)} * w0v; val += (f32x2){DPP0(pbv[e0], 0x10f), DPP0(pbv[e1], 0x10f)} * w0v;
                        val += (f32x2){DPP0(cv[e0], 0x101), DPP0(cv[e1], 0x101)} * w2v; val += (f32x2){DPP0(nbv[e0], 0x11f), DPP0(nbv[e1], 0x11f)} * w2v;
                        const f32x2 ex = gate * (-LOG2E);
                        const f32x2 den = (f32x2){__builtin_amdgcn_exp2f(ex[0]), __builtin_amdgcn_exp2f(ex[1])} + 1.0f;
                        const f32x2 sg = {__builtin_amdgcn_rcpf(den[0]), __builtin_amdgcn_rcpf(den[1])};
                        const f32x2 ov = gate * sg * val; o[e0] = ov[0]; o[e1] = ov[1]; }
                    pk[m].x = cvt_pk_c(o[0], o[1]); pk[m].y = cvt_pk_c(o[2], o[3]);
                }
#pragma unroll
                for (int m2 = 0; m2 < 4; m2 += 2) {
                    const auto rx = __builtin_amdgcn_permlane16_swap(pk[m2].x, pk[m2 + 1].x, false, false);
                    const auto ry = __builtin_amdgcn_permlane16_swap(pk[m2].y, pk[m2 + 1].y, false, false);
                    const int r = ai * HALF + wr * 64 + (m2 + (fq & 1)) * 16 + fr, g = g0 + r;
                    if (r >= 1 && r <= 254 && g >= seq0 && g < send) *(u32x4*)(A5 + (size_t)g * DFF + ch0 - 4 * (fq & 1)) = (u32x4){rx[0], ry[0], rx[1], ry[1]};
                }
            }
        }
    }
};
struct OrderUp {
    int G, c, nP; const char* HM; const char* W; int wgm;
    __device__ bool next(int i, Unit& u) const {
        const long L = (long)i * G + c; if (L >= (long)nP * 43) return false;
        tile_map((int)L, nP, 43, u.pm, u.pn, wgm); u.kind = 0; u.nt = DM / BK;
        int seq0, seqlen, g0; up_panel(u.pm, seq0, seqlen, g0);
        u.a = HM + (long)g0 * (DM * 2); u.b = W + (size_t)u.pn * BM * DM * 2; return true;
    }
};
template <int REP_ = 1> struct EpiQKVZ {
    static constexpr bool PERM = true; static constexpr int REP = REP_;
    bf16_t* QKV; bf16_t* ZBT; const float* tab;
    __device__ __forceinline__ void operator()(const f32x4 (&acc)[2][2][4][2], const Unit& u, int wr, int wc, int fr, int fq) const {
        const int row0 = u.pm * BM + wr * 64 + fr, col0 = u.pn * BM + wc * 32 + 8 * fq;
        if (u.kind == 1) {
#pragma unroll
            for (int ai = 0; ai < 2; ++ai)
#pragma unroll
                for (int m = 0; m < 4; ++m) { bf16_t* rowp = ZBT + (size_t)(row0 + ai * HALF + m * 16) * MROWS + col0;
#pragma unroll
                    for (int bj = 0; bj < 2; ++bj) { const f32x4 v0 = acc[ai][bj][m][0], v1 = acc[ai][bj][m][1];
                        u32x4 w; w.x = cvt_pk_bf16(v0[0], v0[1]); w.y = cvt_pk_bf16(v0[2], v0[3]); w.z = cvt_pk_bf16(v1[0], v1[1]); w.w = cvt_pk_bf16(v1[2], v1[3]);
                        *(u32x4*)(rowp + bj * HALF) = w; } }
        } else {
            const bool rope = (u.pn < 5) && (u.pm < 64);
            const float sc = (u.pn < 4) ? QSCALE : 1.0f;
            const int gi = 4 * wc + fq, f0 = 4 * (gi & 7); const bool rowang = gi < 8;
#pragma unroll
            for (int ai = 0; ai < 2; ++ai)
#pragma unroll
                for (int m = 0; m < 4; ++m) { const int r = row0 + ai * HALF + m * 16;
                    f32x4 cs0 = (f32x4){1.f, 0.f, 1.f, 0.f}, cs1 = cs0;
                    if (rope) { const int tok = r & (SEQ - 1); const int pos = rowang ? (tok >> 6) : (tok & 63); const f32x4* tp = (const f32x4*)(tab + (size_t)(pos * 32 + f0) * 2); cs0 = tp[0]; cs1 = tp[1]; }
                    const f32x4 cv = (f32x4){cs0[0], cs0[2], cs1[0], cs1[2]}, sv = (f32x4){cs0[1], cs0[3], cs1[1], cs1[3]};
                    bf16_t* rowp = QKV + (size_t)r * QKVC + col0;
#pragma unroll
                    for (int bj = 0; bj < 2; ++bj) { const f32x4 a0 = acc[ai][bj][m][0], a1 = acc[ai][bj][m][1];
                        const f32x4 v0 = (a0 * cv - a1 * sv) * sc, v1 = (a1 * cv + a0 * sv) * sc;
                        u32x4 w; w.x = cvt_pk_bf16(v0[0], v0[1]); w.y = cvt_pk_bf16(v0[2], v0[3]); w.z = cvt_pk_bf16(v1[0], v1[1]); w.w = cvt_pk_bf16(v1[2], v1[3]);
                        *(u32x4*)(rowp + bj * HALF) = w; } }
        }
    }
};
struct EpiS5G {
    static constexpr bool PERM = true; static constexpr int REP = 1;
    bf16_t* O;
    __device__ __forceinline__ void operator()(const f32x4 (&acc)[2][2][4][2], const Unit& u, int wr, int wc, int fr, int fq) const {
        const int row0 = u.pm * BM + wr * 64 + fr, col0 = wc * 32 + 8 * fq;
#pragma unroll
        for (int ai = 0; ai < 2; ++ai)
#pragma unroll
            for (int m = 0; m < 4; ++m) { bf16_t* rowp = O + (size_t)(row0 + ai * HALF + m * 16) * 256 + col0;
#pragma unroll
                for (int bj = 0; bj < 2; ++bj) { const f32x4 a0 = acc[ai][bj][m][0], a1 = acc[ai][bj][m][1];
                    u32x4 w; w.x = cvt_pk_bf16(gelu_tanh(a0[0]), gelu_tanh(a0[1])); w.y = cvt_pk_bf16(gelu_tanh(a0[2]), gelu_tanh(a0[3]));
                    w.z = cvt_pk_bf16(gelu_tanh(a1[0]), gelu_tanh(a1[1])); w.w = cvt_pk_bf16(gelu_tanh(a1[2]), gelu_tanh(a1[3]));
                    *(u32x4*)(rowp + bj * HALF) = w; } }
    }
};
struct OrderE1 {
    int G, c; const char* HM; const char* Win;
    __device__ bool next(int i, Unit& u) const {
        const long L = (long)i * G + c; if (L >= 1188) return false;
        if (L < 792) { tile_map((int)L, 12, 66, u.pm, u.pn, WGM_E1); u.kind = 1; u.nt = DM / BK; u.a = Win + (size_t)(QKVC + u.pm * BM) * DM * 2; u.b = HM + (size_t)u.pn * BM * DM * 2; }
        else { tile_map((int)L - 792, 66, 6, u.pm, u.pn, WGM_E1); u.kind = 0; u.nt = DM / BK; u.a = HM + (size_t)u.pm * BM * DM * 2; u.b = Win + (size_t)u.pn * BM * DM * 2; }
        return true;
    }
};
struct OrderS5 {
    int G, c, nt; const char* UA; const char* Bm; size_t bstride; int swapped;
    __device__ bool next(int i, Unit& u) const {
        const long L0 = (long)i * G + c; if (L0 >= S5G * 4) return false;
        const int L = (int)(L0 % NXCD) * (S5G * 4 / NXCD) + (int)(L0 / NXCD);
        const int g = L >> 2, pml = L & 3;
        u.kind = 0; u.nt = nt; const char* ua = UA + ((size_t)g * S5ROWS + (size_t)pml * BM) * S5K * 2; const char* bm = Bm + (size_t)g * bstride;
        if (swapped) { u.pm = g; u.pn = pml; u.a = bm; u.b = ua; } else { u.pm = 5 * g + pml; u.pn = 0; u.a = ua; u.b = bm; }
        return true;
    }
};
}
#define XB_TMO      128
#define XB_XCNT(j)  (256  + 64 * (j))
#define XB_XSUB(j)  (1280 + 64 * (j))
#define XB_XGEN(j)  (2304 + 64 * (j))
#define XB_TOP      3328
#define XB_TOPGEN   3392
#define XCD_BAR_WORDS 3456
#define XB_SPIN_CAP (1u << 22)

__device__ __forceinline__ unsigned xb_ld(unsigned* p)              { return __hip_atomic_load(p, __ATOMIC_RELAXED, __HIP_MEMORY_SCOPE_AGENT); }
__device__ __forceinline__ unsigned xb_add(unsigned* p, unsigned v) { return __hip_atomic_fetch_add(p, v, __ATOMIC_RELAXED, __HIP_MEMORY_SCOPE_AGENT); }
__device__ __forceinline__ unsigned xb_xcc_id() { return (unsigned)__builtin_amdgcn_s_getreg((3 << 11) | 20) & 0xFu; }
#define XB_SPIN(cond, bar) do { unsigned _sp = 0; while (cond) { __builtin_amdgcn_s_sleep(1); \
    if ((++_sp & 255u) == 0u) { if (xb_ld(&(bar)[XB_TMO])) break; if (_sp > XB_SPIN_CAP) { atomicAdd(&(bar)[XB_TMO], 1u); break; } } } } while (0)

struct XcdBarrier {
    unsigned* bar; unsigned x;
    volatile LAS unsigned* st;
};

__device__ __forceinline__ XcdBarrier xcd_barrier_post(unsigned* bar, volatile LAS unsigned* st) {
    XcdBarrier b; b.bar = bar; b.x = xb_xcc_id(); b.st = st;
    if (threadIdx.x == 0) (void)xb_add(&bar[XB_XCNT(b.x)], 1u);
    return b;
}
__device__ __forceinline__ void xcd_barrier_complete(unsigned* bar, unsigned x, unsigned& nloc, unsigned& nx) {
    const unsigned G = gridDim.x * gridDim.y * gridDim.z;
    unsigned sum, cnt, mine, sp = 0u;
    for (;;) {
        sum = 0u; cnt = 0u; mine = 0u;
#pragma unroll
        for (unsigned j = 0; j < 16; ++j) { const unsigned c = xb_ld(&bar[XB_XCNT(j)]); sum += c; cnt += (c > 0u) ? 1u : 0u; mine = (j == x) ? c : mine; }
        if (sum == G) break;
        __builtin_amdgcn_s_sleep(1);
        if ((++sp & 255u) == 0u) { if (xb_ld(&bar[XB_TMO])) break; if (sp > XB_SPIN_CAP) { atomicAdd(&bar[XB_TMO], 1u); break; } }
    }
    nloc = mine > 0u ? mine : 1u; nx = cnt > 0u ? cnt : 1u;
}

__device__ __forceinline__ void xcd_barrier(const XcdBarrier& b) {
    asm volatile("s_waitcnt vmcnt(0)" ::: "memory");
    __syncthreads();
    if (threadIdx.x == 0) {
        unsigned* bar = b.bar;
        __builtin_amdgcn_s_waitcnt(0);
        unsigned nloc = b.st[0], nx = b.st[1];
        if (nloc == 0u) { xcd_barrier_complete(bar, b.x, nloc, nx); b.st[0] = nloc; b.st[1] = nx; }
        const unsigned old = xb_add(&bar[XB_XSUB(b.x)], 1u);
        const unsigned gen = old / nloc;
        if (old + 1u == (gen + 1u) * nloc) {
            __builtin_amdgcn_fence(__ATOMIC_RELEASE, "agent");
            asm volatile("s_waitcnt vmcnt(0)" ::: "memory");
            const unsigned og = xb_add(&bar[XB_TOP], 1u);
            const unsigned tg = og / nx;
            if (og + 1u == (tg + 1u) * nx) xb_add(&bar[XB_TOPGEN], 1u);
            else XB_SPIN(xb_ld(&bar[XB_TOPGEN]) == tg, bar);
            __builtin_amdgcn_fence(__ATOMIC_ACQUIRE, "agent");
            xb_add(&bar[XB_XGEN(b.x)], 1u);
            asm volatile("s_waitcnt vmcnt(0)" ::: "memory");
        } else {
            XB_SPIN(xb_ld(&bar[XB_XGEN(b.x)]) == gen, bar);
            __builtin_amdgcn_fence(__ATOMIC_ACQUIRE, "agent");
            asm volatile("s_waitcnt vmcnt(0)" ::: "memory");
        }
    }
    __syncthreads();
}

#ifndef DUP_SUB
#define DUP_SUB 0
#endif
typedef __bf16 bf16x2w_ __attribute__((ext_vector_type(2)));
DI unsigned cvtpk_c2(float lo, float hi) { const f32x2 v = {lo, hi}; const bf16x2w_ b = __builtin_convertvector(v, bf16x2w_); return __builtin_bit_cast(unsigned, b); }
constexpr size_t MiB = 1u << 20;
constexpr size_t WS_CTL = 0, CTL_BYTES = 1 * MiB;
constexpr size_t WS_MOD = 1 * MiB;
constexpr size_t WS_MODP = 2 * MiB;
constexpr size_t WS_TAB = 7 * MiB;
constexpr size_t WS_HID = 8 * MiB;
constexpr size_t WS_LAML = 13 * MiB;
constexpr size_t WS_XC = 14 * MiB;
constexpr size_t WS_FILTC = 18 * MiB;
constexpr size_t WS_FILT = 22 * MiB;
constexpr size_t WS_TT = 150 * MiB;
constexpr size_t WS_WW = 214 * MiB;
constexpr size_t WS_WUP = 246 * MiB;
constexpr size_t WS_WDOWN = 418 * MiB;
constexpr size_t WS_WIN = 504 * MiB;
constexpr size_t WS_WOUT = 540 * MiB;
constexpr size_t WS_WGLU = 556 * MiB;
constexpr size_t WS_HM = 588 * MiB;
constexpr size_t WS_YAB = 654 * MiB;
constexpr size_t WS_Y = 720 * MiB;
constexpr size_t WS_A5 = 852 * MiB;
constexpr size_t WS_U = 1030 * MiB;
constexpr size_t WS_PART = 1385 * MiB;
constexpr size_t WS_XB = 1453 * MiB;
constexpr size_t WS_END = 1519 * MiB;
constexpr size_t SZ_WUP = (size_t)DFF2 * DM * 2, SZ_WDOWN = (size_t)DM * DFF * 2, SZ_WIN = (size_t)INCOLS * DM * 2, SZ_WOUT = (size_t)DM * DM * 2, SZ_WGLU = (size_t)2 * DM * DM * 2;
constexpr int CW_BAR = 4096;

constexpr int RING_BYTES = 131072, AUX_OFF = 131072, AUX_BYTES = 16384, LDSCTL_OFF = AUX_OFF + AUX_BYTES, LDS_BYTES = LDSCTL_OFF + 512;
constexpr int NWAVES = 8, NTHR = 512;

struct Params { const float* in[33]; float* out; unsigned char* ws; int lo, hi, pad0, pad1; };
struct Frame { LAS unsigned char* lds; int tid, lane, wave, G, bid; };

DI void sincos_rr(float x, float& sn, float& cs) {
    double r = (double)x * 0.15915494309189535; r = r - floor(r); const float rf = (float)r; sn = __builtin_amdgcn_sinf(rf); cs = __builtin_amdgcn_cosf(rf); }
DI float wave_sum(float v) {
#pragma unroll
    for (int o = 1; o < 64; o <<= 1) v += __shfl_xor(v, o);
    return v;
}
DI float block_sum(const Frame& F, float v, LAS float* red) {
    v = wave_sum(v);
    __syncthreads();
    if (F.lane == 0) red[F.wave] = v;
    __syncthreads();
    float t = 0.f;
#pragma unroll
    for (int i = 0; i < NWAVES; ++i) t += red[i];
    return t;
}

DI void transpose_item1(const Frame& F, const float* W, int K, int N, bf16* WT, int item, int mode) {
    const int nb = N >> 7; const int kb = item / nb, nbk = item - kb * nb; const int k0 = kb * 64, n0 = nbk * 128;
    LAS unsigned short* tile = (LAS unsigned short*)F.lds;
    const int tn = (F.tid & 31) * 4, tk = (F.tid >> 5) * 4;
    const int nd = n0 + tn; int ns = nd;
    if (mode == 2) { const int tile = nd >> 8, pp = nd & 255; ns = ((pp >> 2) & 1) * DFF + 128 * tile + 4 * (pp >> 3); }
    if (mode == 3) ns = ((nd >> 2) & 1) * DM + 4 * (nd >> 3);
    if (mode == 1 && nd < 1280) { const int d = nd & 127, gi = d >> 3, n = (d >> 2) & 1; ns = (nd & ~127) + ((gi < 8) ? 0 : 64) + 32 * n + 4 * (gi & 7); }
    f32x4 v[4];
#pragma unroll
    for (int i = 0; i < 4; ++i) v[i] = *(const f32x4*)(W + (size_t)(k0 + tk + i) * N + ns);
#pragma unroll
    for (int e = 0; e < 4; ++e) { u32x2 w; w.x = pk2(v[0][e], v[1][e]); w.y = pk2(v[2][e], v[3][e]); *(LAS u32x2*)(tile + (tn + e) * 72 + tk) = w; }
    __syncthreads();
#pragma unroll
    for (int i = 0; i < 2; ++i) { const int p = F.tid + 512 * i, n = p >> 3, kc = p & 7;
        const u32x4 w = *(const LAS u32x4*)(tile + n * 72 + kc * 8);
        *(u32x4*)(WT + (size_t)(n0 + n) * K + k0 + kc * 8) = w; }
    __syncthreads();
}
DI void transpose_item(const Frame& F, const float* W, int K, int N, bf16* WT, int item, int mode) { transpose_item1(F, W, K, N, WT, item, mode); if (DUP_SUB == 9) transpose_item1(F, W, K, N, WT, item, mode); }
DI void modp_unit(const Frame& F, const Params& P, int u) {
    const int cb = u % 24, lk = u / 24, kc = lk & 7, l = lk >> 3;
    LAS float* sv = (LAS float*)F.lds;
    for (int i = F.tid; i < 768; i += NTHR) { const int r = i >> 8, k = i & 255, kk = kc * 256 + k; const float v = (r < 2) ? P.in[1][r * DM + kk] : P.in[3][kk]; sv[i] = v / (1.0f + expf(-v)); }
    __syncthreads();
    const int j = cb * 512 + F.tid; const float* w = P.in[4] + ((size_t)l * DM + kc * 256) * (NMOD * DM) + j;
    float a0 = 0.f, a1 = 0.f, a2 = 0.f;
#pragma unroll 1
    for (int k0 = 0; k0 < 256; k0 += 32) { float wv[32];
#pragma unroll
        for (int k = 0; k < 32; ++k) wv[k] = __builtin_nontemporal_load(w + (size_t)(k0 + k) * (NMOD * DM));
#pragma unroll
        for (int k = 0; k < 32; ++k) { a0 += sv[k0 + k] * wv[k]; a1 += sv[256 + k0 + k] * wv[k]; a2 += sv[512 + k0 + k] * wv[k]; } }
    float* mp = (float*)(P.ws + WS_MODP) + (size_t)(l * 8 + kc) * 3 * (NMOD * DM) + j;
    mp[0] = a0; mp[NMOD * DM] = a1; mp[2 * NMOD * DM] = a2;
    __syncthreads();
}
DI void hid_unit(const Frame& F, const Params& P, int u) {
    int l, n, tb; float* dst;
    if (u < 256) { l = u >> 7; n = SEQ; tb = u & 127; dst = (float*)(P.ws + WS_HID) + (size_t)l * SEQ * 64; }
    else { const int v = u - 256; l = v >> 2; n = CTXL; tb = v & 3; dst = (float*)(P.ws + WS_HID + 4 * MiB) + (size_t)l * CTXL * 64; }
    LAS float* zs = (LAS float*)F.lds; LAS float* h1 = zs + 64 * 33;
    const int pos0 = tb * 64;
    const float wstep = 6.283185307179586f / (float)n;
    for (int i = F.tid; i < 64 * 33; i += NTHR) { const int pos = i / 33, k = i - pos * 33; const int ti = pos0 + pos; float val;
        if (k == 0) val = (float)ti / (float)(n - 1);
        else { const int kb = (k - 1) & 15; const float band = 1e-4f + (float)kb * ((15.0f - 1e-4f) / 15.0f); const float ang = (wstep * (float)ti) * band; float sn, cs; sincos_rr(ang, sn, cs); val = (k <= 16) ? cs : -sn; }
        zs[i] = val; }
    __syncthreads();
    const int pos = F.tid >> 3, h0 = (F.tid & 7) * 8;
    const float* w1 = P.in[16] + (size_t)l * 33 * 64; const float* b1 = P.in[17] + l * 64; const float* w2 = P.in[18] + (size_t)l * 64 * 64; const float* b2 = P.in[19] + l * 64; const float* fr = P.in[21] + l * 64;
    float acc[8];
#pragma unroll
    for (int e = 0; e < 8; ++e) acc[e] = b1[h0 + e];
#pragma unroll 1
    for (int k = 0; k < 33; ++k) { const float zv = zs[pos * 33 + k];
#pragma unroll
        for (int e = 0; e < 8; ++e) acc[e] += zv * w1[k * 64 + h0 + e]; }
#pragma unroll
    for (int e = 0; e < 8; ++e) { float sn, cs; sincos_rr(fr[h0 + e] * acc[e], sn, cs); h1[pos * 65 + h0 + e] = sn; }
    __syncthreads();
#pragma unroll
    for (int e = 0; e < 8; ++e) acc[e] = b2[h0 + e];
#pragma unroll 1
    for (int k = 0; k < 64; ++k) { const float hv = h1[pos * 65 + k];
#pragma unroll
        for (int e = 0; e < 8; ++e) acc[e] += hv * w2[k * 64 + h0 + e]; }
#pragma unroll
    for (int e = 0; e < 8; ++e) { float sn, cs; sincos_rr(fr[h0 + e] * acc[e], sn, cs); dst[(size_t)(pos0 + pos) * 64 + h0 + e] = sn; }
    __syncthreads();
}
DI void tab_unit(const Frame& F, const Params& P) {
    float* tab = (float*)(P.ws + WS_TAB);
    for (int i = F.tid; i < 4096; i += NTHR) { const int pos = i >> 5, f = i & 31; const float inv = exp2f(-(float)(2 * f) * (13.287712379549449f / 64.0f)); const float ang = (float)pos * inv; float sn, cs; sincos_rr(ang, sn, cs); tab[2 * i] = cs; tab[2 * i + 1] = sn; }
}
DI void s5_unit(const Frame& F, const Params& P, int u) {
    const int jo = u >> 7, g = u & 127;
    LAS float* pw = (LAS float*)F.lds;
    LAS float* bb = pw + 2 * 64 * 17 * 2;
    LAS float* cc = bb + 2 * 64 * 16 * 2;
    LAS float* Kt = cc + 2 * 16 * 64 * 2;
    if (F.tid < 128) { const int dir = F.tid >> 6, p = F.tid & 63; const int gi = ((jo * 2 + dir) * S5G + g);
        const float lr = P.in[23][(size_t)gi * 64 + p], li = P.in[24][(size_t)gi * 64 + p]; const float st = expf(P.in[25][gi]);
        float pr1 = 1.f, pi1 = 0.f;
        for (int d = 0; d <= 16; ++d) { const float a = lr * st * (float)d, b = li * st * (float)d; const float mag = expf(a); float sn, cs; sincos_rr(b, sn, cs);
            pw[((dir * 64 + p) * 17 + d) * 2] = mag * cs; pw[((dir * 64 + p) * 17 + d) * 2 + 1] = mag * sn; if (d == 1) { pr1 = mag * cs; pi1 = mag * sn; } }
        float* lamL = (float*)(P.ws + WS_LAML) + ((size_t)gi * 64 + p) * 2; lamL[0] = pw[((dir * 64 + p) * 17 + 16) * 2]; lamL[1] = pw[((dir * 64 + p) * 17 + 16) * 2 + 1];
        const float den = 1.0f / (lr * lr + li * li); const float nr = pr1 - 1.0f, ni = pi1; const float qr = (nr * lr + ni * li) * den, qi = (ni * lr - nr * li) * den;
        for (int j = 0; j < 16; ++j) { const float br = P.in[26][((size_t)gi * 64 + p) * 16 + j], bi = P.in[27][((size_t)gi * 64 + p) * 16 + j];
            bb[((dir * 64 + p) * 16 + j) * 2] = qr * br - qi * bi; bb[((dir * 64 + p) * 16 + j) * 2 + 1] = qr * bi + qi * br; } }
    for (int i = F.tid; i < 2048; i += NTHR) { const int dir = i >> 10, j = (i >> 6) & 15, p = i & 63; const size_t si = (((size_t)(jo * 2 + dir) * S5G + g) * 16 + j) * 64 + p;
        cc[i * 2] = P.in[28][si]; cc[i * 2 + 1] = P.in[29][si]; }
    __syncthreads();
    { const int dir = F.tid >> 8, d = (F.tid >> 4) & 15, j = F.tid & 15; float s16[16];
#pragma unroll
        for (int jp = 0; jp < 16; ++jp) s16[jp] = 0.f;
#pragma unroll 2
        for (int p = 0; p < 64; ++p) { const float cr = cc[((dir * 16 + j) * 64 + p) * 2], ci = cc[((dir * 16 + j) * 64 + p) * 2 + 1];
            const float wr_ = pw[((dir * 64 + p) * 17 + d) * 2], wi_ = pw[((dir * 64 + p) * 17 + d) * 2 + 1];
            const float xr = cr * wr_ - ci * wi_, xi = cr * wi_ + ci * wr_;
#pragma unroll
            for (int jp = 0; jp < 16; ++jp) s16[jp] += xr * bb[((dir * 64 + p) * 16 + jp) * 2] - xi * bb[((dir * 64 + p) * 16 + jp) * 2 + 1]; }
#pragma unroll
        for (int jp = 0; jp < 16; ++jp) Kt[((dir * 16 + d) * 16 + j) * 16 + jp] = s16[jp]; }
    __syncthreads();
    bf16* TT = (bf16*)(P.ws + WS_TT) + ((size_t)(jo * S5G + g) * 256) * 512;
    const float* dv = P.in[30] + (size_t)jo * DM + g * 16;
    for (int q = F.tid; q < 256 * 64; q += NTHR) { const int row = q >> 6, k0 = (q & 63) * 8; const int t = row >> 4, j = row & 15; float v[8];
        if (k0 < 256) { const int s = k0 >> 4, jp0 = k0 & 15;
#pragma unroll
            for (int e = 0; e < 8; ++e) { float x = 0.f; if (s <= t) x += Kt[((0 * 16 + (t - s)) * 16 + j) * 16 + jp0 + e]; if (s >= t) x += Kt[((1 * 16 + (s - t)) * 16 + j) * 16 + jp0 + e];
                if (s == t && j == jp0 + e) x += dv[j]; v[e] = x; } }
        else { const int region = (k0 - 256) >> 6, p0 = (k0 - 256) & 63, dir = region >> 1, pwr = dir == 0 ? t + 1 : 16 - t;
#pragma unroll
            for (int e = 0; e < 8; ++e) { const int p = p0 + e; const float cr = cc[((dir * 16 + j) * 64 + p) * 2], ci = cc[((dir * 16 + j) * 64 + p) * 2 + 1];
                const float wr_ = pw[((dir * 64 + p) * 17 + pwr) * 2], wi_ = pw[((dir * 64 + p) * 17 + pwr) * 2 + 1];
                v[e] = (region & 1) ? -(cr * wi_ + ci * wr_) : (cr * wr_ - ci * wi_); } }
        u32x4 w; w.x = pk2(v[0], v[1]); w.y = pk2(v[2], v[3]); w.z = pk2(v[4], v[5]); w.w = pk2(v[6], v[7]);
        *(u32x4*)(TT + (size_t)row * 512 + k0) = w; }
    bf16* WW = (bf16*)(P.ws + WS_WW) + ((size_t)(jo * S5G + g) * 256) * 256;
    for (int q = F.tid; q < 256 * 32; q += NTHR) { const int row = q >> 5, k0 = (q & 31) * 8; const int s = k0 >> 4, jp0 = k0 & 15; const int region = row >> 6, p = row & 63, dir = region >> 1, pwr = dir == 0 ? 15 - s : s; float v[8];
        const float wr_ = pw[((dir * 64 + p) * 17 + pwr) * 2], wi_ = pw[((dir * 64 + p) * 17 + pwr) * 2 + 1];
#pragma unroll
        for (int e = 0; e < 8; ++e) { const float br = bb[((dir * 64 + p) * 16 + jp0 + e) * 2], bi = bb[((dir * 64 + p) * 16 + jp0 + e) * 2 + 1];
            v[e] = (region & 1) ? (wr_ * bi + wi_ * br) : (wr_ * br - wi_ * bi); }
        u32x4 w; w.x = pk2(v[0], v[1]); w.y = pk2(v[2], v[3]); w.z = pk2(v[4], v[5]); w.w = pk2(v[6], v[7]);
        *(u32x4*)(WW + (size_t)row * 256 + k0) = w; }
    __syncthreads();
}
struct TrJob { const float* src; bf16* dst; int N, K; };
DI void tr_decode(const Frame& F, const Params& P, int r, TrJob& J) {
    constexpr int IT_UP = (DM / 64) * (DFF2 / 128), IT_DOWN = (DFF / 64) * (DM / 128), IT_IN = (DM / 64) * (INCOLS / 128), IT_OUT = (DM / 64) * (DM / 128), IT_GLU = (DM / 64) * (2 * DM / 128);
    const float* W; bf16* WT; int K, N, mode;
    if (r < 4 * (IT_UP + IT_DOWN)) { const int l = r / (IT_UP + IT_DOWN); r -= l * (IT_UP + IT_DOWN);
        if (r < IT_UP) { W = P.in[7] + (size_t)l * DM * DFF2; K = DM; N = DFF2; WT = (bf16*)(P.ws + WS_WUP + l * SZ_WUP); mode = 2; }
        else { W = P.in[10] + (size_t)l * DFF * DM; K = DFF; N = DM; WT = (bf16*)(P.ws + WS_WDOWN + l * SZ_WDOWN); r -= IT_UP; mode = 0; } }
    else { r -= 4 * (IT_UP + IT_DOWN); const int j = r / (IT_IN + IT_OUT + IT_GLU); r -= j * (IT_IN + IT_OUT + IT_GLU);
        if (r < IT_IN) { W = P.in[11] + (size_t)j * DM * INCOLS; K = DM; N = INCOLS; WT = (bf16*)(P.ws + WS_WIN + j * SZ_WIN); mode = 1; }
        else if (r < IT_IN + IT_OUT) { W = P.in[12] + (size_t)j * DM * DM; K = DM; N = DM; WT = (bf16*)(P.ws + WS_WOUT + j * SZ_WOUT); r -= IT_IN; mode = 0; }
        else { W = P.in[31] + (size_t)j * DM * 2 * DM; K = DM; N = 2 * DM; WT = (bf16*)(P.ws + WS_WGLU + j * SZ_WGLU); r -= IT_IN + IT_OUT; mode = 3; } }
    const int nb = N >> 7; const int kb = r / nb, nbk = r - kb * nb; const int k0 = kb * 64, n0 = nbk * 128;
    const int tn = (F.tid & 31) * 4, tk = (F.tid >> 5) * 4;
    const int nd = n0 + tn; int ns = nd;
    if (mode == 2) { const int tile = nd >> 8, pp = nd & 255; ns = ((pp >> 2) & 1) * DFF + 128 * tile + 4 * (pp >> 3); }
    if (mode == 3) ns = ((nd >> 2) & 1) * DM + 4 * (nd >> 3);
    if (mode == 1 && nd < 1280) { const int d = nd & 127, gi = d >> 3, n = (d >> 2) & 1; ns = (nd & ~127) + ((gi < 8) ? 0 : 64) + 32 * n + 4 * (gi & 7); }
    J.src = W + (size_t)(k0 + tk) * N + ns; J.N = N; J.K = K; J.dst = WT + (size_t)(n0 + (F.tid >> 3)) * K + k0 + (F.tid & 7) * 8;
}
DI void tr_load(const TrJob& J, f32x4 (&v)[4]) {
#pragma unroll
    for (int i = 0; i < 4; ++i) v[i] = *(const f32x4*)(J.src + (size_t)i * J.N);
}
DI void tr_store(const Frame& F, const TrJob& J, const f32x4 (&v)[4], int buf) {
    LAS unsigned short* tile = (LAS unsigned short*)F.lds + buf * (128 * 72);
    const int tn = (F.tid & 31) * 4, tk = (F.tid >> 5) * 4;
#pragma unroll
    for (int e = 0; e < 4; ++e) { u32x2 w; w.x = pk2(v[0][e], v[1][e]); w.y = pk2(v[2][e], v[3][e]); *(LAS u32x2*)(tile + (tn + e) * 72 + tk) = w; }
    __syncthreads();
    const int n = F.tid >> 3, kc = F.tid & 7;
    const u32x4 w0 = *(const LAS u32x4*)(tile + n * 72 + kc * 8), w1 = *(const LAS u32x4*)(tile + (n + 64) * 72 + kc * 8);
    *(u32x4*)(J.dst) = w0; *(u32x4*)(J.dst + (size_t)64 * J.K) = w1;
}
DI void tr_run(const Frame& F, const Params& P, int r, const int rend) {
    if (r >= rend) return;
    TrJob J0, J1, J2; f32x4 v0[4], v1[4], v2[4];
    tr_decode(F, P, r, J0); tr_load(J0, v0);
    const int rb = (r + F.G < rend) ? r + F.G : r; tr_decode(F, P, rb, J1); tr_load(J1, v1);
    int buf = 0;
#pragma unroll 1
    for (; r < rend; r += F.G) {
        const int rc = (r + 2 * F.G < rend) ? r + 2 * F.G : r; tr_decode(F, P, rc, J2); tr_load(J2, v2);
        tr_store(F, J0, v0, buf); buf ^= 1;
        J0 = J1; J1 = J2;
#pragma unroll
        for (int i = 0; i < 4; ++i) { v0[i] = v1[i]; v1[i] = v2[i]; }
    }
    __syncthreads();
}
DI void p0_prologue(const Frame& F, const Params& P) {
    constexpr int IT_UP = (DM / 64) * (DFF2 / 128), IT_DOWN = (DFF / 64) * (DM / 128), IT_IN = (DM / 64) * (INCOLS / 128), IT_OUT = (DM / 64) * (DM / 128), IT_GLU = (DM / 64) * (2 * DM / 128);
    constexpr int NT = 4 * (IT_UP + IT_DOWN) + 2 * (IT_IN + IT_OUT + IT_GLU);
    constexpr int N_S5 = 256, N_MODP = 768, N_HID = 264;
    constexpr int NPRE = N_MODP + N_HID + 1;
    int it = F.bid;
    for (; it < NPRE; it += F.G) {
        int r = it;
        if (r < N_MODP) { modp_unit(F, P, r); if (DUP_SUB == 8) modp_unit(F, P, r); continue; } r -= N_MODP;
        if (r < N_HID) { hid_unit(F, P, r); continue; } r -= N_HID;
        tab_unit(F, P);
    }
    const int r0 = it - NPRE; const int nmine = r0 < NT ? (NT - r0 + F.G - 1) / F.G : 0;
    const int cut = r0 + F.G * ((nmine * (F.bid & 3)) / 3);
    tr_run(F, P, r0, cut < NT ? cut : NT);
    for (int u = F.bid; u < N_S5; u += F.G) { s5_unit(F, P, u); if (DUP_SUB == 7) s5_unit(F, P, u); }
    tr_run(F, P, cut, NT);
}
DI void filt_unit(const Frame& F, const Params& P, int u) {
    int l, n, tb, ct; const float* hid; bf16* dst;
    if (u < 2048) { l = u >> 10; tb = (u >> 3) & 127; ct = u & 7; n = SEQ; hid = (const float*)(P.ws + WS_HID) + (size_t)l * SEQ * 64; dst = (bf16*)(P.ws + WS_FILT) + (size_t)l * 2 * 1024 * SEQ; }
    else { const int v = u - 2048; l = v >> 5; tb = (v >> 3) & 3; ct = v & 7; n = CTXL; hid = (const float*)(P.ws + WS_HID + 4 * MiB) + (size_t)l * CTXL * 64; dst = (bf16*)(P.ws + WS_FILTC) + (size_t)l * 2 * 1024 * CTXL; }
    LAS unsigned short* hsb = (LAS unsigned short*)F.lds;
    LAS unsigned short* w3t = hsb + 64 * 72;
    const int t0 = tb * 64;
    { const int pos = F.tid >> 3, k8 = (F.tid & 7) * 8; const f32x4 a = *(const f32x4*)(hid + (size_t)(t0 + pos) * 64 + k8), bq = *(const f32x4*)(hid + (size_t)(t0 + pos) * 64 + k8 + 4);
        u32x4 w; w.x = pk2(a[0], a[1]); w.y = pk2(a[2], a[3]); w.z = pk2(bq[0], bq[1]); w.w = pk2(bq[2], bq[3]); *(LAS u32x4*)(hsb + pos * 72 + k8) = w; }
    const float* w3 = P.in[20] + (size_t)l * 64 * 2048;
    { const int c4 = (F.tid & 63) * 4, k4 = (F.tid >> 6) * 4;
#pragma unroll
        for (int half = 0; half < 2; ++half) { f32x4 v[4];
#pragma unroll
            for (int i = 0; i < 4; ++i) v[i] = *(const f32x4*)(w3 + (size_t)(32 * half + k4 + i) * 2048 + ct * 256 + c4);
#pragma unroll
            for (int e = 0; e < 4; ++e) { u32x2 w; w.x = pk2(v[0][e], v[1][e]); w.y = pk2(v[2][e], v[3][e]); *(LAS u32x2*)(w3t + (c4 + e) * 72 + 32 * half + k4) = w; } } }
    __syncthreads();
    const int r = F.lane & 31, h = F.lane >> 5;
    f32x16 acc[2];
#pragma unroll
    for (int nt = 0; nt < 2; ++nt)
#pragma unroll
        for (int i = 0; i < 16; ++i) acc[nt][i] = 0.f;
#pragma unroll
    for (int s = 0; s < 4; ++s) { const bf16x8 a = *(const LAS bf16x8*)(w3t + (32 * F.wave + r) * 72 + 16 * s + 8 * h);
#pragma unroll
        for (int nt = 0; nt < 2; ++nt) { const bf16x8 bq = *(const LAS bf16x8*)(hsb + (nt * 32 + r) * 72 + 16 * s + 8 * h); acc[nt] = __builtin_amdgcn_mfma_f32_32x32x16_bf16(bq, a, acc[nt], 0, 0, 0); } }
    const int col = ct * 256 + 32 * F.wave + r, dir = col >> 10, c = col & 1023;
    const float delta = 3.0701134573253945f + (float)c * (12.280453829301578f / 1023.0f);
    bf16* drow = dst + ((size_t)(dir * 1024 + c)) * n + t0;
    const float tsc = -delta / (float)(n - 1);
#pragma unroll
    for (int nt = 0; nt < 2; ++nt)
#pragma unroll
        for (int kp = 0; kp < 4; kp += 2) {
            unsigned g[2][2];
#pragma unroll
            for (int q = 0; q < 2; ++q) { float v[4];
#pragma unroll
                for (int e = 0; e < 4; ++e) { const int t = t0 + nt * 32 + 8 * (kp + q) + 4 * h + e; v[e] = acc[nt][4 * (kp + q) + e] * fast_exp((float)t * tsc); }
                g[q][0] = cvtpk_c2(v[0], v[1]); g[q][1] = cvtpk_c2(v[2], v[3]); }
            const auto rx = __builtin_amdgcn_permlane32_swap(g[0][0], g[1][0], false, false);
            const auto ry = __builtin_amdgcn_permlane32_swap(g[0][1], g[1][1], false, false);
            *(u32x4*)(drow + nt * 32 + 8 * kp + (h ? 8 : 0)) = (u32x4){rx[0], ry[0], rx[1], ry[1]}; }
    __syncthreads();
}
DI void p1_phase(const Frame& F, const Params& P) {
    for (int u = F.bid; u < 2048 + 64; u += F.G) filt_unit(F, P, u);
    const float* mp = (const float*)(P.ws + WS_MODP); float* mo = (float*)(P.ws + WS_MOD);
    for (int i = F.bid * NTHR + F.tid; i < DEPTH * 3 * NMOD * DM; i += F.G * NTHR) { const int j = i % (NMOD * DM), lr = i / (NMOD * DM), l = lr / 3, r = lr - 3 * l;
        float s = P.in[5][(size_t)l * NMOD * DM + j];
#pragma unroll
        for (int kc = 0; kc < 8; ++kc) s += mp[((size_t)(l * 8 + kc) * 3 + r) * (NMOD * DM) + j];
        mo[i] = s; }
}
typedef short v4i16_t __attribute__((ext_vector_type(4)));
DI s16x4 vtr(const LAS unsigned char* p) { return __builtin_bit_cast(s16x4, __builtin_amdgcn_ds_read_tr16_b64_v4i16((LAS v4i16_t*)p)); }
DI void ld8f(const float* p, float (&v)[8]) { const f32x4 a = *(const f32x4*)p, b = *(const f32x4*)(p + 4); v[0] = a[0]; v[1] = a[1]; v[2] = a[2]; v[3] = a[3]; v[4] = b[0]; v[5] = b[1]; v[6] = b[2]; v[7] = b[3]; }
DI void st8f(float* p, const float (&v)[8]) { *(f32x4*)p = (f32x4){v[0], v[1], v[2], v[3]}; *(f32x4*)(p + 4) = (f32x4){v[4], v[5], v[6], v[7]}; }
DI void ld8b(const bf16* p, float (&v)[8]) { const u32x4 w = *(const u32x4*)p; v[0] = bflo(w.x); v[1] = bfhi(w.x); v[2] = bflo(w.y); v[3] = bfhi(w.y); v[4] = bflo(w.z); v[5] = bfhi(w.z); v[6] = bflo(w.w); v[7] = bfhi(w.w); }
DI void cv8b(const u32x4 w, float (&v)[8]) { v[0] = bflo(w.x); v[1] = bfhi(w.x); v[2] = bflo(w.y); v[3] = bfhi(w.y); v[4] = bflo(w.z); v[5] = bfhi(w.z); v[6] = bflo(w.w); v[7] = bfhi(w.w); }
template <int SRC, bool XIN_BF, bool XOUT_BF>
DI void row_phase(const Frame& F, const bf16* ysrc, const bf16* part, int nparts, int nrows, const void* xin_lat, const void* xin_ctx, void* xout_lat, void* xout_ctx,
                  const float* gA, const float* modA, int mA, bool do_mod, const float* gB, const float* modB, int shiftc, int scalec, bf16* HM, bf16* UA) {
    const int gw = F.bid * NWAVES + F.wave, NGW = F.G * NWAVES;
    constexpr int LDY = (SRC == 2) ? 2 * DM : DM;
    for (int r = gw; r < nrows; r += NGW) {
        const int set = r < SEQ ? 0 : (r < NLAT ? 1 : 2);
        float x[4][8];
        if (XIN_BF) { const bf16* xr = (const bf16*)xin_lat + (size_t)r * DM + 8 * F.lane;
#pragma unroll
            for (int j = 0; j < 4; ++j) ld8b(xr + 512 * j, x[j]); }
        else { const float* xr = r < NLAT ? (const float*)xin_lat + (size_t)r * DM : (const float*)xin_ctx + (size_t)(r - NLAT) * DM;
#pragma unroll
            for (int j = 0; j < 4; ++j) ld8f(xr + 8 * F.lane + 512 * j, x[j]); }
        if (SRC != 0) {
            float y[4][8];
            if (r >= NLAT && nparts > 0) {
#pragma unroll
                for (int j = 0; j < 4; ++j)
#pragma unroll
                    for (int e = 0; e < 8; ++e) y[j][e] = 0.f;
                float g[4][8];
                if (SRC == 2) {
#pragma unroll
                    for (int j = 0; j < 4; ++j)
#pragma unroll
                        for (int e = 0; e < 8; ++e) g[j][e] = 0.f; }
                if (SRC == 3) {
                    float g[4][8];
#pragma unroll
                    for (int j = 0; j < 4; ++j)
#pragma unroll
                        for (int e = 0; e < 8; ++e) g[j][e] = 0.f;
#pragma unroll 1
                    for (int k0 = 0; k0 < nparts; k0 += 2) {
                        u32x4 w0[2][4], w1[2][4];
#pragma unroll
                        for (int kk = 0; kk < 2; ++kk) { const bf16* pr = part + ((size_t)(k0 + kk) * NCTX + (r - NLAT)) * (2 * DM) + 16 * F.lane;
#pragma unroll
                            for (int j = 0; j < 4; ++j) { w0[kk][j] = *(const u32x4*)(pr + 1024 * j); w1[kk][j] = *(const u32x4*)(pr + 1024 * j + 8); } }
#pragma unroll
                        for (int kk = 0; kk < 2; ++kk)
#pragma unroll
                            for (int j = 0; j < 4; ++j) { float t0[8], t1[8]; cv8b(w0[kk][j], t0); cv8b(w1[kk][j], t1);
#pragma unroll
                                for (int e = 0; e < 4; ++e) { y[j][e] += t0[e]; g[j][e] += t0[4 + e]; y[j][4 + e] += t1[e]; g[j][4 + e] += t1[4 + e]; } } }
#pragma unroll
                    for (int j = 0; j < 4; ++j)
#pragma unroll
                        for (int e = 0; e < 8; ++e) y[j][e] *= sigmoidf_(g[j][e]);
                } else
                if (SRC == 2) {
#pragma unroll 1
                for (int k = 0; k < nparts; ++k) { const bf16* pr = part + ((size_t)k * NCTX + (r - NLAT)) * LDY + 8 * F.lane;
#pragma unroll
                    for (int j = 0; j < 4; ++j) { float t[8]; ld8b(pr + 512 * j, t);
#pragma unroll
                        for (int e = 0; e < 8; ++e) y[j][e] += t[e];
                        ld8b(pr + DM + 512 * j, t);
#pragma unroll
                        for (int e = 0; e < 8; ++e) g[j][e] += t[e]; } }
                } else {
#pragma unroll 1
                for (int k0 = 0; k0 < nparts; k0 += 4) {
                    u32x4 w[4][4]; float wt[4];
#pragma unroll
                    for (int kk = 0; kk < 4; ++kk) { const int k = k0 + kk; const int kc = k < nparts ? k : nparts - 1; wt[kk] = k < nparts ? 1.0f : 0.0f;
                        const bf16* pr = part + ((size_t)kc * NCTX + (r - NLAT)) * LDY + 8 * F.lane;
#pragma unroll
                        for (int j = 0; j < 4; ++j) w[kk][j] = *(const u32x4*)(pr + 512 * j); }
#pragma unroll
                    for (int kk = 0; kk < 4; ++kk)
#pragma unroll
                        for (int j = 0; j < 4; ++j) { float t[8]; cv8b(w[kk][j], t);
#pragma unroll
                            for (int e = 0; e < 8; ++e) y[j][e] += t[e] * wt[kk]; } }
                }
                if (SRC == 2) {
#pragma unroll
                    for (int j = 0; j < 4; ++j)
#pragma unroll
                        for (int e = 0; e < 8; ++e) y[j][e] *= sigmoidf_(g[j][e]); }
            } else {
                const bf16* yr = ysrc + (size_t)r * LDY + 8 * F.lane;
#pragma unroll
                for (int j = 0; j < 4; ++j) ld8b(yr + 512 * j, y[j]);
                if (SRC == 2) {
#pragma unroll
                    for (int j = 0; j < 4; ++j) { float t[8]; ld8b(yr + DM + 512 * j, t);
#pragma unroll
                        for (int e = 0; e < 8; ++e) y[j][e] *= sigmoidf_(t[e]); } }
            }
            float ss = 0.f;
#pragma unroll
            for (int j = 0; j < 4; ++j)
#pragma unroll
                for (int e = 0; e < 8; ++e) ss += y[j][e] * y[j][e];
            ss = wave_sum(ss);
            const float rs = __builtin_amdgcn_rsqf(ss * (1.0f / DM) + RMS_EPS);
            const float* mm = modA + (size_t)set * (NMOD * DM) + mA * DM;
#pragma unroll
            for (int j = 0; j < 4; ++j) { const int c = 8 * F.lane + 512 * j; float ga[8], mv[8]; ld8f(gA + c, ga); ld8f(mm + c, mv);
#pragma unroll
                for (int e = 0; e < 8; ++e) x[j][e] += mv[e] * (y[j][e] * rs * ga[e]);
                if (XOUT_BF) { u32x4 w; w.x = pk2(x[j][0], x[j][1]); w.y = pk2(x[j][2], x[j][3]); w.z = pk2(x[j][4], x[j][5]); w.w = pk2(x[j][6], x[j][7]); *(u32x4*)((bf16*)xout_lat + (size_t)r * DM + c) = w; }
                else { float* xo = r < NLAT ? (float*)xout_lat + (size_t)r * DM : (float*)xout_ctx + (size_t)(r - NLAT) * DM; st8f(xo + c, x[j]); } }
        }
        if (do_mod) {
            float ss = 0.f;
#pragma unroll
            for (int j = 0; j < 4; ++j)
#pragma unroll
                for (int e = 0; e < 8; ++e) ss += x[j][e] * x[j][e];
            ss = wave_sum(ss);
            const float rs = __builtin_amdgcn_rsqf(ss * (1.0f / DM) + RMS_EPS);
            const float* mb = modB + (size_t)set * (NMOD * DM);
            bf16* hr = HM + (size_t)r * DM;
            int cr = 0; if (UA) cr = r < NLAT ? ((r >> 13) * 512 + ((r & (SEQ - 1)) >> 4)) : (1024 + ((r - NLAT) >> 4));
#pragma unroll
            for (int j = 0; j < 4; ++j) { const int c = 8 * F.lane + 512 * j; float gb[8], sc[8], sh[8]; ld8f(gB + c, gb); ld8f(mb + scalec * DM + c, sc); ld8f(mb + shiftc * DM + c, sh);
                float h[8];
#pragma unroll
                for (int e = 0; e < 8; ++e) h[e] = (x[j][e] * rs * gb[e]) * (sc[e] + 1.0f) + sh[e];
                u32x4 w; w.x = pk2(h[0], h[1]); w.y = pk2(h[2], h[3]); w.z = pk2(h[4], h[5]); w.w = pk2(h[6], h[7]);
                if (HM) *(u32x4*)(hr + c) = w;
                if (UA) *(u32x4*)(UA + ((size_t)(c >> 4) * S5ROWS + cr) * S5K + (r & 15) * 16 + (c & 15)) = w; }
        }
    }
}
DI void load8(const bf16* p, float (&v)[8]) { const u32x4 w = *(const u32x4*)p; v[0] = bflo(w.x); v[1] = bfhi(w.x); v[2] = bflo(w.y); v[3] = bfhi(w.y); v[4] = bflo(w.z); v[5] = bfhi(w.z); v[6] = bflo(w.w); v[7] = bfhi(w.w); }
DI void convglu_phase(const Frame& F, const bf16* U, bf16* A5, const float* cw, const float* cb, int nrows) {
    const int gw = F.bid * NWAVES + F.wave, NGW = F.G * NWAVES;
    constexpr int NCC = 11; const int NRC = nrows / 32;
    for (int wu = gw; wu < NRC * NCC; wu += NGW) {
        const int cc = wu % NCC, rc = wu / NCC; const int c0 = cc * 512 + F.lane * 8; const int r0 = rc * 32;
        if (c0 < DFF) {
            float wg[3][8], wv[3][8], bg[8], bv[8];
#pragma unroll
            for (int k = 0; k < 3; ++k)
#pragma unroll
                for (int e = 0; e < 8; ++e) { wg[k][e] = cw[(size_t)k * DFF2 + c0 + e]; wv[k][e] = cw[(size_t)k * DFF2 + DFF + c0 + e]; }
#pragma unroll
            for (int e = 0; e < 8; ++e) { bg[e] = cb[c0 + e]; bv[e] = cb[DFF + c0 + e]; }
            const int seqlen = r0 < NLAT ? SEQ : CTXL; const int rs0 = r0 < NLAT ? (r0 & (SEQ - 1)) : ((r0 - NLAT) & (CTXL - 1));
            float pg[8], pv[8], cg[8], cv[8], ng[8], nv[8];
            if (rs0 > 0) { load8(U + (size_t)(r0 - 1) * DFF2 + c0, pg); load8(U + (size_t)(r0 - 1) * DFF2 + DFF + c0, pv); }
            else {
#pragma unroll
                for (int e = 0; e < 8; ++e) { pg[e] = 0.f; pv[e] = 0.f; } }
            load8(U + (size_t)r0 * DFF2 + c0, cg); load8(U + (size_t)r0 * DFF2 + DFF + c0, cv);
            for (int i = 0; i < 32; ++i) { const int r = r0 + i;
                if (rs0 + i + 1 < seqlen) { load8(U + (size_t)(r + 1) * DFF2 + c0, ng); load8(U + (size_t)(r + 1) * DFF2 + DFF + c0, nv); }
                else {
#pragma unroll
                    for (int e = 0; e < 8; ++e) { ng[e] = 0.f; nv[e] = 0.f; } }
                float o[8];
#pragma unroll
                for (int e = 0; e < 8; ++e) { const float g = pg[e] * wg[0][e] + cg[e] * wg[1][e] + ng[e] * wg[2][e] + bg[e]; const float v = pv[e] * wv[0][e] + cv[e] * wv[1][e] + nv[e] * wv[2][e] + bv[e]; o[e] = siluf_(g) * v; }
                u32x4 w; w.x = pk2(o[0], o[1]); w.y = pk2(o[2], o[3]); w.z = pk2(o[4], o[5]); w.w = pk2(o[6], o[7]);
                *(u32x4*)(A5 + (size_t)r * DFF + c0) = w;
#pragma unroll
                for (int e = 0; e < 8; ++e) { pg[e] = cg[e]; pv[e] = cv[e]; cg[e] = ng[e]; cv[e] = nv[e]; } }
        }
    }
}
#define ZP(i) ((i) + ((i) >> 4))
DI f32x2 cmul(f32x2 a, f32x2 b) { return (f32x2){a[0] * b[0] - a[1] * b[1], a[0] * b[1] + a[1] * b[0]}; }
DI f32x2 cmulc(f32x2 a, f32x2 b) { return (f32x2){a[0] * b[0] + a[1] * b[1], a[1] * b[0] - a[0] * b[1]}; }
DI f32x2 mulmi(f32x2 a) { return (f32x2){a[1], -a[0]}; }
DI f32x2 mulpi(f32x2 a) { return (f32x2){-a[1], a[0]}; }
#define BFLY_F(x0, x1, x2, x3, y0, y1, y2, y3) do { const f32x2 t0_ = (x0) + (x2), t1_ = (x0) - (x2), t2_ = (x1) + (x3), t3_ = mulmi((x1) - (x3)); y0 = t0_ + t2_; y1 = t1_ + t3_; y2 = t0_ - t2_; y3 = t1_ - t3_; } while (0)
#define BFLY_I(x0, x1, x2, x3, y0, y1, y2, y3) do { const f32x2 t0_ = (x0) + (x2), t1_ = (x0) - (x2), t2_ = (x1) + (x3), t3_ = mulpi((x1) - (x3)); y0 = t0_ + t2_; y1 = t1_ + t3_; y2 = t0_ - t2_; y3 = t1_ - t3_; } while (0)
#define W16_1 ((f32x2){0.92387953251128674f, -0.38268343236508977f})
#define W16_2 ((f32x2){0.70710678118654752f, -0.70710678118654752f})
#define W16_3 ((f32x2){0.38268343236508977f, -0.92387953251128674f})
#define W16_6 ((f32x2){-0.70710678118654752f, -0.70710678118654752f})
#define W16_9 ((f32x2){-0.92387953251128674f, 0.38268343236508977f})
template <int Q2> DI void fft_pass16_fwd(const Frame& F, LAS f32x2* Z) {
    constexpr int L = 16 * Q2, ST = Q2 >= 16 ? Q2 + Q2 / 16 : Q2; constexpr float invL = 1.0f / (float)L;
#pragma unroll 1
    for (int g = F.tid; g < 1024; g += NTHR) { const int j = g & (Q2 - 1), base = ((g - j) << 4) + j;
        LAS f32x2* zp = Z + ZP(base);
        f32x2 x[16];
#pragma unroll
        for (int m = 0; m < 16; ++m) x[m] = zp[m * ST];
        const float rev = (float)j * invL; const f32x2 t1 = {__builtin_amdgcn_cosf(rev), -__builtin_amdgcn_sinf(rev)};
        const f32x2 t2 = cmul(t1, t1), t3 = cmul(t2, t1), t4 = cmul(t2, t2), t8 = cmul(t4, t4), t12 = cmul(t8, t4);
        BFLY_F(x[0], x[4], x[8], x[12], x[0], x[4], x[8], x[12]);          x[4] = cmul(x[4], t1); x[8] = cmul(x[8], t2); x[12] = cmul(x[12], t3);
        BFLY_F(x[1], x[5], x[9], x[13], x[1], x[5], x[9], x[13]);          x[5] = cmul(cmul(x[5], W16_1), t1); x[9] = cmul(cmul(x[9], W16_2), t2); x[13] = cmul(cmul(x[13], W16_3), t3);
        BFLY_F(x[2], x[6], x[10], x[14], x[2], x[6], x[10], x[14]);        x[6] = cmul(cmul(x[6], W16_2), t1); x[10] = cmul(mulmi(x[10]), t2); x[14] = cmul(cmul(x[14], W16_6), t3);
        BFLY_F(x[3], x[7], x[11], x[15], x[3], x[7], x[11], x[15]);        x[7] = cmul(cmul(x[7], W16_3), t1); x[11] = cmul(cmul(x[11], W16_6), t2); x[15] = cmul(cmul(x[15], W16_9), t3);
#pragma unroll
        for (int ap = 0; ap < 4; ++ap) { f32x2 z0, z1, z2, z3; BFLY_F(x[4 * ap], x[4 * ap + 1], x[4 * ap + 2], x[4 * ap + 3], z0, z1, z2, z3);
            zp[(4 * ap) * ST] = z0; zp[(4 * ap + 1) * ST] = cmul(z1, t4); zp[(4 * ap + 2) * ST] = cmul(z2, t8); zp[(4 * ap + 3) * ST] = cmul(z3, t12); } }
    __syncthreads();
}
template <int Q2> DI void fft_pass16_inv(const Frame& F, LAS f32x2* Z) {
    constexpr int L = 16 * Q2, ST = Q2 >= 16 ? Q2 + Q2 / 16 : Q2; constexpr float invL = 1.0f / (float)L;
#pragma unroll 1
    for (int g = F.tid; g < 1024; g += NTHR) { const int j = g & (Q2 - 1), base = ((g - j) << 4) + j;
        LAS f32x2* zp = Z + ZP(base);
        f32x2 v[16];
#pragma unroll
        for (int m = 0; m < 16; ++m) v[m] = zp[m * ST];
        const float rev = (float)j * invL; const f32x2 t1 = {__builtin_amdgcn_cosf(rev), -__builtin_amdgcn_sinf(rev)};
        const f32x2 t2 = cmul(t1, t1), t3 = cmul(t2, t1), t4 = cmul(t2, t2), t8 = cmul(t4, t4), t12 = cmul(t8, t4);
#pragma unroll
        for (int ap = 0; ap < 4; ++ap) BFLY_I(v[4 * ap], cmulc(v[4 * ap + 1], t4), cmulc(v[4 * ap + 2], t8), cmulc(v[4 * ap + 3], t12), v[4 * ap], v[4 * ap + 1], v[4 * ap + 2], v[4 * ap + 3]);
        f32x2 o0, o1, o2, o3;
        BFLY_I(v[0], cmulc(v[4], t1), cmulc(v[8], t2), cmulc(v[12], t3), o0, o1, o2, o3);
        zp[0] = o0; zp[4 * ST] = o1; zp[8 * ST] = o2; zp[12 * ST] = o3;
        BFLY_I(v[1], cmulc(cmulc(v[5], t1), W16_1), cmulc(cmulc(v[9], t2), W16_2), cmulc(cmulc(v[13], t3), W16_3), o0, o1, o2, o3);
        zp[ST] = o0; zp[5 * ST] = o1; zp[9 * ST] = o2; zp[13 * ST] = o3;
        BFLY_I(v[2], cmulc(cmulc(v[6], t1), W16_2), mulpi(cmulc(v[10], t2)), cmulc(cmulc(v[14], t3), W16_6), o0, o1, o2, o3);
        zp[2 * ST] = o0; zp[6 * ST] = o1; zp[10 * ST] = o2; zp[14 * ST] = o3;
        BFLY_I(v[3], cmulc(cmulc(v[7], t1), W16_3), cmulc(cmulc(v[11], t2), W16_6), cmulc(cmulc(v[15], t3), W16_9), o0, o1, o2, o3);
        zp[3 * ST] = o0; zp[7 * ST] = o1; zp[11 * ST] = o2; zp[15 * ST] = o3; }
    __syncthreads();
}
template <bool ZHALF = false> DI void fft_fwd(const Frame& F0, LAS f32x2* Z) {
    Frame F = F0; { int t_ = F0.tid; asm volatile("" : "+v"(t_)); F.tid = t_; }
#pragma unroll 2
    for (int u = F.tid; u < 4096; u += NTHR) { const int j = u; LAS f32x2* zp = Z + ZP(j);
        const f32x2 a0 = zp[0], a1 = zp[4352];
        f32x2 y0, y1, y2, y3;
        if (ZHALF) { const f32x2 m1 = mulmi(a1); y0 = a0 + a1; y1 = a0 + m1; y2 = a0 - a1; y3 = a0 - m1; }
        else { const f32x2 a2 = zp[8704], a3 = zp[13056]; BFLY_F(a0, a1, a2, a3, y0, y1, y2, y3); }
        const float rev = (float)j * (1.0f / 16384.0f); const f32x2 w1 = {__builtin_amdgcn_cosf(rev), -__builtin_amdgcn_sinf(rev)}; const f32x2 w2 = cmul(w1, w1), w3 = cmul(w2, w1);
        zp[0] = y0; zp[4352] = cmul(y1, w1); zp[8704] = cmul(y2, w2); zp[13056] = cmul(y3, w3); }
    __syncthreads();
    fft_pass16_fwd<256>(F, Z); fft_pass16_fwd<16>(F, Z); fft_pass16_fwd<1>(F, Z);
}
DI void fft_fwd_to_regs(const Frame& F0, LAS f32x2* Z, f32x2 (&hs)[32], const float sc, const float add) {
    Frame F = F0; { int t_ = F0.tid; asm volatile("" : "+v"(t_)); F.tid = t_; }
#pragma unroll 2
    for (int u = F.tid; u < 4096; u += NTHR) { const int j = u; LAS f32x2* zp = Z + ZP(j);
        const f32x2 a0 = zp[0], a1 = zp[4352], a2 = zp[8704], a3 = zp[13056];
        f32x2 y0, y1, y2, y3; BFLY_F(a0, a1, a2, a3, y0, y1, y2, y3);
        const float rev = (float)j * (1.0f / 16384.0f); const f32x2 w1 = {__builtin_amdgcn_cosf(rev), -__builtin_amdgcn_sinf(rev)}; const f32x2 w2 = cmul(w1, w1), w3 = cmul(w2, w1);
        zp[0] = y0; zp[4352] = cmul(y1, w1); zp[8704] = cmul(y2, w2); zp[13056] = cmul(y3, w3); }
    __syncthreads();
    fft_pass16_fwd<256>(F, Z); fft_pass16_fwd<16>(F, Z);
#pragma unroll
    for (int gi = 0; gi < 2; ++gi) { const int base = (F.tid + 512 * gi) << 4;
        const LAS f32x2* zp = Z + ZP(base);
        f32x2 x[16];
#pragma unroll
        for (int m = 0; m < 16; ++m) x[m] = zp[m];
        BFLY_F(x[0], x[4], x[8], x[12], x[0], x[4], x[8], x[12]);
        BFLY_F(x[1], x[5], x[9], x[13], x[1], x[5], x[9], x[13]);          x[5] = cmul(x[5], W16_1); x[9] = cmul(x[9], W16_2); x[13] = cmul(x[13], W16_3);
        BFLY_F(x[2], x[6], x[10], x[14], x[2], x[6], x[10], x[14]);        x[6] = cmul(x[6], W16_2); x[10] = mulmi(x[10]); x[14] = cmul(x[14], W16_6);
        BFLY_F(x[3], x[7], x[11], x[15], x[3], x[7], x[11], x[15]);        x[7] = cmul(x[7], W16_3); x[11] = cmul(x[11], W16_6); x[15] = cmul(x[15], W16_9);
#pragma unroll
        for (int ap = 0; ap < 4; ++ap) { f32x2 z0, z1, z2, z3; BFLY_F(x[4 * ap], x[4 * ap + 1], x[4 * ap + 2], x[4 * ap + 3], z0, z1, z2, z3);
            hs[16 * gi + 4 * ap] = (f32x2){z0[0] * sc + add, z0[1] * sc}; hs[16 * gi + 4 * ap + 1] = (f32x2){z1[0] * sc + add, z1[1] * sc};
            hs[16 * gi + 4 * ap + 2] = (f32x2){z2[0] * sc + add, z2[1] * sc}; hs[16 * gi + 4 * ap + 3] = (f32x2){z3[0] * sc + add, z3[1] * sc}; } }
    __syncthreads();
}
DI void fft_pass16_inv1_mul(const Frame& F, LAS f32x2* Z, const f32x2 (&hs)[32]) {
#pragma unroll
    for (int gi = 0; gi < 2; ++gi) { const int base = (F.tid + 512 * gi) << 4;
        LAS f32x2* zp = Z + ZP(base);
        f32x2 v[16];
#pragma unroll
        for (int m = 0; m < 16; ++m) v[m] = cmul(zp[m], hs[16 * gi + m]);
#pragma unroll
        for (int ap = 0; ap < 4; ++ap) BFLY_I(v[4 * ap], v[4 * ap + 1], v[4 * ap + 2], v[4 * ap + 3], v[4 * ap], v[4 * ap + 1], v[4 * ap + 2], v[4 * ap + 3]);
        f32x2 o0, o1, o2, o3;
        BFLY_I(v[0], v[4], v[8], v[12], o0, o1, o2, o3);
        zp[0] = o0; zp[4] = o1; zp[8] = o2; zp[12] = o3;
        BFLY_I(v[1], cmulc(v[5], W16_1), cmulc(v[9], W16_2), cmulc(v[13], W16_3), o0, o1, o2, o3);
        zp[1] = o0; zp[5] = o1; zp[9] = o2; zp[13] = o3;
        BFLY_I(v[2], cmulc(v[6], W16_2), mulpi(v[10]), cmulc(v[14], W16_6), o0, o1, o2, o3);
        zp[2] = o0; zp[6] = o1; zp[10] = o2; zp[14] = o3;
        BFLY_I(v[3], cmulc(v[7], W16_3), cmulc(v[11], W16_6), cmulc(v[15], W16_9), o0, o1, o2, o3);
        zp[3] = o0; zp[7] = o1; zp[11] = o2; zp[15] = o3; }
    __syncthreads();
}
DI void fft_inv_mul_lo(const Frame& F0, LAS f32x2* Z, const f32x2 (&hs)[32]) {
    Frame F = F0; { int t_ = F0.tid; asm volatile("" : "+v"(t_)); F.tid = t_; }
    fft_pass16_inv1_mul(F, Z, hs); fft_pass16_inv<16>(F, Z); fft_pass16_inv<256>(F, Z);
#pragma unroll 2
    for (int u = F.tid; u < 4096; u += NTHR) { const int j = u; LAS f32x2* zp = Z + ZP(j);
        const float rev = (float)j * (1.0f / 16384.0f); const f32x2 w1 = {__builtin_amdgcn_cosf(rev), -__builtin_amdgcn_sinf(rev)}; const f32x2 w2 = cmul(w1, w1), w3 = cmul(w2, w1);
        const f32x2 a0 = zp[0], a1 = cmulc(zp[4352], w1), a2 = cmulc(zp[8704], w2), a3 = cmulc(zp[13056], w3);
        f32x2 x0, x1, x2, x3; BFLY_I(a0, a1, a2, a3, x0, x1, x2, x3);
        zp[0] = x0; zp[4352] = x1; }
    __syncthreads();
}
DI float dw3(const LAS unsigned short* row, int t, int n, float w0, float w1, float w2, float b) {
    const float m = bf2f(row[t]); const float l = t > 0 ? bf2f(row[t - 1]) : 0.f; const float r = t + 1 < n ? bf2f(row[t + 1]) : 0.f;
    return l * w0 + m * w1 + r * w2 + b;
}
DI void dw3x4(const LAS unsigned short* row, int t, int n, float w0, float w1, float w2, float b, float (&o)[4]) {
    const u32x2 m = *(const LAS u32x2*)(row + t);
    const float c0 = bflo(m.x), c1 = bfhi(m.x), c2 = bflo(m.y), c3 = bfhi(m.y);
    const float l = t > 0 ? bf2f(row[t - 1]) : 0.f; const float r = t + 4 < n ? bf2f(row[t + 4]) : 0.f;
    o[0] = l * w0 + c0 * w1 + c1 * w2 + b; o[1] = c0 * w0 + c1 * w1 + c2 * w2 + b; o[2] = c1 * w0 + c2 * w1 + c3 * w2 + b; o[3] = c2 * w0 + c3 * w1 + r * w2 + b;
}
DI void hyena_taps(const Frame& F, const Params& P, int je, int c, u32x4 (&wf)[2], u32x4 (&wb)[2]) {
    const bf16* filt = (const bf16*)(P.ws + WS_FILT) + (size_t)je * 2 * 1024 * SEQ;
    const bf16* ff = filt + (size_t)c * SEQ; const bf16* fb = filt + (size_t)(1024 + c) * SEQ;
#pragma unroll
    for (int q = 0; q < 2; ++q) { const int pc = F.tid + 512 * q; wf[q] = *(const u32x4*)(ff + 8 * pc); wb[q] = *(const u32x4*)(fb + 8184 - 8 * pc); }
}
DI void hyena_unit(const Frame& F0, const Params& P, int je, int c, int cn, u32x4 (&wf)[2], u32x4 (&wb)[2]) {
    Frame F = F0; { int t_ = F0.tid; asm volatile("" : "+v"(t_)); F.tid = t_; F.lane = t_ & 63; }
    LAS f32x2* Z = (LAS f32x2*)F.lds;
    LAS float* aux = (LAS float*)(F.lds + AUX_OFF + 8192);
    LAS float* red = aux + 1536;
    const bf16* ZBT = (const bf16*)(P.ws + WS_U + 50 * MiB);
    bf16* YBT = (bf16*)(P.ws + WS_U + 150 * MiB);
    const bf16* filt = (const bf16*)(P.ws + WS_FILT) + (size_t)je * 2 * 1024 * SEQ;
    const bf16* ff = filt + (size_t)c * SEQ; const bf16* fb = filt + (size_t)(1024 + c) * SEQ;
    const float* hw = P.in[14] + (size_t)je * 3 * HYC; const float* hb = P.in[15] + (size_t)je * HYC;
    float l1 = 0.f;
    u32x4 rawpf[8]; u32x4 cpf = {0u, 0u, 0u, 0u}; bf16 hcpf = 0;
    const bf16* fc = (const bf16*)(P.ws + WS_FILTC) + (size_t)je * 2 * 1024 * CTXL;
    {
#pragma unroll
        for (int k = 0; k < 8; ++k) { const int i = F.tid + 512 * k, rr = i >> 10, piece = i & 1023; const int b = rr & 1, which = rr >> 1;
            rawpf[k] = *(const u32x4*)(ZBT + (size_t)((which ? 2048 : 1024) + c) * MROWS + b * SEQ + piece * 8); }
        { const int i = F.tid; if (i >= 255 && i < 511) hcpf = fc[(size_t)c * CTXL + (i - 255)]; else if (i < 255) hcpf = fc[(size_t)(1024 + c) * CTXL + (255 - i)];
            if (i < 192) { const int rw = i >> 5, pc = i & 31; const int bb2 = rw / 3, which = rw - 3 * bb2; cpf = *(const u32x4*)(ZBT + (size_t)(which * 1024 + c) * MROWS + NLAT + bb2 * CTXL + pc * 8); } }
#pragma unroll
        for (int q = 0; q < 2; ++q) { const int pc = F.tid + 512 * q; float v[8];
            v[0] = bflo(wf[q].x); v[1] = bfhi(wf[q].x); v[2] = bflo(wf[q].y); v[3] = bfhi(wf[q].y); v[4] = bflo(wf[q].z); v[5] = bfhi(wf[q].z); v[6] = bflo(wf[q].w); v[7] = bfhi(wf[q].w);
            LAS f32x2* zp = Z + ZP(8 * pc);
#pragma unroll
            for (int e = 0; e < 8; ++e) { l1 += fabsf(v[e]); zp[e] = (f32x2){v[e], 0.f}; }
            v[0] = bflo(wb[q].x); v[1] = bfhi(wb[q].x); v[2] = bflo(wb[q].y); v[3] = bfhi(wb[q].y); v[4] = bflo(wb[q].z); v[5] = bfhi(wb[q].z); v[6] = bflo(wb[q].w); v[7] = bfhi(wb[q].w);
#pragma unroll
            for (int e = 0; e < 8; ++e) { const int i = 8193 + 8 * pc + e; if (i < 16384) { l1 += fabsf(v[7 - e]); Z[ZP(i)] = (f32x2){v[7 - e], 0.f}; } } }
        if (F.tid == 0) Z[ZP(SEQ)] = (f32x2){0.f, 0.f};
        if (cn >= 0) hyena_taps(F, P, je, cn, wf, wb);
    }
    l1 = block_sum(F, l1, red);
    const float bias = P.in[22][(size_t)je * 1024 + c];
    const float hscale = 1.0f / (l1 * 16384.0f), hadd = bias * (1.0f / 16384.0f);
    f32x2 hs[32];
    fft_fwd_to_regs(F, Z, hs, hscale, hadd);
    LAS unsigned short* raw = (LAS unsigned short*)(F.lds + 69632);
#pragma unroll
    for (int k = 0; k < 8; ++k) { const int i = F.tid + 512 * k, rr = i >> 10, piece = i & 1023; *(LAS u32x4*)(raw + rr * SEQ + piece * 8) = rawpf[k]; }
    __syncthreads();
    const float wx10 = hw[1024 + c], wx11 = hw[HYC + 1024 + c], wx12 = hw[2 * HYC + 1024 + c], bx1 = hb[1024 + c];
    const float wv0 = hw[2048 + c], wv1 = hw[HYC + 2048 + c], wv2 = hw[2 * HYC + 2048 + c], bv = hb[2048 + c];
    const float wx00 = hw[c], wx01 = hw[HYC + c], wx02 = hw[2 * HYC + c], bx0 = hb[c];
#pragma unroll 1
    for (int k = 0; k < 4; ++k) { const int t = 4 * (k * 512 + F.tid);
        float pv0[4], px0[4], pv1[4], px1[4];
        dw3x4(raw + 2 * SEQ, t, SEQ, wv0, wv1, wv2, bv, pv0); dw3x4(raw, t, SEQ, wx10, wx11, wx12, bx1, px0);
        dw3x4(raw + 3 * SEQ, t, SEQ, wv0, wv1, wv2, bv, pv1); dw3x4(raw + SEQ, t, SEQ, wx10, wx11, wx12, bx1, px1);
        LAS f32x2* zp = Z + ZP(t);
#pragma unroll
        for (int e = 0; e < 4; ++e) zp[e] = (f32x2){pv0[e] * px0[e], pv1[e] * px1[e]}; }
    __syncthreads();
    u32x4 x0pf[4];
#pragma unroll
    for (int k = 0; k < 4; ++k) { const int i = F.tid + 512 * k, b = i >> 10, piece = i & 1023; x0pf[k] = *(const u32x4*)(ZBT + (size_t)c * MROWS + b * SEQ + piece * 8); }
    fft_fwd<true>(F, Z);
    fft_inv_mul_lo(F, Z, hs);
#pragma unroll
    for (int k = 0; k < 4; ++k) { const int i = F.tid + 512 * k, b = i >> 10, piece = i & 1023; *(LAS u32x4*)(raw + b * SEQ + piece * 8) = x0pf[k]; }
    __syncthreads();
#pragma unroll 1
    for (int k = 0; k < 4; ++k) { const int t = 4 * (k * 512 + F.tid);
        float g0[4], g1[4]; dw3x4(raw, t, SEQ, wx00, wx01, wx02, bx0, g0); dw3x4(raw + SEQ, t, SEQ, wx00, wx01, wx02, bx0, g1);
        const LAS f32x2* zp = Z + ZP(t); const f32x2 z0 = zp[0], z1 = zp[1], z2 = zp[2], z3 = zp[3];
        u32x2 w0_, w1_; w0_.x = pk2(z0[0] * g0[0], z1[0] * g0[1]); w0_.y = pk2(z2[0] * g0[2], z3[0] * g0[3]); w1_.x = pk2(z0[1] * g1[0], z1[1] * g1[1]); w1_.y = pk2(z2[1] * g1[2], z3[1] * g1[3]);
        *(u32x2*)(YBT + (size_t)c * MROWS + t) = w0_; *(u32x2*)(YBT + (size_t)c * MROWS + SEQ + t) = w1_; }
    LAS float* hc = aux; LAS float* vvc = aux + 512; LAS float* x0c = aux + 1024;
    __syncthreads();
    { const int i = F.tid; float v;
        if (i < 511) v = bf2f(hcpf); else v = 0.f;
        hc[i] = v; float l1c = block_sum(F, fabsf(v), red);
        const int b = i >> 8, t = i & 255;
        LAS unsigned short* crow = (LAS unsigned short*)(F.lds + 16384);
        if (i < 192) { const int rw = i >> 5, pc = i & 31; const int bb2 = rw / 3, which = rw - 3 * bb2;
            const u32x4 w = cpf;
            LAS unsigned short* d = crow + rw * 272 + 1 + pc * 8;
            d[0] = (unsigned short)(w.x & 0xffff); d[1] = (unsigned short)(w.x >> 16); d[2] = (unsigned short)(w.y & 0xffff); d[3] = (unsigned short)(w.y >> 16);
            d[4] = (unsigned short)(w.z & 0xffff); d[5] = (unsigned short)(w.z >> 16); d[6] = (unsigned short)(w.w & 0xffff); d[7] = (unsigned short)(w.w >> 16); }
        else if (i < 204) { const int k = i - 192; crow[(k >> 1) * 272 + ((k & 1) ? 257 : 0)] = 0; }
        __syncthreads();
        auto rd = [&](int which, int tt) -> float { return bf2f(crow[(3 * b + which) * 272 + 1 + tt]); };
        const float pv_ = rd(2, t - 1) * wv0 + rd(2, t) * wv1 + rd(2, t + 1) * wv2 + bv;
        const float px1 = rd(1, t - 1) * wx10 + rd(1, t) * wx11 + rd(1, t + 1) * wx12 + bx1;
        const float px0 = rd(0, t - 1) * wx00 + rd(0, t) * wx01 + rd(0, t + 1) * wx02 + bx0;
        vvc[i] = pv_ * px1; x0c[i] = px0;
        __syncthreads();
        { LAS float* part = (LAS float*)F.lds;
            const int t4 = (F.tid & 63) * 4, bb = (F.tid >> 6) & 1, sq = F.tid >> 7;
            float a0 = 0.f, a1 = 0.f, a2 = 0.f, a3 = 0.f;
            int d = t4 - sq * 64 + 255;
            float h1 = hc[d + 1], h2 = hc[d + 2], h3 = hc[d + 3];
#pragma unroll 8
            for (int s = 0; s < 64; ++s) { const float h0 = hc[d - s]; const float v = vvc[bb * 256 + sq * 64 + s];
                a0 += h0 * v; a1 += h1 * v; a2 += h2 * v; a3 += h3 * v; h3 = h2; h2 = h1; h1 = h0; }
            *(LAS f32x4*)(part + (sq * 2 + bb) * 256 + t4) = (f32x4){a0, a1, a2, a3}; }
        __syncthreads();
        { const LAS float* part = (const LAS float*)F.lds;
            float s = (part[(0 * 2 + b) * 256 + t] + part[(1 * 2 + b) * 256 + t]) + (part[(2 * 2 + b) * 256 + t] + part[(3 * 2 + b) * 256 + t]);
            s = s / l1c;
            YBT[(size_t)c * MROWS + NLAT + i] = (bf16)f2bf((s + vvc[i] * bias) * x0c[i]); }
    }
    __syncthreads();
}
DI void ybt_transpose_phase(const Frame& F, const Params& P) {
    const bf16* YBT = (const bf16*)(P.ws + WS_U + 150 * MiB); bf16* YAB = (bf16*)(P.ws + WS_YAB);
    LAS unsigned char* tile = F.lds + F.wave * 16384;
    const int gw = F.bid * NWAVES + F.wave, NGW = F.G * NWAVES;
    const int rr = F.lane >> 3, piece = F.lane & 7;
    const int i16 = F.lane & 15, tq = i16 >> 2, tp = i16 & 3, g16 = F.lane >> 4;
    for (int tu = gw; tu < 16 * (MROWS / 64); tu += NGW) { const int cb = tu & 15, tb = tu >> 4; const int c0 = cb * 64, t0 = tb * 64;
        u32x4 v[8];
#pragma unroll
        for (int i = 0; i < 8; ++i) v[i] = *(const u32x4*)(YBT + (size_t)(c0 + 8 * i + rr) * MROWS + t0 + piece * 8);
#pragma unroll
        for (int i = 0; i < 8; ++i) *(LAS u32x4*)(tile + (8 * i + rr) * 192 + piece * 16) = v[i];
        asm volatile("s_waitcnt lgkmcnt(0)" ::: "memory");
        bf16* dst = YAB + (size_t)(t0 + F.lane) * DM + 1024 + c0;
#pragma unroll
        for (int k = 0; k < 8; ++k) {
            const LAS unsigned char* ap = tile + (8 * k + tq) * 192 + 32 * g16 + 8 * tp;
            const s16x4 lo = vtr(ap), hi = vtr(ap + 4 * 192);
            const bf16x8 o = __builtin_shufflevector(lo, hi, 0, 1, 2, 3, 4, 5, 6, 7);
            *(bf16x8*)(dst + 8 * k) = o; }
        asm volatile("s_waitcnt lgkmcnt(0)" ::: "memory");
    }
}
typedef __bf16 bf16x2_t __attribute__((ext_vector_type(2)));
DI unsigned cvtpk_s(float lo, float hi) { const f32x2 v = {lo, hi}; const bf16x2_t b = __builtin_convertvector(v, bf16x2_t); return __builtin_bit_cast(unsigned, b); }
DI int crow(int i, int h) { return (i & 3) + 8 * (i >> 2) + 4 * h; }
#define MFMA32(a, b, c) __builtin_amdgcn_mfma_f32_32x32x16_bf16((a), (b), (c), 0, 0, 0)
constexpr int KPITCH = 272, VPITCH = 320, VS_OFF = 128 * KPITCH;

DI void attn_unit(const Frame& F, const Params& P, int je, int au) {
    int b, qb, hk, hp; bool isctx;
    if (au < 512) { isctx = false; const int idx = (au & 7) * 64 + (au >> 3);
        hp = idx & 1; qb = (idx >> 1) & 63; hk = (idx >> 7) & 1; b = idx >> 8; }
    else { const int v = au - 512; isctx = true; hp = v & 1; hk = (v >> 1) & 1; qb = (v >> 2) & 1; b = v >> 3; }
    const bf16* QKV = (const bf16*)(P.ws + WS_U); bf16* YAB = (bf16*)(P.ws + WS_YAB);
    const int r = F.lane & 31, h = F.lane >> 5;
    const int qsub = F.wave & 3, head = hk * 4 + hp * 2 + (F.wave >> 2);
    const int seqbase = isctx ? (NLAT + b * CTXL) : b * SEQ;
    const int qrow = seqbase + qb * 128 + qsub * 32 + r;
    const bf16* qbase = QKV + (size_t)qrow * QKVC + head * HD + 8 * h;
    bf16x8 qf[8];
#pragma unroll
    for (int s = 0; s < 8; ++s) qf[s] = *(const bf16x8*)(qbase + 16 * s);
    float m = P.in[13][je * 8 + head] * LOG2E, l = (h == 0) ? 1.0f : 0.0f;
    f32x16 O[4];
#pragma unroll
    for (int dt = 0; dt < 4; ++dt)
#pragma unroll
        for (int i = 0; i < 16; ++i) O[dt][i] = 0.f;
    const LAS unsigned char* Ks = F.lds; const LAS unsigned char* Vs = F.lds + VS_OFF;
    const int ql = qsub * 32 + r;
    const int i16 = F.lane & 15, tq = i16 >> 2, tp = i16 & 3, blk = (F.lane >> 4) & 1;
    int nb = 0, brow[5], btype[5];
#pragma unroll
    for (int bi = 0; bi < 5; ++bi) { int krow0, type; bool ok;
        if (bi < 3) { const int kb = qb - 1 + bi; ok = !isctx && kb >= 0 && kb < SEQ / 128; krow0 = b * SEQ + kb * 128; type = bi; }
        else { ok = true; krow0 = NLAT + b * CTXL + (bi - 3) * 128; type = 1; }
        if (ok) {
#pragma unroll
            for (int q = 0; q < 5; ++q) if (q == nb) { brow[q] = krow0; btype[q] = type; }
            ++nb; } }
    u32x4 kreg[4], vreg[4];
    const int pkey = F.tid >> 4, ppc = F.tid & 15;
#define ATT_PREFETCH(krow0_) do { const bf16* src_ = QKV + (size_t)((krow0_) + pkey) * QKVC + hk * HD + ppc * 8 + QCOLS; \
        _Pragma("unroll") for (int i_ = 0; i_ < 4; ++i_) { kreg[i_] = *(const u32x4*)(src_ + (size_t)i_ * 32 * QKVC); vreg[i_] = *(const u32x4*)(src_ + (size_t)i_ * 32 * QKVC + KVC); } } while (0)
    ATT_PREFETCH(brow[0]);
    for (int bi = 0; bi < nb; ++bi) {
        int krow_next = 0, type = 1;
#pragma unroll
        for (int q = 0; q < 5; ++q) { if (q == bi) type = btype[q]; if (q == bi + 1) krow_next = brow[q]; }
        __syncthreads();
#pragma unroll
        for (int i = 0; i < 4; ++i) { *(LAS u32x4*)(F.lds + (pkey + 32 * i) * KPITCH + ppc * 16) = kreg[i]; *(LAS u32x4*)(F.lds + VS_OFF + (pkey + 32 * i) * VPITCH + ppc * 16) = vreg[i]; }
        __syncthreads();
        if (bi + 1 < nb) ATT_PREFETCH(krow_next);
#pragma unroll 1
        for (int hb = 0; hb < 2; ++hb) {
            f32x16 st[2];
#pragma unroll
            for (int k2 = 0; k2 < 2; ++k2) { const int kt = 2 * hb + k2;
#pragma unroll
                for (int i = 0; i < 16; ++i) st[k2][i] = 0.f;
#pragma unroll
                for (int s = 0; s < 8; ++s) { const bf16x8 kf = *(const LAS bf16x8*)(Ks + (kt * 32 + r) * KPITCH + (16 * s + 8 * h) * 2); st[k2] = MFMA32(kf, qf[s], st[k2]); }
                __builtin_amdgcn_sched_barrier(0); }
            if (type != 1) { int qlv = ql; asm volatile("" : "+v"(qlv));
#pragma unroll
                for (int k2 = 0; k2 < 2; ++k2)
#pragma unroll
                    for (int i = 0; i < 16; ++i) { const int kl = (2 * hb + k2) * 32 + crow(i, h); const bool ok = (type == 0) ? (kl >= qlv) : (kl <= qlv); st[k2][i] = ok ? st[k2][i] : -1e30f; } }
            float mx = st[0][0];
#pragma unroll
            for (int k2 = 0; k2 < 2; ++k2)
#pragma unroll
                for (int i = 0; i < 16; ++i) mx = fmaxf(mx, st[k2][i]);
            mx = fmaxf(mx, __shfl_xor(mx, 32));
            const float mnew = fmaxf(m, mx), alpha = __builtin_amdgcn_exp2f(m - mnew); m = mnew;
            float ls = 0.f;
#pragma unroll
            for (int k2 = 0; k2 < 2; ++k2)
#pragma unroll
                for (int i = 0; i < 16; ++i) { const float pe = __builtin_amdgcn_exp2f(st[k2][i] - mnew); st[k2][i] = pe; ls += pe; }
            l = l * alpha + ls;
#pragma unroll
            for (int dt = 0; dt < 4; ++dt)
#pragma unroll
                for (int i = 0; i < 16; ++i) O[dt][i] *= alpha;
#pragma unroll
            for (int k2 = 0; k2 < 2; ++k2)
#pragma unroll
                for (int s = 0; s < 2; ++s) { const int kt = 2 * hb + k2;
                    u32x4 pw; pw.x = cvtpk_s(st[k2][8 * s + 0], st[k2][8 * s + 1]); pw.y = cvtpk_s(st[k2][8 * s + 2], st[k2][8 * s + 3]); pw.z = cvtpk_s(st[k2][8 * s + 4], st[k2][8 * s + 5]); pw.w = cvtpk_s(st[k2][8 * s + 6], st[k2][8 * s + 7]);
                    const bf16x8 pf = __builtin_bit_cast(bf16x8, pw);
#pragma unroll
                    for (int dt = 0; dt < 4; ++dt) {
                        const LAS unsigned char* vp = Vs + (kt * 32 + 16 * s + 4 * h + tq) * VPITCH + 64 * dt + 32 * blk + 8 * tp;
                        const s16x4 lo = vtr(vp), hi = vtr(vp + 8 * VPITCH);
                        const bf16x8 vf = __builtin_shufflevector(lo, hi, 0, 1, 2, 3, 4, 5, 6, 7);
                        O[dt] = MFMA32(vf, pf, O[dt]); }
                    __builtin_amdgcn_sched_barrier(0); }
        }
    }
#undef ATT_PREFETCH
    const float lt = l + __shfl_xor(l, 32); const float inv = 1.0f / lt;
    bf16* orow = YAB + (size_t)qrow * DM + head * HD;
#pragma unroll
    for (int dt = 0; dt < 4; ++dt)
#pragma unroll
        for (int ig = 0; ig < 4; ++ig) { u32x2 w; w.x = cvtpk_s(O[dt][4 * ig] * inv, O[dt][4 * ig + 1] * inv); w.y = cvtpk_s(O[dt][4 * ig + 2] * inv, O[dt][4 * ig + 3] * inv);
            *(u32x2*)(orow + dt * 32 + 8 * ig + 4 * h) = w; }
    __syncthreads();
}
DI void unpack8(const u32x4 w, float (&v)[8]) { v[0] = bflo(w.x); v[1] = bfhi(w.x); v[2] = bflo(w.y); v[3] = bfhi(w.y); v[4] = bflo(w.z); v[5] = bfhi(w.z); v[6] = bflo(w.w); v[7] = bfhi(w.w); }
DI void s5_carry_phase(const Frame& F, const Params& P, int jo) {
    const int fr = F.lane & 15, fq = F.lane >> 4;
    for (int blk = F.bid; blk < 2 * S5G; blk += F.G) {
        const int g = blk & 127, b = blk >> 7;
        bf16* ET = (bf16*)(P.ws + WS_U) + (size_t)g * 256 * S5ROWS;
        bf16* UAg = (bf16*)(P.ws + WS_A5) + (size_t)g * S5ROWS * S5K;
        const bf16* UAc = UAg + (size_t)(1024 + b * 16) * S5K;
        const bf16* WWg = (const bf16*)(P.ws + WS_WW) + (size_t)(jo * S5G + g) * 256 * 256;
        const bf16* TTg = (const bf16*)(P.ws + WS_TT) + (size_t)(jo * S5G + g) * 256 * 512;
        const int rc0 = 1024 + b * 16, rl0 = b * 512;
#pragma unroll 1
        for (int mt = F.wave; mt < 16; mt += NWAVES) { pg8::f32x4 acc = {0.f, 0.f, 0.f, 0.f};
#pragma unroll
            for (int ks = 0; ks < 8; ++ks) { const bf16x8 a = *(const bf16x8*)(WWg + (size_t)(mt * 16 + fr) * 256 + 32 * ks + 8 * fq), bq = *(const bf16x8*)(UAc + (size_t)fr * S5K + 32 * ks + 8 * fq);
                acc = __builtin_amdgcn_mfma_f32_16x16x32_bf16(a, bq, acc, 0, 0, 0); }
#pragma unroll
            for (int j = 0; j < 4; ++j) ET[(size_t)(mt * 16 + 4 * fq + j) * S5ROWS + rc0 + fr] = (bf16)f2bf(acc[j]); }
        asm volatile("s_waitcnt vmcnt(0)" ::: "memory"); __syncthreads();
        const int p = F.lane, dir = F.wave & 1;
        const float* lp = (const float*)(P.ws + WS_LAML) + ((size_t)((jo * 2 + dir) * S5G + g) * 64 + p) * 2;
        const float lr = lp[0], li = lp[1];
        const bf16* Er = ET + (size_t)(dir * 128 + p) * S5ROWS;
        bf16* Ug = UAg + 256 + dir * 128 + p;
        float sr = 0.f, si = 0.f;
        if (F.wave < 2) {
            float cr[16], ci[16];
            { float t8[8]; unpack8(*(const u32x4*)(Er + rc0), t8);
#pragma unroll
              for (int e = 0; e < 8; ++e) cr[e] = t8[e];
              unpack8(*(const u32x4*)(Er + rc0 + 8), t8);
#pragma unroll
              for (int e = 0; e < 8; ++e) cr[8 + e] = t8[e];
              unpack8(*(const u32x4*)(Er + 64 * S5ROWS + rc0), t8);
#pragma unroll
              for (int e = 0; e < 8; ++e) ci[e] = t8[e];
              unpack8(*(const u32x4*)(Er + 64 * S5ROWS + rc0 + 8), t8);
#pragma unroll
              for (int e = 0; e < 8; ++e) ci[8 + e] = t8[e]; }
#pragma unroll
            for (int q = 0; q < 16; ++q) { const int qq = dir == 0 ? q : 15 - q; const int row = rc0 + qq;
                Ug[(size_t)row * S5K] = (bf16)f2bf(sr); Ug[(size_t)row * S5K + 64] = (bf16)f2bf(si);
                const float xr = dir == 0 ? cr[q] : cr[15 - q], xi = dir == 0 ? ci[q] : ci[15 - q];
                const float nr = lr * sr - li * si + xr, ni = lr * si + li * sr + xi; sr = nr; si = ni; } }
        asm volatile("s_waitcnt vmcnt(0)" ::: "memory"); __syncthreads();
        if (F.wave < 2) {
#define S5BLK(bq) (dir == 0 ? rl0 + 8 * (bq) : rl0 + 504 - 8 * (bq))
            u32x4 er[4], ei[4];
#pragma unroll
            for (int k = 0; k < 4; ++k) { const int row = S5BLK(k); er[k] = *(const u32x4*)(Er + row); ei[k] = *(const u32x4*)(Er + 64 * S5ROWS + row); }
#pragma unroll 1
            for (int b0 = 0; b0 < 64; b0 += 4) {
                u32x4 nr_[4], ni_[4];
#pragma unroll
                for (int k = 0; k < 4; ++k) { const int bq = b0 + 4 + k; if (bq < 64) { const int row = S5BLK(bq); nr_[k] = *(const u32x4*)(Er + row); ni_[k] = *(const u32x4*)(Er + 64 * S5ROWS + row); } else { nr_[k] = (u32x4){0u, 0u, 0u, 0u}; ni_[k] = nr_[k]; } }
#pragma unroll
                for (int k = 0; k < 4; ++k) { const int row0 = S5BLK(b0 + k); float vr[8], vi[8]; unpack8(er[k], vr); unpack8(ei[k], vi);
#pragma unroll
                    for (int e = 0; e < 8; ++e) { const int ee = dir == 0 ? e : 7 - e; const int row = row0 + ee;
                        Ug[(size_t)row * S5K] = (bf16)f2bf(sr); Ug[(size_t)row * S5K + 64] = (bf16)f2bf(si);
                        const float xr = dir == 0 ? vr[e] : vr[7 - e], xi = dir == 0 ? vi[e] : vi[7 - e];
                        const float nr = lr * sr - li * si + xr, ni = lr * si + li * sr + xi; sr = nr; si = ni; } }
#pragma unroll
                for (int k = 0; k < 4; ++k) { er[k] = nr_[k]; ei[k] = ni_[k]; }
            }
#undef S5BLK
        } else {
            bf16* G2c = (bf16*)(P.ws + WS_Y) + ((size_t)g * S5ROWS + rc0) * 256;
#pragma unroll 1
            for (int mt = F.wave - 2; mt < 16; mt += NWAVES - 2) { pg8::f32x4 acc = {0.f, 0.f, 0.f, 0.f};
#pragma unroll
                for (int ks = 0; ks < 16; ++ks) { const bf16x8 a = *(const bf16x8*)(TTg + (size_t)(mt * 16 + fr) * 512 + 32 * ks + 8 * fq), bq = *(const bf16x8*)(UAc + (size_t)fr * S5K + 32 * ks + 8 * fq);
                    acc = __builtin_amdgcn_mfma_f32_16x16x32_bf16(a, bq, acc, 0, 0, 0); }
                u32x2 w; w.x = pk2(gelu_tanh(acc[0]), gelu_tanh(acc[1])); w.y = pk2(gelu_tanh(acc[2]), gelu_tanh(acc[3]));
                *(u32x2*)(G2c + (size_t)fr * 256 + mt * 16 + 4 * fq) = w; }
        }
        __syncthreads();
    }
}
constexpr int N_PHASES = 3 + 4 * 8;
#ifndef WGM_C2
#define WGM_C2 8
#endif
#ifndef WGM_E1
#define WGM_E1 4
#endif
#ifndef STAGGER_US
#define STAGGER_US 0
#endif
#ifndef REV_C4
#define REV_C4 0
#endif
#ifndef WGM_O4
#define WGM_O4 4
#endif
#ifndef WGM_C4
#define WGM_C4 4
#endif
#ifndef DUP_MASK_VALUE
#define DUP_MASK_VALUE 0ull
#endif
constexpr unsigned long long DUP_MASK = DUP_MASK_VALUE;
#ifndef DUP_SUB
#define DUP_SUB 0
#endif
typedef const Params __attribute__((address_space(4)))* ParamsK;
__global__ void __launch_bounds__(NTHR, 2) hybrid_fwd(Params Parg) {
    extern __shared__ __attribute__((aligned(16))) unsigned char lds_raw[];
    Frame F0; F0.lds = (LAS unsigned char*)lds_raw; F0.tid = threadIdx.x; F0.lane = F0.tid & 63; F0.wave = __builtin_amdgcn_readfirstlane(F0.tid >> 6); F0.G = gridDim.x; F0.bid = blockIdx.x;
    for (int u = F0.tid; u < (LDS_BYTES - LDSCTL_OFF) / 4; u += NTHR) ((LAS unsigned*)(F0.lds + LDSCTL_OFF))[u] = 0u;
    __syncthreads();
    XcdBarrier bar = xcd_barrier_post((unsigned*)(Parg.ws + WS_CTL) + CW_BAR, (volatile LAS unsigned*)(F0.lds + LDSCTL_OFF + 64));
    const int lo = Parg.lo, hi = Parg.hi; int ph = 0;
#define RUNP() (lo <= ph && ph < hi)
#define PHASE_BEGIN for (int rep_ = 0; RUNP() && rep_ < (((DUP_MASK >> ph) & 1ull) ? 2 : 1); ++rep_)
#define SEAM() do { if (lo <= ph && ph + 1 < hi) { XcdBarrier bl_ = bar; asm volatile("" : "+s"(bl_.x)); xcd_barrier(bl_); if (DUP_SUB == 6) xcd_barrier(bl_); } ++ph; } while (0)
#define LOCALS() Frame F = F0; { int t_ = F0.tid; asm volatile("" : "+v"(t_)); F.tid = t_; F.lane = t_ & 63; F.wave = __builtin_amdgcn_readfirstlane(t_ >> 6); int b_ = F0.bid, g_ = F0.G; asm volatile("" : "+s"(b_), "+s"(g_)); F.bid = b_; F.G = g_; } \
    ParamsK pk_ = (ParamsK)__builtin_amdgcn_kernarg_segment_ptr(); asm volatile("" : "+s"(pk_)); Params P; _Pragma("unroll") for (int i_ = 0; i_ < 33; ++i_) P.in[i_] = pk_->in[i_]; P.out = pk_->out; P.ws = pk_->ws; P.lo = 0; P.hi = 0; P.pad0 = 0; P.pad1 = 0; unsigned char* const ws = P.ws; (void)ws
#define W_MOD ((float*)(ws + WS_MOD))
#define W_XC ((float*)(ws + WS_XC))
#define W_XB ((bf16*)(ws + WS_XB))
#define W_HM ((bf16*)(ws + WS_HM))
#define W_YAB ((bf16*)(ws + WS_YAB))
#define W_Y ((bf16*)(ws + WS_Y))
#define W_PART ((bf16*)(ws + WS_PART))
#define W_A5 ((bf16*)(ws + WS_A5))
#define W_U ((bf16*)(ws + WS_U))
#define W_ZBT ((bf16*)(ws + WS_U + 50 * MiB))
#define W_F32U ((float*)(ws + WS_U))

    PHASE_BEGIN { LOCALS(); p0_prologue(F, P); }
    SEAM();
    PHASE_BEGIN { LOCALS(); p1_phase(F, P); }
    SEAM();
    PHASE_BEGIN { LOCALS(); row_phase<0, false, false>(F, nullptr, nullptr, 0, MROWS, P.in[0], P.in[2], nullptr, nullptr, nullptr, nullptr, 0, true, P.in[6], W_MOD, 0, 1, W_HM, nullptr); }
    SEAM();
    { constexpr int layer = 0;
        constexpr int jj = layer >> 1; constexpr bool LASTL = (layer == DEPTH - 1); constexpr int NROWS_L = LASTL ? NLAT : MROWS;
        if ((layer & 1) == 0) {
            PHASE_BEGIN { LOCALS();
                pg8::OrderE1 S{F.G, F.bid, (const char*)W_HM, (const char*)(ws + WS_WIN + jj * SZ_WIN)};
                typedef pg8::EpiQKVZ<(DUP_SUB == 5 && layer == 0) ? 3 : 1> EpiE1; EpiE1 E{W_U, W_ZBT, (const float*)(ws + WS_TAB)};
                pg8::gemm_phase<EpiE1, pg8::OrderE1, true>(F.lds, F.tid, pg8::Gemm{DM, DM}, S, E);
            }
            SEAM();
            PHASE_BEGIN { LOCALS();
                { u32x4 twf[2], twb[2]; int c = F.bid;
                    if (c < 1024) hyena_taps(F, P, jj, c, twf, twb);
#pragma unroll 1
                    for (; c < 1024; c += F.G) hyena_unit(F, P, jj, c, (c + F.G < 1024) ? c + F.G : -1, twf, twb); }
                for (int rr_ = 0; rr_ < ((DUP_SUB == 2 && layer == 0) ? 2 : 1); ++rr_) for (int au = F.bid; au < 528; au += F.G) attn_unit(F, P, jj, au);
            }
            SEAM();
            PHASE_BEGIN { LOCALS(); ybt_transpose_phase(F, P); }
            SEAM();
            PHASE_BEGIN { LOCALS();
                pg8::OrderSplit S; S.init(W_YAB, ws + WS_WOUT + jj * SZ_WOUT, DM, DM, DM, DM, 1, F.G, F.bid);
                pg8::EpiYb E{W_Y, DM, nullptr, W_PART};
                pg8::gemm_phase<pg8::EpiYb, pg8::OrderSplit, true>(F.lds, F.tid, pg8::Gemm{DM, DM}, S, E);
            }
            SEAM();
        } else {
            PHASE_BEGIN { LOCALS();
                pg8::OrderS5 S{F.G, F.bid, 256 / 64, (const char*)W_A5, (const char*)(ws + WS_WW + (size_t)jj * S5G * 256 * 256 * 2), (size_t)256 * 256 * 2, 1};
                pg8::EpiBf16g E{W_U, S5ROWS};
                pg8::gemm_phase<pg8::EpiBf16g, pg8::OrderS5, true>(F.lds, F.tid, pg8::Gemm{256, S5K}, S, E);
            }
            SEAM();
            PHASE_BEGIN { LOCALS(); s5_carry_phase(F, P, jj); }
            SEAM();
            PHASE_BEGIN { LOCALS();
                pg8::OrderS5 S{F.G, F.bid, S5K / 64, (const char*)W_A5, (const char*)(ws + WS_TT + (size_t)jj * S5G * 256 * 512 * 2), (size_t)256 * 512 * 2, 0};
                pg8::EpiS5G E{W_Y};
                pg8::gemm_phase<pg8::EpiS5G, pg8::OrderS5, true>(F.lds, F.tid, pg8::Gemm{S5K, S5K}, S, E);
            }
            SEAM();
            PHASE_BEGIN { LOCALS();
                pg8::OrderSplit S; S.init(W_Y, ws + WS_WGLU + jj * SZ_WGLU, 2 * DM, DM, DM, DM, LASTL ? 0 : 1, F.G, F.bid, 1, WGM_O4);
                pg8::EpiGlu E{W_U, P.in[32] + (size_t)jj * 2 * DM, W_PART};
                pg8::gemm_phase<pg8::EpiGlu, pg8::OrderSplit, true, 1>(F.lds, F.tid, pg8::Gemm{DM, DM}, S, E);
            }
            SEAM();
        }
        PHASE_BEGIN { LOCALS();
            const float* modl = W_MOD + (size_t)layer * 3 * NMOD * DM; const float* ngl = P.in[6] + (size_t)layer * 4 * DM;
            if (layer == 0) { if ((layer & 1) == 0) row_phase<1, false, true>(F, W_Y, W_PART, 8, NROWS_L, P.in[0], P.in[2], W_XB, nullptr, ngl + 1 * DM, modl, 2, true, ngl + 2 * DM, modl, 3, 4, W_HM, nullptr); }
            else if ((layer & 1) == 0) row_phase<1, true, true>(F, W_Y, W_PART, 8, NROWS_L, W_XB, nullptr, W_XB, nullptr, ngl + 1 * DM, modl, 2, true, ngl + 2 * DM, modl, 3, 4, W_HM, nullptr);
            else row_phase<3, true, true>(F, W_U, W_PART, 8, NROWS_L, W_XB, nullptr, W_XB, nullptr, ngl + 1 * DM, modl, 2, true, ngl + 2 * DM, modl, 3, 4, W_HM, nullptr);
        }
        SEAM();
        PHASE_BEGIN { LOCALS();
            if (STAGGER_US > 0) { const unsigned long long t0_ = __builtin_amdgcn_s_memrealtime(); const unsigned long long dl_ = (unsigned long long)(((F.bid >> 3) & 3) * STAGGER_US * 100); while (__builtin_amdgcn_s_memrealtime() - t0_ < dl_) __builtin_amdgcn_s_sleep(4); }
            pg8::OrderUp S{F.G, F.bid, LASTL ? 66 : 70, (const char*)W_HM, (const char*)(ws + WS_WUP + layer * SZ_WUP), WGM_C2};
            typedef pg8::EpiUpGlu<(DUP_SUB == 3 && layer == 0) ? 2 : 1> EpiUp; EpiUp E{W_A5, P.in[8] + (size_t)layer * 3 * DFF2, P.in[9] + (size_t)layer * DFF2, (LAS float*)(F.lds + AUX_OFF)};
            pg8::gemm_phase<EpiUp, pg8::OrderUp, true>(F.lds, F.tid, pg8::Gemm{DM, DM}, S, E);
        }
        SEAM();
        PHASE_BEGIN { LOCALS();
            pg8::OrderSplit S; S.init(W_A5, ws + WS_WDOWN + layer * SZ_WDOWN, DM, DFF, DFF, DFF, LASTL ? 0 : 1, F.G, F.bid, 0, WGM_C4, REV_C4);
            pg8::EpiYb E{W_Y, DM, nullptr, W_PART};
            pg8::gemm_phase<pg8::EpiYb, pg8::OrderSplit, true>(F.lds, F.tid, pg8::Gemm{DFF, DFF}, S, E);
        }
        SEAM();
        PHASE_BEGIN { LOCALS();
            const float* modl = W_MOD + (size_t)layer * 3 * NMOD * DM; const float* ngl = P.in[6] + (size_t)layer * 4 * DM;
            if (LASTL) row_phase<1, true, false>(F, W_Y, W_PART, 15, NROWS_L, W_XB, nullptr, P.out, nullptr, ngl + 3 * DM, modl, 5, false, nullptr, nullptr, 0, 1, nullptr, nullptr);
            else row_phase<1, true, true>(F, W_Y, W_PART, 15, NROWS_L, W_XB, nullptr, W_XB, nullptr, ngl + 3 * DM, modl, 5, true, ngl + 4 * DM, modl + 3 * NMOD * DM, 0, 1, ((layer & 1) == 0) ? nullptr : W_HM, ((layer & 1) == 0) ? W_A5 : nullptr);
        }
        SEAM();
    }
    { constexpr int layer = 1;
        constexpr int jj = layer >> 1; constexpr bool LASTL = (layer == DEPTH - 1); constexpr int NROWS_L = LASTL ? NLAT : MROWS;
        if ((layer & 1) == 0) {
            PHASE_BEGIN { LOCALS();
                pg8::OrderE1 S{F.G, F.bid, (const char*)W_HM, (const char*)(ws + WS_WIN + jj * SZ_WIN)};
                typedef pg8::EpiQKVZ<(DUP_SUB == 5 && layer == 0) ? 3 : 1> EpiE1; EpiE1 E{W_U, W_ZBT, (const float*)(ws + WS_TAB)};
                pg8::gemm_phase<EpiE1, pg8::OrderE1, true>(F.lds, F.tid, pg8::Gemm{DM, DM}, S, E);
            }
            SEAM();
            PHASE_BEGIN { LOCALS();
                { u32x4 twf[2], twb[2]; int c = F.bid;
                    if (c < 1024) hyena_taps(F, P, jj, c, twf, twb);
#pragma unroll 1
                    for (; c < 1024; c += F.G) hyena_unit(F, P, jj, c, (c + F.G < 1024) ? c + F.G : -1, twf, twb); }
                for (int rr_ = 0; rr_ < ((DUP_SUB == 2 && layer == 0) ? 2 : 1); ++rr_) for (int au = F.bid; au < 528; au += F.G) attn_unit(F, P, jj, au);
            }
            SEAM();
            PHASE_BEGIN { LOCALS(); ybt_transpose_phase(F, P); }
            SEAM();
            PHASE_BEGIN { LOCALS();
                pg8::OrderSplit S; S.init(W_YAB, ws + WS_WOUT + jj * SZ_WOUT, DM, DM, DM, DM, 1, F.G, F.bid);
                pg8::EpiYb E{W_Y, DM, nullptr, W_PART};
                pg8::gemm_phase<pg8::EpiYb, pg8::OrderSplit, true>(F.lds, F.tid, pg8::Gemm{DM, DM}, S, E);
            }
            SEAM();
        } else {
            PHASE_BEGIN { LOCALS();
                pg8::OrderS5 S{F.G, F.bid, 256 / 64, (const char*)W_A5, (const char*)(ws + WS_WW + (size_t)jj * S5G * 256 * 256 * 2), (size_t)256 * 256 * 2, 1};
                pg8::EpiBf16g E{W_U, S5ROWS};
                pg8::gemm_phase<pg8::EpiBf16g, pg8::OrderS5, true>(F.lds, F.tid, pg8::Gemm{256, S5K}, S, E);
            }
            SEAM();
            PHASE_BEGIN { LOCALS(); s5_carry_phase(F, P, jj); }
            SEAM();
            PHASE_BEGIN { LOCALS();
                pg8::OrderS5 S{F.G, F.bid, S5K / 64, (const char*)W_A5, (const char*)(ws + WS_TT + (size_t)jj * S5G * 256 * 512 * 2), (size_t)256 * 512 * 2, 0};
                pg8::EpiS5G E{W_Y};
                pg8::gemm_phase<pg8::EpiS5G, pg8::OrderS5, true>(F.lds, F.tid, pg8::Gemm{S5K, S5K}, S, E);
            }
            SEAM();
            PHASE_BEGIN { LOCALS();
                pg8::OrderSplit S; S.init(W_Y, ws + WS_WGLU + jj * SZ_WGLU, 2 * DM, DM, DM, DM, LASTL ? 0 : 1, F.G, F.bid, 1, WGM_O4);
                pg8::EpiGlu E{W_U, P.in[32] + (size_t)jj * 2 * DM, W_PART};
                pg8::gemm_phase<pg8::EpiGlu, pg8::OrderSplit, true, 1>(F.lds, F.tid, pg8::Gemm{DM, DM}, S, E);
            }
            SEAM();
        }
        PHASE_BEGIN { LOCALS();
            const float* modl = W_MOD + (size_t)layer * 3 * NMOD * DM; const float* ngl = P.in[6] + (size_t)layer * 4 * DM;
            if (layer == 0) { if ((layer & 1) == 0) row_phase<1, false, true>(F, W_Y, W_PART, 8, NROWS_L, P.in[0], P.in[2], W_XB, nullptr, ngl + 1 * DM, modl, 2, true, ngl + 2 * DM, modl, 3, 4, W_HM, nullptr); }
            else if ((layer & 1) == 0) row_phase<1, true, true>(F, W_Y, W_PART, 8, NROWS_L, W_XB, nullptr, W_XB, nullptr, ngl + 1 * DM, modl, 2, true, ngl + 2 * DM, modl, 3, 4, W_HM, nullptr);
            else row_phase<3, true, true>(F, W_U, W_PART, 8, NROWS_L, W_XB, nullptr, W_XB, nullptr, ngl + 1 * DM, modl, 2, true, ngl + 2 * DM, modl, 3, 4, W_HM, nullptr);
        }
        SEAM();
        PHASE_BEGIN { LOCALS();
            if (STAGGER_US > 0) { const unsigned long long t0_ = __builtin_amdgcn_s_memrealtime(); const unsigned long long dl_ = (unsigned long long)(((F.bid >> 3) & 3) * STAGGER_US * 100); while (__builtin_amdgcn_s_memrealtime() - t0_ < dl_) __builtin_amdgcn_s_sleep(4); }
            pg8::OrderUp S{F.G, F.bid, LASTL ? 66 : 70, (const char*)W_HM, (const char*)(ws + WS_WUP + layer * SZ_WUP), WGM_C2};
            typedef pg8::EpiUpGlu<(DUP_SUB == 3 && layer == 0) ? 2 : 1> EpiUp; EpiUp E{W_A5, P.in[8] + (size_t)layer * 3 * DFF2, P.in[9] + (size_t)layer * DFF2, (LAS float*)(F.lds + AUX_OFF)};
            pg8::gemm_phase<EpiUp, pg8::OrderUp, true>(F.lds, F.tid, pg8::Gemm{DM, DM}, S, E);
        }
        SEAM();
        PHASE_BEGIN { LOCALS();
            pg8::OrderSplit S; S.init(W_A5, ws + WS_WDOWN + layer * SZ_WDOWN, DM, DFF, DFF, DFF, LASTL ? 0 : 1, F.G, F.bid, 0, WGM_C4, REV_C4);
            pg8::EpiYb E{W_Y, DM, nullptr, W_PART};
            pg8::gemm_phase<pg8::EpiYb, pg8::OrderSplit, true>(F.lds, F.tid, pg8::Gemm{DFF, DFF}, S, E);
        }
        SEAM();
        PHASE_BEGIN { LOCALS();
            const float* modl = W_MOD + (size_t)layer * 3 * NMOD * DM; const float* ngl = P.in[6] + (size_t)layer * 4 * DM;
            if (LASTL) row_phase<1, true, false>(F, W_Y, W_PART, 15, NROWS_L, W_XB, nullptr, P.out, nullptr, ngl + 3 * DM, modl, 5, false, nullptr, nullptr, 0, 1, nullptr, nullptr);
            else row_phase<1, true, true>(F, W_Y, W_PART, 15, NROWS_L, W_XB, nullptr, W_XB, nullptr, ngl + 3 * DM, modl, 5, true, ngl + 4 * DM, modl + 3 * NMOD * DM, 0, 1, ((layer & 1) == 0) ? nullptr : W_HM, ((layer & 1) == 0) ? W_A5 : nullptr);
        }
        SEAM();
    }
    { constexpr int layer = 2;
        constexpr int jj = layer >> 1; constexpr bool LASTL = (layer == DEPTH - 1); constexpr int NROWS_L = LASTL ? NLAT : MROWS;
        if ((layer & 1) == 0) {
            PHASE_BEGIN { LOCALS();
                pg8::OrderE1 S{F.G, F.bid, (const char*)W_HM, (const char*)(ws + WS_WIN + jj * SZ_WIN)};
                typedef pg8::EpiQKVZ<(DUP_SUB == 5 && layer == 0) ? 3 : 1> EpiE1; EpiE1 E{W_U, W_ZBT, (const float*)(ws + WS_TAB)};
                pg8::gemm_phase<EpiE1, pg8::OrderE1, true>(F.lds, F.tid, pg8::Gemm{DM, DM}, S, E);
            }
            SEAM();
            PHASE_BEGIN { LOCALS();
                { u32x4 twf[2], twb[2]; int c = F.bid;
                    if (c < 1024) hyena_taps(F, P, jj, c, twf, twb);
#pragma unroll 1
                    for (; c < 1024; c += F.G) hyena_unit(F, P, jj, c, (c + F.G < 1024) ? c + F.G : -1, twf, twb); }
                for (int rr_ = 0; rr_ < ((DUP_SUB == 2 && layer == 0) ? 2 : 1); ++rr_) for (int au = F.bid; au < 528; au += F.G) attn_unit(F, P, jj, au);
            }
            SEAM();
            PHASE_BEGIN { LOCALS(); ybt_transpose_phase(F, P); }
            SEAM();
            PHASE_BEGIN { LOCALS();
                pg8::OrderSplit S; S.init(W_YAB, ws + WS_WOUT + jj * SZ_WOUT, DM, DM, DM, DM, 1, F.G, F.bid);
                pg8::EpiYb E{W_Y, DM, nullptr, W_PART};
                pg8::gemm_phase<pg8::EpiYb, pg8::OrderSplit, true>(F.lds, F.tid, pg8::Gemm{DM, DM}, S, E);
            }
            SEAM();
        } else {
            PHASE_BEGIN { LOCALS();
                pg8::OrderS5 S{F.G, F.bid, 256 / 64, (const char*)W_A5, (const char*)(ws + WS_WW + (size_t)jj * S5G * 256 * 256 * 2), (size_t)256 * 256 * 2, 1};
                pg8::EpiBf16g E{W_U, S5ROWS};
                pg8::gemm_phase<pg8::EpiBf16g, pg8::OrderS5, true>(F.lds, F.tid, pg8::Gemm{256, S5K}, S, E);
            }
            SEAM();
            PHASE_BEGIN { LOCALS(); s5_carry_phase(F, P, jj); }
            SEAM();
            PHASE_BEGIN { LOCALS();
                pg8::OrderS5 S{F.G, F.bid, S5K / 64, (const char*)W_A5, (const char*)(ws + WS_TT + (size_t)jj * S5G * 256 * 512 * 2), (size_t)256 * 512 * 2, 0};
                pg8::EpiS5G E{W_Y};
                pg8::gemm_phase<pg8::EpiS5G, pg8::OrderS5, true>(F.lds, F.tid, pg8::Gemm{S5K, S5K}, S, E);
            }
            SEAM();
            PHASE_BEGIN { LOCALS();
                pg8::OrderSplit S; S.init(W_Y, ws + WS_WGLU + jj * SZ_WGLU, 2 * DM, DM, DM, DM, LASTL ? 0 : 1, F.G, F.bid, 1, WGM_O4);
                pg8::EpiGlu E{W_U, P.in[32] + (size_t)jj * 2 * DM, W_PART};
                pg8::gemm_phase<pg8::EpiGlu, pg8::OrderSplit, true, 1>(F.lds, F.tid, pg8::Gemm{DM, DM}, S, E);
            }
            SEAM();
        }
        PHASE_BEGIN { LOCALS();
            const float* modl = W_MOD + (size_t)layer * 3 * NMOD * DM; const float* ngl = P.in[6] + (size_t)layer * 4 * DM;
            if (layer == 0) { if ((layer & 1) == 0) row_phase<1, false, true>(F, W_Y, W_PART, 8, NROWS_L, P.in[0], P.in[2], W_XB, nullptr, ngl + 1 * DM, modl, 2, true, ngl + 2 * DM, modl, 3, 4, W_HM, nullptr); }
            else if ((layer & 1) == 0) row_phase<1, true, true>(F, W_Y, W_PART, 8, NROWS_L, W_XB, nullptr, W_XB, nullptr, ngl + 1 * DM, modl, 2, true, ngl + 2 * DM, modl, 3, 4, W_HM, nullptr);
            else row_phase<3, true, true>(F, W_U, W_PART, 8, NROWS_L, W_XB, nullptr, W_XB, nullptr, ngl + 1 * DM, modl, 2, true, ngl + 2 * DM, modl, 3, 4, W_HM, nullptr);
        }
        SEAM();
        PHASE_BEGIN { LOCALS();
            if (STAGGER_US > 0) { const unsigned long long t0_ = __builtin_amdgcn_s_memrealtime(); const unsigned long long dl_ = (unsigned long long)(((F.bid >> 3) & 3) * STAGGER_US * 100); while (__builtin_amdgcn_s_memrealtime() - t0_ < dl_) __builtin_amdgcn_s_sleep(4); }
            pg8::OrderUp S{F.G, F.bid, LASTL ? 66 : 70, (const char*)W_HM, (const char*)(ws + WS_WUP + layer * SZ_WUP), WGM_C2};
            typedef pg8::EpiUpGlu<(DUP_SUB == 3 && layer == 0) ? 2 : 1> EpiUp; EpiUp E{W_A5, P.in[8] + (size_t)layer * 3 * DFF2, P.in[9] + (size_t)layer * DFF2, (LAS float*)(F.lds + AUX_OFF)};
            pg8::gemm_phase<EpiUp, pg8::OrderUp, true>(F.lds, F.tid, pg8::Gemm{DM, DM}, S, E);
        }
        SEAM();
        PHASE_BEGIN { LOCALS();
            pg8::OrderSplit S; S.init(W_A5, ws + WS_WDOWN + layer * SZ_WDOWN, DM, DFF, DFF, DFF, LASTL ? 0 : 1, F.G, F.bid, 0, WGM_C4, REV_C4);
            pg8::EpiYb E{W_Y, DM, nullptr, W_PART};
            pg8::gemm_phase<pg8::EpiYb, pg8::OrderSplit, true>(F.lds, F.tid, pg8::Gemm{DFF, DFF}, S, E);
        }
        SEAM();
        PHASE_BEGIN { LOCALS();
            const float* modl = W_MOD + (size_t)layer * 3 * NMOD * DM; const float* ngl = P.in[6] + (size_t)layer * 4 * DM;
            if (LASTL) row_phase<1, true, false>(F, W_Y, W_PART, 15, NROWS_L, W_XB, nullptr, P.out, nullptr, ngl + 3 * DM, modl, 5, false, nullptr, nullptr, 0, 1, nullptr, nullptr);
            else row_phase<1, true, true>(F, W_Y, W_PART, 15, NROWS_L, W_XB, nullptr, W_XB, nullptr, ngl + 3 * DM, modl, 5, true, ngl + 4 * DM, modl + 3 * NMOD * DM, 0, 1, ((layer & 1) == 0) ? nullptr : W_HM, ((layer & 1) == 0) ? W_A5 : nullptr);
        }
        SEAM();
    }
    { constexpr int layer = 3;
        constexpr int jj = layer >> 1; constexpr bool LASTL = (layer == DEPTH - 1); constexpr int NROWS_L = LASTL ? NLAT : MROWS;
        if ((layer & 1) == 0) {
            PHASE_BEGIN { LOCALS();
                pg8::OrderE1 S{F.G, F.bid, (const char*)W_HM, (const char*)(ws + WS_WIN + jj * SZ_WIN)};
                typedef pg8::EpiQKVZ<(DUP_SUB == 5 && layer == 0) ? 3 : 1> EpiE1; EpiE1 E{W_U, W_ZBT, (const float*)(ws + WS_TAB)};
                pg8::gemm_phase<EpiE1, pg8::OrderE1, true>(F.lds, F.tid, pg8::Gemm{DM, DM}, S, E);
            }
            SEAM();
            PHASE_BEGIN { LOCALS();
                { u32x4 twf[2], twb[2]; int c = F.bid;
                    if (c < 1024) hyena_taps(F, P, jj, c, twf, twb);
#pragma unroll 1
                    for (; c < 1024; c += F.G) hyena_unit(F, P, jj, c, (c + F.G < 1024) ? c + F.G : -1, twf, twb); }
                for (int rr_ = 0; rr_ < ((DUP_SUB == 2 && layer == 0) ? 2 : 1); ++rr_) for (int au = F.bid; au < 528; au += F.G) attn_unit(F, P, jj, au);
            }
            SEAM();
            PHASE_BEGIN { LOCALS(); ybt_transpose_phase(F, P); }
            SEAM();
            PHASE_BEGIN { LOCALS();
                pg8::OrderSplit S; S.init(W_YAB, ws + WS_WOUT + jj * SZ_WOUT, DM, DM, DM, DM, 1, F.G, F.bid);
                pg8::EpiYb E{W_Y, DM, nullptr, W_PART};
                pg8::gemm_phase<pg8::EpiYb, pg8::OrderSplit, true>(F.lds, F.tid, pg8::Gemm{DM, DM}, S, E);
            }
            SEAM();
        } else {
            PHASE_BEGIN { LOCALS();
                pg8::OrderS5 S{F.G, F.bid, 256 / 64, (const char*)W_A5, (const char*)(ws + WS_WW + (size_t)jj * S5G * 256 * 256 * 2), (size_t)256 * 256 * 2, 1};
                pg8::EpiBf16g E{W_U, S5ROWS};
                pg8::gemm_phase<pg8::EpiBf16g, pg8::OrderS5, true>(F.lds, F.tid, pg8::Gemm{256, S5K}, S, E);
            }
            SEAM();
            PHASE_BEGIN { LOCALS(); s5_carry_phase(F, P, jj); }
            SEAM();
            PHASE_BEGIN { LOCALS();
                pg8::OrderS5 S{F.G, F.bid, S5K / 64, (const char*)W_A5, (const char*)(ws + WS_TT + (size_t)jj * S5G * 256 * 512 * 2), (size_t)256 * 512 * 2, 0};
                pg8::EpiS5G E{W_Y};
                pg8::gemm_phase<pg8::EpiS5G, pg8::OrderS5, true>(F.lds, F.tid, pg8::Gemm{S5K, S5K}, S, E);
            }
            SEAM();
            PHASE_BEGIN { LOCALS();
                pg8::OrderSplit S; S.init(W_Y, ws + WS_WGLU + jj * SZ_WGLU, 2 * DM, DM, DM, DM, LASTL ? 0 : 1, F.G, F.bid, 1, WGM_O4);
                pg8::EpiGlu E{W_U, P.in[32] + (size_t)jj * 2 * DM, W_PART};
                pg8::gemm_phase<pg8::EpiGlu, pg8::OrderSplit, true, 1>(F.lds, F.tid, pg8::Gemm{DM, DM}, S, E);
            }
            SEAM();
        }
        PHASE_BEGIN { LOCALS();
            const float* modl = W_MOD + (size_t)layer * 3 * NMOD * DM; const float* ngl = P.in[6] + (size_t)layer * 4 * DM;
            if (layer == 0) { if ((layer & 1) == 0) row_phase<1, false, true>(F, W_Y, W_PART, 8, NROWS_L, P.in[0], P.in[2], W_XB, nullptr, ngl + 1 * DM, modl, 2, true, ngl + 2 * DM, modl, 3, 4, W_HM, nullptr); }
            else if ((layer & 1) == 0) row_phase<1, true, true>(F, W_Y, W_PART, 8, NROWS_L, W_XB, nullptr, W_XB, nullptr, ngl + 1 * DM, modl, 2, true, ngl + 2 * DM, modl, 3, 4, W_HM, nullptr);
            else row_phase<3, true, true>(F, W_U, W_PART, 8, NROWS_L, W_XB, nullptr, W_XB, nullptr, ngl + 1 * DM, modl, 2, true, ngl + 2 * DM, modl, 3, 4, W_HM, nullptr);
        }
        SEAM();
        PHASE_BEGIN { LOCALS();
            if (STAGGER_US > 0) { const unsigned long long t0_ = __builtin_amdgcn_s_memrealtime(); const unsigned long long dl_ = (unsigned long long)(((F.bid >> 3) & 3) * STAGGER_US * 100); while (__builtin_amdgcn_s_memrealtime() - t0_ < dl_) __builtin_amdgcn_s_sleep(4); }
            pg8::OrderUp S{F.G, F.bid, LASTL ? 66 : 70, (const char*)W_HM, (const char*)(ws + WS_WUP + layer * SZ_WUP), WGM_C2};
            typedef pg8::EpiUpGlu<(DUP_SUB == 3 && layer == 0) ? 2 : 1> EpiUp; EpiUp E{W_A5, P.in[8] + (size_t)layer * 3 * DFF2, P.in[9] + (size_t)layer * DFF2, (LAS float*)(F.lds + AUX_OFF)};
            pg8::gemm_phase<EpiUp, pg8::OrderUp, true>(F.lds, F.tid, pg8::Gemm{DM, DM}, S, E);
        }
        SEAM();
        PHASE_BEGIN { LOCALS();
            pg8::OrderSplit S; S.init(W_A5, ws + WS_WDOWN + layer * SZ_WDOWN, DM, DFF, DFF, DFF, LASTL ? 0 : 1, F.G, F.bid, 0, WGM_C4, REV_C4);
            pg8::EpiYb E{W_Y, DM, nullptr, W_PART};
            pg8::gemm_phase<pg8::EpiYb, pg8::OrderSplit, true>(F.lds, F.tid, pg8::Gemm{DFF, DFF}, S, E);
        }
        SEAM();
        PHASE_BEGIN { LOCALS();
            const float* modl = W_MOD + (size_t)layer * 3 * NMOD * DM; const float* ngl = P.in[6] + (size_t)layer * 4 * DM;
            if (LASTL) row_phase<1, true, false>(F, W_Y, W_PART, 15, NROWS_L, W_XB, nullptr, P.out, nullptr, ngl + 3 * DM, modl, 5, false, nullptr, nullptr, 0, 1, nullptr, nullptr);
            else row_phase<1, true, true>(F, W_Y, W_PART, 15, NROWS_L, W_XB, nullptr, W_XB, nullptr, ngl + 3 * DM, modl, 5, true, ngl + 4 * DM, modl + 3 * NMOD * DM, 0, 1, ((layer & 1) == 0) ? nullptr : W_HM, ((layer & 1) == 0) ? W_A5 : nullptr);
        }
        SEAM();
    }
#undef RUNP
#undef SEAM
}

extern "C" void kernel_launch(void* const* d_in, const int* in_sizes, int n_in, void* d_out, int out_size, void* d_ws, size_t ws_size, hipStream_t stream) {
    static int grid = 0;
    if (grid == 0) {
        if (n_in != 33 || out_size != NLAT * DM || ws_size < WS_END) { fprintf(stderr, "kernel_launch: unexpected problem (n_in %d, out %d, ws %zu < %zu)\n", n_in, out_size, ws_size, (size_t)WS_END); grid = -1; return; }
        int dev = 0, cus = 0, per_cu = 0;
        if (hipGetDevice(&dev) != hipSuccess || hipDeviceGetAttribute(&cus, hipDeviceAttributeMultiprocessorCount, dev) != hipSuccess) { grid = -1; return; }
        if (hipFuncSetAttribute((const void*)hybrid_fwd, hipFuncAttributeMaxDynamicSharedMemorySize, LDS_BYTES) != hipSuccess) { fprintf(stderr, "kernel_launch: hipFuncSetAttribute failed\n"); grid = -1; return; }
        if (hipOccupancyMaxActiveBlocksPerMultiprocessor(&per_cu, (const void*)hybrid_fwd, NTHR, LDS_BYTES) != hipSuccess || per_cu < 1) fprintf(stderr, "kernel_launch: occupancy query reports %d blocks per CU\n", per_cu);
        (void)hipGetLastError();
        grid = cus;
    }
    if (grid < 0) return;
    if (hipMemsetAsync((char*)d_ws + WS_CTL, 0, CTL_BYTES, stream) != hipSuccess) return;
    Params p{};
    for (int i = 0; i < 33; ++i) p.in[i] = (const float*)d_in[i];
    p.out = (float*)d_out; p.ws = (unsigned char*)d_ws; p.pad0 = 0; p.pad1 = 0;
#ifdef MK_PER_PHASE
    for (int ph = 0; ph < N_PHASES; ++ph) { p.lo = ph; p.hi = ph + 1; hipLaunchKernelGGL(hybrid_fwd, dim3(grid), dim3(NTHR), LDS_BYTES, stream, p); }
#else
    p.lo = 0; p.hi = N_PHASES;
    hipLaunchKernelGGL(hybrid_fwd, dim3(grid), dim3(NTHR), LDS_BYTES, stream, p);
#endif
    const hipError_t le = hipPeekAtLastError();
    if (le != hipSuccess) fprintf(stderr, "kernel_launch: launch failed: %s\n", hipGetErrorName(le));
}
```

```cpp
#include <hip/hip_runtime.h>
#include <cstdio>
#include <cstdint>
namespace pg8 {
#define PG8_LAS __attribute__((address_space(3)))
typedef unsigned short bf16_t;
typedef short bf16x8 __attribute__((ext_vector_type(8)));
typedef float f32x4 __attribute__((ext_vector_type(4)));
typedef unsigned u32x4 __attribute__((ext_vector_type(4)));
typedef unsigned u32x2 __attribute__((ext_vector_type(2)));
constexpr int BM = 256, BK = 64, HALF = 128, HTB = HALF * BK * 2  , STAGE_BYTES = 8 * HTB, NXCD = 8, WGM = 4;

__host__ __device__ __forceinline__ int lds_byte(int r, int c) { const int st = (r >> 4) * 2 + (c >> 5), rr = r & 15, cc = c & 31, ob = rr * 64 + cc * 2; return st * 1024 + (ob ^ (((ob >> 9) & 1) << 5)); }
__host__ __device__ __forceinline__ void stage_rc(int b, int& R, int& C) { const int st = b / 1024, sb = b % 1024, swz = sb ^ (((sb >> 9) & 1) << 5); R = (st >> 1) * 16 + swz / 64; C = (st & 1) * 32 + (swz % 64) / 2; }
__host__ __device__ __forceinline__ int perm32(int rho) { const int n = rho >> 4, i = rho & 15; return 8 * (i >> 2) + 4 * n + (i & 3); }

struct Unit { int pm, pn, kind, nt; const char* a; const char* b; };
struct Gemm { int lda, ldb; };

__host__ __device__ __forceinline__ void tile_map(int wgid, int nM, int nN, int& pm, int& pn, const int wgm = WGM) {
    const int nwg = nM * nN;
    { const int q = nwg / NXCD, r = nwg % NXCD, xcd = wgid % NXCD, off = wgid / NXCD; wgid = (xcd < r ? xcd * (q + 1) : r * (q + 1) + (xcd - r) * q) + off; }
    const int nig = wgm * nN, gid = wgid / nig, fm = gid * wgm, gsz = (nM - fm) < wgm ? (nM - fm) : wgm;
    pm = fm + ((wgid % nig) % gsz); pn = (wgid % nig) / gsz;
}
struct StaticOrder {
    int nM, nN, nwg, G, c, nt; const char* A; const char* Bt; size_t ta, tb;
    __device__ void init(const void* A_, const void* Bt_, int M, int N, int K, int lda, int ldb, int G_, int c_) { nt = K / BK; nM = M / BM; nN = N / BM; nwg = nM * nN; G = G_; c = c_; A = (const char*)A_; Bt = (const char*)Bt_; ta = (size_t)BM * lda * 2; tb = (size_t)BM * ldb * 2; }
    __device__ bool next(int i, Unit& u) const {
        const long L = (long)i * G + c; if (L >= nwg) return false;
        tile_map((int)L, nM, nN, u.pm, u.pn); u.kind = 0; u.nt = nt; u.a = A + (size_t)u.pm * ta; u.b = Bt + (size_t)u.pn * tb; return true;
    }
};

__device__ __forceinline__ unsigned cvt_pk_bf16(float lo, float hi) { unsigned r; asm volatile("v_cvt_pk_bf16_f32 %0, %1, %2" : "=v"(r) : "v"(lo), "v"(hi)); return r; }

template <class Epi, class Sched, bool ALIGN_EPI, int AMODE = 0>
__device__ __forceinline__ void gemm_phase(PG8_LAS unsigned char* lds, const int tid, const Gemm g, const Sched& S, const Epi& E) {
    const int wid = __builtin_amdgcn_readfirstlane(tid >> 6), lane = tid & 63, wr = wid >> 2, wc = wid & 3, fr = lane & 15, fq = lane >> 4;
    unsigned voffA[2], voffB[2];
#pragma unroll
    for (int i = 0; i < 2; ++i) { int R, C; stage_rc(tid * 16 + i * 8192, R, C); const int Rb = Epi::PERM ? ((R & ~31) + perm32(R & 31)) : R;
        voffA[i] = AMODE == 1 ? (unsigned)((C >> 4) * (1280 * 256) + (R >> 4) * 256 + (R & 15) * 16 + (C & 15)) * 2u : (unsigned)(R * g.lda + C) * 2u; voffB[i] = (unsigned)(Rb * g.ldb + C) * 2u; }
    const size_t kstepB = (size_t)(BK * 2), kstepA = AMODE == 1 ? (size_t)4 * 1280 * 256 * 2 : (size_t)(BK * 2);
    const size_t hstepA = AMODE == 1 ? (size_t)8 * 256 * 2 : (size_t)HALF * g.lda * 2, hstepB = (size_t)HALF * g.ldb * 2;
    const unsigned ldsw = (unsigned)wid * 1024u;
    const int aoff = lds_byte(wr * 64 + fr, fq * 8), boff = lds_byte(wc * 32 + fr, fq * 8);
#define PG8_SA(b, h) (((b) * 2 + (h)) * HTB)
#define PG8_SB(b, h) ((4 + (b) * 2 + (h)) * HTB)
#define PG8_STAGE(bufoff, gbase, voff) do { _Pragma("unroll") for (int _i = 0; _i < 2; ++_i) \
        __builtin_amdgcn_global_load_lds((const unsigned*)((const char*)(gbase) + (voff)[_i]), (PG8_LAS unsigned*)(lds + (bufoff) + ldsw + _i * 8192), 16, 0, 0); } while (0)
#define PG8_LDA(dst, b, h) do { _Pragma("unroll") for (int m = 0; m < 4; ++m) _Pragma("unroll") for (int k = 0; k < 2; ++k) dst[m][k] = *(const PG8_LAS bf16x8*)(lds + PG8_SA(b, h) + aoff + m * 2048 + k * 1024); } while (0)
#define PG8_LDB(dst, b, h) do { _Pragma("unroll") for (int n = 0; n < 2; ++n) _Pragma("unroll") for (int k = 0; k < 2; ++k) dst[n][k] = *(const PG8_LAS bf16x8*)(lds + PG8_SB(b, h) + boff + n * 2048 + k * 1024); } while (0)
#define PG8_MMA(ai, bj, At, Bt) do { __builtin_amdgcn_s_setprio(1); _Pragma("unroll") for (int m = 0; m < 4; ++m) _Pragma("unroll") for (int n = 0; n < 2; ++n) _Pragma("unroll") for (int k = 0; k < 2; ++k) \
        acc[ai][bj][m][n] = __builtin_amdgcn_mfma_f32_16x16x32_bf16(Bt[n][k], At[m][k], acc[ai][bj][m][n], 0, 0, 0); __builtin_amdgcn_s_setprio(0); } while (0)
#define PG8_WAIT_V(n) asm volatile("s_waitcnt vmcnt(" #n ")" ::: "memory")
#define PG8_WAIT_L(n) asm volatile("s_waitcnt lgkmcnt(" #n ")" ::: "memory")
#define PG8_BAR __builtin_amdgcn_s_barrier()
#define PG8_SCHED __builtin_amdgcn_sched_barrier(0)
    Unit cur, nxt; int ui = 0;
    if (!S.next(0, cur)) return;
    f32x4 acc[2][2][4][2];
#pragma unroll
    for (int a = 0; a < 2; ++a)
#pragma unroll
        for (int b = 0; b < 2; ++b)
#pragma unroll
            for (int m = 0; m < 4; ++m)
#pragma unroll
                for (int n = 0; n < 2; ++n) acc[a][b][m][n] = (f32x4){0.f, 0.f, 0.f, 0.f};
    bf16x8 At[4][2], B0[2][2], B1[2][2];
    const char* cA = cur.a; const char* cB = cur.b;
    PG8_STAGE(PG8_SB(0, 0), cB, voffB); PG8_STAGE(PG8_SB(0, 1), cB + hstepB, voffB); PG8_STAGE(PG8_SA(0, 0), cA, voffA); PG8_STAGE(PG8_SA(0, 1), cA + hstepA, voffA);
    if (wr == 1) PG8_BAR;
    PG8_WAIT_V(2); PG8_BAR;
    PG8_STAGE(PG8_SB(1, 0), cB + kstepB, voffB); PG8_STAGE(PG8_SA(1, 0), cA + kstepA, voffA); PG8_STAGE(PG8_SB(1, 1), cB + hstepB + kstepB, voffB);
    PG8_WAIT_V(6); PG8_BAR;
    for (;;) {
        const bool has_next = S.next(ui + 1, nxt);
        const char* nA = has_next ? nxt.a : cA; const char* nB = has_next ? nxt.b : cB;
        const int nt = cur.nt;
        for (int t = 0; t < nt; t += 2) {
            const bool last = (t == nt - 2);
            const char* a1 = cA + (size_t)(t + 1) * kstepA;
            const char* a2 = last ? nA : cA + (size_t)(t + 2) * kstepA; const char* b2 = last ? nB : cB + (size_t)(t + 2) * kstepB;
            const char* a3 = a2 + kstepA; const char* b3 = b2 + kstepB;
            PG8_LDB(B0, 0, 0); PG8_LDB(B1, 0, 1); PG8_SCHED; PG8_LDA(At, 0, 0); PG8_STAGE(PG8_SA(1, 1), a1 + hstepA, voffA);
            PG8_WAIT_V(8); PG8_WAIT_L(0); PG8_BAR; PG8_MMA(0, 0, At, B0); PG8_MMA(0, 1, At, B1); PG8_BAR; PG8_SCHED;
            PG8_LDA(At, 0, 1); PG8_STAGE(PG8_SB(0, 0), b2, voffB); PG8_STAGE(PG8_SB(0, 1), b2 + hstepB, voffB); PG8_STAGE(PG8_SA(0, 0), a2, voffA);
            PG8_WAIT_V(8); PG8_WAIT_L(0); PG8_BAR; PG8_MMA(1, 0, At, B0); PG8_MMA(1, 1, At, B1); PG8_BAR; PG8_SCHED;
            PG8_LDB(B0, 1, 0); PG8_LDB(B1, 1, 1); PG8_SCHED; PG8_LDA(At, 1, 0); PG8_STAGE(PG8_SA(0, 1), a2 + hstepA, voffA);
            PG8_WAIT_V(8); PG8_WAIT_L(0); PG8_BAR; PG8_MMA(0, 0, At, B0); PG8_MMA(0, 1, At, B1); PG8_BAR; PG8_SCHED;
            PG8_LDA(At, 1, 1); PG8_STAGE(PG8_SB(1, 0), b3, voffB); PG8_STAGE(PG8_SB(1, 1), b3 + hstepB, voffB); PG8_STAGE(PG8_SA(1, 0), a3, voffA);
            PG8_WAIT_V(8); PG8_WAIT_L(0); PG8_BAR; PG8_MMA(1, 0, At, B0); PG8_MMA(1, 1, At, B1); PG8_BAR; PG8_SCHED;
        }
        if constexpr (ALIGN_EPI) { if (wr == 0) PG8_BAR; }
        { int fr_ = fr, fq_ = fq; asm volatile("" : "+v"(fr_), "+v"(fq_)); if constexpr (Epi::REP == 1) E(acc, cur, wr, wc, fr_, fq_); else { int nrep_ = Epi::REP; asm volatile("" : "+s"(nrep_)); _Pragma("unroll 1") for (int rep_e = 0; rep_e < nrep_; ++rep_e) E(acc, cur, wr, wc, fr_, fq_); } }
        if (!has_next) break;
#pragma unroll
        for (int a = 0; a < 2; ++a)
#pragma unroll
            for (int b = 0; b < 2; ++b)
#pragma unroll
                for (int m = 0; m < 4; ++m)
#pragma unroll
                    for (int n = 0; n < 2; ++n) acc[a][b][m][n] = (f32x4){0.f, 0.f, 0.f, 0.f};
        cur = nxt; cA = nA; cB = nB; ++ui;
        if constexpr (ALIGN_EPI) { if (wr == 1) PG8_BAR; }
    }
    PG8_WAIT_V(0);
    if constexpr (!ALIGN_EPI) { if (wr == 0) PG8_BAR; }
    PG8_BAR;
#undef PG8_SA
#undef PG8_SB
#undef PG8_STAGE
#undef PG8_LDA
#undef PG8_LDB
#undef PG8_MMA
#undef PG8_WAIT_V
#undef PG8_WAIT_L
#undef PG8_BAR
#undef PG8_SCHED
}
}
#ifndef WGM_E1
#define WGM_E1 4
#endif
constexpr int DM = 2048, NBATCH = 2, SEQ = 8192, DEPTH = 4, CTXL = 256;
constexpr int NLAT = NBATCH * SEQ, NCTX = NBATCH * CTXL, MROWS = NLAT + NCTX;
constexpr int DFF = 5504, DFF2 = 11008, NMOD = 6;
constexpr int QCOLS = 1024, KVC = 256, HYC = 3072, INCOLS = 4608, QKVC = 1536, HD = 128;
constexpr int S5G = 128, S5P = 64, S5J = 16, S5L = 16, S5ROWS = 1280, S5K = 512;
constexpr float RMS_EPS = 1e-6f;
constexpr float LOG2E = 1.4426950408889634f;
constexpr float QSCALE = 0.08838834764831845f * LOG2E;

typedef unsigned short bf16;
typedef float f32x4 __attribute__((ext_vector_type(4)));
typedef float f32x2 __attribute__((ext_vector_type(2)));
typedef float f32x16 __attribute__((ext_vector_type(16)));
typedef unsigned u32x4 __attribute__((ext_vector_type(4)));
typedef unsigned u32x2 __attribute__((ext_vector_type(2)));
typedef short bf16x8 __attribute__((ext_vector_type(8)));
typedef short s16x4 __attribute__((ext_vector_type(4)));
#define GAS __attribute__((address_space(1)))
#define LAS __attribute__((address_space(3)))
#define DI __device__ __forceinline__

DI unsigned f2bf(float f) { unsigned u = __builtin_bit_cast(unsigned, f); return (u + 0x7fffu + ((u >> 16) & 1u)) >> 16; }
DI unsigned pk2(float lo, float hi) { return pg8::cvt_pk_bf16(lo, hi); }
DI float bf2f(unsigned short b) { return __builtin_bit_cast(float, ((unsigned)b) << 16); }
DI float bflo(unsigned w) { return __builtin_bit_cast(float, w << 16); }
DI float bfhi(unsigned w) { return __builtin_bit_cast(float, w & 0xffff0000u); }
DI float fast_exp(float x) { return __builtin_amdgcn_exp2f(x * LOG2E); }
DI float sigmoidf_(float x) { return __builtin_amdgcn_rcpf(1.0f + fast_exp(-x)); }
DI float siluf_(float x) { return x * sigmoidf_(x); }
DI float gelu_tanh(float x) { const float z = 0.7978845608028654f * (x + 0.044715f * x * x * x); const float e = fast_exp(2.0f * z); const float th = 1.0f - 2.0f * __builtin_amdgcn_rcpf(e + 1.0f); return 0.5f * x * (1.0f + th); }

namespace pg8 {
typedef __bf16 bf16x2v_ __attribute__((ext_vector_type(2)));
__device__ __forceinline__ unsigned cvt_pk_c(float lo, float hi) { const f32x2 v = {lo, hi}; const bf16x2v_ b = __builtin_convertvector(v, bf16x2v_); return __builtin_bit_cast(unsigned, b); }
struct EpiF32g {
    static constexpr bool PERM = false; static constexpr int REP = 1;
    float* C; int ldc; const float* bias;
    __device__ __forceinline__ void operator()(const f32x4 (&acc)[2][2][4][2], const Unit& u, int wr, int wc, int fr, int fq) const {
        const int row0 = u.pm * BM + wr * 64 + fr, col0 = u.pn * BM + wc * 32 + 4 * fq;
        f32x4 bv[2][2];
#pragma unroll
        for (int bj = 0; bj < 2; ++bj)
#pragma unroll
            for (int n = 0; n < 2; ++n) bv[bj][n] = bias ? *(const f32x4*)(bias + col0 + bj * HALF + n * 16) : (f32x4){0.f, 0.f, 0.f, 0.f};
#pragma unroll
        for (int ai = 0; ai < 2; ++ai)
#pragma unroll
            for (int m = 0; m < 4; ++m) { float* rowp = C + (size_t)(row0 + ai * HALF + m * 16) * ldc + col0;
#pragma unroll
                for (int bj = 0; bj < 2; ++bj)
#pragma unroll
                    for (int n = 0; n < 2; ++n) *(f32x4*)(rowp + bj * HALF + n * 16) = acc[ai][bj][m][n] + bv[bj][n]; }
    }
};
struct EpiBf16g {
    static constexpr bool PERM = true; static constexpr int REP = 1;
    bf16_t* O; int ldc;
    __device__ __forceinline__ void operator()(const f32x4 (&acc)[2][2][4][2], const Unit& u, int wr, int wc, int fr, int fq) const {
        const int row0 = u.pm * BM + wr * 64 + fr, col0 = u.pn * BM + wc * 32 + 8 * fq;
#pragma unroll
        for (int ai = 0; ai < 2; ++ai)
#pragma unroll
            for (int m = 0; m < 4; ++m) { bf16_t* rowp = O + (size_t)(row0 + ai * HALF + m * 16) * ldc + col0;
#pragma unroll
                for (int bj = 0; bj < 2; ++bj) { const f32x4 v0 = acc[ai][bj][m][0], v1 = acc[ai][bj][m][1];
                    u32x4 w; w.x = cvt_pk_bf16(v0[0], v0[1]); w.y = cvt_pk_bf16(v0[2], v0[3]); w.z = cvt_pk_bf16(v1[0], v1[1]); w.w = cvt_pk_bf16(v1[2], v1[3]);
                    *(u32x4*)(rowp + bj * HALF) = w; } }
    }
};
struct EpiYb {
    static constexpr bool PERM = true; static constexpr int REP = 1;
    bf16_t* O; int ldc; const float* bias; bf16_t* part;
    __device__ __forceinline__ void operator()(const f32x4 (&acc)[2][2][4][2], const Unit& u, int wr, int wc, int fr, int fq) const {
        const int col0 = u.pn * BM + wc * 32 + 8 * fq;
        const bool addb = bias != nullptr && (u.kind == 0 || u.kind == 16);
        f32x4 bv[2][2];
#pragma unroll
        for (int bj = 0; bj < 2; ++bj)
#pragma unroll
            for (int n = 0; n < 2; ++n) bv[bj][n] = addb ? *(const f32x4*)(bias + col0 + bj * HALF + 4 * n) : (f32x4){0.f, 0.f, 0.f, 0.f};
        if (u.kind >= 16) {
            bf16_t* base = part + ((size_t)(u.kind - 16) * NCTX + (size_t)(u.pm - NLAT / BM) * BM + wr * 64 + fr) * ldc + col0;
#pragma unroll
            for (int ai = 0; ai < 2; ++ai)
#pragma unroll
                for (int m = 0; m < 4; ++m) { bf16_t* rowp = base + (size_t)(ai * HALF + m * 16) * ldc;
#pragma unroll
                    for (int bj = 0; bj < 2; ++bj) { const f32x4 v0 = acc[ai][bj][m][0] + bv[bj][0], v1 = acc[ai][bj][m][1] + bv[bj][1];
                        u32x4 w; w.x = cvt_pk_bf16(v0[0], v0[1]); w.y = cvt_pk_bf16(v0[2], v0[3]); w.z = cvt_pk_bf16(v1[0], v1[1]); w.w = cvt_pk_bf16(v1[2], v1[3]);
                        *(u32x4*)(rowp + bj * HALF) = w; } }
        } else {
            const int row0 = u.pm * BM + wr * 64 + fr;
#pragma unroll
            for (int ai = 0; ai < 2; ++ai)
#pragma unroll
                for (int m = 0; m < 4; ++m) { bf16_t* rowp = O + (size_t)(row0 + ai * HALF + m * 16) * ldc + col0;
#pragma unroll
                    for (int bj = 0; bj < 2; ++bj) { const f32x4 v0 = acc[ai][bj][m][0] + bv[bj][0], v1 = acc[ai][bj][m][1] + bv[bj][1];
                        u32x4 w; w.x = cvt_pk_bf16(v0[0], v0[1]); w.y = cvt_pk_bf16(v0[2], v0[3]); w.z = cvt_pk_bf16(v1[0], v1[1]); w.w = cvt_pk_bf16(v1[2], v1[3]);
                        *(u32x4*)(rowp + bj * HALF) = w; } }
        }
    }
};
struct EpiGlu {
    static constexpr bool PERM = true; static constexpr int REP = 1;
    bf16_t* O; const float* bias; bf16_t* part;
    __device__ __forceinline__ void operator()(const f32x4 (&acc)[2][2][4][2], const Unit& u, int wr, int wc, int fr, int fq) const {
        const int col0 = u.pn * BM + wc * 32 + 8 * fq;
        const bool addb = (u.kind == 0 || u.kind == 16);
        f32x4 ba[2], bg[2];
#pragma unroll
        for (int bj = 0; bj < 2; ++bj) { const int ch = (col0 + bj * HALF) >> 1; ba[bj] = addb ? *(const f32x4*)(bias + ch) : (f32x4){0.f, 0.f, 0.f, 0.f}; bg[bj] = addb ? *(const f32x4*)(bias + DM + ch) : (f32x4){0.f, 0.f, 0.f, 0.f}; }
        if (u.kind >= 16) {
            bf16_t* base = part + ((size_t)(u.kind - 16) * NCTX + (size_t)(u.pm - NLAT / BM) * BM + wr * 64 + fr) * (2 * DM) + col0;
#pragma unroll
            for (int ai = 0; ai < 2; ++ai)
#pragma unroll
                for (int m = 0; m < 4; ++m) { bf16_t* rowp = base + (size_t)(ai * HALF + m * 16) * (2 * DM);
#pragma unroll
                    for (int bj = 0; bj < 2; ++bj) { const f32x4 v0 = acc[ai][bj][m][0] + ba[bj], v1 = acc[ai][bj][m][1] + bg[bj];
                        u32x4 w; w.x = cvt_pk_bf16(v0[0], v0[1]); w.y = cvt_pk_bf16(v0[2], v0[3]); w.z = cvt_pk_bf16(v1[0], v1[1]); w.w = cvt_pk_bf16(v1[2], v1[3]);
                        *(u32x4*)(rowp + bj * HALF) = w; } }
        } else {
            const int row0 = u.pm * BM + wr * 64 + fr;
#pragma unroll
            for (int ai = 0; ai < 2; ++ai)
#pragma unroll
                for (int bj = 0; bj < 2; ++bj) { const int ch0 = (col0 + bj * HALF) >> 1;
                    u32x2 pk[4];
#pragma unroll
                    for (int m = 0; m < 4; ++m) { const f32x4 a = acc[ai][bj][m][0] + ba[bj], g = acc[ai][bj][m][1] + bg[bj]; float o[4];
#pragma unroll
                        for (int e = 0; e < 4; ++e) o[e] = a[e] * sigmoidf_(g[e]);
                        pk[m].x = cvt_pk_c(o[0], o[1]); pk[m].y = cvt_pk_c(o[2], o[3]); }
#pragma unroll
                    for (int m2 = 0; m2 < 4; m2 += 2) {
                        const auto rx = __builtin_amdgcn_permlane16_swap(pk[m2].x, pk[m2 + 1].x, false, false);
                        const auto ry = __builtin_amdgcn_permlane16_swap(pk[m2].y, pk[m2 + 1].y, false, false);
                        const int r = row0 + ai * HALF + (m2 + (fq & 1)) * 16;
                        *(u32x4*)(O + (size_t)r * DM + ch0 - 4 * (fq & 1)) = (u32x4){rx[0], ry[0], rx[1], ry[1]}; } }
        }
    }
};
struct OrderSplit {
    int nN, G, c, nt_full, nmain, nchunk, split, ktype, amode, wgm, rev; const char* A; const char* Bt; size_t ta, tb;
    __device__ size_t aoff(int pm, int k0) const { if (!amode) return (size_t)pm * ta + (size_t)k0 * BK * 2; const int cr0 = pm < 64 ? ((pm >> 5) * 512 + (pm & 31) * 16) : (1024 + (pm - 64) * 16); return (size_t)cr0 * 512 + (size_t)k0 * (4 * 1280 * 256 * 2); }
    __device__ void init(const void* A_, const void* Bt_, int N, int K, int lda, int ldb, int split_, int G_, int c_, int amode_ = 0, int wgm_ = WGM, int rev_ = 0) { amode = amode_; wgm = wgm_; rev = rev_; nN = N / BM; G = G_; c = c_; nt_full = K / BK; nmain = (NLAT / BM) * nN; ktype = (K == 2048) ? 0 : 1; nchunk = ktype ? 15 : 8; split = split_;
        A = (const char*)A_; Bt = (const char*)Bt_; ta = (size_t)BM * lda * 2; tb = (size_t)BM * ldb * 2; }
    __device__ bool next(int i, Unit& u) const {
        const long L = (long)i * G + c;
        if (L < nmain) { tile_map((int)L, NLAT / BM, nN, u.pm, u.pn, wgm); if (rev) u.pm = NLAT / BM - 1 - u.pm; u.kind = 0; u.nt = nt_full; u.a = A + aoff(u.pm, 0); u.b = Bt + (size_t)u.pn * tb; return true; }
        if (!split) return false;
        const int s = (int)(L - nmain); if (s >= 2 * nN * nchunk) return false;
        const int tile = s / nchunk, chunk = s - tile * nchunk; const int pmc = tile / nN; u.pn = tile - pmc * nN; u.pm = NLAT / BM + pmc; u.kind = 16 + chunk;
        int k0, ntc; if (ktype == 0) { k0 = chunk * 4; ntc = 4; } else if (chunk < 13) { k0 = chunk * 6; ntc = 6; } else { k0 = 78 + (chunk - 13) * 4; ntc = 4; }
        u.nt = ntc; u.a = A + aoff(u.pm, k0); u.b = Bt + (size_t)u.pn * tb + (size_t)k0 * BK * 2; return true;
    }
};
#define DPP0(src, ctrl) __builtin_bit_cast(float, __builtin_amdgcn_update_dpp(0, __builtin_bit_cast(int, (float)(src)), (ctrl), 0xf, 0xf, true))
__device__ __forceinline__ void up_panel(int pm, int& seq0, int& seqlen, int& g0) {
    int p; if (pm < 66) { const int b = pm / 33; p = pm - 33 * b; seq0 = b * SEQ; seqlen = SEQ; } else { const int c = pm - 66; p = c & 1; seq0 = NLAT + (c >> 1) * CTXL; seqlen = CTXL; }
    g0 = seq0 + 254 * p - 1;
}
template <int REP_ = 1> struct EpiUpGlu {
    static constexpr bool PERM = true; static constexpr int REP = REP_;
    bf16_t* A5; const float* cw; const float* cb; PG8_LAS float* halo;
    __device__ __forceinline__ void operator()(f32x4 (&acc)[2][2][4][2], const Unit& u, int wr, int wc, int fr, int fq) const {
        int seq0, seqlen, g0; up_panel(u.pm, seq0, seqlen, g0);
        const int send = seq0 + seqlen;
        const int cl = wc * 32 + 8 * fq;
        if (g0 < seq0 || g0 + BM > send) {
#pragma unroll
            for (int ai = 0; ai < 2; ++ai)
#pragma unroll
                for (int m = 0; m < 4; ++m) { const int g = g0 + ai * HALF + wr * 64 + m * 16 + fr; const bool in = g >= seq0 && g < send;
#pragma unroll
                    for (int bj = 0; bj < 2; ++bj)
#pragma unroll
                        for (int n = 0; n < 2; ++n)
#pragma unroll
                            for (int e = 0; e < 4; ++e) acc[ai][bj][m][n][e] = in ? acc[ai][bj][m][n][e] : 0.f; } }
#pragma unroll
        for (int ai = 0; ai < 2; ++ai)
#pragma unroll
            for (int bj = 0; bj < 2; ++bj)
#pragma unroll
                for (int n = 0; n < 2; ++n) {
                    if (fr == 0) *(PG8_LAS f32x4*)(halo + (2 * ai + wr) * 512 + bj * 128 + cl + 4 * n) = acc[ai][bj][0][n];
                    if (fr == 15) *(PG8_LAS f32x4*)(halo + (2 * ai + wr) * 512 + 256 + bj * 128 + cl + 4 * n) = acc[ai][bj][3][n]; }
        asm volatile("s_waitcnt lgkmcnt(0)" ::: "memory"); __builtin_amdgcn_s_barrier(); asm volatile("" ::: "memory");
#pragma unroll
        for (int bj = 0; bj < 2; ++bj) {
            const int ch0 = 128 * u.pn + 64 * bj + 16 * wc + 4 * fq;
            f32x4 wg[3], wv[3];
#pragma unroll
            for (int k = 0; k < 3; ++k) { wg[k] = *(const f32x4*)(cw + (size_t)k * DFF2 + ch0); wv[k] = *(const f32x4*)(cw + (size_t)k * DFF2 + DFF + ch0); }
            const f32x4 bg = *(const f32x4*)(cb + ch0), bv = *(const f32x4*)(cb + DFF + ch0);
#pragma unroll
            for (int ai = 0; ai < 2; ++ai) { const int blk = 2 * ai + wr;
                f32x4 hag = (f32x4){0.f, 0.f, 0.f, 0.f}, hav = hag, hbg = hag, hbv = hag;
                if (blk > 0) { hag = *(const PG8_LAS f32x4*)(halo + (blk - 1) * 512 + 256 + bj * 128 + cl); hav = *(const PG8_LAS f32x4*)(halo + (blk - 1) * 512 + 256 + bj * 128 + cl + 4); }
                if (blk < 3) { hbg = *(const PG8_LAS f32x4*)(halo + (blk + 1) * 512 + bj * 128 + cl); hbv = *(const PG8_LAS f32x4*)(halo + (blk + 1) * 512 + bj * 128 + cl + 4); }
                u32x2 pk[4];
#pragma unroll
                for (int m = 0; m < 4; ++m) {
                    const f32x4 cg = acc[ai][bj][m][0], cv = acc[ai][bj][m][1];
                    const f32x4 pbg = m > 0 ? acc[ai][bj][m > 0 ? m - 1 : 0][0] : hag, pbv = m > 0 ? acc[ai][bj][m > 0 ? m - 1 : 0][1] : hav;
                    const f32x4 nbg = m < 3 ? acc[ai][bj][m < 3 ? m + 1 : 3][0] : hbg, nbv = m < 3 ? acc[ai][bj][m < 3 ? m + 1 : 3][1] : hbv;
                    float o[4];
#pragma unroll
                    for (int ep = 0; ep < 2; ++ep) { const int e0 = 2 * ep, e1 = 2 * ep + 1;
                        const f32x2 w0g = {wg[0][e0], wg[0][e1]}, w1g = {wg[1][e0], wg[1][e1]}, w2g = {wg[2][e0], wg[2][e1]};
                        const f32x2 w0v = {wv[0][e0], wv[0][e1]}, w1v = {wv[1][e0], wv[1][e1]}, w2v = {wv[2][e0], wv[2][e1]};
                        f32x2 gate = (f32x2){bg[e0], bg[e1]} + (f32x2){cg[e0], cg[e1]} * w1g;
                        gate += (f32x2){DPP0(cg[e0], 0x111), DPP0(cg[e1], 0x111)} * w0g; gate += (f32x2){DPP0(pbg[e0], 0x10f), DPP0(pbg[e1], 0x10f)} * w0g;
                        gate += (f32x2){DPP0(cg[e0], 0x101), DPP0(cg[e1], 0x101)} * w2g; gate += (f32x2){DPP0(nbg[e0], 0x11f), DPP0(nbg[e1], 0x11f)} * w2g;
                        f32x2 val = (f32x2){bv[e0], bv[e1]} + (f32x2){cv[e0], cv[e1]} * w1v;
                        val += (f32x2){DPP0(cv[e0], 0x111), DPP0(cv[e1], 0x111)} * w0v; val += (f32x2){DPP0(pbv[e0], 0x10f), DPP0(pbv[e1], 0x10f)} * w0v;
                        val += (f32x2){DPP0(cv[e0], 0x101), DPP0(cv[e1], 0x101)} * w2v; val += (f32x2){DPP0(nbv[e0], 0x11f), DPP0(nbv[e1], 0x11f)} * w2v;
                        const f32x2 ex = gate * (-LOG2E);
                        const f32x2 den = (f32x2){__builtin_amdgcn_exp2f(ex[0]), __builtin_amdgcn_exp2f(ex[1])} + 1.0f;
                        const f32x2 sg = {__builtin_amdgcn_rcpf(den[0]), __builtin_amdgcn_rcpf(den[1])};
                        const f32x2 ov = gate * sg * val; o[e0] = ov[0]; o[e1] = ov[1]; }
                    pk[m].x = cvt_pk_c(o[0], o[1]); pk[m].y = cvt_pk_c(o[2], o[3]);
                }
#pragma unroll
                for (int m2 = 0; m2 < 4; m2 += 2) {
                    const auto rx = __builtin_amdgcn_permlane16_swap(pk[m2].x, pk[m2 + 1].x, false, false);
                    const auto ry = __builtin_amdgcn_permlane16_swap(pk[m2].y, pk[m2 + 1].y, false, false);
                    const int r = ai * HALF + wr * 64 + (m2 + (fq & 1)) * 16 + fr, g = g0 + r;
                    if (r >= 1 && r <= 254 && g >= seq0 && g < send) *(u32x4*)(A5 + (size_t)g * DFF + ch0 - 4 * (fq & 1)) = (u32x4){rx[0], ry[0], rx[1], ry[1]};
                }
            }
        }
    }
};
struct OrderUp {
    int G, c, nP; const char* HM; const char* W; int wgm;
    __device__ bool next(int i, Unit& u) const {
        const long L = (long)i * G + c; if (L >= (long)nP * 43) return false;
        tile_map((int)L, nP, 43, u.pm, u.pn, wgm); u.kind = 0; u.nt = DM / BK;
        int seq0, seqlen, g0; up_panel(u.pm, seq0, seqlen, g0);
        u.a = HM + (long)g0 * (DM * 2); u.b = W + (size_t)u.pn * BM * DM * 2; return true;
    }
};
template <int REP_ = 1> struct EpiQKVZ {
    static constexpr bool PERM = true; static constexpr int REP = REP_;
    bf16_t* QKV; bf16_t* ZBT; const float* tab;
    __device__ __forceinline__ void operator()(const f32x4 (&acc)[2][2][4][2], const Unit& u, int wr, int wc, int fr, int fq) const {
        const int row0 = u.pm * BM + wr * 64 + fr, col0 = u.pn * BM + wc * 32 + 8 * fq;
        if (u.kind == 1) {
#pragma unroll
            for (int ai = 0; ai < 2; ++ai)
#pragma unroll
                for (int m = 0; m < 4; ++m) { bf16_t* rowp = ZBT + (size_t)(row0 + ai * HALF + m * 16) * MROWS + col0;
#pragma unroll
                    for (int bj = 0; bj < 2; ++bj) { const f32x4 v0 = acc[ai][bj][m][0], v1 = acc[ai][bj][m][1];
                        u32x4 w; w.x = cvt_pk_bf16(v0[0], v0[1]); w.y = cvt_pk_bf16(v0[2], v0[3]); w.z = cvt_pk_bf16(v1[0], v1[1]); w.w = cvt_pk_bf16(v1[2], v1[3]);
                        *(u32x4*)(rowp + bj * HALF) = w; } }
        } else {
            const bool rope = (u.pn < 5) && (u.pm < 64);
            const float sc = (u.pn < 4) ? QSCALE : 1.0f;
            const int gi = 4 * wc + fq, f0 = 4 * (gi & 7); const bool rowang = gi < 8;
#pragma unroll
            for (int ai = 0; ai < 2; ++ai)
#pragma unroll
                for (int m = 0; m < 4; ++m) { const int r = row0 + ai * HALF + m * 16;
                    f32x4 cs0 = (f32x4){1.f, 0.f, 1.f, 0.f}, cs1 = cs0;
                    if (rope) { const int tok = r & (SEQ - 1); const int pos = rowang ? (tok >> 6) : (tok & 63); const f32x4* tp = (const f32x4*)(tab + (size_t)(pos * 32 + f0) * 2); cs0 = tp[0]; cs1 = tp[1]; }
                    const f32x4 cv = (f32x4){cs0[0], cs0[2], cs1[0], cs1[2]}, sv = (f32x4){cs0[1], cs0[3], cs1[1], cs1[3]};
                    bf16_t* rowp = QKV + (size_t)r * QKVC + col0;
#pragma unroll
                    for (int bj = 0; bj < 2; ++bj) { const f32x4 a0 = acc[ai][bj][m][0], a1 = acc[ai][bj][m][1];
                        const f32x4 v0 = (a0 * cv - a1 * sv) * sc, v1 = (a1 * cv + a0 * sv) * sc;
                        u32x4 w; w.x = cvt_pk_bf16(v0[0], v0[1]); w.y = cvt_pk_bf16(v0[2], v0[3]); w.z = cvt_pk_bf16(v1[0], v1[1]); w.w = cvt_pk_bf16(v1[2], v1[3]);
                        *(u32x4*)(rowp + bj * HALF) = w; } }
        }
    }
};
struct EpiS5G {
    static constexpr bool PERM = true; static constexpr int REP = 1;
    bf16_t* O;
    __device__ __forceinline__ void operator()(const f32x4 (&acc)[2][2][4][2], const Unit& u, int wr, int wc, int fr, int fq) const {
        const int row0 = u.pm * BM + wr * 64 + fr, col0 = wc * 32 + 8 * fq;
#pragma unroll
        for (int ai = 0; ai < 2; ++ai)
#pragma unroll
            for (int m = 0; m < 4; ++m) { bf16_t* rowp = O + (size_t)(row0 + ai * HALF + m * 16) * 256 + col0;
#pragma unroll
                for (int bj = 0; bj < 2; ++bj) { const f32x4 a0 = acc[ai][bj][m][0], a1 = acc[ai][bj][m][1];
                    u32x4 w; w.x = cvt_pk_bf16(gelu_tanh(a0[0]), gelu_tanh(a0[1])); w.y = cvt_pk_bf16(gelu_tanh(a0[2]), gelu_tanh(a0[3]));
                    w.z = cvt_pk_bf16(gelu_tanh(a1[0]), gelu_tanh(a1[1])); w.w = cvt_pk_bf16(gelu_tanh(a1[2]), gelu_tanh(a1[3]));
                    *(u32x4*)(rowp + bj * HALF) = w; } }
    }
};
struct OrderE1 {
    int G, c; const char* HM; const char* Win;
    __device__ bool next(int i, Unit& u) const {
        const long L = (long)i * G + c; if (L >= 1188) return false;
        if (L < 792) { tile_map((int)L, 12, 66, u.pm, u.pn, WGM_E1); u.kind = 1; u.nt = DM / BK; u.a = Win + (size_t)(QKVC + u.pm * BM) * DM * 2; u.b = HM + (size_t)u.pn * BM * DM * 2; }
        else { tile_map((int)L - 792, 66, 6, u.pm, u.pn, WGM_E1); u.kind = 0; u.nt = DM / BK; u.a = HM + (size_t)u.pm * BM * DM * 2; u.b = Win + (size_t)u.pn * BM * DM * 2; }
        return true;
    }
};
struct OrderS5 {
    int G, c, nt; const char* UA; const char* Bm; size_t bstride; int swapped;
    __device__ bool next(int i, Unit& u) const {
        const long L0 = (long)i * G + c; if (L0 >= S5G * 4) return false;
        const int L = (int)(L0 % NXCD) * (S5G * 4 / NXCD) + (int)(L0 / NXCD);
        const int g = L >> 2, pml = L & 3;
        u.kind = 0; u.nt = nt; const char* ua = UA + ((size_t)g * S5ROWS + (size_t)pml * BM) * S5K * 2; const char* bm = Bm + (size_t)g * bstride;
        if (swapped) { u.pm = g; u.pn = pml; u.a = bm; u.b = ua; } else { u.pm = 5 * g + pml; u.pn = 0; u.a = ua; u.b = bm; }
        return true;
    }
};
}
#define XB_TMO      128
#define XB_XCNT(j)  (256  + 64 * (j))
#define XB_XSUB(j)  (1280 + 64 * (j))
#define XB_XGEN(j)  (2304 + 64 * (j))
#define XB_TOP      3328
#define XB_TOPGEN   3392
#define XCD_BAR_WORDS 3456
#define XB_SPIN_CAP (1u << 22)

__device__ __forceinline__ unsigned xb_ld(unsigned* p)              { return __hip_atomic_load(p, __ATOMIC_RELAXED, __HIP_MEMORY_SCOPE_AGENT); }
__device__ __forceinline__ unsigned xb_add(unsigned* p, unsigned v) { return __hip_atomic_fetch_add(p, v, __ATOMIC_RELAXED, __HIP_MEMORY_SCOPE_AGENT); }
__device__ __forceinline__ unsigned xb_xcc_id() { return (unsigned)__builtin_amdgcn_s_getreg((3 << 11) | 20) & 0xFu; }
#define XB_SPIN(cond, bar) do { unsigned _sp = 0; while (cond) { __builtin_amdgcn_s_sleep(1); \
    if ((++_sp & 255u) == 0u) { if (xb_ld(&(bar)[XB_TMO])) break; if (_sp > XB_SPIN_CAP) { atomicAdd(&(bar)[XB_TMO], 1u); break; } } } } while (0)

struct XcdBarrier {
    unsigned* bar; unsigned x;
    volatile LAS unsigned* st;
};

__device__ __forceinline__ XcdBarrier xcd_barrier_post(unsigned* bar, volatile LAS unsigned* st) {
    XcdBarrier b; b.bar = bar; b.x = xb_xcc_id(); b.st = st;
    if (threadIdx.x == 0) (void)xb_add(&bar[XB_XCNT(b.x)], 1u);
    return b;
}
__device__ __forceinline__ void xcd_barrier_complete(unsigned* bar, unsigned x, unsigned& nloc, unsigned& nx) {
    const unsigned G = gridDim.x * gridDim.y * gridDim.z;
    unsigned sum, cnt, mine, sp = 0u;
    for (;;) {
        sum = 0u; cnt = 0u; mine = 0u;
#pragma unroll
        for (unsigned j = 0; j < 16; ++j) { const unsigned c = xb_ld(&bar[XB_XCNT(j)]); sum += c; cnt += (c > 0u) ? 1u : 0u; mine = (j == x) ? c : mine; }
        if (sum == G) break;
        __builtin_amdgcn_s_sleep(1);
        if ((++sp & 255u) == 0u) { if (xb_ld(&bar[XB_TMO])) break; if (sp > XB_SPIN_CAP) { atomicAdd(&bar[XB_TMO], 1u); break; } }
    }
    nloc = mine > 0u ? mine : 1u; nx = cnt > 0u ? cnt : 1u;
}

__device__ __forceinline__ void xcd_barrier(const XcdBarrier& b) {
    asm volatile("s_waitcnt vmcnt(0)" ::: "memory");
    __syncthreads();
    if (threadIdx.x == 0) {
        unsigned* bar = b.bar;
        __builtin_amdgcn_s_waitcnt(0);
        unsigned nloc = b.st[0], nx = b.st[1];
        if (nloc == 0u) { xcd_barrier_complete(bar, b.x, nloc, nx); b.st[0] = nloc; b.st[1] = nx; }
        const unsigned old = xb_add(&bar[XB_XSUB(b.x)], 1u);
        const unsigned gen = old / nloc;
        if (old + 1u == (gen + 1u) * nloc) {
            __builtin_amdgcn_fence(__ATOMIC_RELEASE, "agent");
            asm volatile("s_waitcnt vmcnt(0)" ::: "memory");
            const unsigned og = xb_add(&bar[XB_TOP], 1u);
            const unsigned tg = og / nx;
            if (og + 1u == (tg + 1u) * nx) xb_add(&bar[XB_TOPGEN], 1u);
            else XB_SPIN(xb_ld(&bar[XB_TOPGEN]) == tg, bar);
            __builtin_amdgcn_fence(__ATOMIC_ACQUIRE, "agent");
            xb_add(&bar[XB_XGEN(b.x)], 1u);
            asm volatile("s_waitcnt vmcnt(0)" ::: "memory");
        } else {
            XB_SPIN(xb_ld(&bar[XB_XGEN(b.x)]) == gen, bar);
            __builtin_amdgcn_fence(__ATOMIC_ACQUIRE, "agent");
            asm volatile("s_waitcnt vmcnt(0)" ::: "memory");
        }
    }
    __syncthreads();
}

#ifndef DUP_SUB
#define DUP_SUB 0
#endif
typedef __bf16 bf16x2w_ __attribute__((ext_vector_type(2)));
DI unsigned cvtpk_c2(float lo, float hi) { const f32x2 v = {lo, hi}; const bf16x2w_ b = __builtin_convertvector(v, bf16x2w_); return __builtin_bit_cast(unsigned, b); }
constexpr size_t MiB = 1u << 20;
constexpr size_t WS_CTL = 0, CTL_BYTES = 1 * MiB;
constexpr size_t WS_MOD = 1 * MiB;
constexpr size_t WS_MODP = 2 * MiB;
constexpr size_t WS_TAB = 7 * MiB;
constexpr size_t WS_HID = 8 * MiB;
constexpr size_t WS_LAML = 13 * MiB;
constexpr size_t WS_XC = 14 * MiB;
constexpr size_t WS_FILTC = 18 * MiB;
constexpr size_t WS_FILT = 22 * MiB;
constexpr size_t WS_TT = 150 * MiB;
constexpr size_t WS_WW = 214 * MiB;
constexpr size_t WS_WUP = 246 * MiB;
constexpr size_t WS_WDOWN = 418 * MiB;
constexpr size_t WS_WIN = 504 * MiB;
constexpr size_t WS_WOUT = 540 * MiB;
constexpr size_t WS_WGLU = 556 * MiB;
constexpr size_t WS_HM = 588 * MiB;
constexpr size_t WS_YAB = 654 * MiB;
constexpr size_t WS_Y = 720 * MiB;
constexpr size_t WS_A5 = 852 * MiB;
constexpr size_t WS_U = 1030 * MiB;
constexpr size_t WS_PART = 1385 * MiB;
constexpr size_t WS_XB = 1453 * MiB;
constexpr size_t WS_END = 1519 * MiB;
constexpr size_t SZ_WUP = (size_t)DFF2 * DM * 2, SZ_WDOWN = (size_t)DM * DFF * 2, SZ_WIN = (size_t)INCOLS * DM * 2, SZ_WOUT = (size_t)DM * DM * 2, SZ_WGLU = (size_t)2 * DM * DM * 2;
constexpr int CW_BAR = 4096;

constexpr int RING_BYTES = 131072, AUX_OFF = 131072, AUX_BYTES = 16384, LDSCTL_OFF = AUX_OFF + AUX_BYTES, LDS_BYTES = LDSCTL_OFF + 512;
constexpr int NWAVES = 8, NTHR = 512;

struct Params { const float* in[33]; float* out; unsigned char* ws; int lo, hi, pad0, pad1; };
struct Frame { LAS unsigned char* lds; int tid, lane, wave, G, bid; };

DI void sincos_rr(float x, float& sn, float& cs) {
    double r = (double)x * 0.15915494309189535; r = r - floor(r); const float rf = (float)r; sn = __builtin_amdgcn_sinf(rf); cs = __builtin_amdgcn_cosf(rf); }
DI float wave_sum(float v) {
#pragma unroll
    for (int o = 1; o < 64; o <<= 1) v += __shfl_xor(v, o);
    return v;
}
DI float block_sum(const Frame& F, float v, LAS float* red) {
    v = wave_sum(v);
    __syncthreads();
    if (F.lane == 0) red[F.wave] = v;
    __syncthreads();
    float t = 0.f;
#pragma unroll
    for (int i = 0; i < NWAVES; ++i) t += red[i];
    return t;
}

DI void transpose_item1(const Frame& F, const float* W, int K, int N, bf16* WT, int item, int mode) {
    const int nb = N >> 7; const int kb = item / nb, nbk = item - kb * nb; const int k0 = kb * 64, n0 = nbk * 128;
    LAS unsigned short* tile = (LAS unsigned short*)F.lds;
    const int tn = (F.tid & 31) * 4, tk = (F.tid >> 5) * 4;
    const int nd = n0 + tn; int ns = nd;
    if (mode == 2) { const int tile = nd >> 8, pp = nd & 255; ns = ((pp >> 2) & 1) * DFF + 128 * tile + 4 * (pp >> 3); }
    if (mode == 3) ns = ((nd >> 2) & 1) * DM + 4 * (nd >> 3);
    if (mode == 1 && nd < 1280) { const int d = nd & 127, gi = d >> 3, n = (d >> 2) & 1; ns = (nd & ~127) + ((gi < 8) ? 0 : 64) + 32 * n + 4 * (gi & 7); }
    f32x4 v[4];
#pragma unroll
    for (int i = 0; i < 4; ++i) v[i] = *(const f32x4*)(W + (size_t)(k0 + tk + i) * N + ns);
#pragma unroll
    for (int e = 0; e < 4; ++e) { u32x2 w; w.x = pk2(v[0][e], v[1][e]); w.y = pk2(v[2][e], v[3][e]); *(LAS u32x2*)(tile + (tn + e) * 72 + tk) = w; }
    __syncthreads();
#pragma unroll
    for (int i = 0; i < 2; ++i) { const int p = F.tid + 512 * i, n = p >> 3, kc = p & 7;
        const u32x4 w = *(const LAS u32x4*)(tile + n * 72 + kc * 8);
        *(u32x4*)(WT + (size_t)(n0 + n) * K + k0 + kc * 8) = w; }
    __syncthreads();
}
DI void transpose_item(const Frame& F, const float* W, int K, int N, bf16* WT, int item, int mode) { transpose_item1(F, W, K, N, WT, item, mode); if (DUP_SUB == 9) transpose_item1(F, W, K, N, WT, item, mode); }
DI void modp_unit(const Frame& F, const Params& P, int u) {
    const int cb = u % 24, lk = u / 24, kc = lk & 7, l = lk >> 3;
    LAS float* sv = (LAS float*)F.lds;
    for (int i = F.tid; i < 768; i += NTHR) { const int r = i >> 8, k = i & 255, kk = kc * 256 + k; const float v = (r < 2) ? P.in[1][r * DM + kk] : P.in[3][kk]; sv[i] = v / (1.0f + expf(-v)); }
    __syncthreads();
    const int j = cb * 512 + F.tid; const float* w = P.in[4] + ((size_t)l * DM + kc * 256) * (NMOD * DM) + j;
    float a0 = 0.f, a1 = 0.f, a2 = 0.f;
#pragma unroll 1
    for (int k0 = 0; k0 < 256; k0 += 32) { float wv[32];
#pragma unroll
        for (int k = 0; k < 32; ++k) wv[k] = __builtin_nontemporal_load(w + (size_t)(k0 + k) * (NMOD * DM));
#pragma unroll
        for (int k = 0; k < 32; ++k) { a0 += sv[k0 + k] * wv[k]; a1 += sv[256 + k0 + k] * wv[k]; a2 += sv[512 + k0 + k] * wv[k]; } }
    float* mp = (float*)(P.ws + WS_MODP) + (size_t)(l * 8 + kc) * 3 * (NMOD * DM) + j;
    mp[0] = a0; mp[NMOD * DM] = a1; mp[2 * NMOD * DM] = a2;
    __syncthreads();
}
DI void hid_unit(const Frame& F, const Params& P, int u) {
    int l, n, tb; float* dst;
    if (u < 256) { l = u >> 7; n = SEQ; tb = u & 127; dst = (float*)(P.ws + WS_HID) + (size_t)l * SEQ * 64; }
    else { const int v = u - 256; l = v >> 2; n = CTXL; tb = v & 3; dst = (float*)(P.ws + WS_HID + 4 * MiB) + (size_t)l * CTXL * 64; }
    LAS float* zs = (LAS float*)F.lds; LAS float* h1 = zs + 64 * 33;
    const int pos0 = tb * 64;
    const float wstep = 6.283185307179586f / (float)n;
    for (int i = F.tid; i < 64 * 33; i += NTHR) { const int pos = i / 33, k = i - pos * 33; const int ti = pos0 + pos; float val;
        if (k == 0) val = (float)ti / (float)(n - 1);
        else { const int kb = (k - 1) & 15; const float band = 1e-4f + (float)kb * ((15.0f - 1e-4f) / 15.0f); const float ang = (wstep * (float)ti) * band; float sn, cs; sincos_rr(ang, sn, cs); val = (k <= 16) ? cs : -sn; }
        zs[i] = val; }
    __syncthreads();
    const int pos = F.tid >> 3, h0 = (F.tid & 7) * 8;
    const float* w1 = P.in[16] + (size_t)l * 33 * 64; const float* b1 = P.in[17] + l * 64; const float* w2 = P.in[18] + (size_t)l * 64 * 64; const float* b2 = P.in[19] + l * 64; const float* fr = P.in[21] + l * 64;
    float acc[8];
#pragma unroll
    for (int e = 0; e < 8; ++e) acc[e] = b1[h0 + e];
#pragma unroll 1
    for (int k = 0; k < 33; ++k) { const float zv = zs[pos * 33 + k];
#pragma unroll
        for (int e = 0; e < 8; ++e) acc[e] += zv * w1[k * 64 + h0 + e]; }
#pragma unroll
    for (int e = 0; e < 8; ++e) { float sn, cs; sincos_rr(fr[h0 + e] * acc[e], sn, cs); h1[pos * 65 + h0 + e] = sn; }
    __syncthreads();
#pragma unroll
    for (int e = 0; e < 8; ++e) acc[e] = b2[h0 + e];
#pragma unroll 1
    for (int k = 0; k < 64; ++k) { const float hv = h1[pos * 65 + k];
#pragma unroll
        for (int e = 0; e < 8; ++e) acc[e] += hv * w2[k * 64 + h0 + e]; }
#pragma unroll
    for (int e = 0; e < 8; ++e) { float sn, cs; sincos_rr(fr[h0 + e] * acc[e], sn, cs); dst[(size_t)(pos0 + pos) * 64 + h0 + e] = sn; }
    __syncthreads();
}
DI void tab_unit(const Frame& F, const Params& P) {
    float* tab = (float*)(P.ws + WS_TAB);
    for (int i = F.tid; i < 4096; i += NTHR) { const int pos = i >> 5, f = i & 31; const float inv = exp2f(-(float)(2 * f) * (13.287712379549449f / 64.0f)); const float ang = (float)pos * inv; float sn, cs; sincos_rr(ang, sn, cs); tab[2 * i] = cs; tab[2 * i + 1] = sn; }
}
DI void s5_unit(const Frame& F, const Params& P, int u) {
    const int jo = u >> 7, g = u & 127;
    LAS float* pw = (LAS float*)F.lds;
    LAS float* bb = pw + 2 * 64 * 17 * 2;
    LAS float* cc = bb + 2 * 64 * 16 * 2;
    LAS float* Kt = cc + 2 * 16 * 64 * 2;
    if (F.tid < 128) { const int dir = F.tid >> 6, p = F.tid & 63; const int gi = ((jo * 2 + dir) * S5G + g);
        const float lr = P.in[23][(size_t)gi * 64 + p], li = P.in[24][(size_t)gi * 64 + p]; const float st = expf(P.in[25][gi]);
        float pr1 = 1.f, pi1 = 0.f;
        for (int d = 0; d <= 16; ++d) { const float a = lr * st * (float)d, b = li * st * (float)d; const float mag = expf(a); float sn, cs; sincos_rr(b, sn, cs);
            pw[((dir * 64 + p) * 17 + d) * 2] = mag * cs; pw[((dir * 64 + p) * 17 + d) * 2 + 1] = mag * sn; if (d == 1) { pr1 = mag * cs; pi1 = mag * sn; } }
        float* lamL = (float*)(P.ws + WS_LAML) + ((size_t)gi * 64 + p) * 2; lamL[0] = pw[((dir * 64 + p) * 17 + 16) * 2]; lamL[1] = pw[((dir * 64 + p) * 17 + 16) * 2 + 1];
        const float den = 1.0f / (lr * lr + li * li); const float nr = pr1 - 1.0f, ni = pi1; const float qr = (nr * lr + ni * li) * den, qi = (ni * lr - nr * li) * den;
        for (int j = 0; j < 16; ++j) { const float br = P.in[26][((size_t)gi * 64 + p) * 16 + j], bi = P.in[27][((size_t)gi * 64 + p) * 16 + j];
            bb[((dir * 64 + p) * 16 + j) * 2] = qr * br - qi * bi; bb[((dir * 64 + p) * 16 + j) * 2 + 1] = qr * bi + qi * br; } }
    for (int i = F.tid; i < 2048; i += NTHR) { const int dir = i >> 10, j = (i >> 6) & 15, p = i & 63; const size_t si = (((size_t)(jo * 2 + dir) * S5G + g) * 16 + j) * 64 + p;
        cc[i * 2] = P.in[28][si]; cc[i * 2 + 1] = P.in[29][si]; }
    __syncthreads();
    { const int dir = F.tid >> 8, d = (F.tid >> 4) & 15, j = F.tid & 15; float s16[16];
#pragma unroll
        for (int jp = 0; jp < 16; ++jp) s16[jp] = 0.f;
#pragma unroll 2
        for (int p = 0; p < 64; ++p) { const float cr = cc[((dir * 16 + j) * 64 + p) * 2], ci = cc[((dir * 16 + j) * 64 + p) * 2 + 1];
            const float wr_ = pw[((dir * 64 + p) * 17 + d) * 2], wi_ = pw[((dir * 64 + p) * 17 + d) * 2 + 1];
            const float xr = cr * wr_ - ci * wi_, xi = cr * wi_ + ci * wr_;
#pragma unroll
            for (int jp = 0; jp < 16; ++jp) s16[jp] += xr * bb[((dir * 64 + p) * 16 + jp) * 2] - xi * bb[((dir * 64 + p) * 16 + jp) * 2 + 1]; }
#pragma unroll
        for (int jp = 0; jp < 16; ++jp) Kt[((dir * 16 + d) * 16 + j) * 16 + jp] = s16[jp]; }
    __syncthreads();
    bf16* TT = (bf16*)(P.ws + WS_TT) + ((size_t)(jo * S5G + g) * 256) * 512;
    const float* dv = P.in[30] + (size_t)jo * DM + g * 16;
    for (int q = F.tid; q < 256 * 64; q += NTHR) { const int row = q >> 6, k0 = (q & 63) * 8; const int t = row >> 4, j = row & 15; float v[8];
        if (k0 < 256) { const int s = k0 >> 4, jp0 = k0 & 15;
#pragma unroll
            for (int e = 0; e < 8; ++e) { float x = 0.f; if (s <= t) x += Kt[((0 * 16 + (t - s)) * 16 + j) * 16 + jp0 + e]; if (s >= t) x += Kt[((1 * 16 + (s - t)) * 16 + j) * 16 + jp0 + e];
                if (s == t && j == jp0 + e) x += dv[j]; v[e] = x; } }
        else { const int region = (k0 - 256) >> 6, p0 = (k0 - 256) & 63, dir = region >> 1, pwr = dir == 0 ? t + 1 : 16 - t;
#pragma unroll
            for (int e = 0; e < 8; ++e) { const int p = p0 + e; const float cr = cc[((dir * 16 + j) * 64 + p) * 2], ci = cc[((dir * 16 + j) * 64 + p) * 2 + 1];
                const float wr_ = pw[((dir * 64 + p) * 17 + pwr) * 2], wi_ = pw[((dir * 64 + p) * 17 + pwr) * 2 + 1];
                v[e] = (region & 1) ? -(cr * wi_ + ci * wr_) : (cr * wr_ - ci * wi_); } }
        u32x4 w; w.x = pk2(v[0], v[1]); w.y = pk2(v[2], v[3]); w.z = pk2(v[4], v[5]); w.w = pk2(v[6], v[7]);
        *(u32x4*)(TT + (size_t)row * 512 + k0) = w; }
    bf16* WW = (bf16*)(P.ws + WS_WW) + ((size_t)(jo * S5G + g) * 256) * 256;
    for (int q = F.tid; q < 256 * 32; q += NTHR) { const int row = q >> 5, k0 = (q & 31) * 8; const int s = k0 >> 4, jp0 = k0 & 15; const int region = row >> 6, p = row & 63, dir = region >> 1, pwr = dir == 0 ? 15 - s : s; float v[8];
        const float wr_ = pw[((dir * 64 + p) * 17 + pwr) * 2], wi_ = pw[((dir * 64 + p) * 17 + pwr) * 2 + 1];
#pragma unroll
        for (int e = 0; e < 8; ++e) { const float br = bb[((dir * 64 + p) * 16 + jp0 + e) * 2], bi = bb[((dir * 64 + p) * 16 + jp0 + e) * 2 + 1];
            v[e] = (region & 1) ? (wr_ * bi + wi_ * br) : (wr_ * br - wi_ * bi); }
        u32x4 w; w.x = pk2(v[0], v[1]); w.y = pk2(v[2], v[3]); w.z = pk2(v[4], v[5]); w.w = pk2(v[6], v[7]);
        *(u32x4*)(WW + (size_t)row * 256 + k0) = w; }
    __syncthreads();
}
struct TrJob { const float* src; bf16* dst; int N, K; };
DI void tr_decode(const Frame& F, const Params& P, int r, TrJob& J) {
    constexpr int IT_UP = (DM / 64) * (DFF2 / 128), IT_DOWN = (DFF / 64) * (DM / 128), IT_IN = (DM / 64) * (INCOLS / 128), IT_OUT = (DM / 64) * (DM / 128), IT_GLU = (DM / 64) * (2 * DM / 128);
    const float* W; bf16* WT; int K, N, mode;
    if (r < 4 * (IT_UP + IT_DOWN)) { const int l = r / (IT_UP + IT_DOWN); r -= l * (IT_UP + IT_DOWN);
        if (r < IT_UP) { W = P.in[7] + (size_t)l * DM * DFF2; K = DM; N = DFF2; WT = (bf16*)(P.ws + WS_WUP + l * SZ_WUP); mode = 2; }
        else { W = P.in[10] + (size_t)l * DFF * DM; K = DFF; N = DM; WT = (bf16*)(P.ws + WS_WDOWN + l * SZ_WDOWN); r -= IT_UP; mode = 0; } }
    else { r -= 4 * (IT_UP + IT_DOWN); const int j = r / (IT_IN + IT_OUT + IT_GLU); r -= j * (IT_IN + IT_OUT + IT_GLU);
        if (r < IT_IN) { W = P.in[11] + (size_t)j * DM * INCOLS; K = DM; N = INCOLS; WT = (bf16*)(P.ws + WS_WIN + j * SZ_WIN); mode = 1; }
        else if (r < IT_IN + IT_OUT) { W = P.in[12] + (size_t)j * DM * DM; K = DM; N = DM; WT = (bf16*)(P.ws + WS_WOUT + j * SZ_WOUT); r -= IT_IN; mode = 0; }
        else { W = P.in[31] + (size_t)j * DM * 2 * DM; K = DM; N = 2 * DM; WT = (bf16*)(P.ws + WS_WGLU + j * SZ_WGLU); r -= IT_IN + IT_OUT; mode = 3; } }
    const int nb = N >> 7; const int kb = r / nb, nbk = r - kb * nb; const int k0 = kb * 64, n0 = nbk * 128;
    const int tn = (F.tid & 31) * 4, tk = (F.tid >> 5) * 4;
    const int nd = n0 + tn; int ns = nd;
    if (mode == 2) { const int tile = nd >> 8, pp = nd & 255; ns = ((pp >> 2) & 1) * DFF + 128 * tile + 4 * (pp >> 3); }
    if (mode == 3) ns = ((nd >> 2) & 1) * DM + 4 * (nd >> 3);
    if (mode == 1 && nd < 1280) { const int d = nd & 127, gi = d >> 3, n = (d >> 2) & 1; ns = (nd & ~127) + ((gi < 8) ? 0 : 64) + 32 * n + 4 * (gi & 7); }
    J.src = W + (size_t)(k0 + tk) * N + ns; J.N = N; J.K = K; J.dst = WT + (size_t)(n0 + (F.tid >> 3)) * K + k0 + (F.tid & 7) * 8;
}
DI void tr_load(const TrJob& J, f32x4 (&v)[4]) {
#pragma unroll
    for (int i = 0; i < 4; ++i) v[i] = *(const f32x4*)(J.src + (size_t)i * J.N);
}
DI void tr_store(const Frame& F, const TrJob& J, const f32x4 (&v)[4], int buf) {
    LAS unsigned short* tile = (LAS unsigned short*)F.lds + buf * (128 * 72);
    const int tn = (F.tid & 31) * 4, tk = (F.tid >> 5) * 4;
#pragma unroll
    for (int e = 0; e < 4; ++e) { u32x2 w; w.x = pk2(v[0][e], v[1][e]); w.y = pk2(v[2][e], v[3][e]); *(LAS u32x2*)(tile + (tn + e) * 72 + tk) = w; }
    __syncthreads();
    const int n = F.tid >> 3, kc = F.tid & 7;
    const u32x4 w0 = *(const LAS u32x4*)(tile + n * 72 + kc * 8), w1 = *(const LAS u32x4*)(tile + (n + 64) * 72 + kc * 8);
    *(u32x4*)(J.dst) = w0; *(u32x4*)(J.dst + (size_t)64 * J.K) = w1;
}
DI void tr_run(const Frame& F, const Params& P, int r, const int rend) {
    if (r >= rend) return;
    TrJob J0, J1, J2; f32x4 v0[4], v1[4], v2[4];
    tr_decode(F, P, r, J0); tr_load(J0, v0);
    const int rb = (r + F.G < rend) ? r + F.G : r; tr_decode(F, P, rb, J1); tr_load(J1, v1);
    int buf = 0;
#pragma unroll 1
    for (; r < rend; r += F.G) {
        const int rc = (r + 2 * F.G < rend) ? r + 2 * F.G : r; tr_decode(F, P, rc, J2); tr_load(J2, v2);
        tr_store(F, J0, v0, buf); buf ^= 1;
        J0 = J1; J1 = J2;
#pragma unroll
        for (int i = 0; i < 4; ++i) { v0[i] = v1[i]; v1[i] = v2[i]; }
    }
    __syncthreads();
}
DI void p0_prologue(const Frame& F, const Params& P) {
    constexpr int IT_UP = (DM / 64) * (DFF2 / 128), IT_DOWN = (DFF / 64) * (DM / 128), IT_IN = (DM / 64) * (INCOLS / 128), IT_OUT = (DM / 64) * (DM / 128), IT_GLU = (DM / 64) * (2 * DM / 128);
    constexpr int NT = 4 * (IT_UP + IT_DOWN) + 2 * (IT_IN + IT_OUT + IT_GLU);
    constexpr int N_S5 = 256, N_MODP = 768, N_HID = 264;
    constexpr int NPRE = N_MODP + N_HID + 1;
    int it = F.bid;
    for (; it < NPRE; it += F.G) {
        int r = it;
        if (r < N_MODP) { modp_unit(F, P, r); if (DUP_SUB == 8) modp_unit(F, P, r); continue; } r -= N_MODP;
        if (r < N_HID) { hid_unit(F, P, r); continue; } r -= N_HID;
        tab_unit(F, P);
    }
    const int r0 = it - NPRE; const int nmine = r0 < NT ? (NT - r0 + F.G - 1) / F.G : 0;
    const int cut = r0 + F.G * ((nmine * (F.bid & 3)) / 3);
    tr_run(F, P, r0, cut < NT ? cut : NT);
    for (int u = F.bid; u < N_S5; u += F.G) { s5_unit(F, P, u); if (DUP_SUB == 7) s5_unit(F, P, u); }
    tr_run(F, P, cut, NT);
}
DI void filt_unit(const Frame& F, const Params& P, int u) {
    int l, n, tb, ct; const float* hid; bf16* dst;
    if (u < 2048) { l = u >> 10; tb = (u >> 3) & 127; ct = u & 7; n = SEQ; hid = (const float*)(P.ws + WS_HID) + (size_t)l * SEQ * 64; dst = (bf16*)(P.ws + WS_FILT) + (size_t)l * 2 * 1024 * SEQ; }
    else { const int v = u - 2048; l = v >> 5; tb = (v >> 3) & 3; ct = v & 7; n = CTXL; hid = (const float*)(P.ws + WS_HID + 4 * MiB) + (size_t)l * CTXL * 64; dst = (bf16*)(P.ws + WS_FILTC) + (size_t)l * 2 * 1024 * CTXL; }
    LAS unsigned short* hsb = (LAS unsigned short*)F.lds;
    LAS unsigned short* w3t = hsb + 64 * 72;
    const int t0 = tb * 64;
    { const int pos = F.tid >> 3, k8 = (F.tid & 7) * 8; const f32x4 a = *(const f32x4*)(hid + (size_t)(t0 + pos) * 64 + k8), bq = *(const f32x4*)(hid + (size_t)(t0 + pos) * 64 + k8 + 4);
        u32x4 w; w.x = pk2(a[0], a[1]); w.y = pk2(a[2], a[3]); w.z = pk2(bq[0], bq[1]); w.w = pk2(bq[2], bq[3]); *(LAS u32x4*)(hsb + pos * 72 + k8) = w; }
    const float* w3 = P.in[20] + (size_t)l * 64 * 2048;
    { const int c4 = (F.tid & 63) * 4, k4 = (F.tid >> 6) * 4;
#pragma unroll
        for (int half = 0; half < 2; ++half) { f32x4 v[4];
#pragma unroll
            for (int i = 0; i < 4; ++i) v[i] = *(const f32x4*)(w3 + (size_t)(32 * half + k4 + i) * 2048 + ct * 256 + c4);
#pragma unroll
            for (int e = 0; e < 4; ++e) { u32x2 w; w.x = pk2(v[0][e], v[1][e]); w.y = pk2(v[2][e], v[3][e]); *(LAS u32x2*)(w3t + (c4 + e) * 72 + 32 * half + k4) = w; } } }
    __syncthreads();
    const int r = F.lane & 31, h = F.lane >> 5;
    f32x16 acc[2];
#pragma unroll
    for (int nt = 0; nt < 2; ++nt)
#pragma unroll
        for (int i = 0; i < 16; ++i) acc[nt][i] = 0.f;
#pragma unroll
    for (int s = 0; s < 4; ++s) { const bf16x8 a = *(const LAS bf16x8*)(w3t + (32 * F.wave + r) * 72 + 16 * s + 8 * h);
#pragma unroll
        for (int nt = 0; nt < 2; ++nt) { const bf16x8 bq = *(const LAS bf16x8*)(hsb + (nt * 32 + r) * 72 + 16 * s + 8 * h); acc[nt] = __builtin_amdgcn_mfma_f32_32x32x16_bf16(bq, a, acc[nt], 0, 0, 0); } }
    const int col = ct * 256 + 32 * F.wave + r, dir = col >> 10, c = col & 1023;
    const float delta = 3.0701134573253945f + (float)c * (12.280453829301578f / 1023.0f);
    bf16* drow = dst + ((size_t)(dir * 1024 + c)) * n + t0;
    const float tsc = -delta / (float)(n - 1);
#pragma unroll
    for (int nt = 0; nt < 2; ++nt)
#pragma unroll
        for (int kp = 0; kp < 4; kp += 2) {
            unsigned g[2][2];
#pragma unroll
            for (int q = 0; q < 2; ++q) { float v[4];
#pragma unroll
                for (int e = 0; e < 4; ++e) { const int t = t0 + nt * 32 + 8 * (kp + q) + 4 * h + e; v[e] = acc[nt][4 * (kp + q) + e] * fast_exp((float)t * tsc); }
                g[q][0] = cvtpk_c2(v[0], v[1]); g[q][1] = cvtpk_c2(v[2], v[3]); }
            const auto rx = __builtin_amdgcn_permlane32_swap(g[0][0], g[1][0], false, false);
            const auto ry = __builtin_amdgcn_permlane32_swap(g[0][1], g[1][1], false, false);
            *(u32x4*)(drow + nt * 32 + 8 * kp + (h ? 8 : 0)) = (u32x4){rx[0], ry[0], rx[1], ry[1]}; }
    __syncthreads();
}
DI void p1_phase(const Frame& F, const Params& P) {
    for (int u = F.bid; u < 2048 + 64; u += F.G) filt_unit(F, P, u);
    const float* mp = (const float*)(P.ws + WS_MODP); float* mo = (float*)(P.ws + WS_MOD);
    for (int i = F.bid * NTHR + F.tid; i < DEPTH * 3 * NMOD * DM; i += F.G * NTHR) { const int j = i % (NMOD * DM), lr = i / (NMOD * DM), l = lr / 3, r = lr - 3 * l;
        float s = P.in[5][(size_t)l * NMOD * DM + j];
#pragma unroll
        for (int kc = 0; kc < 8; ++kc) s += mp[((size_t)(l * 8 + kc) * 3 + r) * (NMOD * DM) + j];
        mo[i] = s; }
}
typedef short v4i16_t __attribute__((ext_vector_type(4)));
DI s16x4 vtr(const LAS unsigned char* p) { return __builtin_bit_cast(s16x4, __builtin_amdgcn_ds_read_tr16_b64_v4i16((LAS v4i16_t*)p)); }
DI void ld8f(const float* p, float (&v)[8]) { const f32x4 a = *(const f32x4*)p, b = *(const f32x4*)(p + 4); v[0] = a[0]; v[1] = a[1]; v[2] = a[2]; v[3] = a[3]; v[4] = b[0]; v[5] = b[1]; v[6] = b[2]; v[7] = b[3]; }
DI void st8f(float* p, const float (&v)[8]) { *(f32x4*)p = (f32x4){v[0], v[1], v[2], v[3]}; *(f32x4*)(p + 4) = (f32x4){v[4], v[5], v[6], v[7]}; }
DI void ld8b(const bf16* p, float (&v)[8]) { const u32x4 w = *(const u32x4*)p; v[0] = bflo(w.x); v[1] = bfhi(w.x); v[2] = bflo(w.y); v[3] = bfhi(w.y); v[4] = bflo(w.z); v[5] = bfhi(w.z); v[6] = bflo(w.w); v[7] = bfhi(w.w); }
DI void cv8b(const u32x4 w, float (&v)[8]) { v[0] = bflo(w.x); v[1] = bfhi(w.x); v[2] = bflo(w.y); v[3] = bfhi(w.y); v[4] = bflo(w.z); v[5] = bfhi(w.z); v[6] = bflo(w.w); v[7] = bfhi(w.w); }
template <int SRC, bool XIN_BF, bool XOUT_BF>
DI void row_phase(const Frame& F, const bf16* ysrc, const bf16* part, int nparts, int nrows, const void* xin_lat, const void* xin_ctx, void* xout_lat, void* xout_ctx,
                  const float* gA, const float* modA, int mA, bool do_mod, const float* gB, const float* modB, int shiftc, int scalec, bf16* HM, bf16* UA) {
    const int gw = F.bid * NWAVES + F.wave, NGW = F.G * NWAVES;
    constexpr int LDY = (SRC == 2) ? 2 * DM : DM;
    constexpr bool PIPE = XIN_BF && (SRC == 1 || SRC == 3);
    u32x4 xpf[4], ypf[4];
    if (PIPE && gw < nrows) { const bf16* xr = (const bf16*)xin_lat + (size_t)gw * DM + 8 * F.lane;
#pragma unroll
        for (int j = 0; j < 4; ++j) xpf[j] = *(const u32x4*)(xr + 512 * j);
        if (!(gw >= NLAT && nparts > 0)) { const bf16* yr = ysrc + (size_t)gw * DM + 8 * F.lane;
#pragma unroll
            for (int j = 0; j < 4; ++j) ypf[j] = *(const u32x4*)(yr + 512 * j); } }
    for (int r = gw; r < nrows; r += NGW) {
        const int set = r < SEQ ? 0 : (r < NLAT ? 1 : 2);
        float x[4][8];
        if (PIPE) {
#pragma unroll
            for (int j = 0; j < 4; ++j) cv8b(xpf[j], x[j]); }
        else if (XIN_BF) { const bf16* xr = (const bf16*)xin_lat + (size_t)r * DM + 8 * F.lane;
#pragma unroll
            for (int j = 0; j < 4; ++j) ld8b(xr + 512 * j, x[j]); }
        else { const float* xr = r < NLAT ? (const float*)xin_lat + (size_t)r * DM : (const float*)xin_ctx + (size_t)(r - NLAT) * DM;
#pragma unroll
            for (int j = 0; j < 4; ++j) ld8f(xr + 8 * F.lane + 512 * j, x[j]); }
        if (SRC != 0) {
            float y[4][8];
            if (r >= NLAT && nparts > 0) {
#pragma unroll
                for (int j = 0; j < 4; ++j)
#pragma unroll
                    for (int e = 0; e < 8; ++e) y[j][e] = 0.f;
                float g[4][8];
                if (SRC == 2) {
#pragma unroll
                    for (int j = 0; j < 4; ++j)
#pragma unroll
                        for (int e = 0; e < 8; ++e) g[j][e] = 0.f; }
                if (SRC == 3) {
                    float g[4][8];
#pragma unroll
                    for (int j = 0; j < 4; ++j)
#pragma unroll
                        for (int e = 0; e < 8; ++e) g[j][e] = 0.f;
#pragma unroll 1
                    for (int k0 = 0; k0 < nparts; k0 += 2) {
                        u32x4 w0[2][4], w1[2][4];
#pragma unroll
                        for (int kk = 0; kk < 2; ++kk) { const bf16* pr = part + ((size_t)(k0 + kk) * NCTX + (r - NLAT)) * (2 * DM) + 16 * F.lane;
#pragma unroll
                            for (int j = 0; j < 4; ++j) { w0[kk][j] = *(const u32x4*)(pr + 1024 * j); w1[kk][j] = *(const u32x4*)(pr + 1024 * j + 8); } }
#pragma unroll
                        for (int kk = 0; kk < 2; ++kk)
#pragma unroll
                            for (int j = 0; j < 4; ++j) { float t0[8], t1[8]; cv8b(w0[kk][j], t0); cv8b(w1[kk][j], t1);
#pragma unroll
                                for (int e = 0; e < 4; ++e) { y[j][e] += t0[e]; g[j][e] += t0[4 + e]; y[j][4 + e] += t1[e]; g[j][4 + e] += t1[4 + e]; } } }
#pragma unroll
                    for (int j = 0; j < 4; ++j)
#pragma unroll
                        for (int e = 0; e < 8; ++e) y[j][e] *= sigmoidf_(g[j][e]);
                } else
                if (SRC == 2) {
#pragma unroll 1
                for (int k = 0; k < nparts; ++k) { const bf16* pr = part + ((size_t)k * NCTX + (r - NLAT)) * LDY + 8 * F.lane;
#pragma unroll
                    for (int j = 0; j < 4; ++j) { float t[8]; ld8b(pr + 512 * j, t);
#pragma unroll
                        for (int e = 0; e < 8; ++e) y[j][e] += t[e];
                        ld8b(pr + DM + 512 * j, t);
#pragma unroll
                        for (int e = 0; e < 8; ++e) g[j][e] += t[e]; } }
                } else {
#pragma unroll 1
                for (int k0 = 0; k0 < nparts; k0 += 4) {
                    u32x4 w[4][4]; float wt[4];
#pragma unroll
                    for (int kk = 0; kk < 4; ++kk) { const int k = k0 + kk; const int kc = k < nparts ? k : nparts - 1; wt[kk] = k < nparts ? 1.0f : 0.0f;
                        const bf16* pr = part + ((size_t)kc * NCTX + (r - NLAT)) * LDY + 8 * F.lane;
#pragma unroll
                        for (int j = 0; j < 4; ++j) w[kk][j] = *(const u32x4*)(pr + 512 * j); }
#pragma unroll
                    for (int kk = 0; kk < 4; ++kk)
#pragma unroll
                        for (int j = 0; j < 4; ++j) { float t[8]; cv8b(w[kk][j], t);
#pragma unroll
                            for (int e = 0; e < 8; ++e) y[j][e] += t[e] * wt[kk]; } }
                }
                if (SRC == 2) {
#pragma unroll
                    for (int j = 0; j < 4; ++j)
#pragma unroll
                        for (int e = 0; e < 8; ++e) y[j][e] *= sigmoidf_(g[j][e]); }
            } else if (PIPE) {
#pragma unroll
                for (int j = 0; j < 4; ++j) cv8b(ypf[j], y[j]);
            } else {
                const bf16* yr = ysrc + (size_t)r * LDY + 8 * F.lane;
#pragma unroll
                for (int j = 0; j < 4; ++j) ld8b(yr + 512 * j, y[j]);
                if (SRC == 2) {
#pragma unroll
                    for (int j = 0; j < 4; ++j) { float t[8]; ld8b(yr + DM + 512 * j, t);
#pragma unroll
                        for (int e = 0; e < 8; ++e) y[j][e] *= sigmoidf_(t[e]); } }
            }
            if (PIPE) { const int rn = r + NGW;
                if (rn < nrows) { const bf16* xr = (const bf16*)xin_lat + (size_t)rn * DM + 8 * F.lane;
#pragma unroll
                    for (int j = 0; j < 4; ++j) xpf[j] = *(const u32x4*)(xr + 512 * j);
                    if (!(rn >= NLAT && nparts > 0)) { const bf16* yr = ysrc + (size_t)rn * DM + 8 * F.lane;
#pragma unroll
                        for (int j = 0; j < 4; ++j) ypf[j] = *(const u32x4*)(yr + 512 * j); } } }
            float ss = 0.f;
#pragma unroll
            for (int j = 0; j < 4; ++j)
#pragma unroll
                for (int e = 0; e < 8; ++e) ss += y[j][e] * y[j][e];
            ss = wave_sum(ss);
            const float rs = __builtin_amdgcn_rsqf(ss * (1.0f / DM) + RMS_EPS);
            const float* mm = modA + (size_t)set * (NMOD * DM) + mA * DM;
#pragma unroll
            for (int j = 0; j < 4; ++j) { const int c = 8 * F.lane + 512 * j; float ga[8], mv[8]; ld8f(gA + c, ga); ld8f(mm + c, mv);
#pragma unroll
                for (int e = 0; e < 8; ++e) x[j][e] += mv[e] * (y[j][e] * rs * ga[e]);
                if (XOUT_BF) { u32x4 w; w.x = pk2(x[j][0], x[j][1]); w.y = pk2(x[j][2], x[j][3]); w.z = pk2(x[j][4], x[j][5]); w.w = pk2(x[j][6], x[j][7]); *(u32x4*)((bf16*)xout_lat + (size_t)r * DM + c) = w; }
                else { float* xo = r < NLAT ? (float*)xout_lat + (size_t)r * DM : (float*)xout_ctx + (size_t)(r - NLAT) * DM; st8f(xo + c, x[j]); } }
        }
        if (do_mod) {
            float ss = 0.f;
#pragma unroll
            for (int j = 0; j < 4; ++j)
#pragma unroll
                for (int e = 0; e < 8; ++e) ss += x[j][e] * x[j][e];
            ss = wave_sum(ss);
            const float rs = __builtin_amdgcn_rsqf(ss * (1.0f / DM) + RMS_EPS);
            const float* mb = modB + (size_t)set * (NMOD * DM);
            bf16* hr = HM + (size_t)r * DM;
            int cr = 0; if (UA) cr = r < NLAT ? ((r >> 13) * 512 + ((r & (SEQ - 1)) >> 4)) : (1024 + ((r - NLAT) >> 4));
#pragma unroll
            for (int j = 0; j < 4; ++j) { const int c = 8 * F.lane + 512 * j; float gb[8], sc[8], sh[8]; ld8f(gB + c, gb); ld8f(mb + scalec * DM + c, sc); ld8f(mb + shiftc * DM + c, sh);
                float h[8];
#pragma unroll
                for (int e = 0; e < 8; ++e) h[e] = (x[j][e] * rs * gb[e]) * (sc[e] + 1.0f) + sh[e];
                u32x4 w; w.x = pk2(h[0], h[1]); w.y = pk2(h[2], h[3]); w.z = pk2(h[4], h[5]); w.w = pk2(h[6], h[7]);
                if (HM) *(u32x4*)(hr + c) = w;
                if (UA) *(u32x4*)(UA + ((size_t)(c >> 4) * S5ROWS + cr) * S5K + (r & 15) * 16 + (c & 15)) = w; }
        }
    }
}
DI void load8(const bf16* p, float (&v)[8]) { const u32x4 w = *(const u32x4*)p; v[0] = bflo(w.x); v[1] = bfhi(w.x); v[2] = bflo(w.y); v[3] = bfhi(w.y); v[4] = bflo(w.z); v[5] = bfhi(w.z); v[6] = bflo(w.w); v[7] = bfhi(w.w); }
DI void convglu_phase(const Frame& F, const bf16* U, bf16* A5, const float* cw, const float* cb, int nrows) {
    const int gw = F.bid * NWAVES + F.wave, NGW = F.G * NWAVES;
    constexpr int NCC = 11; const int NRC = nrows / 32;
    for (int wu = gw; wu < NRC * NCC; wu += NGW) {
        const int cc = wu % NCC, rc = wu / NCC; const int c0 = cc * 512 + F.lane * 8; const int r0 = rc * 32;
        if (c0 < DFF) {
            float wg[3][8], wv[3][8], bg[8], bv[8];
#pragma unroll
            for (int k = 0; k < 3; ++k)
#pragma unroll
                for (int e = 0; e < 8; ++e) { wg[k][e] = cw[(size_t)k * DFF2 + c0 + e]; wv[k][e] = cw[(size_t)k * DFF2 + DFF + c0 + e]; }
#pragma unroll
            for (int e = 0; e < 8; ++e) { bg[e] = cb[c0 + e]; bv[e] = cb[DFF + c0 + e]; }
            const int seqlen = r0 < NLAT ? SEQ : CTXL; const int rs0 = r0 < NLAT ? (r0 & (SEQ - 1)) : ((r0 - NLAT) & (CTXL - 1));
            float pg[8], pv[8], cg[8], cv[8], ng[8], nv[8];
            if (rs0 > 0) { load8(U + (size_t)(r0 - 1) * DFF2 + c0, pg); load8(U + (size_t)(r0 - 1) * DFF2 + DFF + c0, pv); }
            else {
#pragma unroll
                for (int e = 0; e < 8; ++e) { pg[e] = 0.f; pv[e] = 0.f; } }
            load8(U + (size_t)r0 * DFF2 + c0, cg); load8(U + (size_t)r0 * DFF2 + DFF + c0, cv);
            for (int i = 0; i < 32; ++i) { const int r = r0 + i;
                if (rs0 + i + 1 < seqlen) { load8(U + (size_t)(r + 1) * DFF2 + c0, ng); load8(U + (size_t)(r + 1) * DFF2 + DFF + c0, nv); }
                else {
#pragma unroll
                    for (int e = 0; e < 8; ++e) { ng[e] = 0.f; nv[e] = 0.f; } }
                float o[8];
#pragma unroll
                for (int e = 0; e < 8; ++e) { const float g = pg[e] * wg[0][e] + cg[e] * wg[1][e] + ng[e] * wg[2][e] + bg[e]; const float v = pv[e] * wv[0][e] + cv[e] * wv[1][e] + nv[e] * wv[2][e] + bv[e]; o[e] = siluf_(g) * v; }
                u32x4 w; w.x = pk2(o[0], o[1]); w.y = pk2(o[2], o[3]); w.z = pk2(o[4], o[5]); w.w = pk2(o[6], o[7]);
                *(u32x4*)(A5 + (size_t)r * DFF + c0) = w;
#pragma unroll
                for (int e = 0; e < 8; ++e) { pg[e] = cg[e]; pv[e] = cv[e]; cg[e] = ng[e]; cv[e] = nv[e]; } }
        }
    }
}
#define ZP(i) ((i) + ((i) >> 4))
DI f32x2 cmul(f32x2 a, f32x2 b) { return (f32x2){a[0] * b[0] - a[1] * b[1], a[0] * b[1] + a[1] * b[0]}; }
DI f32x2 cmulc(f32x2 a, f32x2 b) { return (f32x2){a[0] * b[0] + a[1] * b[1], a[1] * b[0] - a[0] * b[1]}; }
DI f32x2 mulmi(f32x2 a) { return (f32x2){a[1], -a[0]}; }
DI f32x2 mulpi(f32x2 a) { return (f32x2){-a[1], a[0]}; }
#define BFLY_F(x0, x1, x2, x3, y0, y1, y2, y3) do { const f32x2 t0_ = (x0) + (x2), t1_ = (x0) - (x2), t2_ = (x1) + (x3), t3_ = mulmi((x1) - (x3)); y0 = t0_ + t2_; y1 = t1_ + t3_; y2 = t0_ - t2_; y3 = t1_ - t3_; } while (0)
#define BFLY_I(x0, x1, x2, x3, y0, y1, y2, y3) do { const f32x2 t0_ = (x0) + (x2), t1_ = (x0) - (x2), t2_ = (x1) + (x3), t3_ = mulpi((x1) - (x3)); y0 = t0_ + t2_; y1 = t1_ + t3_; y2 = t0_ - t2_; y3 = t1_ - t3_; } while (0)
#define W16_1 ((f32x2){0.92387953251128674f, -0.38268343236508977f})
#define W16_2 ((f32x2){0.70710678118654752f, -0.70710678118654752f})
#define W16_3 ((f32x2){0.38268343236508977f, -0.92387953251128674f})
#define W16_6 ((f32x2){-0.70710678118654752f, -0.70710678118654752f})
#define W16_9 ((f32x2){-0.92387953251128674f, 0.38268343236508977f})
template <int Q2> DI void fft_pass16_fwd(const Frame& F, LAS f32x2* Z) {
    constexpr int L = 16 * Q2, ST = Q2 >= 16 ? Q2 + Q2 / 16 : Q2; constexpr float invL = 1.0f / (float)L;
#pragma unroll 1
    for (int g = F.tid; g < 1024; g += NTHR) { const int j = g & (Q2 - 1), base = ((g - j) << 4) + j;
        LAS f32x2* zp = Z + ZP(base);
        f32x2 x[16];
#pragma unroll
        for (int m = 0; m < 16; ++m) x[m] = zp[m * ST];
        const float rev = (float)j * invL; const f32x2 t1 = {__builtin_amdgcn_cosf(rev), -__builtin_amdgcn_sinf(rev)};
        const f32x2 t2 = cmul(t1, t1), t3 = cmul(t2, t1), t4 = cmul(t2, t2), t8 = cmul(t4, t4), t12 = cmul(t8, t4);
        BFLY_F(x[0], x[4], x[8], x[12], x[0], x[4], x[8], x[12]);          x[4] = cmul(x[4], t1); x[8] = cmul(x[8], t2); x[12] = cmul(x[12], t3);
        BFLY_F(x[1], x[5], x[9], x[13], x[1], x[5], x[9], x[13]);          x[5] = cmul(cmul(x[5], W16_1), t1); x[9] = cmul(cmul(x[9], W16_2), t2); x[13] = cmul(cmul(x[13], W16_3), t3);
        BFLY_F(x[2], x[6], x[10], x[14], x[2], x[6], x[10], x[14]);        x[6] = cmul(cmul(x[6], W16_2), t1); x[10] = cmul(mulmi(x[10]), t2); x[14] = cmul(cmul(x[14], W16_6), t3);
        BFLY_F(x[3], x[7], x[11], x[15], x[3], x[7], x[11], x[15]);        x[7] = cmul(cmul(x[7], W16_3), t1); x[11] = cmul(cmul(x[11], W16_6), t2); x[15] = cmul(cmul(x[15], W16_9), t3);
#pragma unroll
        for (int ap = 0; ap < 4; ++ap) { f32x2 z0, z1, z2, z3; BFLY_F(x[4 * ap], x[4 * ap + 1], x[4 * ap + 2], x[4 * ap + 3], z0, z1, z2, z3);
            zp[(4 * ap) * ST] = z0; zp[(4 * ap + 1) * ST] = cmul(z1, t4); zp[(4 * ap + 2) * ST] = cmul(z2, t8); zp[(4 * ap + 3) * ST] = cmul(z3, t12); } }
    __syncthreads();
}
template <int Q2> DI void fft_pass16_inv(const Frame& F, LAS f32x2* Z) {
    constexpr int L = 16 * Q2, ST = Q2 >= 16 ? Q2 + Q2 / 16 : Q2; constexpr float invL = 1.0f / (float)L;
#pragma unroll 1
    for (int g = F.tid; g < 1024; g += NTHR) { const int j = g & (Q2 - 1), base = ((g - j) << 4) + j;
        LAS f32x2* zp = Z + ZP(base);
        f32x2 v[16];
#pragma unroll
        for (int m = 0; m < 16; ++m) v[m] = zp[m * ST];
        const float rev = (float)j * invL; const f32x2 t1 = {__builtin_amdgcn_cosf(rev), -__builtin_amdgcn_sinf(rev)};
        const f32x2 t2 = cmul(t1, t1), t3 = cmul(t2, t1), t4 = cmul(t2, t2), t8 = cmul(t4, t4), t12 = cmul(t8, t4);
#pragma unroll
        for (int ap = 0; ap < 4; ++ap) BFLY_I(v[4 * ap], cmulc(v[4 * ap + 1], t4), cmulc(v[4 * ap + 2], t8), cmulc(v[4 * ap + 3], t12), v[4 * ap], v[4 * ap + 1], v[4 * ap + 2], v[4 * ap + 3]);
        f32x2 o0, o1, o2, o3;
        BFLY_I(v[0], cmulc(v[4], t1), cmulc(v[8], t2), cmulc(v[12], t3), o0, o1, o2, o3);
        zp[0] = o0; zp[4 * ST] = o1; zp[8 * ST] = o2; zp[12 * ST] = o3;
        BFLY_I(v[1], cmulc(cmulc(v[5], t1), W16_1), cmulc(cmulc(v[9], t2), W16_2), cmulc(cmulc(v[13], t3), W16_3), o0, o1, o2, o3);
        zp[ST] = o0; zp[5 * ST] = o1; zp[9 * ST] = o2; zp[13 * ST] = o3;
        BFLY_I(v[2], cmulc(cmulc(v[6], t1), W16_2), mulpi(cmulc(v[10], t2)), cmulc(cmulc(v[14], t3), W16_6), o0, o1, o2, o3);
        zp[2 * ST] = o0; zp[6 * ST] = o1; zp[10 * ST] = o2; zp[14 * ST] = o3;
        BFLY_I(v[3], cmulc(cmulc(v[7], t1), W16_3), cmulc(cmulc(v[11], t2), W16_6), cmulc(cmulc(v[15], t3), W16_9), o0, o1, o2, o3);
        zp[3 * ST] = o0; zp[7 * ST] = o1; zp[11 * ST] = o2; zp[15 * ST] = o3; }
    __syncthreads();
}
template <bool ZHALF = false> DI void fft_fwd(const Frame& F0, LAS f32x2* Z) {
    Frame F = F0; { int t_ = F0.tid; asm volatile("" : "+v"(t_)); F.tid = t_; }
#pragma unroll 2
    for (int u = F.tid; u < 4096; u += NTHR) { const int j = u; LAS f32x2* zp = Z + ZP(j);
        const f32x2 a0 = zp[0], a1 = zp[4352];
        f32x2 y0, y1, y2, y3;
        if (ZHALF) { const f32x2 m1 = mulmi(a1); y0 = a0 + a1; y1 = a0 + m1; y2 = a0 - a1; y3 = a0 - m1; }
        else { const f32x2 a2 = zp[8704], a3 = zp[13056]; BFLY_F(a0, a1, a2, a3, y0, y1, y2, y3); }
        const float rev = (float)j * (1.0f / 16384.0f); const f32x2 w1 = {__builtin_amdgcn_cosf(rev), -__builtin_amdgcn_sinf(rev)}; const f32x2 w2 = cmul(w1, w1), w3 = cmul(w2, w1);
        zp[0] = y0; zp[4352] = cmul(y1, w1); zp[8704] = cmul(y2, w2); zp[13056] = cmul(y3, w3); }
    __syncthreads();
    fft_pass16_fwd<256>(F, Z); fft_pass16_fwd<16>(F, Z); fft_pass16_fwd<1>(F, Z);
}
DI void fft_fwd_to_regs(const Frame& F0, LAS f32x2* Z, f32x2 (&hs)[32], const float sc, const float add) {
    Frame F = F0; { int t_ = F0.tid; asm volatile("" : "+v"(t_)); F.tid = t_; }
#pragma unroll 2
    for (int u = F.tid; u < 4096; u += NTHR) { const int j = u; LAS f32x2* zp = Z + ZP(j);
        const f32x2 a0 = zp[0], a1 = zp[4352], a2 = zp[8704], a3 = zp[13056];
        f32x2 y0, y1, y2, y3; BFLY_F(a0, a1, a2, a3, y0, y1, y2, y3);
        const float rev = (float)j * (1.0f / 16384.0f); const f32x2 w1 = {__builtin_amdgcn_cosf(rev), -__builtin_amdgcn_sinf(rev)}; const f32x2 w2 = cmul(w1, w1), w3 = cmul(w2, w1);
        zp[0] = y0; zp[4352] = cmul(y1, w1); zp[8704] = cmul(y2, w2); zp[13056] = cmul(y3, w3); }
    __syncthreads();
    fft_pass16_fwd<256>(F, Z); fft_pass16_fwd<16>(F, Z);
#pragma unroll
    for (int gi = 0; gi < 2; ++gi) { const int base = (F.tid + 512 * gi) << 4;
        const LAS f32x2* zp = Z + ZP(base);
        f32x2 x[16];
#pragma unroll
        for (int m = 0; m < 16; ++m) x[m] = zp[m];
        BFLY_F(x[0], x[4], x[8], x[12], x[0], x[4], x[8], x[12]);
        BFLY_F(x[1], x[5], x[9], x[13], x[1], x[5], x[9], x[13]);          x[5] = cmul(x[5], W16_1); x[9] = cmul(x[9], W16_2); x[13] = cmul(x[13], W16_3);
        BFLY_F(x[2], x[6], x[10], x[14], x[2], x[6], x[10], x[14]);        x[6] = cmul(x[6], W16_2); x[10] = mulmi(x[10]); x[14] = cmul(x[14], W16_6);
        BFLY_F(x[3], x[7], x[11], x[15], x[3], x[7], x[11], x[15]);        x[7] = cmul(x[7], W16_3); x[11] = cmul(x[11], W16_6); x[15] = cmul(x[15], W16_9);
#pragma unroll
        for (int ap = 0; ap < 4; ++ap) { f32x2 z0, z1, z2, z3; BFLY_F(x[4 * ap], x[4 * ap + 1], x[4 * ap + 2], x[4 * ap + 3], z0, z1, z2, z3);
            hs[16 * gi + 4 * ap] = (f32x2){z0[0] * sc + add, z0[1] * sc}; hs[16 * gi + 4 * ap + 1] = (f32x2){z1[0] * sc + add, z1[1] * sc};
            hs[16 * gi + 4 * ap + 2] = (f32x2){z2[0] * sc + add, z2[1] * sc}; hs[16 * gi + 4 * ap + 3] = (f32x2){z3[0] * sc + add, z3[1] * sc}; } }
    __syncthreads();
}
DI void fft_pass16_inv1_mul(const Frame& F, LAS f32x2* Z, const f32x2 (&hs)[32]) {
#pragma unroll
    for (int gi = 0; gi < 2; ++gi) { const int base = (F.tid + 512 * gi) << 4;
        LAS f32x2* zp = Z + ZP(base);
        f32x2 v[16];
#pragma unroll
        for (int m = 0; m < 16; ++m) v[m] = cmul(zp[m], hs[16 * gi + m]);
#pragma unroll
        for (int ap = 0; ap < 4; ++ap) BFLY_I(v[4 * ap], v[4 * ap + 1], v[4 * ap + 2], v[4 * ap + 3], v[4 * ap], v[4 * ap + 1], v[4 * ap + 2], v[4 * ap + 3]);
        f32x2 o0, o1, o2, o3;
        BFLY_I(v[0], v[4], v[8], v[12], o0, o1, o2, o3);
        zp[0] = o0; zp[4] = o1; zp[8] = o2; zp[12] = o3;
        BFLY_I(v[1], cmulc(v[5], W16_1), cmulc(v[9], W16_2), cmulc(v[13], W16_3), o0, o1, o2, o3);
        zp[1] = o0; zp[5] = o1; zp[9] = o2; zp[13] = o3;
        BFLY_I(v[2], cmulc(v[6], W16_2), mulpi(v[10]), cmulc(v[14], W16_6), o0, o1, o2, o3);
        zp[2] = o0; zp[6] = o1; zp[10] = o2; zp[14] = o3;
        BFLY_I(v[3], cmulc(v[7], W16_3), cmulc(v[11], W16_6), cmulc(v[15], W16_9), o0, o1, o2, o3);
        zp[3] = o0; zp[7] = o1; zp[11] = o2; zp[15] = o3; }
    __syncthreads();
}
DI void fft_inv_mul_lo(const Frame& F0, LAS f32x2* Z, const f32x2 (&hs)[32]) {
    Frame F = F0; { int t_ = F0.tid; asm volatile("" : "+v"(t_)); F.tid = t_; }
    fft_pass16_inv1_mul(F, Z, hs); fft_pass16_inv<16>(F, Z); fft_pass16_inv<256>(F, Z);
#pragma unroll 2
    for (int u = F.tid; u < 4096; u += NTHR) { const int j = u; LAS f32x2* zp = Z + ZP(j);
        const float rev = (float)j * (1.0f / 16384.0f); const f32x2 w1 = {__builtin_amdgcn_cosf(rev), -__builtin_amdgcn_sinf(rev)}; const f32x2 w2 = cmul(w1, w1), w3 = cmul(w2, w1);
        const f32x2 a0 = zp[0], a1 = cmulc(zp[4352], w1), a2 = cmulc(zp[8704], w2), a3 = cmulc(zp[13056], w3);
        f32x2 x0, x1, x2, x3; BFLY_I(a0, a1, a2, a3, x0, x1, x2, x3);
        zp[0] = x0; zp[4352] = x1; }
    __syncthreads();
}
DI float dw3(const LAS unsigned short* row, int t, int n, float w0, float w1, float w2, float b) {
    const float m = bf2f(row[t]); const float l = t > 0 ? bf2f(row[t - 1]) : 0.f; const float r = t + 1 < n ? bf2f(row[t + 1]) : 0.f;
    return l * w0 + m * w1 + r * w2 + b;
}
DI void dw3x4(const LAS unsigned short* row, int t, int n, float w0, float w1, float w2, float b, float (&o)[4]) {
    const u32x2 m = *(const LAS u32x2*)(row + t);
    const float c0 = bflo(m.x), c1 = bfhi(m.x), c2 = bflo(m.y), c3 = bfhi(m.y);
    const float l = t > 0 ? bf2f(row[t - 1]) : 0.f; const float r = t + 4 < n ? bf2f(row[t + 4]) : 0.f;
    o[0] = l * w0 + c0 * w1 + c1 * w2 + b; o[1] = c0 * w0 + c1 * w1 + c2 * w2 + b; o[2] = c1 * w0 + c2 * w1 + c3 * w2 + b; o[3] = c2 * w0 + c3 * w1 + r * w2 + b;
}
DI void hyena_taps(const Frame& F, const Params& P, int je, int c, u32x4 (&wf)[2], u32x4 (&wb)[2]) {
    const bf16* filt = (const bf16*)(P.ws + WS_FILT) + (size_t)je * 2 * 1024 * SEQ;
    const bf16* ff = filt + (size_t)c * SEQ; const bf16* fb = filt + (size_t)(1024 + c) * SEQ;
#pragma unroll
    for (int q = 0; q < 2; ++q) { const int pc = F.tid + 512 * q; wf[q] = *(const u32x4*)(ff + 8 * pc); wb[q] = *(const u32x4*)(fb + 8184 - 8 * pc); }
}
DI void hyena_unit(const Frame& F0, const Params& P, int je, int c, int cn, u32x4 (&wf)[2], u32x4 (&wb)[2]) {
    Frame F = F0; { int t_ = F0.tid; asm volatile("" : "+v"(t_)); F.tid = t_; F.lane = t_ & 63; }
    LAS f32x2* Z = (LAS f32x2*)F.lds;
    LAS float* aux = (LAS float*)(F.lds + AUX_OFF + 8192);
    LAS float* red = aux + 1536;
    const bf16* ZBT = (const bf16*)(P.ws + WS_U + 50 * MiB);
    bf16* YBT = (bf16*)(P.ws + WS_U + 150 * MiB);
    const bf16* filt = (const bf16*)(P.ws + WS_FILT) + (size_t)je * 2 * 1024 * SEQ;
    const bf16* ff = filt + (size_t)c * SEQ; const bf16* fb = filt + (size_t)(1024 + c) * SEQ;
    const float* hw = P.in[14] + (size_t)je * 3 * HYC; const float* hb = P.in[15] + (size_t)je * HYC;
    float l1 = 0.f;
    u32x4 rawpf[8]; u32x4 cpf = {0u, 0u, 0u, 0u}; bf16 hcpf = 0;
    const bf16* fc = (const bf16*)(P.ws + WS_FILTC) + (size_t)je * 2 * 1024 * CTXL;
    {
#pragma unroll
        for (int k = 0; k < 8; ++k) { const int i = F.tid + 512 * k, rr = i >> 10, piece = i & 1023; const int b = rr & 1, which = rr >> 1;
            rawpf[k] = *(const u32x4*)(ZBT + (size_t)((which ? 2048 : 1024) + c) * MROWS + b * SEQ + piece * 8); }
        { const int i = F.tid; if (i >= 255 && i < 511) hcpf = fc[(size_t)c * CTXL + (i - 255)]; else if (i < 255) hcpf = fc[(size_t)(1024 + c) * CTXL + (255 - i)];
            if (i < 192) { const int rw = i >> 5, pc = i & 31; const int bb2 = rw / 3, which = rw - 3 * bb2; cpf = *(const u32x4*)(ZBT + (size_t)(which * 1024 + c) * MROWS + NLAT + bb2 * CTXL + pc * 8); } }
#pragma unroll
        for (int q = 0; q < 2; ++q) { const int pc = F.tid + 512 * q; float v[8];
            v[0] = bflo(wf[q].x); v[1] = bfhi(wf[q].x); v[2] = bflo(wf[q].y); v[3] = bfhi(wf[q].y); v[4] = bflo(wf[q].z); v[5] = bfhi(wf[q].z); v[6] = bflo(wf[q].w); v[7] = bfhi(wf[q].w);
            LAS f32x2* zp = Z + ZP(8 * pc);
#pragma unroll
            for (int e = 0; e < 8; ++e) { l1 += fabsf(v[e]); zp[e] = (f32x2){v[e], 0.f}; }
            v[0] = bflo(wb[q].x); v[1] = bfhi(wb[q].x); v[2] = bflo(wb[q].y); v[3] = bfhi(wb[q].y); v[4] = bflo(wb[q].z); v[5] = bfhi(wb[q].z); v[6] = bflo(wb[q].w); v[7] = bfhi(wb[q].w);
#pragma unroll
            for (int e = 0; e < 8; ++e) { const int i = 8193 + 8 * pc + e; if (i < 16384) { l1 += fabsf(v[7 - e]); Z[ZP(i)] = (f32x2){v[7 - e], 0.f}; } } }
        if (F.tid == 0) Z[ZP(SEQ)] = (f32x2){0.f, 0.f};
        if (cn >= 0) hyena_taps(F, P, je, cn, wf, wb);
    }
    l1 = block_sum(F, l1, red);
    const float bias = P.in[22][(size_t)je * 1024 + c];
    const float hscale = 1.0f / (l1 * 16384.0f), hadd = bias * (1.0f / 16384.0f);
    f32x2 hs[32];
    fft_fwd_to_regs(F, Z, hs, hscale, hadd);
    LAS unsigned short* raw = (LAS unsigned short*)(F.lds + 69632);
#pragma unroll
    for (int k = 0; k < 8; ++k) { const int i = F.tid + 512 * k, rr = i >> 10, piece = i & 1023; *(LAS u32x4*)(raw + rr * SEQ + piece * 8) = rawpf[k]; }
    __syncthreads();
    const float wx10 = hw[1024 + c], wx11 = hw[HYC + 1024 + c], wx12 = hw[2 * HYC + 1024 + c], bx1 = hb[1024 + c];
    const float wv0 = hw[2048 + c], wv1 = hw[HYC + 2048 + c], wv2 = hw[2 * HYC + 2048 + c], bv = hb[2048 + c];
    const float wx00 = hw[c], wx01 = hw[HYC + c], wx02 = hw[2 * HYC + c], bx0 = hb[c];
#pragma unroll 1
    for (int k = 0; k < 4; ++k) { const int t = 4 * (k * 512 + F.tid);
        float pv0[4], px0[4], pv1[4], px1[4];
        dw3x4(raw + 2 * SEQ, t, SEQ, wv0, wv1, wv2, bv, pv0); dw3x4(raw, t, SEQ, wx10, wx11, wx12, bx1, px0);
        dw3x4(raw + 3 * SEQ, t, SEQ, wv0, wv1, wv2, bv, pv1); dw3x4(raw + SEQ, t, SEQ, wx10, wx11, wx12, bx1, px1);
        LAS f32x2* zp = Z + ZP(t);
#pragma unroll
        for (int e = 0; e < 4; ++e) zp[e] = (f32x2){pv0[e] * px0[e], pv1[e] * px1[e]}; }
    __syncthreads();
    u32x4 x0pf[4];
#pragma unroll
    for (int k = 0; k < 4; ++k) { const int i = F.tid + 512 * k, b = i >> 10, piece = i & 1023; x0pf[k] = *(const u32x4*)(ZBT + (size_t)c * MROWS + b * SEQ + piece * 8); }
    fft_fwd<true>(F, Z);
    fft_inv_mul_lo(F, Z, hs);
#pragma unroll
    for (int k = 0; k < 4; ++k) { const int i = F.tid + 512 * k, b = i >> 10, piece = i & 1023; *(LAS u32x4*)(raw + b * SEQ + piece * 8) = x0pf[k]; }
    __syncthreads();
#pragma unroll 1
    for (int k = 0; k < 4; ++k) { const int t = 4 * (k * 512 + F.tid);
        float g0[4], g1[4]; dw3x4(raw, t, SEQ, wx00, wx01, wx02, bx0, g0); dw3x4(raw + SEQ, t, SEQ, wx00, wx01, wx02, bx0, g1);
        const LAS f32x2* zp = Z + ZP(t); const f32x2 z0 = zp[0], z1 = zp[1], z2 = zp[2], z3 = zp[3];
        u32x2 w0_, w1_; w0_.x = pk2(z0[0] * g0[0], z1[0] * g0[1]); w0_.y = pk2(z2[0] * g0[2], z3[0] * g0[3]); w1_.x = pk2(z0[1] * g1[0], z1[1] * g1[1]); w1_.y = pk2(z2[1] * g1[2], z3[1] * g1[3]);
        *(u32x2*)(YBT + (size_t)c * MROWS + t) = w0_; *(u32x2*)(YBT + (size_t)c * MROWS + SEQ + t) = w1_; }
    LAS float* hc = aux; LAS float* vvc = aux + 512; LAS float* x0c = aux + 1024;
    __syncthreads();
    { const int i = F.tid; float v;
        if (i < 511) v = bf2f(hcpf); else v = 0.f;
        hc[i] = v; float l1c = block_sum(F, fabsf(v), red);
        const int b = i >> 8, t = i & 255;
        LAS unsigned short* crow = (LAS unsigned short*)(F.lds + 16384);
        if (i < 192) { const int rw = i >> 5, pc = i & 31; const int bb2 = rw / 3, which = rw - 3 * bb2;
            const u32x4 w = cpf;
            LAS unsigned short* d = crow + rw * 272 + 1 + pc * 8;
            d[0] = (unsigned short)(w.x & 0xffff); d[1] = (unsigned short)(w.x >> 16); d[2] = (unsigned short)(w.y & 0xffff); d[3] = (unsigned short)(w.y >> 16);
            d[4] = (unsigned short)(w.z & 0xffff); d[5] = (unsigned short)(w.z >> 16); d[6] = (unsigned short)(w.w & 0xffff); d[7] = (unsigned short)(w.w >> 16); }
        else if (i < 204) { const int k = i - 192; crow[(k >> 1) * 272 + ((k & 1) ? 257 : 0)] = 0; }
        __syncthreads();
        auto rd = [&](int which, int tt) -> float { return bf2f(crow[(3 * b + which) * 272 + 1 + tt]); };
        const float pv_ = rd(2, t - 1) * wv0 + rd(2, t) * wv1 + rd(2, t + 1) * wv2 + bv;
        const float px1 = rd(1, t - 1) * wx10 + rd(1, t) * wx11 + rd(1, t + 1) * wx12 + bx1;
        const float px0 = rd(0, t - 1) * wx00 + rd(0, t) * wx01 + rd(0, t + 1) * wx02 + bx0;
        vvc[i] = pv_ * px1; x0c[i] = px0;
        __syncthreads();
        { LAS float* part = (LAS float*)F.lds;
            const int t4 = (F.tid & 63) * 4, bb = (F.tid >> 6) & 1, sq = F.tid >> 7;
            float a0 = 0.f, a1 = 0.f, a2 = 0.f, a3 = 0.f;
            int d = t4 - sq * 64 + 255;
            float h1 = hc[d + 1], h2 = hc[d + 2], h3 = hc[d + 3];
#pragma unroll 8
            for (int s = 0; s < 64; ++s) { const float h0 = hc[d - s]; const float v = vvc[bb * 256 + sq * 64 + s];
                a0 += h0 * v; a1 += h1 * v; a2 += h2 * v; a3 += h3 * v; h3 = h2; h2 = h1; h1 = h0; }
            *(LAS f32x4*)(part + (sq * 2 + bb) * 256 + t4) = (f32x4){a0, a1, a2, a3}; }
        __syncthreads();
        { const LAS float* part = (const LAS float*)F.lds;
            float s = (part[(0 * 2 + b) * 256 + t] + part[(1 * 2 + b) * 256 + t]) + (part[(2 * 2 + b) * 256 + t] + part[(3 * 2 + b) * 256 + t]);
            s = s / l1c;
            YBT[(size_t)c * MROWS + NLAT + i] = (bf16)f2bf((s + vvc[i] * bias) * x0c[i]); }
    }
    __syncthreads();
}
DI void ybt_transpose_phase(const Frame& F, const Params& P) {
    const bf16* YBT = (const bf16*)(P.ws + WS_U + 150 * MiB); bf16* YAB = (bf16*)(P.ws + WS_YAB);
    LAS unsigned char* tile = F.lds + F.wave * 16384;
    const int gw = F.bid * NWAVES + F.wave, NGW = F.G * NWAVES;
    const int rr = F.lane >> 3, piece = F.lane & 7;
    const int i16 = F.lane & 15, tq = i16 >> 2, tp = i16 & 3, g16 = F.lane >> 4;
    for (int tu = gw; tu < 16 * (MROWS / 64); tu += NGW) { const int cb = tu & 15, tb = tu >> 4; const int c0 = cb * 64, t0 = tb * 64;
        u32x4 v[8];
#pragma unroll
        for (int i = 0; i < 8; ++i) v[i] = *(const u32x4*)(YBT + (size_t)(c0 + 8 * i + rr) * MROWS + t0 + piece * 8);
#pragma unroll
        for (int i = 0; i < 8; ++i) *(LAS u32x4*)(tile + (8 * i + rr) * 192 + piece * 16) = v[i];
        asm volatile("s_waitcnt lgkmcnt(0)" ::: "memory");
        bf16* dst = YAB + (size_t)(t0 + F.lane) * DM + 1024 + c0;
#pragma unroll
        for (int k = 0; k < 8; ++k) {
            const LAS unsigned char* ap = tile + (8 * k + tq) * 192 + 32 * g16 + 8 * tp;
            const s16x4 lo = vtr(ap), hi = vtr(ap + 4 * 192);
            const bf16x8 o = __builtin_shufflevector(lo, hi, 0, 1, 2, 3, 4, 5, 6, 7);
            *(bf16x8*)(dst + 8 * k) = o; }
        asm volatile("s_waitcnt lgkmcnt(0)" ::: "memory");
    }
}
typedef __bf16 bf16x2_t __attribute__((ext_vector_type(2)));
DI unsigned cvtpk_s(float lo, float hi) { const f32x2 v = {lo, hi}; const bf16x2_t b = __builtin_convertvector(v, bf16x2_t); return __builtin_bit_cast(unsigned, b); }
DI int crow(int i, int h) { return (i & 3) + 8 * (i >> 2) + 4 * h; }
#define MFMA32(a, b, c) __builtin_amdgcn_mfma_f32_32x32x16_bf16((a), (b), (c), 0, 0, 0)
constexpr int KPITCH = 272, VPITCH = 320, VS_OFF = 128 * KPITCH;

DI void attn_unit(const Frame& F, const Params& P, int je, int au) {
    int b, qb, hk, hp; bool isctx;
    if (au < 512) { isctx = false; const int idx = (au & 7) * 64 + (au >> 3);
        hp = idx & 1; qb = (idx >> 1) & 63; hk = (idx >> 7) & 1; b = idx >> 8; }
    else { const int v = au - 512; isctx = true; hp = v & 1; hk = (v >> 1) & 1; qb = (v >> 2) & 1; b = v >> 3; }
    const bf16* QKV = (const bf16*)(P.ws + WS_U); bf16* YAB = (bf16*)(P.ws + WS_YAB);
    const int r = F.lane & 31, h = F.lane >> 5;
    const int qsub = F.wave & 3, head = hk * 4 + hp * 2 + (F.wave >> 2);
    const int seqbase = isctx ? (NLAT + b * CTXL) : b * SEQ;
    const int qrow = seqbase + qb * 128 + qsub * 32 + r;
    const bf16* qbase = QKV + (size_t)qrow * QKVC + head * HD + 8 * h;
    bf16x8 qf[8];
#pragma unroll
    for (int s = 0; s < 8; ++s) qf[s] = *(const bf16x8*)(qbase + 16 * s);
    float m = P.in[13][je * 8 + head] * LOG2E, l = (h == 0) ? 1.0f : 0.0f;
    f32x16 O[4];
#pragma unroll
    for (int dt = 0; dt < 4; ++dt)
#pragma unroll
        for (int i = 0; i < 16; ++i) O[dt][i] = 0.f;
    const LAS unsigned char* Ks = F.lds; const LAS unsigned char* Vs = F.lds + VS_OFF;
    const int ql = qsub * 32 + r;
    const int i16 = F.lane & 15, tq = i16 >> 2, tp = i16 & 3, blk = (F.lane >> 4) & 1;
    int nb = 0, brow[5], btype[5];
#pragma unroll
    for (int bi = 0; bi < 5; ++bi) { int krow0, type; bool ok;
        if (bi < 3) { const int kb = qb - 1 + bi; ok = !isctx && kb >= 0 && kb < SEQ / 128; krow0 = b * SEQ + kb * 128; type = bi; }
        else { ok = true; krow0 = NLAT + b * CTXL + (bi - 3) * 128; type = 1; }
        if (ok) {
#pragma unroll
            for (int q = 0; q < 5; ++q) if (q == nb) { brow[q] = krow0; btype[q] = type; }
            ++nb; } }
    u32x4 kreg[4], vreg[4];
    const int pkey = F.tid >> 4, ppc = F.tid & 15;
#define ATT_PREFETCH(krow0_) do { const bf16* src_ = QKV + (size_t)((krow0_) + pkey) * QKVC + hk * HD + ppc * 8 + QCOLS; \
        _Pragma("unroll") for (int i_ = 0; i_ < 4; ++i_) { kreg[i_] = *(const u32x4*)(src_ + (size_t)i_ * 32 * QKVC); vreg[i_] = *(const u32x4*)(src_ + (size_t)i_ * 32 * QKVC + KVC); } } while (0)
    ATT_PREFETCH(brow[0]);
    for (int bi = 0; bi < nb; ++bi) {
        int krow_next = 0, type = 1;
#pragma unroll
        for (int q = 0; q < 5; ++q) { if (q == bi) type = btype[q]; if (q == bi + 1) krow_next = brow[q]; }
        __syncthreads();
#pragma unroll
        for (int i = 0; i < 4; ++i) { *(LAS u32x4*)(F.lds + (pkey + 32 * i) * KPITCH + ppc * 16) = kreg[i]; *(LAS u32x4*)(F.lds + VS_OFF + (pkey + 32 * i) * VPITCH + ppc * 16) = vreg[i]; }
        __syncthreads();
        if (bi + 1 < nb) ATT_PREFETCH(krow_next);
#pragma unroll 1
        for (int hb = 0; hb < 2; ++hb) {
            f32x16 st[2];
#pragma unroll
            for (int k2 = 0; k2 < 2; ++k2) { const int kt = 2 * hb + k2;
#pragma unroll
                for (int i = 0; i < 16; ++i) st[k2][i] = 0.f;
#pragma unroll
                for (int s = 0; s < 8; ++s) { const bf16x8 kf = *(const LAS bf16x8*)(Ks + (kt * 32 + r) * KPITCH + (16 * s + 8 * h) * 2); st[k2] = MFMA32(kf, qf[s], st[k2]); }
                __builtin_amdgcn_sched_barrier(0); }
            if (type != 1) { int qlv = ql; asm volatile("" : "+v"(qlv));
#pragma unroll
                for (int k2 = 0; k2 < 2; ++k2)
#pragma unroll
                    for (int i = 0; i < 16; ++i) { const int kl = (2 * hb + k2) * 32 + crow(i, h); const bool ok = (type == 0) ? (kl >= qlv) : (kl <= qlv); st[k2][i] = ok ? st[k2][i] : -1e30f; } }
            float mx = st[0][0];
#pragma unroll
            for (int k2 = 0; k2 < 2; ++k2)
#pragma unroll
                for (int i = 0; i < 16; ++i) mx = fmaxf(mx, st[k2][i]);
            mx = fmaxf(mx, __shfl_xor(mx, 32));
            const float mnew = fmaxf(m, mx), alpha = __builtin_amdgcn_exp2f(m - mnew); m = mnew;
            float ls = 0.f;
#pragma unroll
            for (int k2 = 0; k2 < 2; ++k2)
#pragma unroll
                for (int i = 0; i < 16; ++i) { const float pe = __builtin_amdgcn_exp2f(st[k2][i] - mnew); st[k2][i] = pe; ls += pe; }
            l = l * alpha + ls;
#pragma unroll
            for (int dt = 0; dt < 4; ++dt)
#pragma unroll
                for (int i = 0; i < 16; ++i) O[dt][i] *= alpha;
#pragma unroll
            for (int k2 = 0; k2 < 2; ++k2)
#pragma unroll
                for (int s = 0; s < 2; ++s) { const int kt = 2 * hb + k2;
                    u32x4 pw; pw.x = cvtpk_s(st[k2][8 * s + 0], st[k2][8 * s + 1]); pw.y = cvtpk_s(st[k2][8 * s + 2], st[k2][8 * s + 3]); pw.z = cvtpk_s(st[k2][8 * s + 4], st[k2][8 * s + 5]); pw.w = cvtpk_s(st[k2][8 * s + 6], st[k2][8 * s + 7]);
                    const bf16x8 pf = __builtin_bit_cast(bf16x8, pw);
#pragma unroll
                    for (int dt = 0; dt < 4; ++dt) {
                        const LAS unsigned char* vp = Vs + (kt * 32 + 16 * s + 4 * h + tq) * VPITCH + 64 * dt + 32 * blk + 8 * tp;
                        const s16x4 lo = vtr(vp), hi = vtr(vp + 8 * VPITCH);
                        const bf16x8 vf = __builtin_shufflevector(lo, hi, 0, 1, 2, 3, 4, 5, 6, 7);
                        O[dt] = MFMA32(vf, pf, O[dt]); }
                    __builtin_amdgcn_sched_barrier(0); }
        }
    }
#undef ATT_PREFETCH
    const float lt = l + __shfl_xor(l, 32); const float inv = 1.0f / lt;
    bf16* orow = YAB + (size_t)qrow * DM + head * HD;
#pragma unroll
    for (int dt = 0; dt < 4; ++dt)
#pragma unroll
        for (int ig = 0; ig < 4; ++ig) { u32x2 w; w.x = cvtpk_s(O[dt][4 * ig] * inv, O[dt][4 * ig + 1] * inv); w.y = cvtpk_s(O[dt][4 * ig + 2] * inv, O[dt][4 * ig + 3] * inv);
            *(u32x2*)(orow + dt * 32 + 8 * ig + 4 * h) = w; }
    __syncthreads();
}
DI void unpack8(const u32x4 w, float (&v)[8]) { v[0] = bflo(w.x); v[1] = bfhi(w.x); v[2] = bflo(w.y); v[3] = bfhi(w.y); v[4] = bflo(w.z); v[5] = bfhi(w.z); v[6] = bflo(w.w); v[7] = bfhi(w.w); }
DI void s5_carry_phase(const Frame& F, const Params& P, int jo) {
    const int fr = F.lane & 15, fq = F.lane >> 4;
    for (int blk = F.bid; blk < 2 * S5G; blk += F.G) {
        const int g = blk & 127, b = blk >> 7;
        bf16* ET = (bf16*)(P.ws + WS_U) + (size_t)g * 256 * S5ROWS;
        bf16* UAg = (bf16*)(P.ws + WS_A5) + (size_t)g * S5ROWS * S5K;
        const bf16* UAc = UAg + (size_t)(1024 + b * 16) * S5K;
        const bf16* WWg = (const bf16*)(P.ws + WS_WW) + (size_t)(jo * S5G + g) * 256 * 256;
        const bf16* TTg = (const bf16*)(P.ws + WS_TT) + (size_t)(jo * S5G + g) * 256 * 512;
        const int rc0 = 1024 + b * 16, rl0 = b * 512;
#pragma unroll 1
        for (int mt = F.wave; mt < 16; mt += NWAVES) { pg8::f32x4 acc = {0.f, 0.f, 0.f, 0.f};
#pragma unroll
            for (int ks = 0; ks < 8; ++ks) { const bf16x8 a = *(const bf16x8*)(WWg + (size_t)(mt * 16 + fr) * 256 + 32 * ks + 8 * fq), bq = *(const bf16x8*)(UAc + (size_t)fr * S5K + 32 * ks + 8 * fq);
                acc = __builtin_amdgcn_mfma_f32_16x16x32_bf16(a, bq, acc, 0, 0, 0); }
#pragma unroll
            for (int j = 0; j < 4; ++j) ET[(size_t)(mt * 16 + 4 * fq + j) * S5ROWS + rc0 + fr] = (bf16)f2bf(acc[j]); }
        asm volatile("s_waitcnt vmcnt(0)" ::: "memory"); __syncthreads();
        const int p = F.lane, dir = F.wave & 1;
        const float* lp = (const float*)(P.ws + WS_LAML) + ((size_t)((jo * 2 + dir) * S5G + g) * 64 + p) * 2;
        const float lr = lp[0], li = lp[1];
        const bf16* Er = ET + (size_t)(dir * 128 + p) * S5ROWS;
        bf16* Ug = UAg + 256 + dir * 128 + p;
        float sr = 0.f, si = 0.f;
        if (F.wave < 2) {
            float cr[16], ci[16];
            { float t8[8]; unpack8(*(const u32x4*)(Er + rc0), t8);
#pragma unroll
              for (int e = 0; e < 8; ++e) cr[e] = t8[e];
              unpack8(*(const u32x4*)(Er + rc0 + 8), t8);
#pragma unroll
              for (int e = 0; e < 8; ++e) cr[8 + e] = t8[e];
              unpack8(*(const u32x4*)(Er + 64 * S5ROWS + rc0), t8);
#pragma unroll
              for (int e = 0; e < 8; ++e) ci[e] = t8[e];
              unpack8(*(const u32x4*)(Er + 64 * S5ROWS + rc0 + 8), t8);
#pragma unroll
              for (int e = 0; e < 8; ++e) ci[8 + e] = t8[e]; }
#pragma unroll
            for (int q = 0; q < 16; ++q) { const int qq = dir == 0 ? q : 15 - q; const int row = rc0 + qq;
                Ug[(size_t)row * S5K] = (bf16)f2bf(sr); Ug[(size_t)row * S5K + 64] = (bf16)f2bf(si);
                const float xr = dir == 0 ? cr[q] : cr[15 - q], xi = dir == 0 ? ci[q] : ci[15 - q];
                const float nr = lr * sr - li * si + xr, ni = lr * si + li * sr + xi; sr = nr; si = ni; } }
        asm volatile("s_waitcnt vmcnt(0)" ::: "memory"); __syncthreads();
        if (F.wave < 2) {
#define S5BLK(bq) (dir == 0 ? rl0 + 8 * (bq) : rl0 + 504 - 8 * (bq))
            u32x4 er[4], ei[4];
#pragma unroll
            for (int k = 0; k < 4; ++k) { const int row = S5BLK(k); er[k] = *(const u32x4*)(Er + row); ei[k] = *(const u32x4*)(Er + 64 * S5ROWS + row); }
#pragma unroll 1
            for (int b0 = 0; b0 < 64; b0 += 4) {
                u32x4 nr_[4], ni_[4];
#pragma unroll
                for (int k = 0; k < 4; ++k) { const int bq = b0 + 4 + k; if (bq < 64) { const int row = S5BLK(bq); nr_[k] = *(const u32x4*)(Er + row); ni_[k] = *(const u32x4*)(Er + 64 * S5ROWS + row); } else { nr_[k] = (u32x4){0u, 0u, 0u, 0u}; ni_[k] = nr_[k]; } }
#pragma unroll
                for (int k = 0; k < 4; ++k) { const int row0 = S5BLK(b0 + k); float vr[8], vi[8]; unpack8(er[k], vr); unpack8(ei[k], vi);
#pragma unroll
                    for (int e = 0; e < 8; ++e) { const int ee = dir == 0 ? e : 7 - e; const int row = row0 + ee;
                        Ug[(size_t)row * S5K] = (bf16)f2bf(sr); Ug[(size_t)row * S5K + 64] = (bf16)f2bf(si);
                        const float xr = dir == 0 ? vr[e] : vr[7 - e], xi = dir == 0 ? vi[e] : vi[7 - e];
                        const float nr = lr * sr - li * si + xr, ni = lr * si + li * sr + xi; sr = nr; si = ni; } }
#pragma unroll
                for (int k = 0; k < 4; ++k) { er[k] = nr_[k]; ei[k] = ni_[k]; }
            }
#undef S5BLK
        } else {
            bf16* G2c = (bf16*)(P.ws + WS_Y) + ((size_t)g * S5ROWS + rc0) * 256;
#pragma unroll 1
            for (int mt = F.wave - 2; mt < 16; mt += NWAVES - 2) { pg8::f32x4 acc = {0.f, 0.f, 0.f, 0.f};
#pragma unroll
                for (int ks = 0; ks < 16; ++ks) { const bf16x8 a = *(const bf16x8*)(TTg + (size_t)(mt * 16 + fr) * 512 + 32 * ks + 8 * fq), bq = *(const bf16x8*)(UAc + (size_t)fr * S5K + 32 * ks + 8 * fq);
                    acc = __builtin_amdgcn_mfma_f32_16x16x32_bf16(a, bq, acc, 0, 0, 0); }
                u32x2 w; w.x = pk2(gelu_tanh(acc[0]), gelu_tanh(acc[1])); w.y = pk2(gelu_tanh(acc[2]), gelu_tanh(acc[3]));
                *(u32x2*)(G2c + (size_t)fr * 256 + mt * 16 + 4 * fq) = w; }
        }
        __syncthreads();
    }
}
constexpr int N_PHASES = 3 + 4 * 8;
#ifndef WGM_C2
#define WGM_C2 8
#endif
#ifndef WGM_E1
#define WGM_E1 4
#endif
#ifndef STAGGER_US
#define STAGGER_US 0
#endif
#ifndef REV_C4
#define REV_C4 0
#endif
#ifndef WGM_O4
#define WGM_O4 4
#endif
#ifndef WGM_C4
#define WGM_C4 4
#endif
#ifndef DUP_MASK_VALUE
#define DUP_MASK_VALUE 0ull
#endif
constexpr unsigned long long DUP_MASK = DUP_MASK_VALUE;
#ifndef DUP_SUB
#define DUP_SUB 0
#endif
typedef const Params __attribute__((address_space(4)))* ParamsK;
__global__ void __launch_bounds__(NTHR, 2) hybrid_fwd(Params Parg) {
    extern __shared__ __attribute__((aligned(16))) unsigned char lds_raw[];
    Frame F0; F0.lds = (LAS unsigned char*)lds_raw; F0.tid = threadIdx.x; F0.lane = F0.tid & 63; F0.wave = __builtin_amdgcn_readfirstlane(F0.tid >> 6); F0.G = gridDim.x; F0.bid = blockIdx.x;
    for (int u = F0.tid; u < (LDS_BYTES - LDSCTL_OFF) / 4; u += NTHR) ((LAS unsigned*)(F0.lds + LDSCTL_OFF))[u] = 0u;
    __syncthreads();
    XcdBarrier bar = xcd_barrier_post((unsigned*)(Parg.ws + WS_CTL) + CW_BAR, (volatile LAS unsigned*)(F0.lds + LDSCTL_OFF + 64));
    const int lo = Parg.lo, hi = Parg.hi; int ph = 0;
#define RUNP() (lo <= ph && ph < hi)
#define PHASE_BEGIN for (int rep_ = 0; RUNP() && rep_ < (((DUP_MASK >> ph) & 1ull) ? 2 : 1); ++rep_)
#define SEAM() do { if (lo <= ph && ph + 1 < hi) { XcdBarrier bl_ = bar; asm volatile("" : "+s"(bl_.x)); xcd_barrier(bl_); if (DUP_SUB == 6) xcd_barrier(bl_); } ++ph; } while (0)
#define LOCALS() Frame F = F0; { int t_ = F0.tid; asm volatile("" : "+v"(t_)); F.tid = t_; F.lane = t_ & 63; F.wave = __builtin_amdgcn_readfirstlane(t_ >> 6); int b_ = F0.bid, g_ = F0.G; asm volatile("" : "+s"(b_), "+s"(g_)); F.bid = b_; F.G = g_; } \
    ParamsK pk_ = (ParamsK)__builtin_amdgcn_kernarg_segment_ptr(); asm volatile("" : "+s"(pk_)); Params P; _Pragma("unroll") for (int i_ = 0; i_ < 33; ++i_) P.in[i_] = pk_->in[i_]; P.out = pk_->out; P.ws = pk_->ws; P.lo = 0; P.hi = 0; P.pad0 = 0; P.pad1 = 0; unsigned char* const ws = P.ws; (void)ws
#define W_MOD ((float*)(ws + WS_MOD))
#define W_XC ((float*)(ws + WS_XC))
#define W_XB ((bf16*)(ws + WS_XB))
#define W_HM ((bf16*)(ws + WS_HM))
#define W_YAB ((bf16*)(ws + WS_YAB))
#define W_Y ((bf16*)(ws + WS_Y))
#define W_PART ((bf16*)(ws + WS_PART))
#define W_A5 ((bf16*)(ws + WS_A5))
#define W_U ((bf16*)(ws + WS_U))
#define W_ZBT ((bf16*)(ws + WS_U + 50 * MiB))
#define W_F32U ((float*)(ws + WS_U))

    PHASE_BEGIN { LOCALS(); p0_prologue(F, P); }
    SEAM();
    PHASE_BEGIN { LOCALS(); p1_phase(F, P); }
    SEAM();
    PHASE_BEGIN { LOCALS(); row_phase<0, false, false>(F, nullptr, nullptr, 0, MROWS, P.in[0], P.in[2], nullptr, nullptr, nullptr, nullptr, 0, true, P.in[6], W_MOD, 0, 1, W_HM, nullptr); }
    SEAM();
    { constexpr int layer = 0;
        constexpr int jj = layer >> 1; constexpr bool LASTL = (layer == DEPTH - 1); constexpr int NROWS_L = LASTL ? NLAT : MROWS;
        if ((layer & 1) == 0) {
            PHASE_BEGIN { LOCALS();
                pg8::OrderE1 S{F.G, F.bid, (const char*)W_HM, (const char*)(ws + WS_WIN + jj * SZ_WIN)};
                typedef pg8::EpiQKVZ<(DUP_SUB == 5 && layer == 0) ? 3 : 1> EpiE1; EpiE1 E{W_U, W_ZBT, (const float*)(ws + WS_TAB)};
                pg8::gemm_phase<EpiE1, pg8::OrderE1, true>(F.lds, F.tid, pg8::Gemm{DM, DM}, S, E);
            }
            SEAM();
            PHASE_BEGIN { LOCALS();
                { u32x4 twf[2], twb[2]; int c = F.bid;
                    if (c < 1024) hyena_taps(F, P, jj, c, twf, twb);
#pragma unroll 1
                    for (; c < 1024; c += F.G) hyena_unit(F, P, jj, c, (c + F.G < 1024) ? c + F.G : -1, twf, twb); }
                for (int rr_ = 0; rr_ < ((DUP_SUB == 2 && layer == 0) ? 2 : 1); ++rr_) for (int au = F.bid; au < 528; au += F.G) attn_unit(F, P, jj, au);
            }
            SEAM();
            PHASE_BEGIN { LOCALS(); ybt_transpose_phase(F, P); }
            SEAM();
            PHASE_BEGIN { LOCALS();
                pg8::OrderSplit S; S.init(W_YAB, ws + WS_WOUT + jj * SZ_WOUT, DM, DM, DM, DM, 1, F.G, F.bid);
                pg8::EpiYb E{W_Y, DM, nullptr, W_PART};
                pg8::gemm_phase<pg8::EpiYb, pg8::OrderSplit, true>(F.lds, F.tid, pg8::Gemm{DM, DM}, S, E);
            }
            SEAM();
        } else {
            PHASE_BEGIN { LOCALS();
                pg8::OrderS5 S{F.G, F.bid, 256 / 64, (const char*)W_A5, (const char*)(ws + WS_WW + (size_t)jj * S5G * 256 * 256 * 2), (size_t)256 * 256 * 2, 1};
                pg8::EpiBf16g E{W_U, S5ROWS};
                pg8::gemm_phase<pg8::EpiBf16g, pg8::OrderS5, true>(F.lds, F.tid, pg8::Gemm{256, S5K}, S, E);
            }
            SEAM();
            PHASE_BEGIN { LOCALS(); s5_carry_phase(F, P, jj); }
            SEAM();
            PHASE_BEGIN { LOCALS();
                pg8::OrderS5 S{F.G, F.bid, S5K / 64, (const char*)W_A5, (const char*)(ws + WS_TT + (size_t)jj * S5G * 256 * 512 * 2), (size_t)256 * 512 * 2, 0};
                pg8::EpiS5G E{W_Y};
                pg8::gemm_phase<pg8::EpiS5G, pg8::OrderS5, true>(F.lds, F.tid, pg8::Gemm{S5K, S5K}, S, E);
            }
            SEAM();
            PHASE_BEGIN { LOCALS();
                pg8::OrderSplit S; S.init(W_Y, ws + WS_WGLU + jj * SZ_WGLU, 2 * DM, DM, DM, DM, LASTL ? 0 : 1, F.G, F.bid, 1, WGM_O4);
                pg8::EpiGlu E{W_U, P.in[32] + (size_t)jj * 2 * DM, W_PART};
                pg8::gemm_phase<pg8::EpiGlu, pg8::OrderSplit, true, 1>(F.lds, F.tid, pg8::Gemm{DM, DM}, S, E);
            }
            SEAM();
        }
        PHASE_BEGIN { LOCALS();
            const float* modl = W_MOD + (size_t)layer * 3 * NMOD * DM; const float* ngl = P.in[6] + (size_t)layer * 4 * DM;
            if (layer == 0) { if ((layer & 1) == 0) row_phase<1, false, true>(F, W_Y, W_PART, 8, NROWS_L, P.in[0], P.in[2], W_XB, nullptr, ngl + 1 * DM, modl, 2, true, ngl + 2 * DM, modl, 3, 4, W_HM, nullptr); }
            else if ((layer & 1) == 0) row_phase<1, true, true>(F, W_Y, W_PART, 8, NROWS_L, W_XB, nullptr, W_XB, nullptr, ngl + 1 * DM, modl, 2, true, ngl + 2 * DM, modl, 3, 4, W_HM, nullptr);
            else row_phase<3, true, true>(F, W_U, W_PART, 8, NROWS_L, W_XB, nullptr, W_XB, nullptr, ngl + 1 * DM, modl, 2, true, ngl + 2 * DM, modl, 3, 4, W_HM, nullptr);
        }
        SEAM();
        PHASE_BEGIN { LOCALS();
            if (STAGGER_US > 0) { const unsigned long long t0_ = __builtin_amdgcn_s_memrealtime(); const unsigned long long dl_ = (unsigned long long)(((F.bid >> 3) & 3) * STAGGER_US * 100); while (__builtin_amdgcn_s_memrealtime() - t0_ < dl_) __builtin_amdgcn_s_sleep(4); }
            pg8::OrderUp S{F.G, F.bid, LASTL ? 66 : 70, (const char*)W_HM, (const char*)(ws + WS_WUP + layer * SZ_WUP), WGM_C2};
            typedef pg8::EpiUpGlu<(DUP_SUB == 3 && layer == 0) ? 2 : 1> EpiUp; EpiUp E{W_A5, P.in[8] + (size_t)layer * 3 * DFF2, P.in[9] + (size_t)layer * DFF2, (LAS float*)(F.lds + AUX_OFF)};
            pg8::gemm_phase<EpiUp, pg8::OrderUp, true>(F.lds, F.tid, pg8::Gemm{DM, DM}, S, E);
        }
        SEAM();
        PHASE_BEGIN { LOCALS();
            pg8::OrderSplit S; S.init(W_A5, ws + WS_WDOWN + layer * SZ_WDOWN, DM, DFF, DFF, DFF, LASTL ? 0 : 1, F.G, F.bid, 0, WGM_C4, REV_C4);
            pg8::EpiYb E{W_Y, DM, nullptr, W_PART};
            pg8::gemm_phase<pg8::EpiYb, pg8::OrderSplit, true>(F.lds, F.tid, pg8::Gemm{DFF, DFF}, S, E);
        }
        SEAM();
        PHASE_BEGIN { LOCALS();
            const float* modl = W_MOD + (size_t)layer * 3 * NMOD * DM; const float* ngl = P.in[6] + (size_t)layer * 4 * DM;
            if (LASTL) row_phase<1, true, false>(F, W_Y, W_PART, 15, NROWS_L, W_XB, nullptr, P.out, nullptr, ngl + 3 * DM, modl, 5, false, nullptr, nullptr, 0, 1, nullptr, nullptr);
            else row_phase<1, true, true>(F, W_Y, W_PART, 15, NROWS_L, W_XB, nullptr, W_XB, nullptr, ngl + 3 * DM, modl, 5, true, ngl + 4 * DM, modl + 3 * NMOD * DM, 0, 1, ((layer & 1) == 0) ? nullptr : W_HM, ((layer & 1) == 0) ? W_A5 : nullptr);
        }
        SEAM();
    }
    { constexpr int layer = 1;
        constexpr int jj = layer >> 1; constexpr bool LASTL = (layer == DEPTH - 1); constexpr int NROWS_L = LASTL ? NLAT : MROWS;
        if ((layer & 1) == 0) {
            PHASE_BEGIN { LOCALS();
                pg8::OrderE1 S{F.G, F.bid, (const char*)W_HM, (const char*)(ws + WS_WIN + jj * SZ_WIN)};
                typedef pg8::EpiQKVZ<(DUP_SUB == 5 && layer == 0) ? 3 : 1> EpiE1; EpiE1 E{W_U, W_ZBT, (const float*)(ws + WS_TAB)};
                pg8::gemm_phase<EpiE1, pg8::OrderE1, true>(F.lds, F.tid, pg8::Gemm{DM, DM}, S, E);
            }
            SEAM();
            PHASE_BEGIN { LOCALS();
                { u32x4 twf[2], twb[2]; int c = F.bid;
                    if (c < 1024) hyena_taps(F, P, jj, c, twf, twb);
#pragma unroll 1
                    for (; c < 1024; c += F.G) hyena_unit(F, P, jj, c, (c + F.G < 1024) ? c + F.G : -1, twf, twb); }
                for (int rr_ = 0; rr_ < ((DUP_SUB == 2 && layer == 0) ? 2 : 1); ++rr_) for (int au = F.bid; au < 528; au += F.G) attn_unit(F, P, jj, au);
            }
            SEAM();
            PHASE_BEGIN { LOCALS(); ybt_transpose_phase(F, P); }
            SEAM();
            PHASE_BEGIN { LOCALS();
                pg8::OrderSplit S; S.init(W_YAB, ws + WS_WOUT + jj * SZ_WOUT, DM, DM, DM, DM, 1, F.G, F.bid);
                pg8::EpiYb E{W_Y, DM, nullptr, W_PART};
                pg8::gemm_phase<pg8::EpiYb, pg8::OrderSplit, true>(F.lds, F.tid, pg8::Gemm{DM, DM}, S, E);
            }
            SEAM();
        } else {
            PHASE_BEGIN { LOCALS();
                pg8::OrderS5 S{F.G, F.bid, 256 / 64, (const char*)W_A5, (const char*)(ws + WS_WW + (size_t)jj * S5G * 256 * 256 * 2), (size_t)256 * 256 * 2, 1};
                pg8::EpiBf16g E{W_U, S5ROWS};
                pg8::gemm_phase<pg8::EpiBf16g, pg8::OrderS5, true>(F.lds, F.tid, pg8::Gemm{256, S5K}, S, E);
            }
            SEAM();
            PHASE_BEGIN { LOCALS(); s5_carry_phase(F, P, jj); }
            SEAM();
            PHASE_BEGIN { LOCALS();
                pg8::OrderS5 S{F.G, F.bid, S5K / 64, (const char*)W_A5, (const char*)(ws + WS_TT + (size_t)jj * S5G * 256 * 512 * 2), (size_t)256 * 512 * 2, 0};
                pg8::EpiS5G E{W_Y};
                pg8::gemm_phase<pg8::EpiS5G, pg8::OrderS5, true>(F.lds, F.tid, pg8::Gemm{S5K, S5K}, S, E);
            }
            SEAM();
            PHASE_BEGIN { LOCALS();
                pg8::OrderSplit S; S.init(W_Y, ws + WS_WGLU + jj * SZ_WGLU, 2 * DM, DM, DM, DM, LASTL ? 0 : 1, F.G, F.bid, 1, WGM_O4);
                pg8::EpiGlu E{W_U, P.in[32] + (size_t)jj * 2 * DM, W_PART};
                pg8::gemm_phase<pg8::EpiGlu, pg8::OrderSplit, true, 1>(F.lds, F.tid, pg8::Gemm{DM, DM}, S, E);
            }
            SEAM();
        }
        PHASE_BEGIN { LOCALS();
            const float* modl = W_MOD + (size_t)layer * 3 * NMOD * DM; const float* ngl = P.in[6] + (size_t)layer * 4 * DM;
            if (layer == 0) { if ((layer & 1) == 0) row_phase<1, false, true>(F, W_Y, W_PART, 8, NROWS_L, P.in[0], P.in[2], W_XB, nullptr, ngl + 1 * DM, modl, 2, true, ngl + 2 * DM, modl, 3, 4, W_HM, nullptr); }
            else if ((layer & 1) == 0) row_phase<1, true, true>(F, W_Y, W_PART, 8, NROWS_L, W_XB, nullptr, W_XB, nullptr, ngl + 1 * DM, modl, 2, true, ngl + 2 * DM, modl, 3, 4, W_HM, nullptr);
            else row_phase<3, true, true>(F, W_U, W_PART, 8, NROWS_L, W_XB, nullptr, W_XB, nullptr, ngl + 1 * DM, modl, 2, true, ngl + 2 * DM, modl, 3, 4, W_HM, nullptr);
        }
        SEAM();
        PHASE_BEGIN { LOCALS();
            if (STAGGER_US > 0) { const unsigned long long t0_ = __builtin_amdgcn_s_memrealtime(); const unsigned long long dl_ = (unsigned long long)(((F.bid >> 3) & 3) * STAGGER_US * 100); while (__builtin_amdgcn_s_memrealtime() - t0_ < dl_) __builtin_amdgcn_s_sleep(4); }
            pg8::OrderUp S{F.G, F.bid, LASTL ? 66 : 70, (const char*)W_HM, (const char*)(ws + WS_WUP + layer * SZ_WUP), WGM_C2};
            typedef pg8::EpiUpGlu<(DUP_SUB == 3 && layer == 0) ? 2 : 1> EpiUp; EpiUp E{W_A5, P.in[8] + (size_t)layer * 3 * DFF2, P.in[9] + (size_t)layer * DFF2, (LAS float*)(F.lds + AUX_OFF)};
            pg8::gemm_phase<EpiUp, pg8::OrderUp, true>(F.lds, F.tid, pg8::Gemm{DM, DM}, S, E);
        }
        SEAM();
        PHASE_BEGIN { LOCALS();
            pg8::OrderSplit S; S.init(W_A5, ws + WS_WDOWN + layer * SZ_WDOWN, DM, DFF, DFF, DFF, LASTL ? 0 : 1, F.G, F.bid, 0, WGM_C4, REV_C4);
            pg8::EpiYb E{W_Y, DM, nullptr, W_PART};
            pg8::gemm_phase<pg8::EpiYb, pg8::OrderSplit, true>(F.lds, F.tid, pg8::Gemm{DFF, DFF}, S, E);
        }
        SEAM();
        PHASE_BEGIN { LOCALS();
            const float* modl = W_MOD + (size_t)layer * 3 * NMOD * DM; const float* ngl = P.in[6] + (size_t)layer * 4 * DM;
            if (LASTL) row_phase<1, true, false>(F, W_Y, W_PART, 15, NROWS_L, W_XB, nullptr, P.out, nullptr, ngl + 3 * DM, modl, 5, false, nullptr, nullptr, 0, 1, nullptr, nullptr);
            else row_phase<1, true, true>(F, W_Y, W_PART, 15, NROWS_L, W_XB, nullptr, W_XB, nullptr, ngl + 3 * DM, modl, 5, true, ngl + 4 * DM, modl + 3 * NMOD * DM, 0, 1, ((layer & 1) == 0) ? nullptr : W_HM, ((layer & 1) == 0) ? W_A5 : nullptr);
        }
        SEAM();
    }
    { constexpr int layer = 2;
        constexpr int jj = layer >> 1; constexpr bool LASTL = (layer == DEPTH - 1); constexpr int NROWS_L = LASTL ? NLAT : MROWS;
        if ((layer & 1) == 0) {
            PHASE_BEGIN { LOCALS();
                pg8::OrderE1 S{F.G, F.bid, (const char*)W_HM, (const char*)(ws + WS_WIN + jj * SZ_WIN)};
                typedef pg8::EpiQKVZ<(DUP_SUB == 5 && layer == 0) ? 3 : 1> EpiE1; EpiE1 E{W_U, W_ZBT, (const float*)(ws + WS_TAB)};
                pg8::gemm_phase<EpiE1, pg8::OrderE1, true>(F.lds, F.tid, pg8::Gemm{DM, DM}, S, E);
            }
            SEAM();
            PHASE_BEGIN { LOCALS();
                { u32x4 twf[2], twb[2]; int c = F.bid;
                    if (c < 1024) hyena_taps(F, P, jj, c, twf, twb);
#pragma unroll 1
                    for (; c < 1024; c += F.G) hyena_unit(F, P, jj, c, (c + F.G < 1024) ? c + F.G : -1, twf, twb); }
                for (int rr_ = 0; rr_ < ((DUP_SUB == 2 && layer == 0) ? 2 : 1); ++rr_) for (int au = F.bid; au < 528; au += F.G) attn_unit(F, P, jj, au);
            }
            SEAM();
            PHASE_BEGIN { LOCALS(); ybt_transpose_phase(F, P); }
            SEAM();
            PHASE_BEGIN { LOCALS();
                pg8::OrderSplit S; S.init(W_YAB, ws + WS_WOUT + jj * SZ_WOUT, DM, DM, DM, DM, 1, F.G, F.bid);
                pg8::EpiYb E{W_Y, DM, nullptr, W_PART};
                pg8::gemm_phase<pg8::EpiYb, pg8::OrderSplit, true>(F.lds, F.tid, pg8::Gemm{DM, DM}, S, E);
            }
            SEAM();
        } else {
            PHASE_BEGIN { LOCALS();
                pg8::OrderS5 S{F.G, F.bid, 256 / 64, (const char*)W_A5, (const char*)(ws + WS_WW + (size_t)jj * S5G * 256 * 256 * 2), (size_t)256 * 256 * 2, 1};
                pg8::EpiBf16g E{W_U, S5ROWS};
                pg8::gemm_phase<pg8::EpiBf16g, pg8::OrderS5, true>(F.lds, F.tid, pg8::Gemm{256, S5K}, S, E);
            }
            SEAM();
            PHASE_BEGIN { LOCALS(); s5_carry_phase(F, P, jj); }
            SEAM();
            PHASE_BEGIN { LOCALS();
                pg8::OrderS5 S{F.G, F.bid, S5K / 64, (const char*)W_A5, (const char*)(ws + WS_TT + (size_t)jj * S5G * 256 * 512 * 2), (size_t)256 * 512 * 2, 0};
                pg8::EpiS5G E{W_Y};
                pg8::gemm_phase<pg8::EpiS5G, pg8::OrderS5, true>(F.lds, F.tid, pg8::Gemm{S5K, S5K}, S, E);
            }
            SEAM();
            PHASE_BEGIN { LOCALS();
                pg8::OrderSplit S; S.init(W_Y, ws + WS_WGLU + jj * SZ_WGLU, 2 * DM, DM, DM, DM, LASTL ? 0 : 1, F.G, F.bid, 1, WGM_O4);
                pg8::EpiGlu E{W_U, P.in[32] + (size_t)jj * 2 * DM, W_PART};
                pg8::gemm_phase<pg8::EpiGlu, pg8::OrderSplit, true, 1>(F.lds, F.tid, pg8::Gemm{DM, DM}, S, E);
            }
            SEAM();
        }
        PHASE_BEGIN { LOCALS();
            const float* modl = W_MOD + (size_t)layer * 3 * NMOD * DM; const float* ngl = P.in[6] + (size_t)layer * 4 * DM;
            if (layer == 0) { if ((layer & 1) == 0) row_phase<1, false, true>(F, W_Y, W_PART, 8, NROWS_L, P.in[0], P.in[2], W_XB, nullptr, ngl + 1 * DM, modl, 2, true, ngl + 2 * DM, modl, 3, 4, W_HM, nullptr); }
            else if ((layer & 1) == 0) row_phase<1, true, true>(F, W_Y, W_PART, 8, NROWS_L, W_XB, nullptr, W_XB, nullptr, ngl + 1 * DM, modl, 2, true, ngl + 2 * DM, modl, 3, 4, W_HM, nullptr);
            else row_phase<3, true, true>(F, W_U, W_PART, 8, NROWS_L, W_XB, nullptr, W_XB, nullptr, ngl + 1 * DM, modl, 2, true, ngl + 2 * DM, modl, 3, 4, W_HM, nullptr);
        }
        SEAM();
        PHASE_BEGIN { LOCALS();
            if (STAGGER_US > 0) { const unsigned long long t0_ = __builtin_amdgcn_s_memrealtime(); const unsigned long long dl_ = (unsigned long long)(((F.bid >> 3) & 3) * STAGGER_US * 100); while (__builtin_amdgcn_s_memrealtime() - t0_ < dl_) __builtin_amdgcn_s_sleep(4); }
            pg8::OrderUp S{F.G, F.bid, LASTL ? 66 : 70, (const char*)W_HM, (const char*)(ws + WS_WUP + layer * SZ_WUP), WGM_C2};
            typedef pg8::EpiUpGlu<(DUP_SUB == 3 && layer == 0) ? 2 : 1> EpiUp; EpiUp E{W_A5, P.in[8] + (size_t)layer * 3 * DFF2, P.in[9] + (size_t)layer * DFF2, (LAS float*)(F.lds + AUX_OFF)};
            pg8::gemm_phase<EpiUp, pg8::OrderUp, true>(F.lds, F.tid, pg8::Gemm{DM, DM}, S, E);
        }
        SEAM();
        PHASE_BEGIN { LOCALS();
            pg8::OrderSplit S; S.init(W_A5, ws + WS_WDOWN + layer * SZ_WDOWN, DM, DFF, DFF, DFF, LASTL ? 0 : 1, F.G, F.bid, 0, WGM_C4, REV_C4);
            pg8::EpiYb E{W_Y, DM, nullptr, W_PART};
            pg8::gemm_phase<pg8::EpiYb, pg8::OrderSplit, true>(F.lds, F.tid, pg8::Gemm{DFF, DFF}, S, E);
        }
        SEAM();
        PHASE_BEGIN { LOCALS();
            const float* modl = W_MOD + (size_t)layer * 3 * NMOD * DM; const float* ngl = P.in[6] + (size_t)layer * 4 * DM;
            if (LASTL) row_phase<1, true, false>(F, W_Y, W_PART, 15, NROWS_L, W_XB, nullptr, P.out, nullptr, ngl + 3 * DM, modl, 5, false, nullptr, nullptr, 0, 1, nullptr, nullptr);
            else row_phase<1, true, true>(F, W_Y, W_PART, 15, NROWS_L, W_XB, nullptr, W_XB, nullptr, ngl + 3 * DM, modl, 5, true, ngl + 4 * DM, modl + 3 * NMOD * DM, 0, 1, ((layer & 1) == 0) ? nullptr : W_HM, ((layer & 1) == 0) ? W_A5 : nullptr);
        }
        SEAM();
    }
    { constexpr int layer = 3;
        constexpr int jj = layer >> 1; constexpr bool LASTL = (layer == DEPTH - 1); constexpr int NROWS_L = LASTL ? NLAT : MROWS;
        if ((layer & 1) == 0) {
            PHASE_BEGIN { LOCALS();
                pg8::OrderE1 S{F.G, F.bid, (const char*)W_HM, (const char*)(ws + WS_WIN + jj * SZ_WIN)};
                typedef pg8::EpiQKVZ<(DUP_SUB == 5 && layer == 0) ? 3 : 1> EpiE1; EpiE1 E{W_U, W_ZBT, (const float*)(ws + WS_TAB)};
                pg8::gemm_phase<EpiE1, pg8::OrderE1, true>(F.lds, F.tid, pg8::Gemm{DM, DM}, S, E);
            }
            SEAM();
            PHASE_BEGIN { LOCALS();
                { u32x4 twf[2], twb[2]; int c = F.bid;
                    if (c < 1024) hyena_taps(F, P, jj, c, twf, twb);
#pragma unroll 1
                    for (; c < 1024; c += F.G) hyena_unit(F, P, jj, c, (c + F.G < 1024) ? c + F.G : -1, twf, twb); }
                for (int rr_ = 0; rr_ < ((DUP_SUB == 2 && layer == 0) ? 2 : 1); ++rr_) for (int au = F.bid; au < 528; au += F.G) attn_unit(F, P, jj, au);
            }
            SEAM();
            PHASE_BEGIN { LOCALS(); ybt_transpose_phase(F, P); }
            SEAM();
            PHASE_BEGIN { LOCALS();
                pg8::OrderSplit S; S.init(W_YAB, ws + WS_WOUT + jj * SZ_WOUT, DM, DM, DM, DM, 1, F.G, F.bid);
                pg8::EpiYb E{W_Y, DM, nullptr, W_PART};
                pg8::gemm_phase<pg8::EpiYb, pg8::OrderSplit, true>(F.lds, F.tid, pg8::Gemm{DM, DM}, S, E);
            }
            SEAM();
        } else {
            PHASE_BEGIN { LOCALS();
                pg8::OrderS5 S{F.G, F.bid, 256 / 64, (const char*)W_A5, (const char*)(ws + WS_WW + (size_t)jj * S5G * 256 * 256 * 2), (size_t)256 * 256 * 2, 1};
                pg8::EpiBf16g E{W_U, S5ROWS};
                pg8::gemm_phase<pg8::EpiBf16g, pg8::OrderS5, true>(F.lds, F.tid, pg8::Gemm{256, S5K}, S, E);
            }
            SEAM();
            PHASE_BEGIN { LOCALS(); s5_carry_phase(F, P, jj); }
            SEAM();
            PHASE_BEGIN { LOCALS();
                pg8::OrderS5 S{F.G, F.bid, S5K / 64, (const char*)W_A5, (const char*)(ws + WS_TT + (size_t)jj * S5G * 256 * 512 * 2), (size_t)256 * 512 * 2, 0};
                pg8::EpiS5G E{W_Y};
                pg8::gemm_phase<pg8::EpiS5G, pg8::OrderS5, true>(F.lds, F.tid, pg8::Gemm{S5K, S5K}, S, E);
            }
            SEAM();
            PHASE_BEGIN { LOCALS();
                pg8::OrderSplit S; S.init(W_Y, ws + WS_WGLU + jj * SZ_WGLU, 2 * DM, DM, DM, DM, LASTL ? 0 : 1, F.G, F.bid, 1, WGM_O4);
                pg8::EpiGlu E{W_U, P.in[32] + (size_t)jj * 2 * DM, W_PART};
                pg8::gemm_phase<pg8::EpiGlu, pg8::OrderSplit, true, 1>(F.lds, F.tid, pg8::Gemm{DM, DM}, S, E);
            }
            SEAM();
        }
        PHASE_BEGIN { LOCALS();
            const float* modl = W_MOD + (size_t)layer * 3 * NMOD * DM; const float* ngl = P.in[6] + (size_t)layer * 4 * DM;
            if (layer == 0) { if ((layer & 1) == 0) row_phase<1, false, true>(F, W_Y, W_PART, 8, NROWS_L, P.in[0], P.in[2], W_XB, nullptr, ngl + 1 * DM, modl, 2, true, ngl + 2 * DM, modl, 3, 4, W_HM, nullptr); }
            else if ((layer & 1) == 0) row_phase<1, true, true>(F, W_Y, W_PART, 8, NROWS_L, W_XB, nullptr, W_XB, nullptr, ngl + 1 * DM, modl, 2, true, ngl + 2 * DM, modl, 3, 4, W_HM, nullptr);
            else row_phase<3, true, true>(F, W_U, W_PART, 8, NROWS_L, W_XB, nullptr, W_XB, nullptr, ngl + 1 * DM, modl, 2, true, ngl + 2 * DM, modl, 3, 4, W_HM, nullptr);
        }
        SEAM();
        PHASE_BEGIN { LOCALS();
            if (STAGGER_US > 0) { const unsigned long long t0_ = __builtin_amdgcn_s_memrealtime(); const unsigned long long dl_ = (unsigned long long)(((F.bid >> 3) & 3) * STAGGER_US * 100); while (__builtin_amdgcn_s_memrealtime() - t0_ < dl_) __builtin_amdgcn_s_sleep(4); }
            pg8::OrderUp S{F.G, F.bid, LASTL ? 66 : 70, (const char*)W_HM, (const char*)(ws + WS_WUP + layer * SZ_WUP), WGM_C2};
            typedef pg8::EpiUpGlu<(DUP_SUB == 3 && layer == 0) ? 2 : 1> EpiUp; EpiUp E{W_A5, P.in[8] + (size_t)layer * 3 * DFF2, P.in[9] + (size_t)layer * DFF2, (LAS float*)(F.lds + AUX_OFF)};
            pg8::gemm_phase<EpiUp, pg8::OrderUp, true>(F.lds, F.tid, pg8::Gemm{DM, DM}, S, E);
        }
        SEAM();
        PHASE_BEGIN { LOCALS();
            pg8::OrderSplit S; S.init(W_A5, ws + WS_WDOWN + layer * SZ_WDOWN, DM, DFF, DFF, DFF, LASTL ? 0 : 1, F.G, F.bid, 0, WGM_C4, REV_C4);
            pg8::EpiYb E{W_Y, DM, nullptr, W_PART};
            pg8::gemm_phase<pg8::EpiYb, pg8::OrderSplit, true>(F.lds, F.tid, pg8::Gemm{DFF, DFF}, S, E);
        }
        SEAM();
        PHASE_BEGIN { LOCALS();
            const float* modl = W_MOD + (size_t)layer * 3 * NMOD * DM; const float* ngl = P.in[6] + (size_t)layer * 4 * DM;
            if (LASTL) row_phase<1, true, false>(F, W_Y, W_PART, 15, NROWS_L, W_XB, nullptr, P.out, nullptr, ngl + 3 * DM, modl, 5, false, nullptr, nullptr, 0, 1, nullptr, nullptr);
            else row_phase<1, true, true>(F, W_Y, W_PART, 15, NROWS_L, W_XB, nullptr, W_XB, nullptr, ngl + 3 * DM, modl, 5, true, ngl + 4 * DM, modl + 3 * NMOD * DM, 0, 1, ((layer & 1) == 0) ? nullptr : W_HM, ((layer & 1) == 0) ? W_A5 : nullptr);
        }
        SEAM();
    }
#undef RUNP
#undef SEAM
}

extern "C" void kernel_launch(void* const* d_in, const int* in_sizes, int n_in, void* d_out, int out_size, void* d_ws, size_t ws_size, hipStream_t stream) {
    static int grid = 0;
    if (grid == 0) {
        if (n_in != 33 || out_size != NLAT * DM || ws_size < WS_END) { fprintf(stderr, "kernel_launch: unexpected problem (n_in %d, out %d, ws %zu < %zu)\n", n_in, out_size, ws_size, (size_t)WS_END); grid = -1; return; }
        int dev = 0, cus = 0, per_cu = 0;
        if (hipGetDevice(&dev) != hipSuccess || hipDeviceGetAttribute(&cus, hipDeviceAttributeMultiprocessorCount, dev) != hipSuccess) { grid = -1; return; }
        if (hipFuncSetAttribute((const void*)hybrid_fwd, hipFuncAttributeMaxDynamicSharedMemorySize, LDS_BYTES) != hipSuccess) { fprintf(stderr, "kernel_launch: hipFuncSetAttribute failed\n"); grid = -1; return; }
        if (hipOccupancyMaxActiveBlocksPerMultiprocessor(&per_cu, (const void*)hybrid_fwd, NTHR, LDS_BYTES) != hipSuccess || per_cu < 1) fprintf(stderr, "kernel_launch: occupancy query reports %d blocks per CU\n", per_cu);
        (void)hipGetLastError();
        grid = cus;
    }
    if (grid < 0) return;
    if (hipMemsetAsync((char*)d_ws + WS_CTL, 0, CTL_BYTES, stream) != hipSuccess) return;
    Params p{};
    for (int i = 0; i < 33; ++i) p.in[i] = (const float*)d_in[i];
    p.out = (float*)d_out; p.ws = (unsigned char*)d_ws; p.pad0 = 0; p.pad1 = 0;
#ifdef MK_PER_PHASE
    for (int ph = 0; ph < N_PHASES; ++ph) { p.lo = ph; p.hi = ph + 1; hipLaunchKernelGGL(hybrid_fwd, dim3(grid), dim3(NTHR), LDS_BYTES, stream, p); }
#else
    p.lo = 0; p.hi = N_PHASES;
    hipLaunchKernelGGL(hybrid_fwd, dim3(grid), dim3(NTHR), LDS_BYTES, stream, p);
#endif
    const hipError_t le = hipPeekAtLastError();
    if (le != hipSuccess) fprintf(stderr, "kernel_launch: launch failed: %s\n", hipGetErrorName(le));
}
```
